# Optimizing an MI355X kernel written in HIP

```python
import jax, jax.numpy as jnp
from jax import lax
import numpy as np

D_MODEL = 2048
BATCH = 2
SEQ = 4096
DEPTH = 1

GRID_W = 64
CTX_LEN = 256
NORM_EPS = 1e-6

NA_HEADS = 8
NA_HEAD_DIM = 128
NA_WIN_H = 8
NA_WIN_W = 16

GLA_HEADS = 4
GLA_DK = 128
GLA_DV = 256
GLA_GATE_RANK = 16
GLA_GATE_TAU = 16.0
GLA_CHUNK = 64
ROPE_BASE = 10000.0

N_EXPERTS = 64
N_GROUPS = 8
TOPK_GROUPS = 4
TOP_K = 6
D_EXPERT = 512
ROUTED_SCALE = 2.5
MOE_BLOCK = 128

NA_WIDTH = NA_HEADS * NA_HEAD_DIM
GLA_KEY_WIDTH = GLA_HEADS * GLA_DK
GLA_VAL_WIDTH = GLA_HEADS * GLA_DV
MIX_WIDTH = NA_WIDTH + GLA_VAL_WIDTH
SPLIT_SIZES = (NA_WIDTH, NA_WIDTH, NA_WIDTH, GLA_KEY_WIDTH, GLA_KEY_WIDTH,
               GLA_VAL_WIDTH, GLA_VAL_WIDTH, GLA_GATE_RANK, GLA_GATE_RANK)
IN_COLS = sum(SPLIT_SIZES)

kernel_name = 'hybrid_na_gla_moe_dit_layer'


def rms_norm(x, g):
    xf = x.astype(jnp.float32)
    y = xf * lax.rsqrt(jnp.mean(xf * xf, axis=-1, keepdims=True) + NORM_EPS)
    return (y * g.astype(jnp.float32)).astype(x.dtype)


def adaln_params(cond, w_mod, b_mod):
    return jax.nn.silu(cond) @ w_mod + b_mod


def modulate(h, shift, scale):
    return h * (1.0 + scale) + shift


def split_columns(p):
    points, acc = [], 0
    for s in SPLIT_SIZES[:-1]:
        acc += s
        points.append(acc)
    return jnp.split(p, points, axis=-1)


def to_heads(t, n_heads, d_head):
    return t.reshape(t.shape[0], t.shape[1], n_heads, d_head).transpose(0, 2, 1, 3)


def from_heads(t):
    b, n, l, d = t.shape
    return t.transpose(0, 2, 1, 3).reshape(b, l, n * d)


def rope_1d(x, pos):
    half = x.shape[-1] // 2
    inv_freq = ROPE_BASE ** (-jnp.arange(half, dtype=jnp.float32) / half)
    ang = pos.astype(jnp.float32)[:, None] * inv_freq[None, :]
    cos = jnp.cos(ang)[None, :, None, :]
    sin = jnp.sin(ang)[None, :, None, :]
    x1, x2 = x[..., :half], x[..., half:]
    return jnp.concatenate([x1 * cos - x2 * sin, x2 * cos + x1 * sin], axis=-1)


def axial_rope(x, row_pos, col_pos):
    xf = x.astype(jnp.float32)
    half = x.shape[-1] // 2
    return jnp.concatenate([rope_1d(xf[..., :half], row_pos),
                            rope_1d(xf[..., half:], col_pos)], axis=-1).astype(x.dtype)


def neighbourhood_attention(q, k, v, k_ctx, v_ctx, rpb):
    b, h, l, dh = q.shape
    rows = l // GRID_W
    kh = min(NA_WIN_H, rows)
    kw = NA_WIN_W
    scale = dh ** -0.5
    qg = q.reshape(b, h, rows, GRID_W, dh).transpose(2, 0, 1, 3, 4)
    kg = k.reshape(b, h, rows, GRID_W, dh)
    vg = v.reshape(b, h, rows, GRID_W, dh)
    col = jnp.arange(GRID_W)
    col_start = jnp.clip(col - kw // 2, 0, GRID_W - kw)
    col_idx = col_start[:, None] + jnp.arange(kw)[None, :]
    dc = col_idx - col[:, None] + (kw - 1)
    rpb_cols = rpb[:, :, dc]

    def row_block(args):
        r, q_r = args
        rs = jnp.clip(r - kh // 2, 0, rows - kh)
        k_rows = lax.dynamic_slice_in_dim(kg, rs, kh, axis=2)
        v_rows = lax.dynamic_slice_in_dim(vg, rs, kh, axis=2)
        k_win = k_rows[:, :, :, col_idx, :]
        v_win = v_rows[:, :, :, col_idx, :]
        dr = rs + jnp.arange(kh) - r + (NA_WIN_H - 1)
        bias = jnp.take(rpb_cols, dr, axis=1).transpose(0, 2, 1, 3)
        s_loc = jnp.einsum('bhqd,bhiqjd->bhqij', q_r, k_win).astype(jnp.float32) * scale
        s_loc = s_loc + bias.astype(jnp.float32)[None]
        s_ctx = jnp.einsum('bhqd,bhcd->bhqc', q_r, k_ctx).astype(jnp.float32) * scale
        logits = jnp.concatenate([s_loc.reshape(b, h, GRID_W, kh * kw), s_ctx], axis=-1)
        p = jax.nn.softmax(logits, axis=-1).astype(v.dtype)
        p_loc = p[..., :kh * kw].reshape(b, h, GRID_W, kh, kw)
        p_ctx = p[..., kh * kw:]
        return (jnp.einsum('bhqij,bhiqjd->bhqd', p_loc, v_win)
                + jnp.einsum('bhqc,bhcd->bhqd', p_ctx, v_ctx))

    o = lax.map(row_block, (jnp.arange(rows), qg))
    return o.transpose(1, 2, 0, 3, 4).reshape(b, h, l, dh)


def context_attention(q, k, v):
    s = jnp.einsum('bhqd,bhcd->bhqc', q, k).astype(jnp.float32) * (q.shape[-1] ** -0.5)
    p = jax.nn.softmax(s, axis=-1).astype(v.dtype)
    return jnp.einsum('bhqc,bhcd->bhqd', p, v)


def gla_chunk_scan(k, v, g, s0, q=None):
    b, h, l, dk = k.shape
    dv = v.shape[-1]
    n = l // GLA_CHUNK
    mask = jnp.tril(jnp.ones((GLA_CHUNK, GLA_CHUNK), dtype=bool))

    def to_chunks(t):
        return t.reshape(b, h, n, GLA_CHUNK, t.shape[-1]).transpose(2, 0, 1, 3, 4)

    def step(state, xs):
        if q is None:
            kc, vc, gc = xs
            qc = None
        else:
            qc, kc, vc, gc = xs
        cum = jnp.cumsum(gc, axis=2)
        cum_last = cum[:, :, -1:, :]
        new_state = (jnp.exp(cum_last[:, :, 0, :, None]) * state
                     + jnp.einsum('bhsd,bhsv->bhdv', kc * jnp.exp(cum_last - cum), vc))
        if qc is None:
            return new_state, None
        diff = cum[:, :, :, None, :] - cum[:, :, None, :, :]
        decay = jnp.exp(jnp.where(mask[:, :, None], diff, -jnp.inf))
        att = jnp.einsum('bhtd,bhsd,bhtsd->bhts', qc, kc, decay)
        out = (jnp.einsum('bhts,bhsv->bhtv', att, vc)
               + jnp.einsum('bhtd,bhdv->bhtv', qc * jnp.exp(cum), state))
        return new_state, out

    seqs = (k, v, g) if q is None else (q, k, v, g)
    state, out = lax.scan(step, s0, tuple(to_chunks(t) for t in seqs))
    if q is None:
        return None, state
    return out.transpose(1, 2, 0, 3, 4).reshape(b, h, l, dv), state


def gla_bidirectional(q_l, k_l, v_l, gf_l, gb_l, q_c, k_c, v_c, gf_c, gb_c):
    b, h, _, dk = k_l.shape
    dv = v_l.shape[-1]
    s0 = jnp.zeros((b, h, dk, dv), jnp.float32)

    def rev(t):
        return None if t is None else jnp.flip(t, axis=2)

    o_cf, s_cf = gla_chunk_scan(k_c, v_c, gf_c, s0, q_c)
    o_lf, _ = gla_chunk_scan(k_l, v_l, gf_l, s_cf, q_l)
    o_cb, s_cb = gla_chunk_scan(rev(k_c), rev(v_c), rev(gb_c), s0, rev(q_c))
    o_lb, _ = gla_chunk_scan(rev(k_l), rev(v_l), rev(gb_l), s_cb, rev(q_l))
    o_l = o_lf + rev(o_lb)
    o_c = None if q_c is None else o_cf + rev(o_cb)
    return o_l, o_c


def token_mixers(h_lat, h_ctx, w_in, q_norm_g, k_norm_g, na_rpb, gla_gate_up_f, gla_gate_bias_f,
                 gla_gate_up_b, gla_gate_bias_b, gla_norm_g, w_out, need_ctx):
    b, l, _ = h_lat.shape
    p_l = split_columns(h_lat @ w_in)
    p_c = split_columns(h_ctx @ w_in)

    def na_qkv(p):
        bb, ll = p[0].shape[:2]
        q = rms_norm(p[0].reshape(bb, ll, NA_HEADS, NA_HEAD_DIM), q_norm_g)
        k = rms_norm(p[1].reshape(bb, ll, NA_HEADS, NA_HEAD_DIM), k_norm_g)
        v = p[2].reshape(bb, ll, NA_HEADS, NA_HEAD_DIM)
        return q.transpose(0, 2, 1, 3), k.transpose(0, 2, 1, 3), v.transpose(0, 2, 1, 3)

    nq_l, nk_l, nv_l = na_qkv(p_l)
    nq_c, nk_c, nv_c = na_qkv(p_c)
    o_na_l = from_heads(neighbourhood_attention(nq_l, nk_l, nv_l, nk_c, nv_c, na_rpb))

    t = jnp.arange(l)
    row_pos = t // GRID_W
    col_pos = t % GRID_W
    q_scale = GLA_DK ** -0.5

    def gla_qk(p, positioned):
        bb, ll = p[3].shape[:2]
        q = p[3].reshape(bb, ll, GLA_HEADS, GLA_DK)
        k = p[4].reshape(bb, ll, GLA_HEADS, GLA_DK)
        if positioned:
            q = axial_rope(q, row_pos, col_pos)
            k = axial_rope(k, row_pos, col_pos)
        q = (q.astype(jnp.float32) * q_scale).transpose(0, 2, 1, 3)
        k = k.astype(jnp.float32).transpose(0, 2, 1, 3)
        return q, k

    def log_decay(down, up, bias):
        z = (down @ up + bias).astype(jnp.float32)
        return to_heads(jax.nn.log_sigmoid(z) / GLA_GATE_TAU, GLA_HEADS, GLA_DK)

    def gla_values(p):
        return to_heads(p[5].astype(jnp.float32), GLA_HEADS, GLA_DV)

    def gla_out(o, r):
        o = rms_norm(o.transpose(0, 2, 1, 3), gla_norm_g)
        return o.reshape(o.shape[0], o.shape[1], GLA_VAL_WIDTH).astype(r.dtype) * jax.nn.silu(r)

    gq_l, gk_l = gla_qk(p_l, True)
    gq_c, gk_c = gla_qk(p_c, False)
    o_gla_l, o_gla_c = gla_bidirectional(
        gq_l, gk_l, gla_values(p_l),
        log_decay(p_l[7], gla_gate_up_f, gla_gate_bias_f), log_decay(p_l[8], gla_gate_up_b, gla_gate_bias_b),
        gq_c if need_ctx else None, gk_c, gla_values(p_c),
        log_decay(p_c[7], gla_gate_up_f, gla_gate_bias_f), log_decay(p_c[8], gla_gate_up_b, gla_gate_bias_b))

    out_l = jnp.concatenate([o_na_l, gla_out(o_gla_l, p_l[6])], axis=-1) @ w_out
    if not need_ctx:
        return out_l, None
    o_na_c = from_heads(context_attention(nq_c, nk_c, nv_c))
    out_c = jnp.concatenate([o_na_c, gla_out(o_gla_c, p_c[6])], axis=-1) @ w_out
    return out_l, out_c


def moe_ffn(h, router_w, router_bias, w1, w3, w2, ws1, ws3, ws2):
    shape = h.shape
    tok = h.reshape(-1, shape[-1])
    n_tok = tok.shape[0]
    scores = jax.nn.sigmoid((tok @ router_w).astype(jnp.float32))
    biased = scores + router_bias.astype(jnp.float32)
    per_group = N_EXPERTS // N_GROUPS
    group_score = lax.top_k(biased.reshape(n_tok, N_GROUPS, per_group), 2)[0].sum(axis=-1)
    _, gidx = lax.top_k(group_score, TOPK_GROUPS)
    gmask = jnp.sum(jax.nn.one_hot(gidx, N_GROUPS, dtype=jnp.float32), axis=1) > 0
    emask = jnp.repeat(gmask, per_group, axis=1)
    _, eidx = lax.top_k(jnp.where(emask, biased, -jnp.inf), TOP_K)
    sel = jnp.take_along_axis(scores, eidx, axis=1)
    wts = sel / jnp.sum(sel, axis=-1, keepdims=True) * ROUTED_SCALE
    combine = jnp.einsum('tke,tk->te', jax.nn.one_hot(eidx, N_EXPERTS, dtype=jnp.float32), wts).astype(h.dtype)

    def expert_block(args):
        tb, cb = args
        act = jax.nn.silu(jnp.einsum('td,edf->tef', tb, w1)) * jnp.einsum('td,edf->tef', tb, w3)
        return jnp.einsum('tef,efd->td', act * cb[:, :, None], w2)

    n_blk = n_tok // MOE_BLOCK
    routed = lax.map(expert_block, (tok.reshape(n_blk, MOE_BLOCK, shape[-1]),
                                    combine.reshape(n_blk, MOE_BLOCK, N_EXPERTS))).reshape(n_tok, shape[-1])
    shared = (jax.nn.silu(tok @ ws1) * (tok @ ws3)) @ ws2
    return (routed + shared).reshape(shape)


def setup_inputs(seed: int = 0) -> dict:
    key = jax.random.key(seed)
    ks = jax.random.split(key, 26)

    def nrm(k, shape, scale):
        return jax.random.normal(k, shape, jnp.float32) * scale

    return {
        'x': nrm(ks[0], (BATCH, SEQ, D_MODEL), 1.0),
        'c': nrm(ks[1], (BATCH, D_MODEL), 1.0),
        'ctx': nrm(ks[2], (BATCH, CTX_LEN, D_MODEL), 1.0),
        'c_ctx': nrm(ks[3], (D_MODEL,), 1.0),
        'w_mod': nrm(ks[4], (DEPTH, D_MODEL, 6 * D_MODEL), 0.5 * D_MODEL ** -0.5),
        'b_mod': nrm(ks[5], (DEPTH, 6 * D_MODEL), 0.02),
        'norm1_g': 1.0 + nrm(ks[6], (DEPTH, D_MODEL), 0.02),
        'norm2_g': 1.0 + nrm(ks[7], (DEPTH, D_MODEL), 0.02),
        'w_in': nrm(ks[8], (DEPTH, D_MODEL, IN_COLS), D_MODEL ** -0.5),
        'q_norm_g': 1.0 + nrm(ks[9], (DEPTH, NA_HEAD_DIM), 0.02),
        'k_norm_g': 1.0 + nrm(ks[10], (DEPTH, NA_HEAD_DIM), 0.02),
        'na_rpb': nrm(ks[11], (DEPTH, NA_HEADS, 2 * NA_WIN_H - 1, 2 * NA_WIN_W - 1), 0.1),
        'gla_gate_up_f': nrm(ks[12], (DEPTH, GLA_GATE_RANK, GLA_KEY_WIDTH), GLA_GATE_RANK ** -0.5),
        'gla_gate_bias_f': nrm(ks[13], (DEPTH, GLA_KEY_WIDTH), 0.1),
        'gla_gate_up_b': nrm(ks[14], (DEPTH, GLA_GATE_RANK, GLA_KEY_WIDTH), GLA_GATE_RANK ** -0.5),
        'gla_gate_bias_b': nrm(ks[15], (DEPTH, GLA_KEY_WIDTH), 0.1),
        'gla_norm_g': 1.0 + nrm(ks[16], (DEPTH, GLA_DV), 0.02),
        'w_out': nrm(ks[17], (DEPTH, MIX_WIDTH, D_MODEL), MIX_WIDTH ** -0.5),
        'router_w': nrm(ks[18], (DEPTH, D_MODEL, N_EXPERTS), D_MODEL ** -0.5),
        'router_bias': nrm(ks[19], (DEPTH, N_EXPERTS), 0.01),
        'expert_w1': nrm(ks[20], (DEPTH, N_EXPERTS, D_MODEL, D_EXPERT), D_MODEL ** -0.5),
        'expert_w3': nrm(ks[21], (DEPTH, N_EXPERTS, D_MODEL, D_EXPERT), D_MODEL ** -0.5),
        'expert_w2': nrm(ks[22], (DEPTH, N_EXPERTS, D_EXPERT, D_MODEL), D_EXPERT ** -0.5),
        'shared_w1': nrm(ks[23], (DEPTH, D_MODEL, D_EXPERT), D_MODEL ** -0.5),
        'shared_w3': nrm(ks[24], (DEPTH, D_MODEL, D_EXPERT), D_MODEL ** -0.5),
        'shared_w2': nrm(ks[25], (DEPTH, D_EXPERT, D_MODEL), D_EXPERT ** -0.5),
    }


def reference(x, c, ctx, c_ctx, w_mod, b_mod, norm1_g, norm2_g, w_in, q_norm_g, k_norm_g, na_rpb,
              gla_gate_up_f, gla_gate_bias_f, gla_gate_up_b, gla_gate_bias_b, gla_norm_g, w_out,
              router_w, router_bias, expert_w1, expert_w3, expert_w2, shared_w1, shared_w3, shared_w2):
    for layer in range(DEPTH):
        need_ctx = layer < DEPTH - 1
        sh1, sc1, g1, sh2, sc2, g2 = jnp.split(
            adaln_params(c, w_mod[layer], b_mod[layer])[:, None, :], 6, axis=-1)
        csh1, csc1, cg1, csh2, csc2, cg2 = jnp.split(
            adaln_params(c_ctx, w_mod[layer], b_mod[layer]), 6, axis=-1)
        h_l = modulate(rms_norm(x, norm1_g[layer]), sh1, sc1)
        h_c = modulate(rms_norm(ctx, norm1_g[layer]), csh1, csc1)
        o_l, o_c = token_mixers(h_l, h_c, w_in[layer], q_norm_g[layer], k_norm_g[layer], na_rpb[layer],
                                gla_gate_up_f[layer], gla_gate_bias_f[layer], gla_gate_up_b[layer],
                                gla_gate_bias_b[layer], gla_norm_g[layer], w_out[layer], need_ctx)
        x = x + g1 * o_l
        x = x + g2 * moe_ffn(modulate(rms_norm(x, norm2_g[layer]), sh2, sc2), router_w[layer],
                             router_bias[layer], expert_w1[layer], expert_w3[layer], expert_w2[layer],
                             shared_w1[layer], shared_w3[layer], shared_w2[layer])
        if need_ctx:
            ctx = ctx + cg1 * o_c
            ctx = ctx + cg2 * moe_ffn(modulate(rms_norm(ctx, norm2_g[layer]), csh2, csc2), router_w[layer],
                                      router_bias[layer], expert_w1[layer], expert_w3[layer],
                                      expert_w2[layer], shared_w1[layer], shared_w3[layer],
                                      shared_w2[layer])
    return x
```

```cpp
#include <hip/hip_runtime.h>
#include <stdint.h>

#define NT 512
constexpr int D = 2048, SEQ = 4096, CTXL = 256, NB = 2;
constexpr int NLAT = NB * SEQ;
constexpr int NCTX = NB * CTXL;
constexpr int NROW = NLAT + NCTX;
constexpr int INC = 6176;
constexpr int NE = 64, TOPK = 6, DE = 512;
constexpr int NPAIR = NLAT * TOPK;
constexpr int MAXMT = NPAIR / 128 + NE;

struct Params {
    const float *x, *c, *ctx, *c_ctx, *w_mod, *b_mod, *norm1_g, *norm2_g, *w_in, *q_norm_g, *k_norm_g, *na_rpb,
        *up_f, *bias_f, *up_b, *bias_b, *gla_norm_g, *w_out, *router_w, *router_bias, *ew1, *ew3, *ew2, *sw1, *sw3, *sw2;
    float* out;
    float *modp, *mod, *H, *X1, *P, *NQ, *NK, *GQ, *GK, *AF, *AB, *MIX, *OGF, *OGB;
    float *HB, *SHH, *Y, *EW;
    int *EIDX, *PAIRPOS, *LIST, *CNT, *CUR;
};

__device__ __forceinline__ float wave_sum(float v) { for (int o = 32; o > 0; o >>= 1) v += __shfl_xor(v, o); return v; }
__device__ __forceinline__ float wave_max(float v) { for (int o = 32; o > 0; o >>= 1) v = fmaxf(v, __shfl_xor(v, o)); return v; }
__device__ __forceinline__ int wave_min_i(int v) { for (int o = 32; o > 0; o >>= 1) v = min(v, __shfl_xor(v, o)); return v; }
__device__ __forceinline__ float siluf(float v) { return v / (1.f + expf(-v)); }

__device__ void ph_adaln_partial(const Params& p, float* sm) {
    if (blockIdx.x == 0 && threadIdx.x < 128) { if (threadIdx.x < 64) p.CNT[threadIdx.x] = 0; else p.CUR[threadIdx.x - 64] = 0; }
    for (int u = blockIdx.x; u < 24 * 16; u += gridDim.x) {
        const int cb = u % 24, ks = u / 24, k0 = ks * 128;
        __syncthreads();
        for (int i = threadIdx.x; i < 3 * 128; i += NT) {
            const int r = i / 128, k = i % 128;
            const float v = (r < 2) ? p.c[r * D + k0 + k] : p.c_ctx[k0 + k];
            sm[i] = siluf(v);
        }
        __syncthreads();
        const int n = cb * 512 + threadIdx.x;
        float a0 = 0.f, a1 = 0.f, a2 = 0.f;
        for (int k = 0; k < 128; ++k) {
            const float w = p.w_mod[(size_t)(k0 + k) * (6 * D) + n];
            a0 += sm[k] * w; a1 += sm[128 + k] * w; a2 += sm[256 + k] * w;
        }
        float* o = p.modp + (size_t)ks * 3 * 6 * D;
        o[0 * 6 * D + n] = a0; o[1 * 6 * D + n] = a1; o[2 * 6 * D + n] = a2;
    }
}
__device__ void ph_adaln_reduce(const Params& p) {
    for (int i = blockIdx.x * NT + threadIdx.x; i < 3 * 6 * D; i += gridDim.x * NT) {
        float s = p.b_mod[i % (6 * D)];
        for (int k = 0; k < 16; ++k) s += p.modp[(size_t)k * 3 * 6 * D + i];
        p.mod[i] = s;
    }
}
__device__ __forceinline__ float4 rms_mod_row(const float* src, const float* g, const float* sh, const float* sc, float* red) {
    const int t = threadIdx.x;
    const float4 v = *(const float4*)(src + 4 * t);
    float ss = v.x * v.x + v.y * v.y + v.z * v.z + v.w * v.w;
    ss = wave_sum(ss);
    __syncthreads();
    if ((t & 63) == 0) red[t >> 6] = ss;
    __syncthreads();
    float tot = 0.f;
#pragma unroll
    for (int i = 0; i < NT / 64; ++i) tot += red[i];
    const float rs = rsqrtf(tot * (1.f / D) + 1e-6f);
    const float4 gg = *(const float4*)(g + 4 * t), s1 = *(const float4*)(sc + 4 * t), s0 = *(const float4*)(sh + 4 * t);
    float4 o;
    o.x = v.x * rs * gg.x * (1.f + s1.x) + s0.x; o.y = v.y * rs * gg.y * (1.f + s1.y) + s0.y;
    o.z = v.z * rs * gg.z * (1.f + s1.z) + s0.z; o.w = v.w * rs * gg.w * (1.f + s1.w) + s0.w;
    return o;
}
__device__ void ph_norm1(const Params& p, float* sm) {
    for (int row = blockIdx.x; row < NROW; row += gridDim.x) {
        const float* src; int mr;
        if (row < NLAT) { src = p.x + (size_t)row * D; mr = row / SEQ; } else { src = p.ctx + (size_t)(row - NLAT) * D; mr = 2; }
        const float* m = p.mod + (size_t)mr * 6 * D;
        const float4 o = rms_mod_row(src, p.norm1_g, m + 0 * D, m + 1 * D, sm);
        *(float4*)(p.H + (size_t)row * D + 4 * threadIdx.x) = o;
    }
}

template <bool DUAL, class Epi>
__device__ __forceinline__ void gemm_tile(float* sm, const float* A, int lda, const int* rowidx, int row0, int nvalid,
                                          const float* B, const float* B2, int ldb, int n0, int N, int K, Epi epi) {
    float* As = sm;
    float* Bs = sm + 16 * 132;
    float* Bs2 = Bs + 16 * 64;
    const int t = threadIdx.x, ty = t >> 4, tx = t & 15;
    const int ar = t >> 2, akq = (t & 3) * 4;
    const float* arow = nullptr;
    if (ar < nvalid) arow = A + (size_t)(rowidx ? rowidx[ar] : (row0 + ar)) * lda;
    const int bk = t >> 5, bc = (t & 31) * 2;
    const bool bok = (n0 + bc) < N;
    float acc[4][4], acc2[4][4];
#pragma unroll
    for (int i = 0; i < 4; ++i)
#pragma unroll
        for (int j = 0; j < 4; ++j) { acc[i][j] = 0.f; acc2[i][j] = 0.f; }
    for (int k0 = 0; k0 < K; k0 += 16) {
        float4 av = make_float4(0.f, 0.f, 0.f, 0.f);
        if (arow) av = *(const float4*)(arow + k0 + akq);
        float2 bv = make_float2(0.f, 0.f), bv2 = make_float2(0.f, 0.f);
        if (bok) { bv = *(const float2*)(B + (size_t)(k0 + bk) * ldb + n0 + bc); if (DUAL) bv2 = *(const float2*)(B2 + (size_t)(k0 + bk) * ldb + n0 + bc); }
        __syncthreads();
        As[(akq + 0) * 132 + ar] = av.x; As[(akq + 1) * 132 + ar] = av.y; As[(akq + 2) * 132 + ar] = av.z; As[(akq + 3) * 132 + ar] = av.w;
        *(float2*)(Bs + bk * 64 + bc) = bv;
        if (DUAL) *(float2*)(Bs2 + bk * 64 + bc) = bv2;
        __syncthreads();
#pragma unroll
        for (int kk = 0; kk < 16; ++kk) {
            const float4 a = *(const float4*)(As + kk * 132 + ty * 4);
            const float4 b = *(const float4*)(Bs + kk * 64 + tx * 4);
            const float aa[4] = {a.x, a.y, a.z, a.w}, bb[4] = {b.x, b.y, b.z, b.w};
#pragma unroll
            for (int i = 0; i < 4; ++i)
#pragma unroll
                for (int j = 0; j < 4; ++j) acc[i][j] += aa[i] * bb[j];
            if (DUAL) {
                const float4 b2 = *(const float4*)(Bs2 + kk * 64 + tx * 4);
                const float bb2[4] = {b2.x, b2.y, b2.z, b2.w};
#pragma unroll
                for (int i = 0; i < 4; ++i)
#pragma unroll
                    for (int j = 0; j < 4; ++j) acc2[i][j] += aa[i] * bb2[j];
            }
        }
    }
#pragma unroll
    for (int i = 0; i < 4; ++i) {
        const int r = ty * 4 + i;
        if (r < nvalid) {
#pragma unroll
            for (int j = 0; j < 4; ++j) { const int n = n0 + tx * 4 + j; if (n < N) epi(r, n, acc[i][j], acc2[i][j]); }
        }
    }
    __syncthreads();
}

__device__ void ph_inproj(const Params& p, float* sm) {
    constexpr int MT = NROW / 128, NTI = (INC + 63) / 64;
    for (int u = blockIdx.x; u < MT * NTI; u += gridDim.x) {
        const int mt = u % MT, nt = u / MT;
        float* P = p.P;
        gemm_tile<false>(sm, p.H, D, nullptr, mt * 128, 128, p.w_in, nullptr, INC, nt * 64, INC, D,
                         [=](int r, int n, float v, float) { P[(size_t)(mt * 128 + r) * INC + n] = v; });
    }
}

__device__ void ph_postproj(const Params& p, float* sm) {
    const int t = threadIdx.x, w = t >> 6, lane = t & 63;
    for (int row = blockIdx.x; row < NROW; row += gridDim.x) {
        const float* pr = p.P + (size_t)row * INC;
        {
            const float q0 = pr[w * 128 + lane], q1 = pr[w * 128 + 64 + lane];
            const float k0 = pr[1024 + w * 128 + lane], k1 = pr[1024 + w * 128 + 64 + lane];
            const float sq = wave_sum(q0 * q0 + q1 * q1), sk = wave_sum(k0 * k0 + k1 * k1);
            const float rq = rsqrtf(sq * (1.f / 128.f) + 1e-6f), rk = rsqrtf(sk * (1.f / 128.f) + 1e-6f);
            float* nq = p.NQ + (size_t)row * 1024 + w * 128; float* nk = p.NK + (size_t)row * 1024 + w * 128;
            nq[lane] = q0 * rq * p.q_norm_g[lane]; nq[lane + 64] = q1 * rq * p.q_norm_g[lane + 64];
            nk[lane] = k0 * rk * p.k_norm_g[lane]; nk[lane + 64] = k1 * rk * p.k_norm_g[lane + 64];
        }
        {
            const int d = t & 127;
            float qv = pr[3072 + t], kv = pr[3584 + t];
            if (row < NLAT) {
                const int tok = row % SEQ, dd = d & 63, i = dd & 31;
                const float pos = (float)((d < 64) ? (tok / 64) : (tok % 64));
                const float invf = powf(10000.f, -(float)i / 32.f);
                const float ang = pos * invf, cs = cosf(ang), sn = sinf(ang);
                const int partner = (dd < 32) ? (t + 32) : (t - 32);
                const float qp = pr[3072 + partner], kp = pr[3584 + partner];
                if (dd < 32) { qv = qv * cs - qp * sn; kv = kv * cs - kp * sn; }
                else { qv = qv * cs + qp * sn; kv = kv * cs + kp * sn; }
            }
            p.GQ[(size_t)row * 512 + t] = qv * 0.08838834764831845f;
            p.GK[(size_t)row * 512 + t] = kv;
        }
        {
            float zf = p.bias_f[t], zb = p.bias_b[t];
#pragma unroll
            for (int r = 0; r < 16; ++r) { zf += pr[6144 + r] * p.up_f[r * 512 + t]; zb += pr[6160 + r] * p.up_b[r * 512 + t]; }
            const float lf = fminf(zf, 0.f) - log1pf(expf(-fabsf(zf))), lb = fminf(zb, 0.f) - log1pf(expf(-fabsf(zb)));
            p.AF[(size_t)row * 512 + t] = expf(lf * (1.f / 16.f));
            p.AB[(size_t)row * 512 + t] = expf(lb * (1.f / 16.f));
        }
    }
}

__device__ void ph_attn(const Params& p, float* sm) {
    const int t = threadIdx.x, w = t >> 6, lane = t & 63;
    float* qs = sm + w * 128;
    float* ps = sm + 8 * 128 + w * 384;
    int* ks = (int*)(sm + 8 * 128 + 8 * 384) + w * 384;
    for (int u = blockIdx.x; u < NB * 8 * 64 * 8; u += gridDim.x) {
        const int cg = u & 7, r = (u >> 3) & 63, h = (u >> 9) & 7, b = u >> 12;
        const int c = cg * 8 + w;
        const int qrow = b * SEQ + r * 64 + c;
        const int rs = min(max(r - 4, 0), 56), cs = min(max(c - 8, 0), 48);
        qs[lane] = p.NQ[(size_t)qrow * 1024 + h * 128 + lane]; qs[lane + 64] = p.NQ[(size_t)qrow * 1024 + h * 128 + 64 + lane];
        __syncthreads();
        float lg[6]; float mx = -INFINITY;
        const float* kp[6]; float bias[6];
#pragma unroll
        for (int i = 0; i < 6; ++i) {
            const int kk = lane + 64 * i;
            int krow; bias[i] = 0.f;
            if (kk < 128) { const int ir = kk >> 4, j = kk & 15; krow = b * SEQ + (rs + ir) * 64 + cs + j; bias[i] = p.na_rpb[(h * 15 + (rs + ir - r + 7)) * 31 + (cs + j - c + 15)]; }
            else krow = NLAT + b * CTXL + (kk - 128);
            ks[kk] = krow;
            kp[i] = p.NK + (size_t)krow * 1024 + h * 128;
            lg[i] = 0.f;
        }
#pragma unroll 1
        for (int d = 0; d < 128; d += 4) {
            const float4 q = *(const float4*)(qs + d);
#pragma unroll
            for (int i = 0; i < 6; ++i) { const float4 kv = *(const float4*)(kp[i] + d); lg[i] += q.x * kv.x + q.y * kv.y + q.z * kv.z + q.w * kv.w; }
        }
#pragma unroll
        for (int i = 0; i < 6; ++i) { lg[i] = lg[i] * 0.08838834764831845f + bias[i]; mx = fmaxf(mx, lg[i]); }
        mx = wave_max(mx);
        float se = 0.f;
#pragma unroll
        for (int i = 0; i < 6; ++i) { lg[i] = expf(lg[i] - mx); se += lg[i]; ps[lane + 64 * i] = lg[i]; }
        se = wave_sum(se);
        __syncthreads();
        float o0 = 0.f, o1 = 0.f;
        for (int kk = 0; kk < 384; ++kk) {
            const float pv = ps[kk];
            const float* vp = p.P + (size_t)ks[kk] * INC + 2048 + h * 128;
            o0 += pv * vp[lane]; o1 += pv * vp[lane + 64];
        }
        const float inv = 1.f / se;
        p.MIX[(size_t)qrow * D + h * 128 + lane] = o0 * inv;
        p.MIX[(size_t)qrow * D + h * 128 + 64 + lane] = o1 * inv;
        __syncthreads();
    }
}

__device__ void ph_gla(const Params& p) {
    const int t = threadIdx.x, vi = t >> 5, dg = t & 31;
    for (int u = blockIdx.x; u < 256; u += gridDim.x) {
        const int scan = u >> 4, vs = u & 15, dir = scan >> 3, b = (scan >> 2) & 1, h = scan & 3;
        const float* A = dir ? p.AB : p.AF;
        float* OG = dir ? p.OGB : p.OGF;
        float S0 = 0.f, S1 = 0.f, S2 = 0.f, S3 = 0.f;
        const int koff = h * 128 + dg * 4, voff = 4096 + h * 256 + vs * 16 + vi;
        for (int n = 0; n < CTXL + SEQ; ++n) {
            int row; bool lat;
            if (n < CTXL) { row = NLAT + b * CTXL + (dir ? (CTXL - 1 - n) : n); lat = false; }
            else { const int li = n - CTXL; row = b * SEQ + (dir ? (SEQ - 1 - li) : li); lat = true; }
            const float4 a = *(const float4*)(A + (size_t)row * 512 + koff);
            const float4 k = *(const float4*)(p.GK + (size_t)row * 512 + koff);
            const float v = p.P[(size_t)row * INC + voff];
            S0 = a.x * S0 + k.x * v; S1 = a.y * S1 + k.y * v; S2 = a.z * S2 + k.z * v; S3 = a.w * S3 + k.w * v;
            if (lat) {
                const float4 q = *(const float4*)(p.GQ + (size_t)row * 512 + koff);
                float o = q.x * S0 + q.y * S1 + q.z * S2 + q.w * S3;
                o += __shfl_xor(o, 16); o += __shfl_xor(o, 8); o += __shfl_xor(o, 4); o += __shfl_xor(o, 2); o += __shfl_xor(o, 1);
                if (dg == 0) OG[(size_t)row * 1024 + h * 256 + vs * 16 + vi] = o;
            }
        }
    }
}

__device__ void ph_glaout(const Params& p, float* sm) {
    const int t = threadIdx.x, w = t >> 6, lane = t & 63;
    for (int row = blockIdx.x; row < NLAT; row += gridDim.x) {
        const float o0 = p.OGF[(size_t)row * 1024 + t] + p.OGB[(size_t)row * 1024 + t];
        const float o1 = p.OGF[(size_t)row * 1024 + 512 + t] + p.OGB[(size_t)row * 1024 + 512 + t];
        const float s0 = wave_sum(o0 * o0), s1 = wave_sum(o1 * o1);
        __syncthreads();
        if (lane == 0) { sm[w] = s0; sm[8 + w] = s1; }
        __syncthreads();
        const int hb = (w >> 2) * 4;
        const float t0 = sm[hb] + sm[hb + 1] + sm[hb + 2] + sm[hb + 3], t1 = sm[8 + hb] + sm[8 + hb + 1] + sm[8 + hb + 2] + sm[8 + hb + 3];
        const float r0 = rsqrtf(t0 * (1.f / 256.f) + 1e-6f), r1 = rsqrtf(t1 * (1.f / 256.f) + 1e-6f);
        const float g = p.gla_norm_g[t & 255];
        const float ga0 = p.P[(size_t)row * INC + 5120 + t], ga1 = p.P[(size_t)row * INC + 5120 + 512 + t];
        p.MIX[(size_t)row * D + 1024 + t] = o0 * r0 * g * siluf(ga0);
        p.MIX[(size_t)row * D + 1024 + 512 + t] = o1 * r1 * g * siluf(ga1);
    }
}

__device__ void ph_outproj(const Params& p, float* sm) {
    constexpr int MT = NLAT / 128, NTI = D / 64;
    for (int u = blockIdx.x; u < MT * NTI; u += gridDim.x) {
        const int mt = u % MT, nt = u / MT;
        const float* x = p.x; const float* mod = p.mod; float* X1 = p.X1;
        gemm_tile<false>(sm, p.MIX, D, nullptr, mt * 128, 128, p.w_out, nullptr, D, nt * 64, D, D,
                         [=](int r, int n, float v, float) { const int row = mt * 128 + r; const int b = row / SEQ;
                             X1[(size_t)row * D + n] = x[(size_t)row * D + n] + mod[(size_t)b * 6 * D + 2 * D + n] * v; });
    }
}

__device__ void ph_norm2_router(const Params& p, float* sm) {
    const int t = threadIdx.x, lane = t & 63;
    float* red = sm;
    float* hrow = sm + 16;
    float* part = sm + 16 + 2048;
    for (int row = blockIdx.x; row < NLAT; row += gridDim.x) {
        const int b = row / SEQ;
        const float* m = p.mod + (size_t)b * 6 * D;
        const float4 o = rms_mod_row(p.X1 + (size_t)row * D, p.norm2_g, m + 3 * D, m + 4 * D, red);
        *(float4*)(p.H + (size_t)row * D + 4 * t) = o;
        *(float4*)(hrow + 4 * t) = o;
        __syncthreads();
        {
            const int e = t & 63, part_i = t >> 6;
            float s = 0.f;
            for (int k = part_i * 256; k < part_i * 256 + 256; ++k) s += hrow[k] * p.router_w[(size_t)k * NE + e];
            part[part_i * 64 + e] = s;
        }
        __syncthreads();
        if (t < 64) {
            float lgt = 0.f;
#pragma unroll
            for (int i = 0; i < 8; ++i) lgt += part[i * 64 + lane];
            const float sc = 1.f / (1.f + expf(-lgt));
            const float bs = sc + p.router_bias[lane];
            float m1 = bs; m1 = fmaxf(m1, __shfl_xor(m1, 1)); m1 = fmaxf(m1, __shfl_xor(m1, 2)); m1 = fmaxf(m1, __shfl_xor(m1, 4));
            int ai = (bs == m1) ? lane : 64; ai = min(ai, __shfl_xor(ai, 1)); ai = min(ai, __shfl_xor(ai, 2)); ai = min(ai, __shfl_xor(ai, 4));
            float m2 = (lane == ai) ? -INFINITY : bs; m2 = fmaxf(m2, __shfl_xor(m2, 1)); m2 = fmaxf(m2, __shfl_xor(m2, 2)); m2 = fmaxf(m2, __shfl_xor(m2, 4));
            const float gs = m1 + m2;
            float g0 = __shfl(gs, 0), g1 = __shfl(gs, 8), g2 = __shfl(gs, 16), g3 = __shfl(gs, 24), g4 = __shfl(gs, 32), g5 = __shfl(gs, 40), g6 = __shfl(gs, 48), g7 = __shfl(gs, 56);
            unsigned selmask = 0u;
#pragma unroll
            for (int it = 0; it < 4; ++it) {
                float best = -INFINITY; int bi = 0;
                if (!(selmask & 1u) && g0 > best) { best = g0; bi = 0; }
                if (!(selmask & 2u) && g1 > best) { best = g1; bi = 1; }
                if (!(selmask & 4u) && g2 > best) { best = g2; bi = 2; }
                if (!(selmask & 8u) && g3 > best) { best = g3; bi = 3; }
                if (!(selmask & 16u) && g4 > best) { best = g4; bi = 4; }
                if (!(selmask & 32u) && g5 > best) { best = g5; bi = 5; }
                if (!(selmask & 64u) && g6 > best) { best = g6; bi = 6; }
                if (!(selmask & 128u) && g7 > best) { best = g7; bi = 7; }
                selmask |= 1u << bi;
            }
            float cand = ((selmask >> (lane >> 3)) & 1u) ? bs : -INFINITY;
            int myslot = -1; float ssum = 0.f;
#pragma unroll
            for (int k = 0; k < TOPK; ++k) {
                const float mv = wave_max(cand);
                const int idx = wave_min_i((cand == mv) ? lane : 64);
                const float sv = __shfl(sc, idx);
                ssum += sv;
                if (lane == idx) { myslot = k; cand = -INFINITY; }
            }
            if (myslot >= 0) {
                p.EIDX[row * TOPK + myslot] = lane;
                p.EW[row * TOPK + myslot] = sc / ssum * 2.5f;
                atomicAdd(&p.CNT[lane], 1);
            }
        }
        __syncthreads();
    }
}

__device__ void ph_lists(const Params& p, int* smi) {
    if (threadIdx.x == 0) { int o = 0; for (int e = 0; e < NE; ++e) { smi[e] = o; o += p.CNT[e]; } }
    __syncthreads();
    for (int i = blockIdx.x * NT + threadIdx.x; i < NPAIR; i += gridDim.x * NT) {
        const int e = p.EIDX[i];
        const int pos = smi[e] + atomicAdd(&p.CUR[e], 1);
        p.PAIRPOS[i] = pos; p.LIST[pos] = i / TOPK;
    }
}

__device__ __forceinline__ void moe_tables(const Params& p, int* smi) {
    __syncthreads();
    if (threadIdx.x == 0) { int o = 0, tt = 0; for (int e = 0; e < NE; ++e) { smi[e] = o; smi[80 + e] = tt; const int c = p.CNT[e]; o += c; tt += (c + 127) / 128; } smi[64] = o; smi[80 + 64] = tt; }
    __syncthreads();
}
__device__ __forceinline__ int find_expert(const int* tp, int mt) { int e = 0; while (e < NE - 1 && tp[e + 1] <= mt) ++e; return e; }

__device__ void ph_moe_up(const Params& p, float* sm) {
    int* smi = (int*)(sm + 16 * 132 + 2 * 16 * 64);
    moe_tables(p, smi);
    const int* off = smi; const int* tp = smi + 80; const int T = tp[64];
    for (int u = blockIdx.x; u < MAXMT * 8; u += gridDim.x) {
        const int mt = u >> 3, nt = u & 7;
        if (mt >= T) break;
        const int e = find_expert(tp, mt), lt = mt - tp[e], cnt = off[e + 1] - off[e];
        const int r0 = off[e] + lt * 128, nv = min(128, cnt - lt * 128);
        float* HB = p.HB;
        gemm_tile<true>(sm, p.H, D, p.LIST + r0, 0, nv, p.ew1 + (size_t)e * D * DE, p.ew3 + (size_t)e * D * DE, DE, nt * 64, DE, D,
                        [=](int r, int n, float a, float b3) { HB[(size_t)(r0 + r) * DE + n] = siluf(a) * b3; });
    }
}
__device__ void ph_shared_up(const Params& p, float* sm) {
    for (int u = blockIdx.x; u < (NLAT / 128) * 8; u += gridDim.x) {
        const int mt = u >> 3, nt = u & 7;
        float* SHH = p.SHH;
        gemm_tile<true>(sm, p.H, D, nullptr, mt * 128, 128, p.sw1, p.sw3, DE, nt * 64, DE, D,
                        [=](int r, int n, float a, float b3) { SHH[(size_t)(mt * 128 + r) * DE + n] = siluf(a) * b3; });
    }
}
__device__ void ph_moe_down(const Params& p, float* sm) {
    int* smi = (int*)(sm + 16 * 132 + 2 * 16 * 64);
    moe_tables(p, smi);
    const int* off = smi; const int* tp = smi + 80; const int T = tp[64];
    for (int u = blockIdx.x; u < MAXMT * 32; u += gridDim.x) {
        const int mt = u >> 5, nt = u & 31;
        if (mt >= T) break;
        const int e = find_expert(tp, mt), lt = mt - tp[e], cnt = off[e + 1] - off[e];
        const int r0 = off[e] + lt * 128, nv = min(128, cnt - lt * 128);
        float* Y = p.Y;
        gemm_tile<false>(sm, p.HB, DE, nullptr, r0, nv, p.ew2 + (size_t)e * DE * D, nullptr, D, nt * 64, D, DE,
                         [=](int r, int n, float a, float) { Y[(size_t)(r0 + r) * D + n] = a; });
    }
}
__device__ void ph_final(const Params& p, float* sm) {
    for (int u = blockIdx.x; u < (NLAT / 128) * 32; u += gridDim.x) {
        const int mt = u >> 5, nt = u & 31;
        const float* X1 = p.X1; const float* mod = p.mod; const float* Y = p.Y; const float* EW = p.EW; const int* PP = p.PAIRPOS; float* out = p.out;
        gemm_tile<false>(sm, p.SHH, DE, nullptr, mt * 128, 128, p.sw2, nullptr, D, nt * 64, D, DE,
                         [=](int r, int n, float a, float) { const int row = mt * 128 + r; const int b = row / SEQ;
                             float s = a;
#pragma unroll
                             for (int k = 0; k < TOPK; ++k) s += EW[row * TOPK + k] * Y[(size_t)PP[row * TOPK + k] * D + n];
                             out[(size_t)row * D + n] = X1[(size_t)row * D + n] + mod[(size_t)b * 6 * D + 5 * D + n] * s; });
    }
}

#define SMF 4608
#define DEFK(name, call) __global__ void __launch_bounds__(NT) name(Params p) { __shared__ __attribute__((aligned(16))) float sm[SMF]; call; }
DEFK(k_adaln_partial, ph_adaln_partial(p, sm))
DEFK(k_adaln_reduce, ph_adaln_reduce(p))
DEFK(k_norm1, ph_norm1(p, sm))
DEFK(k_inproj, ph_inproj(p, sm))
DEFK(k_postproj, ph_postproj(p, sm))
__global__ void __launch_bounds__(NT) k_attn(Params p) { __shared__ __attribute__((aligned(16))) float sm[8 * 128 + 8 * 384 + 8 * 384]; ph_attn(p, sm); }
DEFK(k_gla, ph_gla(p))
DEFK(k_glaout, ph_glaout(p, sm))
DEFK(k_outproj, ph_outproj(p, sm))
DEFK(k_norm2_router, ph_norm2_router(p, sm))
DEFK(k_lists, ph_lists(p, (int*)sm))
DEFK(k_moe_up, ph_moe_up(p, sm))
DEFK(k_shared_up, ph_shared_up(p, sm))
DEFK(k_moe_down, ph_moe_down(p, sm))
DEFK(k_final, ph_final(p, sm))

extern "C" void kernel_launch(void* const* d_in, const int* in_sizes, int n_in, void* d_out, int out_size, void* d_ws, size_t ws_size, hipStream_t stream) {
    Params p{};
    const float* const* in = (const float* const*)d_in;
    p.x = in[0]; p.c = in[1]; p.ctx = in[2]; p.c_ctx = in[3]; p.w_mod = in[4]; p.b_mod = in[5]; p.norm1_g = in[6]; p.norm2_g = in[7]; p.w_in = in[8];
    p.q_norm_g = in[9]; p.k_norm_g = in[10]; p.na_rpb = in[11]; p.up_f = in[12]; p.bias_f = in[13]; p.up_b = in[14]; p.bias_b = in[15]; p.gla_norm_g = in[16];
    p.w_out = in[17]; p.router_w = in[18]; p.router_bias = in[19]; p.ew1 = in[20]; p.ew3 = in[21]; p.ew2 = in[22]; p.sw1 = in[23]; p.sw3 = in[24]; p.sw2 = in[25];
    p.out = (float*)d_out;
    char* w = (char*)d_ws; size_t o = 0;
    auto take = [&](size_t bytes) { void* r = w + o; o += (bytes + 255) & ~(size_t)255; return r; };
    p.CNT = (int*)take(64 * 4); p.CUR = (int*)take(64 * 4);
    p.modp = (float*)take((size_t)16 * 3 * 6 * D * 4); p.mod = (float*)take((size_t)3 * 6 * D * 4);
    p.EIDX = (int*)take((size_t)NPAIR * 4); p.EW = (float*)take((size_t)NPAIR * 4); p.PAIRPOS = (int*)take((size_t)NPAIR * 4); p.LIST = (int*)take((size_t)NPAIR * 4);
    p.H = (float*)take((size_t)NROW * D * 4);
    p.X1 = (float*)take((size_t)NLAT * D * 4);
    const size_t big = o;
    p.P = (float*)take((size_t)NROW * INC * 4); p.NQ = (float*)take((size_t)NROW * 1024 * 4); p.NK = (float*)take((size_t)NROW * 1024 * 4);
    p.GQ = (float*)take((size_t)NROW * 512 * 4); p.GK = (float*)take((size_t)NROW * 512 * 4); p.AF = (float*)take((size_t)NROW * 512 * 4); p.AB = (float*)take((size_t)NROW * 512 * 4);
    p.MIX = (float*)take((size_t)NLAT * D * 4); p.OGF = (float*)take((size_t)NLAT * 1024 * 4); p.OGB = (float*)take((size_t)NLAT * 1024 * 4);
    o = big;
    p.HB = (float*)take((size_t)NPAIR * DE * 4); p.SHH = (float*)take((size_t)NLAT * DE * 4); p.Y = (float*)take((size_t)NPAIR * D * 4);
    const int G = 1024;
    k_adaln_partial<<<384, NT, 0, stream>>>(p);
    k_adaln_reduce<<<72, NT, 0, stream>>>(p);
    k_norm1<<<G * 2, NT, 0, stream>>>(p);
    k_inproj<<<68 * 97, NT, 0, stream>>>(p);
    k_postproj<<<G * 2, NT, 0, stream>>>(p);
    k_attn<<<G * 4, NT, 0, stream>>>(p);
    k_gla<<<256, NT, 0, stream>>>(p);
    k_glaout<<<G * 2, NT, 0, stream>>>(p);
    k_outproj<<<64 * 32, NT, 0, stream>>>(p);
    k_norm2_router<<<G * 2, NT, 0, stream>>>(p);
    k_lists<<<96, NT, 0, stream>>>(p);
    k_moe_up<<<MAXMT * 8, NT, 0, stream>>>(p);
    k_shared_up<<<64 * 8, NT, 0, stream>>>(p);
    k_moe_down<<<G * 2, NT, 0, stream>>>(p);
    k_final<<<64 * 32, NT, 0, stream>>>(p);
}
```

```cpp
#include <hip/hip_runtime.h>
#include <stdint.h>

#define XB_TMO      128
#define XB_XCNT(j)  (256  + 64 * (j))
#define XB_XSUB(j)  (1280 + 64 * (j))
#define XB_XGEN(j)  (2304 + 64 * (j))
#define XB_TOP      3328
#define XB_TOPGEN   3392
#define XCD_BAR_WORDS 3456
#define XB_SPIN_CAP (1u << 18)
#define LAS __attribute__((address_space(3)))

__device__ __forceinline__ unsigned xb_ld(unsigned* p)              { return __hip_atomic_load(p, __ATOMIC_RELAXED, __HIP_MEMORY_SCOPE_AGENT); }
__device__ __forceinline__ unsigned xb_add(unsigned* p, unsigned v) { return __hip_atomic_fetch_add(p, v, __ATOMIC_RELAXED, __HIP_MEMORY_SCOPE_AGENT); }
__device__ __forceinline__ unsigned xb_xcc_id() { return (unsigned)__builtin_amdgcn_s_getreg((3 << 11) | 20) & 0xFu; }
#define XB_SPIN(cond, bar) do { unsigned _sp = 0; while (cond) { __builtin_amdgcn_s_sleep(1); \
    if ((++_sp & 255u) == 0u) { if (xb_ld(&(bar)[XB_TMO])) break; if (_sp > XB_SPIN_CAP) { atomicAdd(&(bar)[XB_TMO], 1u); break; } } } } while (0)

struct XcdBarrier {
    unsigned* bar; unsigned x;
    volatile LAS unsigned* st;
};

__device__ __forceinline__ XcdBarrier xcd_barrier_post(unsigned* bar, volatile LAS unsigned* st) {
    XcdBarrier b; b.bar = bar; b.x = xb_xcc_id(); b.st = st;
    if (threadIdx.x == 0) (void)xb_add(&bar[XB_XCNT(b.x)], 1u);
    return b;
}
__device__ __forceinline__ void xcd_barrier_complete(unsigned* bar, unsigned x, unsigned& nloc, unsigned& nx) {
    const unsigned G = gridDim.x * gridDim.y * gridDim.z;
    unsigned sum, cnt, mine, sp = 0u;
    for (;;) {
        sum = 0u; cnt = 0u; mine = 0u;
#pragma unroll
        for (unsigned j = 0; j < 16; ++j) { const unsigned c = xb_ld(&bar[XB_XCNT(j)]); sum += c; cnt += (c > 0u) ? 1u : 0u; mine = (j == x) ? c : mine; }
        if (sum == G) break;
        __builtin_amdgcn_s_sleep(1);
        if ((++sp & 255u) == 0u) { if (xb_ld(&bar[XB_TMO])) break; if (sp > XB_SPIN_CAP) { atomicAdd(&bar[XB_TMO], 1u); break; } }
    }
    nloc = mine > 0u ? mine : 1u; nx = cnt > 0u ? cnt : 1u;
}

__device__ __forceinline__ void xcd_barrier(const XcdBarrier& b) {
    asm volatile("s_waitcnt vmcnt(0)" ::: "memory");
    __syncthreads();
    if (threadIdx.x == 0) {
        unsigned* bar = b.bar;
        __builtin_amdgcn_s_waitcnt(0);
        unsigned nloc = b.st[0], nx = b.st[1];
        if (nloc == 0u) { xcd_barrier_complete(bar, b.x, nloc, nx); b.st[0] = nloc; b.st[1] = nx; }
        const unsigned old = xb_add(&bar[XB_XSUB(b.x)], 1u);
        const unsigned gen = old / nloc;
        if (old + 1u == (gen + 1u) * nloc) {
            __builtin_amdgcn_fence(__ATOMIC_RELEASE, "agent");
            asm volatile("s_waitcnt vmcnt(0)" ::: "memory");
            const unsigned og = xb_add(&bar[XB_TOP], 1u);
            const unsigned tg = og / nx;
            if (og + 1u == (tg + 1u) * nx) xb_add(&bar[XB_TOPGEN], 1u);
            else XB_SPIN(xb_ld(&bar[XB_TOPGEN]) == tg, bar);
            __builtin_amdgcn_fence(__ATOMIC_ACQUIRE, "agent");
            xb_add(&bar[XB_XGEN(b.x)], 1u);
            asm volatile("s_waitcnt vmcnt(0)" ::: "memory");
        } else {
            XB_SPIN(xb_ld(&bar[XB_XGEN(b.x)]) == gen, bar);
            __builtin_amdgcn_fence(__ATOMIC_ACQUIRE, "agent");
            asm volatile("s_waitcnt vmcnt(0)" ::: "memory");
        }
    }
    __syncthreads();
}


#define NT 512
constexpr int D = 2048, SEQ = 4096, CTXL = 256, NB = 2;
constexpr int NLAT = NB * SEQ;
constexpr int NCTX = NB * CTXL;
constexpr int NROW = NLAT + NCTX;
constexpr int INC = 6176;
constexpr int NE = 64, TOPK = 6, DE = 512;
constexpr int NPAIR = NLAT * TOPK;
constexpr int MAXMT = NPAIR / 128 + NE;

struct Params {
    const float *x, *c, *ctx, *c_ctx, *w_mod, *b_mod, *norm1_g, *norm2_g, *w_in, *q_norm_g, *k_norm_g, *na_rpb,
        *up_f, *bias_f, *up_b, *bias_b, *gla_norm_g, *w_out, *router_w, *router_bias, *ew1, *ew3, *ew2, *sw1, *sw3, *sw2;
    float* out;
    float *modp, *mod, *H, *X1, *P, *NQ, *NK, *GQ, *GK, *AF, *AB, *MIX, *OGF, *OGB;
    float *HB, *SHH, *Y, *EW;
    int *EIDX, *PAIRPOS, *LIST, *CNT, *CUR;
    unsigned* bar;
};

__device__ __forceinline__ float wave_sum(float v) { for (int o = 32; o > 0; o >>= 1) v += __shfl_xor(v, o); return v; }
__device__ __forceinline__ float wave_max(float v) { for (int o = 32; o > 0; o >>= 1) v = fmaxf(v, __shfl_xor(v, o)); return v; }
__device__ __forceinline__ int wave_min_i(int v) { for (int o = 32; o > 0; o >>= 1) v = min(v, __shfl_xor(v, o)); return v; }
__device__ __forceinline__ float siluf(float v) { return v / (1.f + expf(-v)); }

__device__ void ph_adaln_partial(const Params& p, float* sm) {
    if (blockIdx.x == 0 && threadIdx.x < 128) { if (threadIdx.x < 64) p.CNT[threadIdx.x] = 0; else p.CUR[threadIdx.x - 64] = 0; }
    for (int u = blockIdx.x; u < 24 * 16; u += gridDim.x) {
        const int cb = u % 24, ks = u / 24, k0 = ks * 128;
        __syncthreads();
        for (int i = threadIdx.x; i < 3 * 128; i += NT) {
            const int r = i / 128, k = i % 128;
            const float v = (r < 2) ? p.c[r * D + k0 + k] : p.c_ctx[k0 + k];
            sm[i] = siluf(v);
        }
        __syncthreads();
        const int n = cb * 512 + threadIdx.x;
        float a0 = 0.f, a1 = 0.f, a2 = 0.f;
        for (int k = 0; k < 128; ++k) {
            const float w = p.w_mod[(size_t)(k0 + k) * (6 * D) + n];
            a0 += sm[k] * w; a1 += sm[128 + k] * w; a2 += sm[256 + k] * w;
        }
        float* o = p.modp + (size_t)ks * 3 * 6 * D;
        o[0 * 6 * D + n] = a0; o[1 * 6 * D + n] = a1; o[2 * 6 * D + n] = a2;
    }
}
__device__ void ph_adaln_reduce(const Params& p) {
    for (int i = blockIdx.x * NT + threadIdx.x; i < 3 * 6 * D; i += gridDim.x * NT) {
        float s = p.b_mod[i % (6 * D)];
        for (int k = 0; k < 16; ++k) s += p.modp[(size_t)k * 3 * 6 * D + i];
        p.mod[i] = s;
    }
}
__device__ __forceinline__ float4 rms_mod_row(const float* src, const float* g, const float* sh, const float* sc, float* red) {
    const int t = threadIdx.x;
    const float4 v = *(const float4*)(src + 4 * t);
    float ss = v.x * v.x + v.y * v.y + v.z * v.z + v.w * v.w;
    ss = wave_sum(ss);
    __syncthreads();
    if ((t & 63) == 0) red[t >> 6] = ss;
    __syncthreads();
    float tot = 0.f;
#pragma unroll
    for (int i = 0; i < NT / 64; ++i) tot += red[i];
    const float rs = rsqrtf(tot * (1.f / D) + 1e-6f);
    const float4 gg = *(const float4*)(g + 4 * t), s1 = *(const float4*)(sc + 4 * t), s0 = *(const float4*)(sh + 4 * t);
    float4 o;
    o.x = v.x * rs * gg.x * (1.f + s1.x) + s0.x; o.y = v.y * rs * gg.y * (1.f + s1.y) + s0.y;
    o.z = v.z * rs * gg.z * (1.f + s1.z) + s0.z; o.w = v.w * rs * gg.w * (1.f + s1.w) + s0.w;
    return o;
}
__device__ void ph_norm1(const Params& p, float* sm) {
    for (int row = blockIdx.x; row < NROW; row += gridDim.x) {
        const float* src; int mr;
        if (row < NLAT) { src = p.x + (size_t)row * D; mr = row / SEQ; } else { src = p.ctx + (size_t)(row - NLAT) * D; mr = 2; }
        const float* m = p.mod + (size_t)mr * 6 * D;
        const float4 o = rms_mod_row(src, p.norm1_g, m + 0 * D, m + 1 * D, sm);
        *(float4*)(p.H + (size_t)row * D + 4 * threadIdx.x) = o;
    }
}

template <bool DUAL, class Epi>
__device__ __forceinline__ void gemm_tile(float* sm, const float* A, int lda, const int* rowidx, int row0, int nvalid,
                                          const float* B, const float* B2, int ldb, int n0, int N, int K, Epi epi) {
    float* As = sm;
    float* Bs = sm + 16 * 132;
    float* Bs2 = Bs + 16 * 64;
    const int t = threadIdx.x, ty = t >> 4, tx = t & 15;
    const int ar = t >> 2, akq = (t & 3) * 4;
    const float* arow = nullptr;
    if (ar < nvalid) arow = A + (size_t)(rowidx ? rowidx[ar] : (row0 + ar)) * lda;
    const int bk = t >> 5, bc = (t & 31) * 2;
    const bool bok = (n0 + bc) < N;
    float acc[4][4], acc2[4][4];
#pragma unroll
    for (int i = 0; i < 4; ++i)
#pragma unroll
        for (int j = 0; j < 4; ++j) { acc[i][j] = 0.f; acc2[i][j] = 0.f; }
    for (int k0 = 0; k0 < K; k0 += 16) {
        float4 av = make_float4(0.f, 0.f, 0.f, 0.f);
        if (arow) av = *(const float4*)(arow + k0 + akq);
        float2 bv = make_float2(0.f, 0.f), bv2 = make_float2(0.f, 0.f);
        if (bok) { bv = *(const float2*)(B + (size_t)(k0 + bk) * ldb + n0 + bc); if (DUAL) bv2 = *(const float2*)(B2 + (size_t)(k0 + bk) * ldb + n0 + bc); }
        __syncthreads();
        As[(akq + 0) * 132 + ar] = av.x; As[(akq + 1) * 132 + ar] = av.y; As[(akq + 2) * 132 + ar] = av.z; As[(akq + 3) * 132 + ar] = av.w;
        *(float2*)(Bs + bk * 64 + bc) = bv;
        if (DUAL) *(float2*)(Bs2 + bk * 64 + bc) = bv2;
        __syncthreads();
#pragma unroll
        for (int kk = 0; kk < 16; ++kk) {
            const float4 a = *(const float4*)(As + kk * 132 + ty * 4);
            const float4 b = *(const float4*)(Bs + kk * 64 + tx * 4);
            const float aa[4] = {a.x, a.y, a.z, a.w}, bb[4] = {b.x, b.y, b.z, b.w};
#pragma unroll
            for (int i = 0; i < 4; ++i)
#pragma unroll
                for (int j = 0; j < 4; ++j) acc[i][j] += aa[i] * bb[j];
            if (DUAL) {
                const float4 b2 = *(const float4*)(Bs2 + kk * 64 + tx * 4);
                const float bb2[4] = {b2.x, b2.y, b2.z, b2.w};
#pragma unroll
                for (int i = 0; i < 4; ++i)
#pragma unroll
                    for (int j = 0; j < 4; ++j) acc2[i][j] += aa[i] * bb2[j];
            }
        }
    }
#pragma unroll
    for (int i = 0; i < 4; ++i) {
        const int r = ty * 4 + i;
        if (r < nvalid) {
#pragma unroll
            for (int j = 0; j < 4; ++j) { const int n = n0 + tx * 4 + j; if (n < N) epi(r, n, acc[i][j], acc2[i][j]); }
        }
    }
    __syncthreads();
}

__device__ void ph_inproj(const Params& p, float* sm) {
    constexpr int MT = NROW / 128, NTI = (INC + 63) / 64;
    for (int u = blockIdx.x; u < MT * NTI; u += gridDim.x) {
        const int mt = u % MT, nt = u / MT;
        float* P = p.P;
        gemm_tile<false>(sm, p.H, D, nullptr, mt * 128, 128, p.w_in, nullptr, INC, nt * 64, INC, D,
                         [=](int r, int n, float v, float) { P[(size_t)(mt * 128 + r) * INC + n] = v; });
    }
}

__device__ void ph_postproj(const Params& p, float* sm) {
    const int t = threadIdx.x, w = t >> 6, lane = t & 63;
    for (int row = blockIdx.x; row < NROW; row += gridDim.x) {
        const float* pr = p.P + (size_t)row * INC;
        {
            const float q0 = pr[w * 128 + lane], q1 = pr[w * 128 + 64 + lane];
            const float k0 = pr[1024 + w * 128 + lane], k1 = pr[1024 + w * 128 + 64 + lane];
            const float sq = wave_sum(q0 * q0 + q1 * q1), sk = wave_sum(k0 * k0 + k1 * k1);
            const float rq = rsqrtf(sq * (1.f / 128.f) + 1e-6f), rk = rsqrtf(sk * (1.f / 128.f) + 1e-6f);
            float* nq = p.NQ + (size_t)row * 1024 + w * 128; float* nk = p.NK + (size_t)row * 1024 + w * 128;
            nq[lane] = q0 * rq * p.q_norm_g[lane]; nq[lane + 64] = q1 * rq * p.q_norm_g[lane + 64];
            nk[lane] = k0 * rk * p.k_norm_g[lane]; nk[lane + 64] = k1 * rk * p.k_norm_g[lane + 64];
        }
        {
            const int d = t & 127;
            float qv = pr[3072 + t], kv = pr[3584 + t];
            if (row < NLAT) {
                const int tok = row % SEQ, dd = d & 63, i = dd & 31;
                const float pos = (float)((d < 64) ? (tok / 64) : (tok % 64));
                const float invf = powf(10000.f, -(float)i / 32.f);
                const float ang = pos * invf, cs = cosf(ang), sn = sinf(ang);
                const int partner = (dd < 32) ? (t + 32) : (t - 32);
                const float qp = pr[3072 + partner], kp = pr[3584 + partner];
                if (dd < 32) { qv = qv * cs - qp * sn; kv = kv * cs - kp * sn; }
                else { qv = qv * cs + qp * sn; kv = kv * cs + kp * sn; }
            }
            p.GQ[(size_t)row * 512 + t] = qv * 0.08838834764831845f;
            p.GK[(size_t)row * 512 + t] = kv;
        }
        {
            float zf = p.bias_f[t], zb = p.bias_b[t];
#pragma unroll
            for (int r = 0; r < 16; ++r) { zf += pr[6144 + r] * p.up_f[r * 512 + t]; zb += pr[6160 + r] * p.up_b[r * 512 + t]; }
            const float lf = fminf(zf, 0.f) - log1pf(expf(-fabsf(zf))), lb = fminf(zb, 0.f) - log1pf(expf(-fabsf(zb)));
            p.AF[(size_t)row * 512 + t] = expf(lf * (1.f / 16.f));
            p.AB[(size_t)row * 512 + t] = expf(lb * (1.f / 16.f));
        }
    }
}

__device__ void ph_attn(const Params& p, float* sm) {
    const int t = threadIdx.x, w = t >> 6, lane = t & 63;
    float* qs = sm + w * 128;
    float* ps = sm + 8 * 128 + w * 384;
    int* ks = (int*)(sm + 8 * 128 + 8 * 384) + w * 384;
    for (int u = blockIdx.x; u < NB * 8 * 64 * 8; u += gridDim.x) {
        const int cg = u & 7, r = (u >> 3) & 63, h = (u >> 9) & 7, b = u >> 12;
        const int c = cg * 8 + w;
        const int qrow = b * SEQ + r * 64 + c;
        const int rs = min(max(r - 4, 0), 56), cs = min(max(c - 8, 0), 48);
        qs[lane] = p.NQ[(size_t)qrow * 1024 + h * 128 + lane]; qs[lane + 64] = p.NQ[(size_t)qrow * 1024 + h * 128 + 64 + lane];
        __syncthreads();
        float lg[6]; float mx = -INFINITY;
        const float* kp[6]; float bias[6];
#pragma unroll
        for (int i = 0; i < 6; ++i) {
            const int kk = lane + 64 * i;
            int krow; bias[i] = 0.f;
            if (kk < 128) { const int ir = kk >> 4, j = kk & 15; krow = b * SEQ + (rs + ir) * 64 + cs + j; bias[i] = p.na_rpb[(h * 15 + (rs + ir - r + 7)) * 31 + (cs + j - c + 15)]; }
            else krow = NLAT + b * CTXL + (kk - 128);
            ks[kk] = krow;
            kp[i] = p.NK + (size_t)krow * 1024 + h * 128;
            lg[i] = 0.f;
        }
#pragma unroll 1
        for (int d = 0; d < 128; d += 4) {
            const float4 q = *(const float4*)(qs + d);
#pragma unroll
            for (int i = 0; i < 6; ++i) { const float4 kv = *(const float4*)(kp[i] + d); lg[i] += q.x * kv.x + q.y * kv.y + q.z * kv.z + q.w * kv.w; }
        }
#pragma unroll
        for (int i = 0; i < 6; ++i) { lg[i] = lg[i] * 0.08838834764831845f + bias[i]; mx = fmaxf(mx, lg[i]); }
        mx = wave_max(mx);
        float se = 0.f;
#pragma unroll
        for (int i = 0; i < 6; ++i) { lg[i] = expf(lg[i] - mx); se += lg[i]; ps[lane + 64 * i] = lg[i]; }
        se = wave_sum(se);
        __syncthreads();
        float o0 = 0.f, o1 = 0.f;
        for (int kk = 0; kk < 384; ++kk) {
            const float pv = ps[kk];
            const float* vp = p.P + (size_t)ks[kk] * INC + 2048 + h * 128;
            o0 += pv * vp[lane]; o1 += pv * vp[lane + 64];
        }
        const float inv = 1.f / se;
        p.MIX[(size_t)qrow * D + h * 128 + lane] = o0 * inv;
        p.MIX[(size_t)qrow * D + h * 128 + 64 + lane] = o1 * inv;
        __syncthreads();
    }
}

__device__ void ph_gla(const Params& p) {
    const int t = threadIdx.x, vi = t >> 5, dg = t & 31;
    for (int u = blockIdx.x; u < 256; u += gridDim.x) {
        const int scan = u >> 4, vs = u & 15, dir = scan >> 3, b = (scan >> 2) & 1, h = scan & 3;
        const float* A = dir ? p.AB : p.AF;
        float* OG = dir ? p.OGB : p.OGF;
        float S0 = 0.f, S1 = 0.f, S2 = 0.f, S3 = 0.f;
        const int koff = h * 128 + dg * 4, voff = 4096 + h * 256 + vs * 16 + vi;
        for (int n = 0; n < CTXL + SEQ; ++n) {
            int row; bool lat;
            if (n < CTXL) { row = NLAT + b * CTXL + (dir ? (CTXL - 1 - n) : n); lat = false; }
            else { const int li = n - CTXL; row = b * SEQ + (dir ? (SEQ - 1 - li) : li); lat = true; }
            const float4 a = *(const float4*)(A + (size_t)row * 512 + koff);
            const float4 k = *(const float4*)(p.GK + (size_t)row * 512 + koff);
            const float v = p.P[(size_t)row * INC + voff];
            S0 = a.x * S0 + k.x * v; S1 = a.y * S1 + k.y * v; S2 = a.z * S2 + k.z * v; S3 = a.w * S3 + k.w * v;
            if (lat) {
                const float4 q = *(const float4*)(p.GQ + (size_t)row * 512 + koff);
                float o = q.x * S0 + q.y * S1 + q.z * S2 + q.w * S3;
                o += __shfl_xor(o, 16); o += __shfl_xor(o, 8); o += __shfl_xor(o, 4); o += __shfl_xor(o, 2); o += __shfl_xor(o, 1);
                if (dg == 0) OG[(size_t)row * 1024 + h * 256 + vs * 16 + vi] = o;
            }
        }
    }
}

__device__ void ph_glaout(const Params& p, float* sm) {
    const int t = threadIdx.x, w = t >> 6, lane = t & 63;
    for (int row = blockIdx.x; row < NLAT; row += gridDim.x) {
        const float o0 = p.OGF[(size_t)row * 1024 + t] + p.OGB[(size_t)row * 1024 + t];
        const float o1 = p.OGF[(size_t)row * 1024 + 512 + t] + p.OGB[(size_t)row * 1024 + 512 + t];
        const float s0 = wave_sum(o0 * o0), s1 = wave_sum(o1 * o1);
        __syncthreads();
        if (lane == 0) { sm[w] = s0; sm[8 + w] = s1; }
        __syncthreads();
        const int hb = (w >> 2) * 4;
        const float t0 = sm[hb] + sm[hb + 1] + sm[hb + 2] + sm[hb + 3], t1 = sm[8 + hb] + sm[8 + hb + 1] + sm[8 + hb + 2] + sm[8 + hb + 3];
        const float r0 = rsqrtf(t0 * (1.f / 256.f) + 1e-6f), r1 = rsqrtf(t1 * (1.f / 256.f) + 1e-6f);
        const float g = p.gla_norm_g[t & 255];
        const float ga0 = p.P[(size_t)row * INC + 5120 + t], ga1 = p.P[(size_t)row * INC + 5120 + 512 + t];
        p.MIX[(size_t)row * D + 1024 + t] = o0 * r0 * g * siluf(ga0);
        p.MIX[(size_t)row * D + 1024 + 512 + t] = o1 * r1 * g * siluf(ga1);
    }
}

__device__ void ph_outproj(const Params& p, float* sm) {
    constexpr int MT = NLAT / 128, NTI = D / 64;
    for (int u = blockIdx.x; u < MT * NTI; u += gridDim.x) {
        const int mt = u % MT, nt = u / MT;
        const float* x = p.x; const float* mod = p.mod; float* X1 = p.X1;
        gemm_tile<false>(sm, p.MIX, D, nullptr, mt * 128, 128, p.w_out, nullptr, D, nt * 64, D, D,
                         [=](int r, int n, float v, float) { const int row = mt * 128 + r; const int b = row / SEQ;
                             X1[(size_t)row * D + n] = x[(size_t)row * D + n] + mod[(size_t)b * 6 * D + 2 * D + n] * v; });
    }
}

__device__ void ph_norm2_router(const Params& p, float* sm) {
    const int t = threadIdx.x, lane = t & 63;
    float* red = sm;
    float* hrow = sm + 16;
    float* part = sm + 16 + 2048;
    for (int row = blockIdx.x; row < NLAT; row += gridDim.x) {
        const int b = row / SEQ;
        const float* m = p.mod + (size_t)b * 6 * D;
        const float4 o = rms_mod_row(p.X1 + (size_t)row * D, p.norm2_g, m + 3 * D, m + 4 * D, red);
        *(float4*)(p.H + (size_t)row * D + 4 * t) = o;
        *(float4*)(hrow + 4 * t) = o;
        __syncthreads();
        {
            const int e = t & 63, part_i = t >> 6;
            float s = 0.f;
            for (int k = part_i * 256; k < part_i * 256 + 256; ++k) s += hrow[k] * p.router_w[(size_t)k * NE + e];
            part[part_i * 64 + e] = s;
        }
        __syncthreads();
        if (t < 64) {
            float lgt = 0.f;
#pragma unroll
            for (int i = 0; i < 8; ++i) lgt += part[i * 64 + lane];
            const float sc = 1.f / (1.f + expf(-lgt));
            const float bs = sc + p.router_bias[lane];
            float m1 = bs; m1 = fmaxf(m1, __shfl_xor(m1, 1)); m1 = fmaxf(m1, __shfl_xor(m1, 2)); m1 = fmaxf(m1, __shfl_xor(m1, 4));
            int ai = (bs == m1) ? lane : 64; ai = min(ai, __shfl_xor(ai, 1)); ai = min(ai, __shfl_xor(ai, 2)); ai = min(ai, __shfl_xor(ai, 4));
            float m2 = (lane == ai) ? -INFINITY : bs; m2 = fmaxf(m2, __shfl_xor(m2, 1)); m2 = fmaxf(m2, __shfl_xor(m2, 2)); m2 = fmaxf(m2, __shfl_xor(m2, 4));
            const float gs = m1 + m2;
            float g0 = __shfl(gs, 0), g1 = __shfl(gs, 8), g2 = __shfl(gs, 16), g3 = __shfl(gs, 24), g4 = __shfl(gs, 32), g5 = __shfl(gs, 40), g6 = __shfl(gs, 48), g7 = __shfl(gs, 56);
            unsigned selmask = 0u;
#pragma unroll
            for (int it = 0; it < 4; ++it) {
                float best = -INFINITY; int bi = 0;
                if (!(selmask & 1u) && g0 > best) { best = g0; bi = 0; }
                if (!(selmask & 2u) && g1 > best) { best = g1; bi = 1; }
                if (!(selmask & 4u) && g2 > best) { best = g2; bi = 2; }
                if (!(selmask & 8u) && g3 > best) { best = g3; bi = 3; }
                if (!(selmask & 16u) && g4 > best) { best = g4; bi = 4; }
                if (!(selmask & 32u) && g5 > best) { best = g5; bi = 5; }
                if (!(selmask & 64u) && g6 > best) { best = g6; bi = 6; }
                if (!(selmask & 128u) && g7 > best) { best = g7; bi = 7; }
                selmask |= 1u << bi;
            }
            float cand = ((selmask >> (lane >> 3)) & 1u) ? bs : -INFINITY;
            int myslot = -1; float ssum = 0.f;
#pragma unroll
            for (int k = 0; k < TOPK; ++k) {
                const float mv = wave_max(cand);
                const int idx = wave_min_i((cand == mv) ? lane : 64);
                const float sv = __shfl(sc, idx);
                ssum += sv;
                if (lane == idx) { myslot = k; cand = -INFINITY; }
            }
            if (myslot >= 0) {
                p.EIDX[row * TOPK + myslot] = lane;
                p.EW[row * TOPK + myslot] = sc / ssum * 2.5f;
                atomicAdd(&p.CNT[lane], 1);
            }
        }
        __syncthreads();
    }
}

__device__ void ph_lists(const Params& p, int* smi) {
    if (threadIdx.x == 0) { int o = 0; for (int e = 0; e < NE; ++e) { smi[e] = o; o += p.CNT[e]; } }
    __syncthreads();
    for (int i = blockIdx.x * NT + threadIdx.x; i < NPAIR; i += gridDim.x * NT) {
        const int e = p.EIDX[i];
        const int pos = smi[e] + atomicAdd(&p.CUR[e], 1);
        p.PAIRPOS[i] = pos; p.LIST[pos] = i / TOPK;
    }
}

__device__ __forceinline__ void moe_tables(const Params& p, int* smi) {
    __syncthreads();
    if (threadIdx.x == 0) { int o = 0, tt = 0; for (int e = 0; e < NE; ++e) { smi[e] = o; smi[80 + e] = tt; const int c = p.CNT[e]; o += c; tt += (c + 127) / 128; } smi[64] = o; smi[80 + 64] = tt; }
    __syncthreads();
}
__device__ __forceinline__ int find_expert(const int* tp, int mt) { int e = 0; while (e < NE - 1 && tp[e + 1] <= mt) ++e; return e; }

__device__ void ph_moe_up(const Params& p, float* sm) {
    int* smi = (int*)(sm + 16 * 132 + 2 * 16 * 64);
    moe_tables(p, smi);
    const int* off = smi; const int* tp = smi + 80; const int T = tp[64];
    for (int u = blockIdx.x; u < MAXMT * 8; u += gridDim.x) {
        const int mt = u >> 3, nt = u & 7;
        if (mt >= T) break;
        const int e = find_expert(tp, mt), lt = mt - tp[e], cnt = off[e + 1] - off[e];
        const int r0 = off[e] + lt * 128, nv = min(128, cnt - lt * 128);
        float* HB = p.HB;
        gemm_tile<true>(sm, p.H, D, p.LIST + r0, 0, nv, p.ew1 + (size_t)e * D * DE, p.ew3 + (size_t)e * D * DE, DE, nt * 64, DE, D,
                        [=](int r, int n, float a, float b3) { HB[(size_t)(r0 + r) * DE + n] = siluf(a) * b3; });
    }
}
__device__ void ph_shared_up(const Params& p, float* sm) {
    for (int u = blockIdx.x; u < (NLAT / 128) * 8; u += gridDim.x) {
        const int mt = u >> 3, nt = u & 7;
        float* SHH = p.SHH;
        gemm_tile<true>(sm, p.H, D, nullptr, mt * 128, 128, p.sw1, p.sw3, DE, nt * 64, DE, D,
                        [=](int r, int n, float a, float b3) { SHH[(size_t)(mt * 128 + r) * DE + n] = siluf(a) * b3; });
    }
}
__device__ void ph_moe_down(const Params& p, float* sm) {
    int* smi = (int*)(sm + 16 * 132 + 2 * 16 * 64);
    moe_tables(p, smi);
    const int* off = smi; const int* tp = smi + 80; const int T = tp[64];
    for (int u = blockIdx.x; u < MAXMT * 32; u += gridDim.x) {
        const int mt = u >> 5, nt = u & 31;
        if (mt >= T) break;
        const int e = find_expert(tp, mt), lt = mt - tp[e], cnt = off[e + 1] - off[e];
        const int r0 = off[e] + lt * 128, nv = min(128, cnt - lt * 128);
        float* Y = p.Y;
        gemm_tile<false>(sm, p.HB, DE, nullptr, r0, nv, p.ew2 + (size_t)e * DE * D, nullptr, D, nt * 64, D, DE,
                         [=](int r, int n, float a, float) { Y[(size_t)(r0 + r) * D + n] = a; });
    }
}
__device__ void ph_final(const Params& p, float* sm) {
    for (int u = blockIdx.x; u < (NLAT / 128) * 32; u += gridDim.x) {
        const int mt = u >> 5, nt = u & 31;
        const float* X1 = p.X1; const float* mod = p.mod; const float* Y = p.Y; const float* EW = p.EW; const int* PP = p.PAIRPOS; float* out = p.out;
        gemm_tile<false>(sm, p.SHH, DE, nullptr, mt * 128, 128, p.sw2, nullptr, D, nt * 64, D, DE,
                         [=](int r, int n, float a, float) { const int row = mt * 128 + r; const int b = row / SEQ;
                             float s = a;
#pragma unroll
                             for (int k = 0; k < TOPK; ++k) s += EW[row * TOPK + k] * Y[(size_t)PP[row * TOPK + k] * D + n];
                             out[(size_t)row * D + n] = X1[(size_t)row * D + n] + mod[(size_t)b * 6 * D + 5 * D + n] * s; });
    }
}


__global__ void __launch_bounds__(NT, 2) mega(Params p) {
    __shared__ __attribute__((aligned(16))) float smem[4 + 7168];
    if (threadIdx.x < 4) ((unsigned*)smem)[threadIdx.x] = 0u;
    __syncthreads();
    XcdBarrier bar = xcd_barrier_post(p.bar, (volatile LAS unsigned*)smem);
    float* sm = smem + 4;
    ph_adaln_partial(p, sm);   xcd_barrier(bar);
    ph_adaln_reduce(p);        xcd_barrier(bar);
    ph_norm1(p, sm);           xcd_barrier(bar);
    ph_inproj(p, sm);          xcd_barrier(bar);
    ph_postproj(p, sm);        xcd_barrier(bar);
    ph_gla(p); ph_attn(p, sm); xcd_barrier(bar);
    ph_glaout(p, sm);          xcd_barrier(bar);
    ph_outproj(p, sm);         xcd_barrier(bar);
    ph_norm2_router(p, sm);    xcd_barrier(bar);
    ph_lists(p, (int*)sm);     xcd_barrier(bar);
    ph_moe_up(p, sm); ph_shared_up(p, sm); xcd_barrier(bar);
    ph_moe_down(p, sm);        xcd_barrier(bar);
    ph_final(p, sm);
}

extern "C" void kernel_launch(void* const* d_in, const int* in_sizes, int n_in, void* d_out, int out_size, void* d_ws, size_t ws_size, hipStream_t stream) {
    Params p{};
    const float* const* in = (const float* const*)d_in;
    p.x = in[0]; p.c = in[1]; p.ctx = in[2]; p.c_ctx = in[3]; p.w_mod = in[4]; p.b_mod = in[5]; p.norm1_g = in[6]; p.norm2_g = in[7]; p.w_in = in[8];
    p.q_norm_g = in[9]; p.k_norm_g = in[10]; p.na_rpb = in[11]; p.up_f = in[12]; p.bias_f = in[13]; p.up_b = in[14]; p.bias_b = in[15]; p.gla_norm_g = in[16];
    p.w_out = in[17]; p.router_w = in[18]; p.router_bias = in[19]; p.ew1 = in[20]; p.ew3 = in[21]; p.ew2 = in[22]; p.sw1 = in[23]; p.sw3 = in[24]; p.sw2 = in[25];
    p.out = (float*)d_out;
    char* w = (char*)d_ws; size_t o = 0;
    auto take = [&](size_t bytes) { void* r = w + o; o += (bytes + 255) & ~(size_t)255; return r; };
    p.bar = (unsigned*)take((size_t)XCD_BAR_WORDS * 4);
    p.CNT = (int*)take(64 * 4); p.CUR = (int*)take(64 * 4);
    p.modp = (float*)take((size_t)16 * 3 * 6 * D * 4); p.mod = (float*)take((size_t)3 * 6 * D * 4);
    p.EIDX = (int*)take((size_t)NPAIR * 4); p.EW = (float*)take((size_t)NPAIR * 4); p.PAIRPOS = (int*)take((size_t)NPAIR * 4); p.LIST = (int*)take((size_t)NPAIR * 4);
    p.H = (float*)take((size_t)NROW * D * 4);
    p.X1 = (float*)take((size_t)NLAT * D * 4);
    const size_t big = o;
    p.P = (float*)take((size_t)NROW * INC * 4); p.NQ = (float*)take((size_t)NROW * 1024 * 4); p.NK = (float*)take((size_t)NROW * 1024 * 4);
    p.GQ = (float*)take((size_t)NROW * 512 * 4); p.GK = (float*)take((size_t)NROW * 512 * 4); p.AF = (float*)take((size_t)NROW * 512 * 4); p.AB = (float*)take((size_t)NROW * 512 * 4);
    p.MIX = (float*)take((size_t)NLAT * D * 4); p.OGF = (float*)take((size_t)NLAT * 1024 * 4); p.OGB = (float*)take((size_t)NLAT * 1024 * 4);
    o = big;
    p.HB = (float*)take((size_t)NPAIR * DE * 4); p.SHH = (float*)take((size_t)NLAT * DE * 4); p.Y = (float*)take((size_t)NPAIR * D * 4);
    static int grid = 0;
    if (!grid) {
        int dev = 0, cus = 0, per_cu = 0;
        hipGetDevice(&dev);
        hipDeviceGetAttribute(&cus, hipDeviceAttributeMultiprocessorCount, dev);
        hipOccupancyMaxActiveBlocksPerMultiprocessor(&per_cu, mega, NT, 0);
        if (per_cu < 1) per_cu = 1;
        grid = cus * (per_cu < 2 ? per_cu : 2);
    }
    hipMemsetAsync(p.bar, 0, (size_t)XCD_BAR_WORDS * 4, stream);
    mega<<<grid, NT, 0, stream>>>(p);
}
```

```cpp
#include <hip/hip_runtime.h>
#include <stdint.h>

#define XB_TMO      128
#define XB_XCNT(j)  (256  + 64 * (j))
#define XB_XSUB(j)  (1280 + 64 * (j))
#define XB_XGEN(j)  (2304 + 64 * (j))
#define XB_TOP      3328
#define XB_TOPGEN   3392
#define XCD_BAR_WORDS 3456
#define XB_SPIN_CAP (1u << 18)
#define LAS __attribute__((address_space(3)))

__device__ __forceinline__ unsigned xb_ld(unsigned* p)              { return __hip_atomic_load(p, __ATOMIC_RELAXED, __HIP_MEMORY_SCOPE_AGENT); }
__device__ __forceinline__ unsigned xb_add(unsigned* p, unsigned v) { return __hip_atomic_fetch_add(p, v, __ATOMIC_RELAXED, __HIP_MEMORY_SCOPE_AGENT); }
__device__ __forceinline__ unsigned xb_xcc_id() { return (unsigned)__builtin_amdgcn_s_getreg((3 << 11) | 20) & 0xFu; }
#define XB_SPIN(cond, bar) do { unsigned _sp = 0; while (cond) { __builtin_amdgcn_s_sleep(1); \
    if ((++_sp & 255u) == 0u) { if (xb_ld(&(bar)[XB_TMO])) break; if (_sp > XB_SPIN_CAP) { atomicAdd(&(bar)[XB_TMO], 1u); break; } } } } while (0)

struct XcdBarrier {
    unsigned* bar; unsigned x;
    volatile LAS unsigned* st;
};

__device__ __forceinline__ XcdBarrier xcd_barrier_post(unsigned* bar, volatile LAS unsigned* st) {
    XcdBarrier b; b.bar = bar; b.x = xb_xcc_id(); b.st = st;
    if (threadIdx.x == 0) (void)xb_add(&bar[XB_XCNT(b.x)], 1u);
    return b;
}
__device__ __forceinline__ void xcd_barrier_complete(unsigned* bar, unsigned x, unsigned& nloc, unsigned& nx) {
    const unsigned G = gridDim.x * gridDim.y * gridDim.z;
    unsigned sum, cnt, mine, sp = 0u;
    for (;;) {
        sum = 0u; cnt = 0u; mine = 0u;
#pragma unroll
        for (unsigned j = 0; j < 16; ++j) { const unsigned c = xb_ld(&bar[XB_XCNT(j)]); sum += c; cnt += (c > 0u) ? 1u : 0u; mine = (j == x) ? c : mine; }
        if (sum == G) break;
        __builtin_amdgcn_s_sleep(1);
        if ((++sp & 255u) == 0u) { if (xb_ld(&bar[XB_TMO])) break; if (sp > XB_SPIN_CAP) { atomicAdd(&bar[XB_TMO], 1u); break; } }
    }
    nloc = mine > 0u ? mine : 1u; nx = cnt > 0u ? cnt : 1u;
}

__device__ __forceinline__ void xcd_barrier(const XcdBarrier& b) {
    asm volatile("s_waitcnt vmcnt(0)" ::: "memory");
    __syncthreads();
    if (threadIdx.x == 0) {
        unsigned* bar = b.bar;
        __builtin_amdgcn_s_waitcnt(0);
        unsigned nloc = b.st[0], nx = b.st[1];
        if (nloc == 0u) { xcd_barrier_complete(bar, b.x, nloc, nx); b.st[0] = nloc; b.st[1] = nx; }
        const unsigned old = xb_add(&bar[XB_XSUB(b.x)], 1u);
        const unsigned gen = old / nloc;
        if (old + 1u == (gen + 1u) * nloc) {
            __builtin_amdgcn_fence(__ATOMIC_RELEASE, "agent");
            asm volatile("s_waitcnt vmcnt(0)" ::: "memory");
            const unsigned og = xb_add(&bar[XB_TOP], 1u);
            const unsigned tg = og / nx;
            if (og + 1u == (tg + 1u) * nx) xb_add(&bar[XB_TOPGEN], 1u);
            else XB_SPIN(xb_ld(&bar[XB_TOPGEN]) == tg, bar);
            __builtin_amdgcn_fence(__ATOMIC_ACQUIRE, "agent");
            xb_add(&bar[XB_XGEN(b.x)], 1u);
            asm volatile("s_waitcnt vmcnt(0)" ::: "memory");
        } else {
            XB_SPIN(xb_ld(&bar[XB_XGEN(b.x)]) == gen, bar);
            __builtin_amdgcn_fence(__ATOMIC_ACQUIRE, "agent");
            asm volatile("s_waitcnt vmcnt(0)" ::: "memory");
        }
    }
    __syncthreads();
}


#define NT 512
typedef unsigned short bf16_t;
typedef short bf16x8 __attribute__((ext_vector_type(8)));
typedef float f32x4 __attribute__((ext_vector_type(4)));
typedef unsigned u32x4 __attribute__((ext_vector_type(4)));
typedef unsigned u32x2 __attribute__((ext_vector_type(2)));

constexpr int D = 2048, SEQ = 4096, CTXL = 256, NB = 2;
constexpr int NLAT = NB * SEQ;
constexpr int NCTX = NB * CTXL;
constexpr int NROW = NLAT + NCTX;
constexpr int INC = 6176;
constexpr int PLD = 6144;
constexpr int NE = 64, TOPK = 6, DE = 512;
constexpr int NPAIR = NLAT * TOPK;
constexpr int PADROWS = NPAIR + NE * 256;
constexpr int LDS_STAGE = 131072;
constexpr int LDS_TAB = LDS_STAGE;
constexpr int LDS_BARW = LDS_STAGE + 4096;
constexpr int LDS_BYTES = LDS_BARW + 16 + 8192;

struct Params {
    const float *x, *c, *ctx, *c_ctx, *w_mod, *b_mod, *norm1_g, *norm2_g, *w_in, *q_norm_g, *k_norm_g, *na_rpb,
        *up_f, *bias_f, *up_b, *bias_b, *gla_norm_g, *w_out, *router_w, *router_bias, *ew1, *ew3, *ew2, *sw1, *sw3, *sw2;
    float* out;
    float *mod, *X1, *P, *DD, *NQ, *NK, *GQ, *GK, *AF, *AB, *OGF, *OGB, *EW;
    bf16_t *H, *MIX, *HB, *SHH, *Y, *WinT, *WoutT, *S13T, *S2T, *E13T, *E2T;
    int *EIDX, *PAIRPOS, *LIST, *CNT, *CUR;
    unsigned* bar;
};

__device__ __forceinline__ float wave_sum(float v) { for (int o = 32; o > 0; o >>= 1) v += __shfl_xor(v, o); return v; }
__device__ __forceinline__ float wave_max(float v) { for (int o = 32; o > 0; o >>= 1) v = fmaxf(v, __shfl_xor(v, o)); return v; }
__device__ __forceinline__ int wave_min_i(int v) { for (int o = 32; o > 0; o >>= 1) v = min(v, __shfl_xor(v, o)); return v; }
__device__ __forceinline__ float siluf(float v) { return v / (1.f + expf(-v)); }
__device__ __forceinline__ unsigned cvt_pk_bf16(float lo, float hi) { unsigned r; asm volatile("v_cvt_pk_bf16_f32 %0, %1, %2" : "=v"(r) : "v"(lo), "v"(hi)); return r; }
__device__ __forceinline__ bf16_t f2bf(float f) { return (bf16_t)(cvt_pk_bf16(f, 0.f) & 0xffffu); }
__device__ __forceinline__ float bf2f(unsigned b) { return __uint_as_float(b << 16); }

__device__ __forceinline__ void adaln_item(const Params& p, float* sm, int item) {
    const int t = threadIdx.x, cq = t & 15, kg = t >> 4, n0 = item * 64;
    float* red = sm + 3 * D;
    float a[3][4];
#pragma unroll
    for (int r = 0; r < 3; ++r)
#pragma unroll
        for (int j = 0; j < 4; ++j) a[r][j] = 0.f;
#pragma unroll 4
    for (int k = kg; k < D; k += 32) {
        const float4 w = *(const float4*)(p.w_mod + (size_t)k * (6 * D) + n0 + 4 * cq);
        const float s0 = sm[k], s1 = sm[D + k], s2 = sm[2 * D + k];
        a[0][0] += s0 * w.x; a[0][1] += s0 * w.y; a[0][2] += s0 * w.z; a[0][3] += s0 * w.w;
        a[1][0] += s1 * w.x; a[1][1] += s1 * w.y; a[1][2] += s1 * w.z; a[1][3] += s1 * w.w;
        a[2][0] += s2 * w.x; a[2][1] += s2 * w.y; a[2][2] += s2 * w.z; a[2][3] += s2 * w.w;
    }
    __syncthreads();
#pragma unroll
    for (int r = 0; r < 3; ++r)
#pragma unroll
        for (int j = 0; j < 4; ++j) red[(kg * 3 + r) * 64 + 4 * cq + j] = a[r][j];
    __syncthreads();
    if (t < 192) {
        const int r = t >> 6, cc = t & 63;
        float s = p.b_mod[n0 + cc];
#pragma unroll 8
        for (int g = 0; g < 32; ++g) s += red[(g * 3 + r) * 64 + cc];
        p.mod[(size_t)r * 6 * D + n0 + cc] = s;
    }
    __syncthreads();
}
__device__ __forceinline__ void transpose_item(const float* W, int K, int N, int k0, int n0, bf16_t* WT, int drow0, float* scr, int lane) {
#pragma unroll 8
    for (int kk = 0; kk < 64; ++kk) scr[kk * 65 + lane] = W[(size_t)(k0 + kk) * N + n0 + lane];
    asm volatile("s_waitcnt lgkmcnt(0)" ::: "memory");
    const int c = lane & 7;
#pragma unroll
    for (int j = 0; j < 8; ++j) {
        const int n = (lane >> 3) + 8 * j; const float* s = scr + (8 * c) * 65 + n;
        u32x4 o; o.x = cvt_pk_bf16(s[0], s[65]); o.y = cvt_pk_bf16(s[2 * 65], s[3 * 65]); o.z = cvt_pk_bf16(s[4 * 65], s[5 * 65]); o.w = cvt_pk_bf16(s[6 * 65], s[7 * 65]);
        *(u32x4*)(WT + (size_t)(drow0 + n) * K + k0 + 8 * c) = o;
    }
    asm volatile("s_waitcnt lgkmcnt(0)" ::: "memory");
}
constexpr int CI_WIN = 32 * 96, CI_WOUT = 32 * 32, CI_S13 = 2 * 32 * 8, CI_S2 = 8 * 32, CI_E13 = 64 * 2 * 32 * 8, CI_E2 = 64 * 8 * 32;
constexpr int CI_TOTAL = CI_WIN + CI_WOUT + CI_S13 + CI_S2 + CI_E13 + CI_E2;
__device__ __forceinline__ void convert_item(const Params& p, int it, float* scr, int lane) {
    if (it < CI_WIN) { const int kb = it / 96, nb = it % 96; transpose_item(p.w_in, D, INC, 64 * kb, 64 * nb, p.WinT, 64 * nb, scr, lane); return; }
    it -= CI_WIN;
    if (it < CI_WOUT) { const int kb = it / 32, nb = it % 32; transpose_item(p.w_out, D, D, 64 * kb, 64 * nb, p.WoutT, 64 * nb, scr, lane); return; }
    it -= CI_WOUT;
    if (it < CI_S13) {
        const int which = it / 256, r = it % 256, kb = r / 8, nb = r % 8;
        transpose_item(which ? p.sw3 : p.sw1, D, DE, 64 * kb, 64 * nb, p.S13T, (nb >> 1) * 256 + which * 128 + (nb & 1) * 64, scr, lane); return; }
    it -= CI_S13;
    if (it < CI_S2) { const int kb = it / 32, nb = it % 32; transpose_item(p.sw2, DE, D, 64 * kb, 64 * nb, p.S2T, 64 * nb, scr, lane); return; }
    it -= CI_S2;
    if (it < CI_E13) {
        const int e = it / 512, r0 = it % 512, which = r0 / 256, r = r0 % 256, kb = r / 8, nb = r % 8;
        transpose_item((which ? p.ew3 : p.ew1) + (size_t)e * D * DE, D, DE, 64 * kb, 64 * nb, p.E13T + (size_t)e * 1024 * D, (nb >> 1) * 256 + which * 128 + (nb & 1) * 64, scr, lane); return; }
    it -= CI_E13;
    { const int e = it / 256, r = it % 256, kb = r / 32, nb = r % 32;
      transpose_item(p.ew2 + (size_t)e * DE * D, DE, D, 64 * kb, 64 * nb, p.E2T + (size_t)e * D * DE, 64 * nb, scr, lane); }
}
__device__ void ph_prologue(const Params& p, float* sm) {
    const int t = threadIdx.x, w = t >> 6, lane = t & 63;
    if (blockIdx.x == 0 && t < 128) { if (t < 64) p.CNT[t] = 0; else p.CUR[t - 64] = 0; }
    if (blockIdx.x < 192) {
        for (int i = t; i < 3 * D; i += NT) { const int r = i / D, k = i % D; sm[i] = siluf(r < 2 ? p.c[r * D + k] : p.c_ctx[k]); }
        __syncthreads();
        for (int item = blockIdx.x; item < 192; item += gridDim.x) adaln_item(p, sm, item);
    }
    __syncthreads();
    float* scr = sm + w * (64 * 65);
    for (int it = blockIdx.x * 8 + w; it < CI_TOTAL; it += gridDim.x * 8) convert_item(p, it, scr, lane);
}

__device__ void ph_norm1(const Params& p, float* sm) {
    const int t = threadIdx.x, w = t >> 6, lane = t & 63;
    float* hs = sm; float* red = sm + 8 * D;
    for (int rb = blockIdx.x; rb < NROW / 8; rb += gridDim.x) {
        const int row = rb * 8 + w;
        const float* src; int mr;
        if (row < NLAT) { src = p.x + (size_t)row * D; mr = row / SEQ; } else { src = p.ctx + (size_t)(row - NLAT) * D; mr = 2; }
        const float* m = p.mod + (size_t)mr * 6 * D;
        float4 v[8]; float ss = 0.f;
#pragma unroll
        for (int j = 0; j < 8; ++j) { v[j] = *(const float4*)(src + 256 * j + 4 * lane); ss += v[j].x * v[j].x + v[j].y * v[j].y + v[j].z * v[j].z + v[j].w * v[j].w; }
        ss = wave_sum(ss);
        const float rs = rsqrtf(ss * (1.f / D) + 1e-6f);
        __syncthreads();
#pragma unroll
        for (int j = 0; j < 8; ++j) {
            const int col = 256 * j + 4 * lane;
            const float4 g = *(const float4*)(p.norm1_g + col), sh = *(const float4*)(m + col), sc = *(const float4*)(m + D + col);
            float4 o;
            o.x = v[j].x * rs * g.x * (1.f + sc.x) + sh.x; o.y = v[j].y * rs * g.y * (1.f + sc.y) + sh.y;
            o.z = v[j].z * rs * g.z * (1.f + sc.z) + sh.z; o.w = v[j].w * rs * g.w * (1.f + sc.w) + sh.w;
            *(float4*)(hs + w * D + col) = o;
            u32x2 pk; pk.x = cvt_pk_bf16(o.x, o.y); pk.y = cvt_pk_bf16(o.z, o.w);
            *(u32x2*)(p.H + (size_t)row * D + col) = pk;
        }
        __syncthreads();
        {
            const int j = t & 31, kp = t >> 5;
            float a[8];
#pragma unroll
            for (int r = 0; r < 8; ++r) a[r] = 0.f;
#pragma unroll 4
            for (int k = kp * 128; k < kp * 128 + 128; ++k) {
                const float wv = p.w_in[(size_t)k * INC + PLD + j];
#pragma unroll
                for (int r = 0; r < 8; ++r) a[r] += hs[r * D + k] * wv;
            }
#pragma unroll
            for (int r = 0; r < 8; ++r) red[(kp * 8 + r) * 32 + j] = a[r];
        }
        __syncthreads();
        if (t < 256) {
            const int r = t >> 5, j = t & 31; float s = 0.f;
#pragma unroll
            for (int kp = 0; kp < 16; ++kp) s += red[(kp * 8 + r) * 32 + j];
            p.DD[(size_t)(rb * 8 + r) * 32 + j] = s;
        }
    }
}

namespace g8 {
constexpr int BM = 256, BK = 64, HALF = 128, HTB = HALF * BK * 2;
__device__ __forceinline__ int lds_byte(int r, int c) { const int st = (r >> 4) * 2 + (c >> 5), rr = r & 15, cc = c & 31, ob = rr * 64 + cc * 2; return st * 1024 + (ob ^ (((ob >> 9) & 1) << 5)); }
__device__ __forceinline__ void stage_rc(int b, int& R, int& C) { const int st = b / 1024, sb = b % 1024, swz = sb ^ (((sb >> 9) & 1) << 5); R = (st >> 1) * 16 + swz / 64; C = (st & 1) * 32 + (swz % 64) / 2; }
__device__ __forceinline__ int perm32(int rho) { const int n = rho >> 4, i = rho & 15; return 8 * (i >> 2) + 4 * n + (i & 3); }

struct Unit { const char* A; const int* rows; int row0; const char* Bt; int orow, pn, aux; };

__device__ __forceinline__ bool work_id(int i, int G, int c, int nwg, int& wgid) {
    const long L = (long)i * G + c; if (L >= nwg) return false;
    const int l = (int)L, q = nwg / 8, r = nwg % 8, xcd = l % 8, off = l / 8;
    wgid = (xcd < r ? xcd * (q + 1) : r * (q + 1) + (xcd - r) * q) + off; return true;
}

template <class Epi, class Sched>
__device__ __forceinline__ void gemm_phase(LAS unsigned char* lds, const int K, const Sched& S, const Epi& E) {
    const int tid = threadIdx.x, wid = __builtin_amdgcn_readfirstlane(tid >> 6), lane = tid & 63, wr = wid >> 2, wc = wid & 3, fr = lane & 15, fq = lane >> 4;
    const int nt = K / BK;
    int sR[2]; unsigned sC2[2], voffB[2];
#pragma unroll
    for (int i = 0; i < 2; ++i) { int R, C; stage_rc(tid * 16 + i * 8192, R, C); const int Rb = Epi::PERM ? ((R & ~31) + perm32(R & 31)) : R;
        sR[i] = R; sC2[i] = (unsigned)C * 2u; voffB[i] = (unsigned)(Rb * K + C) * 2u; }
    const size_t kstep = (size_t)(BK * 2);
    const size_t hstep = (size_t)HALF * K * 2;
    const unsigned ldsw = (unsigned)wid * 1024u;
    const int aoff = lds_byte(wr * 64 + fr, fq * 8), boff = lds_byte(wc * 32 + fr, fq * 8);
#define G8_SA(b, h) (((b) * 2 + (h)) * g8::HTB)
#define G8_SB(b, h) ((4 + (b) * 2 + (h)) * g8::HTB)
#define G8_STAGE(bufoff, gbase, v0, v1) do { \
        __builtin_amdgcn_global_load_lds((const unsigned*)((const char*)(gbase) + (v0)), (LAS unsigned*)(lds + (bufoff) + ldsw), 16, 0, 0); \
        __builtin_amdgcn_global_load_lds((const unsigned*)((const char*)(gbase) + (v1)), (LAS unsigned*)(lds + (bufoff) + ldsw + 8192), 16, 0, 0); } while (0)
#define G8_LDA(dst, b, h) do { _Pragma("unroll") for (int m = 0; m < 4; ++m) _Pragma("unroll") for (int k = 0; k < 2; ++k) dst[m][k] = *(const LAS bf16x8*)(lds + G8_SA(b, h) + aoff + m * 2048 + k * 1024); } while (0)
#define G8_LDB(dst, b, h) do { _Pragma("unroll") for (int n = 0; n < 2; ++n) _Pragma("unroll") for (int k = 0; k < 2; ++k) dst[n][k] = *(const LAS bf16x8*)(lds + G8_SB(b, h) + boff + n * 2048 + k * 1024); } while (0)
#define G8_MMA(ai, bj, At, Bt) do { __builtin_amdgcn_s_setprio(1); _Pragma("unroll") for (int m = 0; m < 4; ++m) _Pragma("unroll") for (int n = 0; n < 2; ++n) _Pragma("unroll") for (int k = 0; k < 2; ++k) \
        acc[ai][bj][m][n] = __builtin_amdgcn_mfma_f32_16x16x32_bf16(Bt[n][k], At[m][k], acc[ai][bj][m][n], 0, 0, 0); __builtin_amdgcn_s_setprio(0); } while (0)
#define G8_WAIT_V(n) asm volatile("s_waitcnt vmcnt(" #n ")" ::: "memory")
#define G8_WAIT_L(n) asm volatile("s_waitcnt lgkmcnt(" #n ")" ::: "memory")
#define G8_BAR __builtin_amdgcn_s_barrier()
#define G8_SCHED __builtin_amdgcn_sched_barrier(0)
    Unit cur, nxt; int ui = 0;
    if (!S.next(0, cur)) return;
    f32x4 acc[2][2][4][2];
#pragma unroll
    for (int a = 0; a < 2; ++a)
#pragma unroll
        for (int b = 0; b < 2; ++b)
#pragma unroll
            for (int m = 0; m < 4; ++m)
#pragma unroll
                for (int n = 0; n < 2; ++n) acc[a][b][m][n] = (f32x4){0.f, 0.f, 0.f, 0.f};
    bf16x8 At[4][2], B0[2][2], B1[2][2];
    unsigned vA00, vA01, vA10, vA11, nA00, nA01, nA10, nA11;
#define G8_MKOFF(u, o00, o01, o10, o11) do { \
        int r00, r01, r10, r11; \
        if ((u).rows) { r00 = (u).rows[sR[0]]; r01 = (u).rows[sR[1]]; r10 = (u).rows[128 + sR[0]]; r11 = (u).rows[128 + sR[1]]; } \
        else { r00 = (u).row0 + sR[0]; r01 = (u).row0 + sR[1]; r10 = (u).row0 + 128 + sR[0]; r11 = (u).row0 + 128 + sR[1]; } \
        o00 = (unsigned)r00 * (unsigned)(K * 2) + sC2[0]; o01 = (unsigned)r01 * (unsigned)(K * 2) + sC2[1]; \
        o10 = (unsigned)r10 * (unsigned)(K * 2) + sC2[0]; o11 = (unsigned)r11 * (unsigned)(K * 2) + sC2[1]; } while (0)
    G8_MKOFF(cur, vA00, vA01, vA10, vA11);
    const char* cA = cur.A; const char* cB = cur.Bt;
    G8_STAGE(G8_SB(0, 0), cB, voffB[0], voffB[1]); G8_STAGE(G8_SA(0, 0), cA, vA00, vA01); G8_STAGE(G8_SB(0, 1), cB + hstep, voffB[0], voffB[1]); G8_STAGE(G8_SA(0, 1), cA, vA10, vA11);
    if (wr == 1) G8_BAR;
    G8_WAIT_V(4); G8_BAR;
    G8_STAGE(G8_SB(1, 0), cB + kstep, voffB[0], voffB[1]); G8_STAGE(G8_SA(1, 0), cA + kstep, vA00, vA01); G8_STAGE(G8_SB(1, 1), cB + hstep + kstep, voffB[0], voffB[1]);
    G8_WAIT_V(6); G8_BAR;
    for (;;) {
        const bool has_next = S.next(ui + 1, nxt);
        const char* nA = has_next ? nxt.A : cA; const char* nB = has_next ? nxt.Bt : cB;
        if (has_next) G8_MKOFF(nxt, nA00, nA01, nA10, nA11); else { nA00 = vA00; nA01 = vA01; nA10 = vA10; nA11 = vA11; }
        for (int t = 0; t < nt; t += 2) {
            const bool last = (t == nt - 2);
            const char* a1 = cA + (size_t)(t + 1) * kstep;
            G8_LDB(B0, 0, 0); G8_SCHED; G8_LDA(At, 0, 0); G8_STAGE(G8_SA(1, 1), a1, vA10, vA11);
            G8_WAIT_L(8); G8_BAR; G8_WAIT_L(0); G8_MMA(0, 0, At, B0); G8_BAR; G8_SCHED;
            if (last) { vA00 = nA00; vA01 = nA01; vA10 = nA10; vA11 = nA11; }
            const char* a2 = last ? nA : cA + (size_t)(t + 2) * kstep; const char* b2 = last ? nB : cB + (size_t)(t + 2) * kstep;
            const char* a3 = a2 + kstep; const char* b3 = b2 + kstep;
            G8_LDB(B1, 0, 1); G8_STAGE(G8_SB(0, 0), b2, voffB[0], voffB[1]);
            G8_BAR; G8_WAIT_L(0); G8_MMA(0, 1, At, B1); G8_BAR;
            G8_LDA(At, 0, 1); G8_STAGE(G8_SA(0, 0), a2, vA00, vA01);
            G8_BAR; G8_WAIT_L(0); G8_MMA(1, 0, At, B0); G8_BAR; G8_SCHED;
            G8_STAGE(G8_SB(0, 1), b2 + hstep, voffB[0], voffB[1]);
            G8_WAIT_V(6); G8_BAR; G8_MMA(1, 1, At, B1); G8_BAR;
            G8_LDB(B0, 1, 0); G8_SCHED; G8_LDA(At, 1, 0); G8_STAGE(G8_SA(0, 1), a2, vA10, vA11);
            G8_WAIT_L(8); G8_BAR; G8_WAIT_L(0); G8_MMA(0, 0, At, B0); G8_BAR; G8_SCHED;
            G8_LDB(B1, 1, 1); G8_STAGE(G8_SB(1, 0), b3, voffB[0], voffB[1]);
            G8_BAR; G8_WAIT_L(0); G8_MMA(0, 1, At, B1); G8_BAR;
            G8_LDA(At, 1, 1); G8_STAGE(G8_SA(1, 0), a3, vA00, vA01);
            G8_BAR; G8_WAIT_L(0); G8_MMA(1, 0, At, B0); G8_BAR; G8_SCHED;
            G8_STAGE(G8_SB(1, 1), b3 + hstep, voffB[0], voffB[1]);
            G8_WAIT_V(6); G8_BAR; G8_MMA(1, 1, At, B1); G8_BAR;
        }
        E(acc, cur, wr, wc, fr, fq);
        if (!has_next) break;
#pragma unroll
        for (int a = 0; a < 2; ++a)
#pragma unroll
            for (int b = 0; b < 2; ++b)
#pragma unroll
                for (int m = 0; m < 4; ++m)
#pragma unroll
                    for (int n = 0; n < 2; ++n) acc[a][b][m][n] = (f32x4){0.f, 0.f, 0.f, 0.f};
        cur = nxt; cA = nA; cB = nB; ++ui;
    }
    G8_WAIT_V(0);
    if (wr == 0) G8_BAR;
    G8_BAR;
}
}

struct EpiInproj {
    static constexpr bool PERM = false;
    float* P;
    __device__ __forceinline__ void operator()(const f32x4 (&acc)[2][2][4][2], const g8::Unit& u, int wr, int wc, int fr, int fq) const {
#pragma unroll
        for (int ai = 0; ai < 2; ++ai)
#pragma unroll
            for (int m = 0; m < 4; ++m) { float* rowp = P + (size_t)(u.orow + ai * 128 + wr * 64 + m * 16 + fr) * PLD + u.pn * 256 + wc * 32 + 4 * fq;
#pragma unroll
                for (int bj = 0; bj < 2; ++bj)
#pragma unroll
                    for (int n = 0; n < 2; ++n) *(f32x4*)(rowp + bj * 128 + n * 16) = acc[ai][bj][m][n]; }
    }
};
struct EpiOutproj {
    static constexpr bool PERM = false;
    const float* x; const float* mod; float* X1;
    __device__ __forceinline__ void operator()(const f32x4 (&acc)[2][2][4][2], const g8::Unit& u, int wr, int wc, int fr, int fq) const {
        const int b = u.orow / SEQ; const int col0 = u.pn * 256 + wc * 32 + 4 * fq;
        f32x4 gv[2][2];
#pragma unroll
        for (int bj = 0; bj < 2; ++bj)
#pragma unroll
            for (int n = 0; n < 2; ++n) gv[bj][n] = *(const f32x4*)(mod + (size_t)b * 6 * D + 2 * D + col0 + bj * 128 + n * 16);
#pragma unroll
        for (int ai = 0; ai < 2; ++ai)
#pragma unroll
            for (int m = 0; m < 4; ++m) { const size_t ro = (size_t)(u.orow + ai * 128 + wr * 64 + m * 16 + fr) * D + col0;
#pragma unroll
                for (int bj = 0; bj < 2; ++bj)
#pragma unroll
                    for (int n = 0; n < 2; ++n) { const f32x4 xv = *(const f32x4*)(x + ro + bj * 128 + n * 16);
                        *(f32x4*)(X1 + ro + bj * 128 + n * 16) = xv + gv[bj][n] * acc[ai][bj][m][n]; } }
    }
};
struct EpiUp {
    static constexpr bool PERM = true;
    bf16_t* HB; bf16_t* SHH;
    __device__ __forceinline__ void operator()(const f32x4 (&acc)[2][2][4][2], const g8::Unit& u, int wr, int wc, int fr, int fq) const {
        bf16_t* O = u.aux ? SHH : HB;
#pragma unroll
        for (int ai = 0; ai < 2; ++ai)
#pragma unroll
            for (int m = 0; m < 4; ++m) {
                f32x4 h0, h1;
#pragma unroll
                for (int j = 0; j < 4; ++j) { h0[j] = siluf(acc[ai][0][m][0][j]) * acc[ai][1][m][0][j]; h1[j] = siluf(acc[ai][0][m][1][j]) * acc[ai][1][m][1][j]; }
                u32x4 w; w.x = cvt_pk_bf16(h0[0], h0[1]); w.y = cvt_pk_bf16(h0[2], h0[3]); w.z = cvt_pk_bf16(h1[0], h1[1]); w.w = cvt_pk_bf16(h1[2], h1[3]);
                *(u32x4*)(O + (size_t)(u.orow + ai * 128 + wr * 64 + m * 16 + fr) * DE + u.pn * 128 + wc * 32 + 8 * fq) = w;
            }
    }
};
struct EpiDown {
    static constexpr bool PERM = true;
    bf16_t* Y;
    __device__ __forceinline__ void operator()(const f32x4 (&acc)[2][2][4][2], const g8::Unit& u, int wr, int wc, int fr, int fq) const {
#pragma unroll
        for (int ai = 0; ai < 2; ++ai)
#pragma unroll
            for (int m = 0; m < 4; ++m) { bf16_t* rowp = Y + (size_t)(u.orow + ai * 128 + wr * 64 + m * 16 + fr) * D + u.pn * 256 + wc * 32 + 8 * fq;
#pragma unroll
                for (int bj = 0; bj < 2; ++bj) { const f32x4 v0 = acc[ai][bj][m][0], v1 = acc[ai][bj][m][1];
                    u32x4 w; w.x = cvt_pk_bf16(v0[0], v0[1]); w.y = cvt_pk_bf16(v0[2], v0[3]); w.z = cvt_pk_bf16(v1[0], v1[1]); w.w = cvt_pk_bf16(v1[2], v1[3]);
                    *(u32x4*)(rowp + bj * 128) = w; } }
    }
};
struct EpiFinal {
    static constexpr bool PERM = false;
    const float* X1; const float* mod; const bf16_t* Y; const float* EW; const int* PP; float* out;
    __device__ __forceinline__ void operator()(const f32x4 (&acc)[2][2][4][2], const g8::Unit& u, int wr, int wc, int fr, int fq) const {
        const int b = u.orow / SEQ; const int col0 = u.pn * 256 + wc * 32 + 4 * fq;
        f32x4 gv[2][2];
#pragma unroll
        for (int bj = 0; bj < 2; ++bj)
#pragma unroll
            for (int n = 0; n < 2; ++n) gv[bj][n] = *(const f32x4*)(mod + (size_t)b * 6 * D + 5 * D + col0 + bj * 128 + n * 16);
#pragma unroll
        for (int ai = 0; ai < 2; ++ai)
#pragma unroll
            for (int m = 0; m < 4; ++m) {
                const int row = u.orow + ai * 128 + wr * 64 + m * 16 + fr;
                f32x4 s[2][2];
#pragma unroll
                for (int bj = 0; bj < 2; ++bj)
#pragma unroll
                    for (int n = 0; n < 2; ++n) s[bj][n] = acc[ai][bj][m][n];
#pragma unroll
                for (int k = 0; k < TOPK; ++k) {
                    const float wk = EW[row * TOPK + k]; const bf16_t* yr = Y + (size_t)PP[row * TOPK + k] * D + col0;
#pragma unroll
                    for (int bj = 0; bj < 2; ++bj)
#pragma unroll
                        for (int n = 0; n < 2; ++n) { const u32x2 yv = *(const u32x2*)(yr + bj * 128 + n * 16);
                            s[bj][n][0] += wk * bf2f(yv.x & 0xffffu); s[bj][n][1] += wk * bf2f(yv.x >> 16); s[bj][n][2] += wk * bf2f(yv.y & 0xffffu); s[bj][n][3] += wk * bf2f(yv.y >> 16); }
                }
                const size_t ro = (size_t)row * D + col0;
#pragma unroll
                for (int bj = 0; bj < 2; ++bj)
#pragma unroll
                    for (int n = 0; n < 2; ++n) { const f32x4 xv = *(const f32x4*)(X1 + ro + bj * 128 + n * 16);
                        *(f32x4*)(out + ro + bj * 128 + n * 16) = xv + gv[bj][n] * s[bj][n]; }
            }
    }
};

struct SchedDense {
    const char* A; const char* Bt; int K, nM, nN, G, c;
    __device__ __forceinline__ bool next(int i, g8::Unit& u) const {
        int wgid; if (!g8::work_id(i, G, c, nM * nN, wgid)) return false;
        const int nig = 8 * nN, gid = wgid / nig, fm = gid * 8, gsz = (nM - fm) < 8 ? (nM - fm) : 8;
        const int pm = fm + ((wgid % nig) % gsz), pn = (wgid % nig) / gsz;
        u.A = A; u.rows = nullptr; u.row0 = pm * 256; u.Bt = Bt + (size_t)pn * 256 * K * 2; u.orow = pm * 256; u.pn = pn; u.aux = 0; return true;
    }
};
struct SchedUp {
    const int* tp; const char* H2; const int* LIST; const char* E13T; const char* S13T; int G, c;
    __device__ __forceinline__ bool next(int i, g8::Unit& u) const {
        const int T = tp[NE]; int wgid; if (!g8::work_id(i, G, c, 4 * T + 128, wgid)) return false;
        u.A = H2;
        if (wgid < 4 * T) {
            int e = 0; while (e < NE - 1 && 4 * tp[e + 1] <= wgid) ++e;
            const int tc = tp[e + 1] - tp[e], li = wgid - 4 * tp[e], nt = li / tc, mt = li % tc, r0 = (tp[e] + mt) * 256;
            u.rows = LIST + r0; u.row0 = 0; u.Bt = E13T + ((size_t)e * 1024 + nt * 256) * D * 2; u.orow = r0; u.pn = nt; u.aux = 0;
        } else {
            const int s = wgid - 4 * T, pn = s / 32, pm = s % 32;
            u.rows = nullptr; u.row0 = pm * 256; u.Bt = S13T + (size_t)pn * 256 * D * 2; u.orow = pm * 256; u.pn = pn; u.aux = 1;
        }
        return true;
    }
};
struct SchedDown {
    const int* tp; const char* HB; const char* E2T; int G, c;
    __device__ __forceinline__ bool next(int i, g8::Unit& u) const {
        const int T = tp[NE]; int wgid; if (!g8::work_id(i, G, c, 8 * T, wgid)) return false;
        int e = 0; while (e < NE - 1 && 8 * tp[e + 1] <= wgid) ++e;
        const int tc = tp[e + 1] - tp[e], li = wgid - 8 * tp[e], nt = li / tc, mt = li % tc, r0 = (tp[e] + mt) * 256;
        u.A = HB; u.rows = nullptr; u.row0 = r0; u.Bt = E2T + ((size_t)e * D + nt * 256) * DE * 2; u.orow = r0; u.pn = nt; u.aux = 0; return true;
    }
};
__device__ __forceinline__ void moe_tables(const Params& p, int* tp) {
    __syncthreads();
    if (threadIdx.x == 0) { int tt = 0; for (int e = 0; e < NE; ++e) { tp[e] = tt; tt += (p.CNT[e] + 255) / 256; } tp[NE] = tt; }
    __syncthreads();
}

__device__ void ph_postproj(const Params& p) {
    const int t = threadIdx.x, w = t >> 6, lane = t & 63;
    for (int row = blockIdx.x; row < NROW; row += gridDim.x) {
        const float* pr = p.P + (size_t)row * PLD;
        const float* dd = p.DD + (size_t)row * 32;
        {
            const float q0 = pr[w * 128 + lane], q1 = pr[w * 128 + 64 + lane];
            const float k0 = pr[1024 + w * 128 + lane], k1 = pr[1024 + w * 128 + 64 + lane];
            const float sq = wave_sum(q0 * q0 + q1 * q1), sk = wave_sum(k0 * k0 + k1 * k1);
            const float rq = rsqrtf(sq * (1.f / 128.f) + 1e-6f), rk = rsqrtf(sk * (1.f / 128.f) + 1e-6f);
            float* nq = p.NQ + (size_t)row * 1024 + w * 128; float* nk = p.NK + (size_t)row * 1024 + w * 128;
            nq[lane] = q0 * rq * p.q_norm_g[lane]; nq[lane + 64] = q1 * rq * p.q_norm_g[lane + 64];
            nk[lane] = k0 * rk * p.k_norm_g[lane]; nk[lane + 64] = k1 * rk * p.k_norm_g[lane + 64];
        }
        {
            const int d = t & 127;
            float qv = pr[3072 + t], kv = pr[3584 + t];
            if (row < NLAT) {
                const int tok = row % SEQ, dd2 = d & 63, i = dd2 & 31;
                const float pos = (float)((d < 64) ? (tok / 64) : (tok % 64));
                const float invf = powf(10000.f, -(float)i / 32.f);
                const float ang = pos * invf, cs = cosf(ang), sn = sinf(ang);
                const int partner = (dd2 < 32) ? (t + 32) : (t - 32);
                const float qp = pr[3072 + partner], kp = pr[3584 + partner];
                if (dd2 < 32) { qv = qv * cs - qp * sn; kv = kv * cs - kp * sn; }
                else { qv = qv * cs + qp * sn; kv = kv * cs + kp * sn; }
            }
            p.GQ[(size_t)row * 512 + t] = qv * 0.08838834764831845f;
            p.GK[(size_t)row * 512 + t] = kv;
        }
        {
            float zf = p.bias_f[t], zb = p.bias_b[t];
#pragma unroll
            for (int r = 0; r < 16; ++r) { zf += dd[r] * p.up_f[r * 512 + t]; zb += dd[16 + r] * p.up_b[r * 512 + t]; }
            const float lf = fminf(zf, 0.f) - log1pf(expf(-fabsf(zf))), lb = fminf(zb, 0.f) - log1pf(expf(-fabsf(zb)));
            p.AF[(size_t)row * 512 + t] = expf(lf * (1.f / 16.f));
            p.AB[(size_t)row * 512 + t] = expf(lb * (1.f / 16.f));
        }
    }
}

__device__ void ph_attn(const Params& p, float* sm) {
    const int t = threadIdx.x, w = t >> 6, lane = t & 63;
    float* qs = sm + w * 128;
    float* ps = sm + 8 * 128 + w * 384;
    int* ks = (int*)(sm + 8 * 128 + 8 * 384) + w * 384;
    for (int u = blockIdx.x; u < NB * 8 * 64 * 8; u += gridDim.x) {
        const int cg = u & 7, r = (u >> 3) & 63, h = (u >> 9) & 7, b = u >> 12;
        const int c = cg * 8 + w;
        const int qrow = b * SEQ + r * 64 + c;
        const int rs = min(max(r - 4, 0), 56), cs = min(max(c - 8, 0), 48);
        qs[lane] = p.NQ[(size_t)qrow * 1024 + h * 128 + lane]; qs[lane + 64] = p.NQ[(size_t)qrow * 1024 + h * 128 + 64 + lane];
        __syncthreads();
        float lg[6]; float mx = -INFINITY;
        const float* kp[6]; float bias[6];
#pragma unroll
        for (int i = 0; i < 6; ++i) {
            const int kk = lane + 64 * i;
            int krow; bias[i] = 0.f;
            if (kk < 128) { const int ir = kk >> 4, j = kk & 15; krow = b * SEQ + (rs + ir) * 64 + cs + j; bias[i] = p.na_rpb[(h * 15 + (rs + ir - r + 7)) * 31 + (cs + j - c + 15)]; }
            else krow = NLAT + b * CTXL + (kk - 128);
            ks[kk] = krow;
            kp[i] = p.NK + (size_t)krow * 1024 + h * 128;
            lg[i] = 0.f;
        }
#pragma unroll 1
        for (int d = 0; d < 128; d += 4) {
            const float4 q = *(const float4*)(qs + d);
#pragma unroll
            for (int i = 0; i < 6; ++i) { const float4 kv = *(const float4*)(kp[i] + d); lg[i] += q.x * kv.x + q.y * kv.y + q.z * kv.z + q.w * kv.w; }
        }
#pragma unroll
        for (int i = 0; i < 6; ++i) { lg[i] = lg[i] * 0.08838834764831845f + bias[i]; mx = fmaxf(mx, lg[i]); }
        mx = wave_max(mx);
        float se = 0.f;
#pragma unroll
        for (int i = 0; i < 6; ++i) { lg[i] = expf(lg[i] - mx); se += lg[i]; ps[lane + 64 * i] = lg[i]; }
        se = wave_sum(se);
        __syncthreads();
        float o0 = 0.f, o1 = 0.f;
        for (int kk = 0; kk < 384; ++kk) {
            const float pv = ps[kk];
            const float* vp = p.P + (size_t)ks[kk] * PLD + 2048 + h * 128;
            o0 += pv * vp[lane]; o1 += pv * vp[lane + 64];
        }
        const float inv = 1.f / se;
        p.MIX[(size_t)qrow * D + h * 128 + lane] = f2bf(o0 * inv);
        p.MIX[(size_t)qrow * D + h * 128 + 64 + lane] = f2bf(o1 * inv);
        __syncthreads();
    }
}

__device__ void ph_gla(const Params& p) {
    const int t = threadIdx.x, vi = t >> 5, dg = t & 31;
    for (int u = blockIdx.x; u < 256; u += gridDim.x) {
        const int scan = u >> 4, vs = u & 15, dir = scan >> 3, b = (scan >> 2) & 1, h = scan & 3;
        const float* A = dir ? p.AB : p.AF;
        float* OG = dir ? p.OGB : p.OGF;
        float S0 = 0.f, S1 = 0.f, S2 = 0.f, S3 = 0.f;
        const int koff = h * 128 + dg * 4, voff = 4096 + h * 256 + vs * 16 + vi;
        for (int n = 0; n < CTXL + SEQ; ++n) {
            int row; bool lat;
            if (n < CTXL) { row = NLAT + b * CTXL + (dir ? (CTXL - 1 - n) : n); lat = false; }
            else { const int li = n - CTXL; row = b * SEQ + (dir ? (SEQ - 1 - li) : li); lat = true; }
            const float4 a = *(const float4*)(A + (size_t)row * 512 + koff);
            const float4 k = *(const float4*)(p.GK + (size_t)row * 512 + koff);
            const float v = p.P[(size_t)row * PLD + voff];
            S0 = a.x * S0 + k.x * v; S1 = a.y * S1 + k.y * v; S2 = a.z * S2 + k.z * v; S3 = a.w * S3 + k.w * v;
            if (lat) {
                const float4 q = *(const float4*)(p.GQ + (size_t)row * 512 + koff);
                float o = q.x * S0 + q.y * S1 + q.z * S2 + q.w * S3;
                o += __shfl_xor(o, 16); o += __shfl_xor(o, 8); o += __shfl_xor(o, 4); o += __shfl_xor(o, 2); o += __shfl_xor(o, 1);
                if (dg == 0) OG[(size_t)row * 1024 + h * 256 + vs * 16 + vi] = o;
            }
        }
    }
}

__device__ void ph_glaout(const Params& p, float* sm) {
    const int t = threadIdx.x, w = t >> 6, lane = t & 63;
    for (int row = blockIdx.x; row < NLAT; row += gridDim.x) {
        const float o0 = p.OGF[(size_t)row * 1024 + t] + p.OGB[(size_t)row * 1024 + t];
        const float o1 = p.OGF[(size_t)row * 1024 + 512 + t] + p.OGB[(size_t)row * 1024 + 512 + t];
        const float s0 = wave_sum(o0 * o0), s1 = wave_sum(o1 * o1);
        __syncthreads();
        if (lane == 0) { sm[w] = s0; sm[8 + w] = s1; }
        __syncthreads();
        const int hb = (w >> 2) * 4;
        const float t0 = sm[hb] + sm[hb + 1] + sm[hb + 2] + sm[hb + 3], t1 = sm[8 + hb] + sm[8 + hb + 1] + sm[8 + hb + 2] + sm[8 + hb + 3];
        const float r0 = rsqrtf(t0 * (1.f / 256.f) + 1e-6f), r1 = rsqrtf(t1 * (1.f / 256.f) + 1e-6f);
        const float g = p.gla_norm_g[t & 255];
        const float ga0 = p.P[(size_t)row * PLD + 5120 + t], ga1 = p.P[(size_t)row * PLD + 5120 + 512 + t];
        p.MIX[(size_t)row * D + 1024 + t] = f2bf(o0 * r0 * g * siluf(ga0));
        p.MIX[(size_t)row * D + 1024 + 512 + t] = f2bf(o1 * r1 * g * siluf(ga1));
    }
}

__device__ void ph_norm2_router(const Params& p, float* sm) {
    const int t = threadIdx.x, lane = t & 63;
    float* red = sm;
    float* hrow = sm + 16;
    float* part = sm + 16 + 2048;
    for (int row = blockIdx.x; row < NLAT; row += gridDim.x) {
        const int b = row / SEQ;
        const float* m = p.mod + (size_t)b * 6 * D;
        float4 o;
        {
            const float4 v = *(const float4*)(p.X1 + (size_t)row * D + 4 * t);
            float ss = wave_sum(v.x * v.x + v.y * v.y + v.z * v.z + v.w * v.w);
            __syncthreads();
            if (lane == 0) red[t >> 6] = ss;
            __syncthreads();
            float tot = 0.f;
#pragma unroll
            for (int i = 0; i < NT / 64; ++i) tot += red[i];
            const float rs = rsqrtf(tot * (1.f / D) + 1e-6f);
            const float4 gg = *(const float4*)(p.norm2_g + 4 * t), s1 = *(const float4*)(m + 4 * D + 4 * t), s0 = *(const float4*)(m + 3 * D + 4 * t);
            o.x = v.x * rs * gg.x * (1.f + s1.x) + s0.x; o.y = v.y * rs * gg.y * (1.f + s1.y) + s0.y;
            o.z = v.z * rs * gg.z * (1.f + s1.z) + s0.z; o.w = v.w * rs * gg.w * (1.f + s1.w) + s0.w;
        }
        { u32x2 pk; pk.x = cvt_pk_bf16(o.x, o.y); pk.y = cvt_pk_bf16(o.z, o.w); *(u32x2*)(p.H + (size_t)row * D + 4 * t) = pk; }
        *(float4*)(hrow + 4 * t) = o;
        __syncthreads();
        {
            const int e = t & 63, part_i = t >> 6;
            float s = 0.f;
            for (int k = part_i * 256; k < part_i * 256 + 256; ++k) s += hrow[k] * p.router_w[(size_t)k * NE + e];
            part[part_i * 64 + e] = s;
        }
        __syncthreads();
        if (t < 64) {
            float lgt = 0.f;
#pragma unroll
            for (int i = 0; i < 8; ++i) lgt += part[i * 64 + lane];
            const float sc = 1.f / (1.f + expf(-lgt));
            const float bs = sc + p.router_bias[lane];
            float m1 = bs; m1 = fmaxf(m1, __shfl_xor(m1, 1)); m1 = fmaxf(m1, __shfl_xor(m1, 2)); m1 = fmaxf(m1, __shfl_xor(m1, 4));
            int ai = (bs == m1) ? lane : 64; ai = min(ai, __shfl_xor(ai, 1)); ai = min(ai, __shfl_xor(ai, 2)); ai = min(ai, __shfl_xor(ai, 4));
            float m2 = (lane == ai) ? -INFINITY : bs; m2 = fmaxf(m2, __shfl_xor(m2, 1)); m2 = fmaxf(m2, __shfl_xor(m2, 2)); m2 = fmaxf(m2, __shfl_xor(m2, 4));
            const float gs = m1 + m2;
            float g0 = __shfl(gs, 0), g1 = __shfl(gs, 8), g2 = __shfl(gs, 16), g3 = __shfl(gs, 24), g4 = __shfl(gs, 32), g5 = __shfl(gs, 40), g6 = __shfl(gs, 48), g7 = __shfl(gs, 56);
            unsigned selmask = 0u;
#pragma unroll
            for (int it = 0; it < 4; ++it) {
                float best = -INFINITY; int bi = 0;
                if (!(selmask & 1u) && g0 > best) { best = g0; bi = 0; }
                if (!(selmask & 2u) && g1 > best) { best = g1; bi = 1; }
                if (!(selmask & 4u) && g2 > best) { best = g2; bi = 2; }
                if (!(selmask & 8u) && g3 > best) { best = g3; bi = 3; }
                if (!(selmask & 16u) && g4 > best) { best = g4; bi = 4; }
                if (!(selmask & 32u) && g5 > best) { best = g5; bi = 5; }
                if (!(selmask & 64u) && g6 > best) { best = g6; bi = 6; }
                if (!(selmask & 128u) && g7 > best) { best = g7; bi = 7; }
                selmask |= 1u << bi;
            }
            float cand = ((selmask >> (lane >> 3)) & 1u) ? bs : -INFINITY;
            int myslot = -1; float ssum = 0.f;
#pragma unroll
            for (int k = 0; k < TOPK; ++k) {
                const float mv = wave_max(cand);
                const int idx = wave_min_i((cand == mv) ? lane : 64);
                const float sv = __shfl(sc, idx);
                ssum += sv;
                if (lane == idx) { myslot = k; cand = -INFINITY; }
            }
            if (myslot >= 0) {
                p.EIDX[row * TOPK + myslot] = lane;
                p.EW[row * TOPK + myslot] = sc / ssum * 2.5f;
                atomicAdd(&p.CNT[lane], 1);
            }
        }
        __syncthreads();
    }
}

__device__ void ph_lists(const Params& p, int* tp) {
    moe_tables(p, tp);
    for (int i = blockIdx.x * NT + threadIdx.x; i < NPAIR; i += gridDim.x * NT) {
        const int e = p.EIDX[i];
        const int pos = tp[e] * 256 + atomicAdd(&p.CUR[e], 1);
        p.PAIRPOS[i] = pos; p.LIST[pos] = i / TOPK;
    }
    for (int e = blockIdx.x; e < NE; e += gridDim.x) {
        const int c = p.CNT[e], end = (tp[e + 1] - tp[e]) * 256;
        for (int i = c + threadIdx.x; i < end; i += NT) p.LIST[tp[e] * 256 + i] = 0;
    }
}

__global__ void __launch_bounds__(NT, 2) mega(Params p) {
    extern __shared__ __attribute__((aligned(16))) unsigned char dynlds[];
    if (threadIdx.x < 4) ((unsigned*)(dynlds + LDS_BARW))[threadIdx.x] = 0u;
    __syncthreads();
    XcdBarrier bar = xcd_barrier_post(p.bar, (volatile LAS unsigned*)(dynlds + LDS_BARW));
    float* sm = (float*)dynlds;
    int* tp = (int*)(dynlds + LDS_TAB);
    LAS unsigned char* lds = (LAS unsigned char*)dynlds;
    const int G = gridDim.x, c = blockIdx.x;

    ph_prologue(p, sm);                                   xcd_barrier(bar);
    ph_norm1(p, sm);                                      xcd_barrier(bar);
    { SchedDense S{(const char*)p.H, (const char*)p.WinT, D, NROW / 256, PLD / 256, G, c}; EpiInproj E{p.P};
      g8::gemm_phase(lds, D, S, E); }                     xcd_barrier(bar);
    ph_postproj(p);                                       xcd_barrier(bar);
    ph_gla(p); ph_attn(p, sm);                            xcd_barrier(bar);
    ph_glaout(p, sm);                                     xcd_barrier(bar);
    { SchedDense S{(const char*)p.MIX, (const char*)p.WoutT, D, NLAT / 256, D / 256, G, c}; EpiOutproj E{p.x, p.mod, p.X1};
      g8::gemm_phase(lds, D, S, E); }                     xcd_barrier(bar);
    ph_norm2_router(p, sm);                               xcd_barrier(bar);
    ph_lists(p, tp);                                      xcd_barrier(bar);
    { moe_tables(p, tp);
      SchedUp S{tp, (const char*)p.H, p.LIST, (const char*)p.E13T, (const char*)p.S13T, G, c}; EpiUp E{p.HB, p.SHH};
      g8::gemm_phase(lds, D, S, E); }                     xcd_barrier(bar);
    { SchedDown S{tp, (const char*)p.HB, (const char*)p.E2T, G, c}; EpiDown E{p.Y};
      g8::gemm_phase(lds, DE, S, E); }                    xcd_barrier(bar);
    { SchedDense S{(const char*)p.SHH, (const char*)p.S2T, DE, NLAT / 256, D / 256, G, c}; EpiFinal E{p.X1, p.mod, p.Y, p.EW, p.PAIRPOS, p.out};
      g8::gemm_phase(lds, DE, S, E); }
}

extern "C" void kernel_launch(void* const* d_in, const int* in_sizes, int n_in, void* d_out, int out_size, void* d_ws, size_t ws_size, hipStream_t stream) {
    Params p{};
    const float* const* in = (const float* const*)d_in;
    p.x = in[0]; p.c = in[1]; p.ctx = in[2]; p.c_ctx = in[3]; p.w_mod = in[4]; p.b_mod = in[5]; p.norm1_g = in[6]; p.norm2_g = in[7]; p.w_in = in[8];
    p.q_norm_g = in[9]; p.k_norm_g = in[10]; p.na_rpb = in[11]; p.up_f = in[12]; p.bias_f = in[13]; p.up_b = in[14]; p.bias_b = in[15]; p.gla_norm_g = in[16];
    p.w_out = in[17]; p.router_w = in[18]; p.router_bias = in[19]; p.ew1 = in[20]; p.ew3 = in[21]; p.ew2 = in[22]; p.sw1 = in[23]; p.sw3 = in[24]; p.sw2 = in[25];
    p.out = (float*)d_out;
    char* w = (char*)d_ws; size_t o = 0;
    auto take = [&](size_t bytes) { void* r = w + o; o += (bytes + 255) & ~(size_t)255; return r; };
    p.bar = (unsigned*)take((size_t)XCD_BAR_WORDS * 4);
    p.CNT = (int*)take(64 * 4); p.CUR = (int*)take(64 * 4);
    p.mod = (float*)take((size_t)3 * 6 * D * 4);
    p.EIDX = (int*)take((size_t)NPAIR * 4); p.EW = (float*)take((size_t)NPAIR * 4); p.PAIRPOS = (int*)take((size_t)NPAIR * 4); p.LIST = (int*)take((size_t)PADROWS * 4);
    p.WinT = (bf16_t*)take((size_t)PLD * D * 2); p.WoutT = (bf16_t*)take((size_t)D * D * 2); p.S13T = (bf16_t*)take((size_t)1024 * D * 2); p.S2T = (bf16_t*)take((size_t)D * DE * 2);
    p.E13T = (bf16_t*)take((size_t)NE * 1024 * D * 2); p.E2T = (bf16_t*)take((size_t)NE * D * DE * 2);
    p.H = (bf16_t*)take((size_t)NROW * D * 2);
    p.X1 = (float*)take((size_t)NLAT * D * 4);
    const size_t big = o;
    p.P = (float*)take((size_t)NROW * PLD * 4); p.DD = (float*)take((size_t)NROW * 32 * 4); p.NQ = (float*)take((size_t)NROW * 1024 * 4); p.NK = (float*)take((size_t)NROW * 1024 * 4);
    p.GQ = (float*)take((size_t)NROW * 512 * 4); p.GK = (float*)take((size_t)NROW * 512 * 4); p.AF = (float*)take((size_t)NROW * 512 * 4); p.AB = (float*)take((size_t)NROW * 512 * 4);
    p.MIX = (bf16_t*)take((size_t)NLAT * D * 2); p.OGF = (float*)take((size_t)NLAT * 1024 * 4); p.OGB = (float*)take((size_t)NLAT * 1024 * 4);
    o = big;
    p.HB = (bf16_t*)take((size_t)PADROWS * DE * 2); p.SHH = (bf16_t*)take((size_t)NLAT * DE * 2); p.Y = (bf16_t*)take((size_t)PADROWS * D * 2);
    static int grid = 0;
    if (!grid) {
        int dev = 0, cus = 0, per_cu = 0;
        hipGetDevice(&dev);
        hipDeviceGetAttribute(&cus, hipDeviceAttributeMultiprocessorCount, dev);
        (void)hipFuncSetAttribute((const void*)mega, hipFuncAttributeMaxDynamicSharedMemorySize, LDS_BYTES);
        (void)hipOccupancyMaxActiveBlocksPerMultiprocessor(&per_cu, (const void*)mega, NT, LDS_BYTES);
        (void)hipGetLastError();
        grid = cus;
    }
    (void)hipMemsetAsync(p.bar, 0, (size_t)XCD_BAR_WORDS * 4, stream);
    hipLaunchKernelGGL(mega, dim3(grid), dim3(NT), LDS_BYTES, stream, p);
}
```

```cpp
#include <hip/hip_runtime.h>
#include <stdint.h>

#define XB_TMO      128
#define XB_XCNT(j)  (256  + 64 * (j))
#define XB_XSUB(j)  (1280 + 64 * (j))
#define XB_XGEN(j)  (2304 + 64 * (j))
#define XB_TOP      3328
#define XB_TOPGEN   3392
#define XCD_BAR_WORDS 3456
#define XB_SPIN_CAP (1u << 18)
#define LAS __attribute__((address_space(3)))

__device__ __forceinline__ unsigned xb_ld(unsigned* p)              { return __hip_atomic_load(p, __ATOMIC_RELAXED, __HIP_MEMORY_SCOPE_AGENT); }
__device__ __forceinline__ unsigned xb_add(unsigned* p, unsigned v) { return __hip_atomic_fetch_add(p, v, __ATOMIC_RELAXED, __HIP_MEMORY_SCOPE_AGENT); }
__device__ __forceinline__ unsigned xb_xcc_id() { return (unsigned)__builtin_amdgcn_s_getreg((3 << 11) | 20) & 0xFu; }
#define XB_SPIN(cond, bar) do { unsigned _sp = 0; while (cond) { __builtin_amdgcn_s_sleep(1); \
    if ((++_sp & 255u) == 0u) { if (xb_ld(&(bar)[XB_TMO])) break; if (_sp > XB_SPIN_CAP) { atomicAdd(&(bar)[XB_TMO], 1u); break; } } } } while (0)

struct XcdBarrier {
    unsigned* bar; unsigned x;
    volatile LAS unsigned* st;
};

__device__ __forceinline__ XcdBarrier xcd_barrier_post(unsigned* bar, volatile LAS unsigned* st) {
    XcdBarrier b; b.bar = bar; b.x = xb_xcc_id(); b.st = st;
    if (threadIdx.x == 0) (void)xb_add(&bar[XB_XCNT(b.x)], 1u);
    return b;
}
__device__ __forceinline__ void xcd_barrier_complete(unsigned* bar, unsigned x, unsigned& nloc, unsigned& nx) {
    const unsigned G = gridDim.x * gridDim.y * gridDim.z;
    unsigned sum, cnt, mine, sp = 0u;
    for (;;) {
        sum = 0u; cnt = 0u; mine = 0u;
#pragma unroll
        for (unsigned j = 0; j < 16; ++j) { const unsigned c = xb_ld(&bar[XB_XCNT(j)]); sum += c; cnt += (c > 0u) ? 1u : 0u; mine = (j == x) ? c : mine; }
        if (sum == G) break;
        __builtin_amdgcn_s_sleep(1);
        if ((++sp & 255u) == 0u) { if (xb_ld(&bar[XB_TMO])) break; if (sp > XB_SPIN_CAP) { atomicAdd(&bar[XB_TMO], 1u); break; } }
    }
    nloc = mine > 0u ? mine : 1u; nx = cnt > 0u ? cnt : 1u;
}

__device__ __forceinline__ void xcd_barrier(const XcdBarrier& b) {
    asm volatile("s_waitcnt vmcnt(0)" ::: "memory");
    __syncthreads();
    if (threadIdx.x == 0) {
        unsigned* bar = b.bar;
        __builtin_amdgcn_s_waitcnt(0);
        unsigned nloc = b.st[0], nx = b.st[1];
        if (nloc == 0u) { xcd_barrier_complete(bar, b.x, nloc, nx); b.st[0] = nloc; b.st[1] = nx; }
        const unsigned old = xb_add(&bar[XB_XSUB(b.x)], 1u);
        const unsigned gen = old / nloc;
        if (old + 1u == (gen + 1u) * nloc) {
            __builtin_amdgcn_fence(__ATOMIC_RELEASE, "agent");
            asm volatile("s_waitcnt vmcnt(0)" ::: "memory");
            const unsigned og = xb_add(&bar[XB_TOP], 1u);
            const unsigned tg = og / nx;
            if (og + 1u == (tg + 1u) * nx) xb_add(&bar[XB_TOPGEN], 1u);
            else XB_SPIN(xb_ld(&bar[XB_TOPGEN]) == tg, bar);
            __builtin_amdgcn_fence(__ATOMIC_ACQUIRE, "agent");
            xb_add(&bar[XB_XGEN(b.x)], 1u);
            asm volatile("s_waitcnt vmcnt(0)" ::: "memory");
        } else {
            XB_SPIN(xb_ld(&bar[XB_XGEN(b.x)]) == gen, bar);
            __builtin_amdgcn_fence(__ATOMIC_ACQUIRE, "agent");
            asm volatile("s_waitcnt vmcnt(0)" ::: "memory");
        }
    }
    __syncthreads();
}


#define NT 512
typedef unsigned short bf16_t;
typedef short bf16x8 __attribute__((ext_vector_type(8)));
typedef float f32x4 __attribute__((ext_vector_type(4)));
typedef float f32x16 __attribute__((ext_vector_type(16)));
typedef unsigned u32x4 __attribute__((ext_vector_type(4)));
typedef unsigned u32x2 __attribute__((ext_vector_type(2)));

constexpr int D = 2048, SEQ = 4096, CTXL = 256, NB = 2;
constexpr int NLAT = NB * SEQ;
constexpr int NCTX = NB * CTXL;
constexpr int NROW = NLAT + NCTX;
constexpr int INC = 6176;
constexpr int PLD = 6144;
constexpr int NE = 64, TOPK = 6, DE = 512;
constexpr int NPAIR = NLAT * TOPK;
constexpr int PADROWS = NPAIR + NE * 256;
constexpr int LDS_STAGE = 131072;
constexpr int LDS_TAB = LDS_STAGE;
constexpr int LDS_BARW = LDS_STAGE + 4096;
constexpr int LDS_BYTES = LDS_BARW + 16 + 8192;

struct Params {
    const float *x, *c, *ctx, *c_ctx, *w_mod, *b_mod, *norm1_g, *norm2_g, *w_in, *q_norm_g, *k_norm_g, *na_rpb,
        *up_f, *bias_f, *up_b, *bias_b, *gla_norm_g, *w_out, *router_w, *router_bias, *ew1, *ew3, *ew2, *sw1, *sw3, *sw2;
    float* out;
    float *mod, *X1, *P, *DD, *EW, *RT, *DF, *DB;
    bf16_t *H, *MIX, *HB, *SHH, *Y, *WinT, *WoutT, *S13T, *S2T, *E13T, *E2T, *QF, *KF, *QB, *KB, *KHF, *KHB, *VT, *SS, *NQb, *NKb, *VTn;
    int *EIDX, *PAIRPOS, *LIST, *CNT, *CUR;
    unsigned* bar;
};

__device__ __forceinline__ float wave_sum(float v) { for (int o = 32; o > 0; o >>= 1) v += __shfl_xor(v, o); return v; }
__device__ __forceinline__ float wave_max(float v) { for (int o = 32; o > 0; o >>= 1) v = fmaxf(v, __shfl_xor(v, o)); return v; }
__device__ __forceinline__ int wave_min_i(int v) { for (int o = 32; o > 0; o >>= 1) v = min(v, __shfl_xor(v, o)); return v; }
__device__ __forceinline__ float siluf(float v) { return v / (1.f + expf(-v)); }
__device__ __forceinline__ unsigned cvt_pk_bf16(float lo, float hi) { unsigned r; asm volatile("v_cvt_pk_bf16_f32 %0, %1, %2" : "=v"(r) : "v"(lo), "v"(hi)); return r; }
__device__ __forceinline__ bf16_t f2bf(float f) { return (bf16_t)(cvt_pk_bf16(f, 0.f) & 0xffffu); }
__device__ __forceinline__ float bf2f(unsigned b) { return __uint_as_float(b << 16); }

__device__ __forceinline__ void adaln_item(const Params& p, float* sm, int item) {
    const int t = threadIdx.x, cq = t & 15, kg = t >> 4, n0 = item * 64;
    float* red = sm + 3 * D;
    float a[3][4];
#pragma unroll
    for (int r = 0; r < 3; ++r)
#pragma unroll
        for (int j = 0; j < 4; ++j) a[r][j] = 0.f;
#pragma unroll 4
    for (int k = kg; k < D; k += 32) {
        const float4 w = *(const float4*)(p.w_mod + (size_t)k * (6 * D) + n0 + 4 * cq);
        const float s0 = sm[k], s1 = sm[D + k], s2 = sm[2 * D + k];
        a[0][0] += s0 * w.x; a[0][1] += s0 * w.y; a[0][2] += s0 * w.z; a[0][3] += s0 * w.w;
        a[1][0] += s1 * w.x; a[1][1] += s1 * w.y; a[1][2] += s1 * w.z; a[1][3] += s1 * w.w;
        a[2][0] += s2 * w.x; a[2][1] += s2 * w.y; a[2][2] += s2 * w.z; a[2][3] += s2 * w.w;
    }
    __syncthreads();
#pragma unroll
    for (int r = 0; r < 3; ++r)
#pragma unroll
        for (int j = 0; j < 4; ++j) red[(kg * 3 + r) * 64 + 4 * cq + j] = a[r][j];
    __syncthreads();
    if (t < 192) {
        const int r = t >> 6, cc = t & 63;
        float s = p.b_mod[n0 + cc];
#pragma unroll 8
        for (int g = 0; g < 32; ++g) s += red[(g * 3 + r) * 64 + cc];
        p.mod[(size_t)r * 6 * D + n0 + cc] = s;
    }
    __syncthreads();
}
__device__ __forceinline__ void transpose_item(const float* W, int K, int N, int k0, int n0, bf16_t* WT, int drow0, float* scr, int lane) {
#pragma unroll 8
    for (int kk = 0; kk < 64; ++kk) scr[kk * 65 + lane] = W[(size_t)(k0 + kk) * N + n0 + lane];
    asm volatile("s_waitcnt lgkmcnt(0)" ::: "memory");
    const int c = lane & 7;
#pragma unroll
    for (int j = 0; j < 8; ++j) {
        const int n = (lane >> 3) + 8 * j; const float* s = scr + (8 * c) * 65 + n;
        u32x4 o; o.x = cvt_pk_bf16(s[0], s[65]); o.y = cvt_pk_bf16(s[2 * 65], s[3 * 65]); o.z = cvt_pk_bf16(s[4 * 65], s[5 * 65]); o.w = cvt_pk_bf16(s[6 * 65], s[7 * 65]);
        *(u32x4*)(WT + (size_t)(drow0 + n) * K + k0 + 8 * c) = o;
    }
    asm volatile("s_waitcnt lgkmcnt(0)" ::: "memory");
}
constexpr int CI_WIN = 32 * 96, CI_WOUT = 32 * 32, CI_S13 = 2 * 32 * 8, CI_S2 = 8 * 32, CI_E13 = 64 * 2 * 32 * 8, CI_E2 = 64 * 8 * 32;
constexpr int CI_TOTAL = CI_WIN + CI_WOUT + CI_S13 + CI_S2 + CI_E13 + CI_E2;
__device__ __forceinline__ void convert_item(const Params& p, int it, float* scr, int lane) {
    if (it < CI_WIN) { const int kb = it / 96, nb = it % 96; transpose_item(p.w_in, D, INC, 64 * kb, 64 * nb, p.WinT, 64 * nb, scr, lane); return; }
    it -= CI_WIN;
    if (it < CI_WOUT) { const int kb = it / 32, nb = it % 32; transpose_item(p.w_out, D, D, 64 * kb, 64 * nb, p.WoutT, 64 * nb, scr, lane); return; }
    it -= CI_WOUT;
    if (it < CI_S13) {
        const int which = it / 256, r = it % 256, kb = r / 8, nb = r % 8;
        transpose_item(which ? p.sw3 : p.sw1, D, DE, 64 * kb, 64 * nb, p.S13T, (nb >> 1) * 256 + which * 128 + (nb & 1) * 64, scr, lane); return; }
    it -= CI_S13;
    if (it < CI_S2) { const int kb = it / 32, nb = it % 32; transpose_item(p.sw2, DE, D, 64 * kb, 64 * nb, p.S2T, 64 * nb, scr, lane); return; }
    it -= CI_S2;
    if (it < CI_E13) {
        const int e = it / 512, r0 = it % 512, which = r0 / 256, r = r0 % 256, kb = r / 8, nb = r % 8;
        transpose_item((which ? p.ew3 : p.ew1) + (size_t)e * D * DE, D, DE, 64 * kb, 64 * nb, p.E13T + (size_t)e * 1024 * D, (nb >> 1) * 256 + which * 128 + (nb & 1) * 64, scr, lane); return; }
    it -= CI_E13;
    { const int e = it / 256, r = it % 256, kb = r / 32, nb = r % 32;
      transpose_item(p.ew2 + (size_t)e * DE * D, DE, D, 64 * kb, 64 * nb, p.E2T + (size_t)e * D * DE, 64 * nb, scr, lane); }
}
__device__ void ph_prologue(const Params& p, float* sm) {
    const int t = threadIdx.x, w = t >> 6, lane = t & 63;
    if (blockIdx.x == 0 && t < 128) { if (t < 64) p.CNT[t] = 0; else p.CUR[t - 64] = 0; }
    if (blockIdx.x == gridDim.x - 1) {
        for (int i = t; i < 64 * 32; i += NT) { const float ang = (float)(i >> 5) * powf(10000.f, -(float)(i & 31) / 32.f); p.RT[2 * i] = cosf(ang); p.RT[2 * i + 1] = sinf(ang); }
    }
    if (blockIdx.x < 192) {
        for (int i = t; i < 3 * D; i += NT) { const int r = i / D, k = i % D; sm[i] = siluf(r < 2 ? p.c[r * D + k] : p.c_ctx[k]); }
        __syncthreads();
        for (int item = blockIdx.x; item < 192; item += gridDim.x) adaln_item(p, sm, item);
    }
    __syncthreads();
    float* scr = sm + w * (64 * 65);
    for (int it = blockIdx.x * 8 + w; it < CI_TOTAL; it += gridDim.x * 8) convert_item(p, it, scr, lane);
}

__device__ void ph_norm1(const Params& p, float* sm) {
    const int t = threadIdx.x, w = t >> 6, lane = t & 63;
    float* hs = sm; float* red = sm + 8 * D;
    for (int rb = blockIdx.x; rb < NROW / 8; rb += gridDim.x) {
        const int row = rb * 8 + w;
        const float* src; int mr;
        if (row < NLAT) { src = p.x + (size_t)row * D; mr = row / SEQ; } else { src = p.ctx + (size_t)(row - NLAT) * D; mr = 2; }
        const float* m = p.mod + (size_t)mr * 6 * D;
        float4 v[8]; float ss = 0.f;
#pragma unroll
        for (int j = 0; j < 8; ++j) { v[j] = *(const float4*)(src + 256 * j + 4 * lane); ss += v[j].x * v[j].x + v[j].y * v[j].y + v[j].z * v[j].z + v[j].w * v[j].w; }
        ss = wave_sum(ss);
        const float rs = rsqrtf(ss * (1.f / D) + 1e-6f);
        __syncthreads();
#pragma unroll
        for (int j = 0; j < 8; ++j) {
            const int col = 256 * j + 4 * lane;
            const float4 g = *(const float4*)(p.norm1_g + col), sh = *(const float4*)(m + col), sc = *(const float4*)(m + D + col);
            float4 o;
            o.x = v[j].x * rs * g.x * (1.f + sc.x) + sh.x; o.y = v[j].y * rs * g.y * (1.f + sc.y) + sh.y;
            o.z = v[j].z * rs * g.z * (1.f + sc.z) + sh.z; o.w = v[j].w * rs * g.w * (1.f + sc.w) + sh.w;
            *(float4*)(hs + w * D + col) = o;
            u32x2 pk; pk.x = cvt_pk_bf16(o.x, o.y); pk.y = cvt_pk_bf16(o.z, o.w);
            *(u32x2*)(p.H + (size_t)row * D + col) = pk;
        }
        __syncthreads();
        {
            const int j = t & 31, kp = t >> 5;
            float a[8];
#pragma unroll
            for (int r = 0; r < 8; ++r) a[r] = 0.f;
#pragma unroll 4
            for (int k = kp * 128; k < kp * 128 + 128; ++k) {
                const float wv = p.w_in[(size_t)k * INC + PLD + j];
#pragma unroll
                for (int r = 0; r < 8; ++r) a[r] += hs[r * D + k] * wv;
            }
#pragma unroll
            for (int r = 0; r < 8; ++r) red[(kp * 8 + r) * 32 + j] = a[r];
        }
        __syncthreads();
        if (t < 256) {
            const int r = t >> 5, j = t & 31; float s = 0.f;
#pragma unroll
            for (int kp = 0; kp < 16; ++kp) s += red[(kp * 8 + r) * 32 + j];
            p.DD[(size_t)(rb * 8 + r) * 32 + j] = s;
        }
    }
}

namespace g8 {
constexpr int BM = 256, BK = 64, HALF = 128, HTB = HALF * BK * 2;
__device__ __forceinline__ int lds_byte(int r, int c) { const int st = (r >> 4) * 2 + (c >> 5), rr = r & 15, cc = c & 31, ob = rr * 64 + cc * 2; return st * 1024 + (ob ^ (((ob >> 9) & 1) << 5)); }
__device__ __forceinline__ void stage_rc(int b, int& R, int& C) { const int st = b / 1024, sb = b % 1024, swz = sb ^ (((sb >> 9) & 1) << 5); R = (st >> 1) * 16 + swz / 64; C = (st & 1) * 32 + (swz % 64) / 2; }
__device__ __forceinline__ int perm32(int rho) { const int n = rho >> 4, i = rho & 15; return 8 * (i >> 2) + 4 * n + (i & 3); }

struct Unit { const char* A; const int* rows; int row0; const char* Bt; int orow, pn, aux; };

__device__ __forceinline__ bool work_id(int i, int G, int c, int nwg, int& wgid) {
    const long L = (long)i * G + c; if (L >= nwg) return false;
    const int l = (int)L, q = nwg / 8, r = nwg % 8, xcd = l % 8, off = l / 8;
    wgid = (xcd < r ? xcd * (q + 1) : r * (q + 1) + (xcd - r) * q) + off; return true;
}

template <class Epi, class Sched>
__device__ __forceinline__ void gemm_phase(LAS unsigned char* lds, const int K, const Sched& S, const Epi& E) {
    const int tid = threadIdx.x, wid = __builtin_amdgcn_readfirstlane(tid >> 6), lane = tid & 63, wr = wid >> 2, wc = wid & 3, fr = lane & 15, fq = lane >> 4;
    const int nt = K / BK;
    int sR[2]; unsigned sC2[2], voffB[2];
#pragma unroll
    for (int i = 0; i < 2; ++i) { int R, C; stage_rc(tid * 16 + i * 8192, R, C); const int Rb = Epi::PERM ? ((R & ~31) + perm32(R & 31)) : R;
        sR[i] = R; sC2[i] = (unsigned)C * 2u; voffB[i] = (unsigned)(Rb * K + C) * 2u; }
    const size_t kstep = (size_t)(BK * 2);
    const size_t hstep = (size_t)HALF * K * 2;
    const unsigned ldsw = (unsigned)wid * 1024u;
    const int aoff = lds_byte(wr * 64 + fr, fq * 8), boff = lds_byte(wc * 32 + fr, fq * 8);
#define G8_SA(b, h) (((b) * 2 + (h)) * g8::HTB)
#define G8_SB(b, h) ((4 + (b) * 2 + (h)) * g8::HTB)
#define G8_STAGE(bufoff, gbase, v0, v1) do { \
        __builtin_amdgcn_global_load_lds((const unsigned*)((const char*)(gbase) + (v0)), (LAS unsigned*)(lds + (bufoff) + ldsw), 16, 0, 0); \
        __builtin_amdgcn_global_load_lds((const unsigned*)((const char*)(gbase) + (v1)), (LAS unsigned*)(lds + (bufoff) + ldsw + 8192), 16, 0, 0); } while (0)
#define G8_LDA(dst, b, h) do { _Pragma("unroll") for (int m = 0; m < 4; ++m) _Pragma("unroll") for (int k = 0; k < 2; ++k) dst[m][k] = *(const LAS bf16x8*)(lds + G8_SA(b, h) + aoff + m * 2048 + k * 1024); } while (0)
#define G8_LDB(dst, b, h) do { _Pragma("unroll") for (int n = 0; n < 2; ++n) _Pragma("unroll") for (int k = 0; k < 2; ++k) dst[n][k] = *(const LAS bf16x8*)(lds + G8_SB(b, h) + boff + n * 2048 + k * 1024); } while (0)
#define G8_MMA(ai, bj, At, Bt) do { __builtin_amdgcn_s_setprio(1); _Pragma("unroll") for (int m = 0; m < 4; ++m) _Pragma("unroll") for (int n = 0; n < 2; ++n) _Pragma("unroll") for (int k = 0; k < 2; ++k) \
        acc[ai][bj][m][n] = __builtin_amdgcn_mfma_f32_16x16x32_bf16(Bt[n][k], At[m][k], acc[ai][bj][m][n], 0, 0, 0); __builtin_amdgcn_s_setprio(0); } while (0)
#define G8_WAIT_V(n) asm volatile("s_waitcnt vmcnt(" #n ")" ::: "memory")
#define G8_WAIT_L(n) asm volatile("s_waitcnt lgkmcnt(" #n ")" ::: "memory")
#define G8_BAR __builtin_amdgcn_s_barrier()
#define G8_SCHED __builtin_amdgcn_sched_barrier(0)
    Unit cur, nxt; int ui = 0;
    if (!S.next(0, cur)) return;
    f32x4 acc[2][2][4][2];
#pragma unroll
    for (int a = 0; a < 2; ++a)
#pragma unroll
        for (int b = 0; b < 2; ++b)
#pragma unroll
            for (int m = 0; m < 4; ++m)
#pragma unroll
                for (int n = 0; n < 2; ++n) acc[a][b][m][n] = (f32x4){0.f, 0.f, 0.f, 0.f};
    bf16x8 At[4][2], B0[2][2], B1[2][2];
    unsigned vA00, vA01, vA10, vA11, nA00, nA01, nA10, nA11;
#define G8_MKOFF(u, o00, o01, o10, o11) do { \
        int r00, r01, r10, r11; \
        if ((u).rows) { r00 = (u).rows[sR[0]]; r01 = (u).rows[sR[1]]; r10 = (u).rows[128 + sR[0]]; r11 = (u).rows[128 + sR[1]]; } \
        else { r00 = (u).row0 + sR[0]; r01 = (u).row0 + sR[1]; r10 = (u).row0 + 128 + sR[0]; r11 = (u).row0 + 128 + sR[1]; } \
        o00 = (unsigned)r00 * (unsigned)(K * 2) + sC2[0]; o01 = (unsigned)r01 * (unsigned)(K * 2) + sC2[1]; \
        o10 = (unsigned)r10 * (unsigned)(K * 2) + sC2[0]; o11 = (unsigned)r11 * (unsigned)(K * 2) + sC2[1]; } while (0)
    G8_MKOFF(cur, vA00, vA01, vA10, vA11);
    const char* cA = cur.A; const char* cB = cur.Bt;
    G8_STAGE(G8_SB(0, 0), cB, voffB[0], voffB[1]); G8_STAGE(G8_SA(0, 0), cA, vA00, vA01); G8_STAGE(G8_SB(0, 1), cB + hstep, voffB[0], voffB[1]); G8_STAGE(G8_SA(0, 1), cA, vA10, vA11);
    if (wr == 1) G8_BAR;
    G8_WAIT_V(4); G8_BAR;
    G8_STAGE(G8_SB(1, 0), cB + kstep, voffB[0], voffB[1]); G8_STAGE(G8_SA(1, 0), cA + kstep, vA00, vA01); G8_STAGE(G8_SB(1, 1), cB + hstep + kstep, voffB[0], voffB[1]);
    G8_WAIT_V(6); G8_BAR;
    for (;;) {
        const bool has_next = S.next(ui + 1, nxt);
        const char* nA = has_next ? nxt.A : cA; const char* nB = has_next ? nxt.Bt : cB;
        if (has_next) G8_MKOFF(nxt, nA00, nA01, nA10, nA11); else { nA00 = vA00; nA01 = vA01; nA10 = vA10; nA11 = vA11; }
        for (int t = 0; t < nt; t += 2) {
            const bool last = (t == nt - 2);
            const char* a1 = cA + (size_t)(t + 1) * kstep;
            G8_LDB(B0, 0, 0); G8_SCHED; G8_LDA(At, 0, 0); G8_STAGE(G8_SA(1, 1), a1, vA10, vA11);
            G8_WAIT_L(8); G8_BAR; G8_WAIT_L(0); G8_MMA(0, 0, At, B0); G8_BAR; G8_SCHED;
            if (last) { vA00 = nA00; vA01 = nA01; vA10 = nA10; vA11 = nA11; }
            const char* a2 = last ? nA : cA + (size_t)(t + 2) * kstep; const char* b2 = last ? nB : cB + (size_t)(t + 2) * kstep;
            const char* a3 = a2 + kstep; const char* b3 = b2 + kstep;
            G8_LDB(B1, 0, 1); G8_STAGE(G8_SB(0, 0), b2, voffB[0], voffB[1]);
            G8_BAR; G8_WAIT_L(0); G8_MMA(0, 1, At, B1); G8_BAR;
            G8_LDA(At, 0, 1); G8_STAGE(G8_SA(0, 0), a2, vA00, vA01);
            G8_BAR; G8_WAIT_L(0); G8_MMA(1, 0, At, B0); G8_BAR; G8_SCHED;
            G8_STAGE(G8_SB(0, 1), b2 + hstep, voffB[0], voffB[1]);
            G8_WAIT_V(6); G8_BAR; G8_MMA(1, 1, At, B1); G8_BAR;
            G8_LDB(B0, 1, 0); G8_SCHED; G8_LDA(At, 1, 0); G8_STAGE(G8_SA(0, 1), a2, vA10, vA11);
            G8_WAIT_L(8); G8_BAR; G8_WAIT_L(0); G8_MMA(0, 0, At, B0); G8_BAR; G8_SCHED;
            G8_LDB(B1, 1, 1); G8_STAGE(G8_SB(1, 0), b3, voffB[0], voffB[1]);
            G8_BAR; G8_WAIT_L(0); G8_MMA(0, 1, At, B1); G8_BAR;
            G8_LDA(At, 1, 1); G8_STAGE(G8_SA(1, 0), a3, vA00, vA01);
            G8_BAR; G8_WAIT_L(0); G8_MMA(1, 0, At, B0); G8_BAR; G8_SCHED;
            G8_STAGE(G8_SB(1, 1), b3 + hstep, voffB[0], voffB[1]);
            G8_WAIT_V(6); G8_BAR; G8_MMA(1, 1, At, B1); G8_BAR;
        }
        E(acc, cur, wr, wc, fr, fq);
        if (!has_next) break;
#pragma unroll
        for (int a = 0; a < 2; ++a)
#pragma unroll
            for (int b = 0; b < 2; ++b)
#pragma unroll
                for (int m = 0; m < 4; ++m)
#pragma unroll
                    for (int n = 0; n < 2; ++n) acc[a][b][m][n] = (f32x4){0.f, 0.f, 0.f, 0.f};
        cur = nxt; cA = nA; cB = nB; ++ui;
    }
    G8_WAIT_V(0);
    if (wr == 0) G8_BAR;
    G8_BAR;
}
}

struct EpiInproj {
    static constexpr bool PERM = false;
    float* P;
    __device__ __forceinline__ void operator()(const f32x4 (&acc)[2][2][4][2], const g8::Unit& u, int wr, int wc, int fr, int fq) const {
#pragma unroll
        for (int ai = 0; ai < 2; ++ai)
#pragma unroll
            for (int m = 0; m < 4; ++m) { float* rowp = P + (size_t)(u.orow + ai * 128 + wr * 64 + m * 16 + fr) * PLD + u.pn * 256 + wc * 32 + 4 * fq;
#pragma unroll
                for (int bj = 0; bj < 2; ++bj)
#pragma unroll
                    for (int n = 0; n < 2; ++n) *(f32x4*)(rowp + bj * 128 + n * 16) = acc[ai][bj][m][n]; }
    }
};
struct EpiOutproj {
    static constexpr bool PERM = false;
    const float* x; const float* mod; float* X1;
    __device__ __forceinline__ void operator()(const f32x4 (&acc)[2][2][4][2], const g8::Unit& u, int wr, int wc, int fr, int fq) const {
        const int b = u.orow / SEQ; const int col0 = u.pn * 256 + wc * 32 + 4 * fq;
        f32x4 gv[2][2];
#pragma unroll
        for (int bj = 0; bj < 2; ++bj)
#pragma unroll
            for (int n = 0; n < 2; ++n) gv[bj][n] = *(const f32x4*)(mod + (size_t)b * 6 * D + 2 * D + col0 + bj * 128 + n * 16);
#pragma unroll
        for (int ai = 0; ai < 2; ++ai)
#pragma unroll
            for (int m = 0; m < 4; ++m) { const size_t ro = (size_t)(u.orow + ai * 128 + wr * 64 + m * 16 + fr) * D + col0;
#pragma unroll
                for (int bj = 0; bj < 2; ++bj)
#pragma unroll
                    for (int n = 0; n < 2; ++n) { const f32x4 xv = *(const f32x4*)(x + ro + bj * 128 + n * 16);
                        *(f32x4*)(X1 + ro + bj * 128 + n * 16) = xv + gv[bj][n] * acc[ai][bj][m][n]; } }
    }
};
struct EpiUp {
    static constexpr bool PERM = true;
    bf16_t* HB; bf16_t* SHH;
    __device__ __forceinline__ void operator()(const f32x4 (&acc)[2][2][4][2], const g8::Unit& u, int wr, int wc, int fr, int fq) const {
        bf16_t* O = u.aux ? SHH : HB;
#pragma unroll
        for (int ai = 0; ai < 2; ++ai)
#pragma unroll
            for (int m = 0; m < 4; ++m) {
                f32x4 h0, h1;
#pragma unroll
                for (int j = 0; j < 4; ++j) { h0[j] = siluf(acc[ai][0][m][0][j]) * acc[ai][1][m][0][j]; h1[j] = siluf(acc[ai][0][m][1][j]) * acc[ai][1][m][1][j]; }
                u32x4 w; w.x = cvt_pk_bf16(h0[0], h0[1]); w.y = cvt_pk_bf16(h0[2], h0[3]); w.z = cvt_pk_bf16(h1[0], h1[1]); w.w = cvt_pk_bf16(h1[2], h1[3]);
                *(u32x4*)(O + (size_t)(u.orow + ai * 128 + wr * 64 + m * 16 + fr) * DE + u.pn * 128 + wc * 32 + 8 * fq) = w;
            }
    }
};
struct EpiDown {
    static constexpr bool PERM = true;
    bf16_t* Y;
    __device__ __forceinline__ void operator()(const f32x4 (&acc)[2][2][4][2], const g8::Unit& u, int wr, int wc, int fr, int fq) const {
#pragma unroll
        for (int ai = 0; ai < 2; ++ai)
#pragma unroll
            for (int m = 0; m < 4; ++m) { bf16_t* rowp = Y + (size_t)(u.orow + ai * 128 + wr * 64 + m * 16 + fr) * D + u.pn * 256 + wc * 32 + 8 * fq;
#pragma unroll
                for (int bj = 0; bj < 2; ++bj) { const f32x4 v0 = acc[ai][bj][m][0], v1 = acc[ai][bj][m][1];
                    u32x4 w; w.x = cvt_pk_bf16(v0[0], v0[1]); w.y = cvt_pk_bf16(v0[2], v0[3]); w.z = cvt_pk_bf16(v1[0], v1[1]); w.w = cvt_pk_bf16(v1[2], v1[3]);
                    *(u32x4*)(rowp + bj * 128) = w; } }
    }
};
struct EpiFinal {
    static constexpr bool PERM = false;
    const float* X1; const float* mod; const bf16_t* Y; const float* EW; const int* PP; float* out;
    __device__ __forceinline__ void operator()(const f32x4 (&acc)[2][2][4][2], const g8::Unit& u, int wr, int wc, int fr, int fq) const {
        const int b = u.orow / SEQ; const int col0 = u.pn * 256 + wc * 32 + 4 * fq;
        f32x4 gv[2][2];
#pragma unroll
        for (int bj = 0; bj < 2; ++bj)
#pragma unroll
            for (int n = 0; n < 2; ++n) gv[bj][n] = *(const f32x4*)(mod + (size_t)b * 6 * D + 5 * D + col0 + bj * 128 + n * 16);
#pragma unroll
        for (int ai = 0; ai < 2; ++ai)
#pragma unroll
            for (int m = 0; m < 4; ++m) {
                const int row = u.orow + ai * 128 + wr * 64 + m * 16 + fr;
                f32x4 s[2][2];
#pragma unroll
                for (int bj = 0; bj < 2; ++bj)
#pragma unroll
                    for (int n = 0; n < 2; ++n) s[bj][n] = acc[ai][bj][m][n];
#pragma unroll
                for (int k = 0; k < TOPK; ++k) {
                    const float wk = EW[row * TOPK + k]; const bf16_t* yr = Y + (size_t)PP[row * TOPK + k] * D + col0;
#pragma unroll
                    for (int bj = 0; bj < 2; ++bj)
#pragma unroll
                        for (int n = 0; n < 2; ++n) { const u32x2 yv = *(const u32x2*)(yr + bj * 128 + n * 16);
                            s[bj][n][0] += wk * bf2f(yv.x & 0xffffu); s[bj][n][1] += wk * bf2f(yv.x >> 16); s[bj][n][2] += wk * bf2f(yv.y & 0xffffu); s[bj][n][3] += wk * bf2f(yv.y >> 16); }
                }
                const size_t ro = (size_t)row * D + col0;
#pragma unroll
                for (int bj = 0; bj < 2; ++bj)
#pragma unroll
                    for (int n = 0; n < 2; ++n) { const f32x4 xv = *(const f32x4*)(X1 + ro + bj * 128 + n * 16);
                        *(f32x4*)(out + ro + bj * 128 + n * 16) = xv + gv[bj][n] * s[bj][n]; }
            }
    }
};

struct SchedDense {
    const char* A; const char* Bt; int K, nM, nN, G, c;
    __device__ __forceinline__ bool next(int i, g8::Unit& u) const {
        int wgid; if (!g8::work_id(i, G, c, nM * nN, wgid)) return false;
        const int nig = 8 * nN, gid = wgid / nig, fm = gid * 8, gsz = (nM - fm) < 8 ? (nM - fm) : 8;
        const int pm = fm + ((wgid % nig) % gsz), pn = (wgid % nig) / gsz;
        u.A = A; u.rows = nullptr; u.row0 = pm * 256; u.Bt = Bt + (size_t)pn * 256 * K * 2; u.orow = pm * 256; u.pn = pn; u.aux = 0; return true;
    }
};
struct SchedUp {
    const int* tp; const char* H2; const int* LIST; const char* E13T; const char* S13T; int G, c;
    __device__ __forceinline__ bool next(int i, g8::Unit& u) const {
        const int T = tp[NE]; int wgid; if (!g8::work_id(i, G, c, 4 * T + 128, wgid)) return false;
        u.A = H2;
        if (wgid < 4 * T) {
            int e = 0; while (e < NE - 1 && 4 * tp[e + 1] <= wgid) ++e;
            const int tc = tp[e + 1] - tp[e], li = wgid - 4 * tp[e], nt = li / tc, mt = li % tc, r0 = (tp[e] + mt) * 256;
            u.rows = LIST + r0; u.row0 = 0; u.Bt = E13T + ((size_t)e * 1024 + nt * 256) * D * 2; u.orow = r0; u.pn = nt; u.aux = 0;
        } else {
            const int s = wgid - 4 * T, pn = s / 32, pm = s % 32;
            u.rows = nullptr; u.row0 = pm * 256; u.Bt = S13T + (size_t)pn * 256 * D * 2; u.orow = pm * 256; u.pn = pn; u.aux = 1;
        }
        return true;
    }
};
struct SchedDown {
    const int* tp; const char* HB; const char* E2T; int G, c;
    __device__ __forceinline__ bool next(int i, g8::Unit& u) const {
        const int T = tp[NE]; int wgid; if (!g8::work_id(i, G, c, 8 * T, wgid)) return false;
        int e = 0; while (e < NE - 1 && 8 * tp[e + 1] <= wgid) ++e;
        const int tc = tp[e + 1] - tp[e], li = wgid - 8 * tp[e], nt = li / tc, mt = li % tc, r0 = (tp[e] + mt) * 256;
        u.A = HB; u.rows = nullptr; u.row0 = r0; u.Bt = E2T + ((size_t)e * D + nt * 256) * DE * 2; u.orow = r0; u.pn = nt; u.aux = 0; return true;
    }
};
__device__ __forceinline__ void moe_tables(const Params& p, int* tp) {
    __syncthreads();
    if (threadIdx.x == 0) { int tt = 0; for (int e = 0; e < NE; ++e) { tp[e] = tt; tt += (p.CNT[e] + 255) / 256; } tp[NE] = tt; }
    __syncthreads();
}

constexpr int NTOK = SEQ + CTXL;
__device__ void ph_naprep(const Params& p) {
    const int t = threadIdx.x, w = t >> 6, lane = t & 63;
    for (int u = blockIdx.x; u < 272; u += gridDim.x) {
        const int b = u / 136, s = u % 136; const bool lat = s < 128;
        const int row0 = lat ? (b * SEQ + 32 * s) : (NLAT + b * CTXL + 32 * (s - 128)), tok0 = lat ? 32 * s : (SEQ + 32 * (s - 128));
        for (int pi = w; pi < 512; pi += 8) {
            const int which = pi & 1, hh = (pi >> 1) & 7, tt = pi >> 4;
            if (which == 0 && !lat) continue;
            const float* src = p.P + (size_t)(row0 + tt) * PLD + which * 1024 + hh * 128;
            const float x0 = src[lane], x1 = src[lane + 64];
            const float ss = wave_sum(x0 * x0 + x1 * x1);
            const float r = rsqrtf(ss * (1.f / 128.f) + 1e-6f) * (which ? 1.f : 0.08838834764831845f * 1.4426950408889634f);
            const float* g = which ? p.k_norm_g : p.q_norm_g;
            bf16_t* dst = (which ? p.NKb : p.NQb) + (size_t)(row0 + tt) * 1024 + hh * 128;
            dst[lane] = f2bf(x0 * r * g[lane]); dst[lane + 64] = f2bf(x1 * r * g[lane + 64]);
        }
#pragma unroll 1
        for (int i = 0; i < 2; ++i) {
            const int col = t + 512 * i, hh = col >> 7, dv = col & 127;
            unsigned pk[16];
#pragma unroll
            for (int s2 = 0; s2 < 16; ++s2) pk[s2] = cvt_pk_bf16(p.P[(size_t)(row0 + 2 * s2) * PLD + 2048 + col], p.P[(size_t)(row0 + 2 * s2 + 1) * PLD + 2048 + col]);
            bf16_t* o = p.VTn + ((size_t)(b * 8 + hh) * 128 + dv) * NTOK + tok0;
#pragma unroll
            for (int q4 = 0; q4 < 4; ++q4) *(u32x4*)(o + 8 * q4) = (u32x4){pk[4 * q4], pk[4 * q4 + 1], pk[4 * q4 + 2], pk[4 * q4 + 3]};
        }
    }
}

__device__ void ph_attn(const Params& p, float* sm) {
    const int t = threadIdx.x, w = t >> 6, lane = t & 63, l31 = lane & 31, hi = lane >> 5;
    for (int u = blockIdx.x; u < 256; u += gridDim.x) {
        const int rg = u & 15, h = (u >> 4) & 7, b = u >> 7;
        __syncthreads();
        for (int i = t; i < 15 * 31; i += NT) sm[i] = p.na_rpb[h * 465 + i] * 1.4426950408889634f;
        __syncthreads();
        const int r = 4 * rg + (w >> 1), qt = w & 1, c = 32 * qt + l31;
        const int rs = min(max(r - 4, 0), 56), cs = min(max(c - 8, 0), 48);
        const int qrow = b * SEQ + r * 64 + c;
        bf16x8 qf[8];
#pragma unroll
        for (int ks = 0; ks < 8; ++ks) qf[ks] = *(const bf16x8*)(p.NQb + (size_t)qrow * 1024 + h * 128 + 16 * ks + 8 * hi);
        f32x16 o0, o1, o2, o3;
#pragma unroll
        for (int e = 0; e < 16; ++e) { o0[e] = 0.f; o1[e] = 0.f; o2[e] = 0.f; o3[e] = 0.f; }
        float m = -INFINITY, l = 0.f;
        const bf16_t* vtb = p.VTn + ((size_t)(b * 8 + h) * 128 + l31) * NTOK + 4 * hi;
        bf16x8 kc[8];
        {
            const bf16_t* kp = p.NKb + (size_t)(NLAT + b * CTXL + l31) * 1024 + h * 128 + 8 * hi;
#pragma unroll
            for (int ks = 0; ks < 8; ++ks) kc[ks] = *(const bf16x8*)(kp + 16 * ks);
        }
#pragma unroll 1
        for (int tl = 0; tl < 24; ++tl) {
            bf16x8 kn[8];
            {
                const int t1 = (tl + 1 < 24) ? tl + 1 : 23;
                int krow;
                if (t1 < 8) krow = NLAT + b * CTXL + 32 * t1 + l31;
                else { const int li = t1 - 8; krow = b * SEQ + (rs + (li >> 1)) * 64 + 32 * (li & 1) + l31; }
                const bf16_t* kp = p.NKb + (size_t)krow * 1024 + h * 128 + 8 * hi;
#pragma unroll
                for (int ks = 0; ks < 8; ++ks) kn[ks] = *(const bf16x8*)(kp + 16 * ks);
            }
            f32x16 s;
#pragma unroll
            for (int e = 0; e < 16; ++e) s[e] = 0.f;
#pragma unroll
            for (int ks = 0; ks < 8; ++ks) s = __builtin_amdgcn_mfma_f32_32x32x16_bf16(kc[ks], qf[ks], s, 0, 0, 0);
            const bool loc = tl >= 8; const int li = tl - 8, wi = li >> 1, half = li & 1;
            const int tokb = loc ? ((rs + wi) * 64 + 32 * half) : (SEQ + 32 * tl);
            bf16x8 va[4][2];
#pragma unroll
            for (int n = 0; n < 4; ++n)
#pragma unroll
                for (int s2 = 0; s2 < 2; ++s2) {
                    const bf16_t* vp = vtb + (size_t)(32 * n) * NTOK + tokb + 16 * s2;
                    const u32x2 lo = *(const u32x2*)vp, hi8 = *(const u32x2*)(vp + 8);
                    const u32x4 cat = (u32x4){lo.x, lo.y, hi8.x, hi8.y};
                    va[n][s2] = __builtin_bit_cast(bf16x8, cat);
                }
            if (loc) {
                const int dr = rs + wi - r + 7;
#pragma unroll
                for (int e = 0; e < 16; ++e) {
                    const int kcol = 32 * half + (e & 3) + 8 * (e >> 2) + 4 * hi;
                    const bool vis = (unsigned)(kcol - cs) < 16u;
                    const float bias = sm[vis ? (dr * 31 + kcol - c + 15) : 0];
                    s[e] = vis ? (s[e] + bias) : -INFINITY;
                }
            }
            float mt = s[0];
#pragma unroll
            for (int e = 1; e < 16; ++e) mt = fmaxf(mt, s[e]);
            mt = fmaxf(mt, __shfl_xor(mt, 32));
            const float mn = fmaxf(m, mt);
            const float alpha = __builtin_amdgcn_exp2f(m - mn);
            m = mn;
            float ps = 0.f;
#pragma unroll
            for (int e = 0; e < 16; ++e) { s[e] = __builtin_amdgcn_exp2f(s[e] - mn); ps += s[e]; }
            l = l * alpha + ps;
#pragma unroll
            for (int e = 0; e < 16; ++e) { o0[e] *= alpha; o1[e] *= alpha; o2[e] *= alpha; o3[e] *= alpha; }
            bf16x8 pb[2];
#pragma unroll
            for (int s2 = 0; s2 < 2; ++s2) {
                const u32x4 cat = (u32x4){cvt_pk_bf16(s[8 * s2], s[8 * s2 + 1]), cvt_pk_bf16(s[8 * s2 + 2], s[8 * s2 + 3]), cvt_pk_bf16(s[8 * s2 + 4], s[8 * s2 + 5]), cvt_pk_bf16(s[8 * s2 + 6], s[8 * s2 + 7])};
                pb[s2] = __builtin_bit_cast(bf16x8, cat);
            }
#pragma unroll
            for (int s2 = 0; s2 < 2; ++s2) {
                o0 = __builtin_amdgcn_mfma_f32_32x32x16_bf16(va[0][s2], pb[s2], o0, 0, 0, 0);
                o1 = __builtin_amdgcn_mfma_f32_32x32x16_bf16(va[1][s2], pb[s2], o1, 0, 0, 0);
                o2 = __builtin_amdgcn_mfma_f32_32x32x16_bf16(va[2][s2], pb[s2], o2, 0, 0, 0);
                o3 = __builtin_amdgcn_mfma_f32_32x32x16_bf16(va[3][s2], pb[s2], o3, 0, 0, 0);
            }
#pragma unroll
            for (int ks = 0; ks < 8; ++ks) kc[ks] = kn[ks];
        }
        l += __shfl_xor(l, 32);
        const float inv = 1.f / l;
        bf16_t* orow = p.MIX + (size_t)qrow * D + h * 128 + 4 * hi;
#pragma unroll
        for (int g = 0; g < 4; ++g) {
            u32x2 pk;
            pk.x = cvt_pk_bf16(o0[4 * g] * inv, o0[4 * g + 1] * inv); pk.y = cvt_pk_bf16(o0[4 * g + 2] * inv, o0[4 * g + 3] * inv); *(u32x2*)(orow + 0 + 8 * g) = pk;
            pk.x = cvt_pk_bf16(o1[4 * g] * inv, o1[4 * g + 1] * inv); pk.y = cvt_pk_bf16(o1[4 * g + 2] * inv, o1[4 * g + 3] * inv); *(u32x2*)(orow + 32 + 8 * g) = pk;
            pk.x = cvt_pk_bf16(o2[4 * g] * inv, o2[4 * g + 1] * inv); pk.y = cvt_pk_bf16(o2[4 * g + 2] * inv, o2[4 * g + 3] * inv); *(u32x2*)(orow + 64 + 8 * g) = pk;
            pk.x = cvt_pk_bf16(o3[4 * g] * inv, o3[4 * g + 1] * inv); pk.y = cvt_pk_bf16(o3[4 * g + 2] * inv, o3[4 * g + 3] * inv); *(u32x2*)(orow + 96 + 8 * g) = pk;
        }
    }
}

__device__ __forceinline__ float logsigf(float z) { return fminf(z, 0.f) - log1pf(expf(-fabsf(z))); }

__device__ void ph_glaprep(const Params& p, float* sm) {
    const int t = threadIdx.x, d = t & 127, tq = t >> 7;
    float* qs = sm;
    float* ksm = sm + 8192;
    float* dds = sm + 16384;
    float* tot = sm + 16384 + 2048;
    for (int u = blockIdx.x; u < 8 * 68; u += gridDim.x) {
        const int bh = u / 68, c = u % 68, b = bh >> 2, h = bh & 3;
        const bool lat = c >= 4; const int j = c - 4;
        const int row0 = lat ? (b * SEQ + 64 * j) : (NLAT + b * CTXL + 64 * c);
        __syncthreads();
        for (int i = t; i < 64 * 128; i += NT) { const int tt = i >> 7, dd = i & 127;
            qs[i] = p.P[(size_t)(row0 + tt) * PLD + 3072 + h * 128 + dd]; ksm[i] = p.P[(size_t)(row0 + tt) * PLD + 3584 + h * 128 + dd]; }
        for (int i = t; i < 64 * 32; i += NT) dds[i] = p.DD[(size_t)row0 * 32 + i];
        __syncthreads();
        float gf[16], gb[16];
        {
            float upf[16], upb[16];
#pragma unroll
            for (int r = 0; r < 16; ++r) { upf[r] = p.up_f[r * 512 + h * 128 + d]; upb[r] = p.up_b[r * 512 + h * 128 + d]; }
            const float bf = p.bias_f[h * 128 + d], bb = p.bias_b[h * 128 + d];
            float sf = 0.f, sb = 0.f;
#pragma unroll
            for (int i = 0; i < 16; ++i) {
                const float* dr = dds + (16 * tq + i) * 32; float zf = bf, zb = bb;
#pragma unroll
                for (int r = 0; r < 16; ++r) { zf += dr[r] * upf[r]; zb += dr[16 + r] * upb[r]; }
                gf[i] = logsigf(zf) * (1.f / 16.f); gb[i] = logsigf(zb) * (1.f / 16.f); sf += gf[i]; sb += gb[i];
            }
            tot[tq * 128 + d] = sf; tot[(4 + tq) * 128 + d] = sb;
        }
        __syncthreads();
        float basef = 0.f, baseb = 0.f, allf = 0.f, allb = 0.f;
#pragma unroll
        for (int q4 = 0; q4 < 4; ++q4) { const float a = tot[q4 * 128 + d], bq = tot[(4 + q4) * 128 + d]; allf += a; allb += bq; if (q4 < tq) basef += a; if (q4 > tq) baseb += bq; }
        { float run = basef;
#pragma unroll
          for (int i = 0; i < 16; ++i) { run += gf[i]; gf[i] = run; }
          run = baseb;
#pragma unroll
          for (int i = 15; i >= 0; --i) { run += gb[i]; gb[i] = run; } }
        const int dd2 = d & 63, ii = dd2 & 31, partner = (dd2 < 32) ? (d + 32) : (d - 32);
        const float sgn = (dd2 < 32) ? -1.f : 1.f;
        unsigned khf[8], khb[8]; float pkf = 0.f, pkb = 0.f;
        const size_t tb = ((size_t)(bh * 64 + j) * 64) * 128;
#pragma unroll
        for (int i = 0; i < 16; ++i) {
            const int tt = 16 * tq + i;
            float qv = qs[tt * 128 + d], kv = ksm[tt * 128 + d];
            if (lat) {
                const int pos = (d < 64) ? j : tt;
                const float cs = p.RT[(pos * 32 + ii) * 2], sn = p.RT[(pos * 32 + ii) * 2 + 1];
                const float qp = qs[tt * 128 + partner], kp = ksm[tt * 128 + partner];
                qv = qv * cs + sgn * qp * sn; kv = kv * cs + sgn * kp * sn;
            }
            qv *= 0.08838834764831845f;
            const float ef = expf(gf[i]), eb = expf(gb[i]);
            if (lat) {
                p.QF[tb + (size_t)tt * 128 + d] = f2bf(qv * ef); p.KF[tb + (size_t)tt * 128 + d] = f2bf(kv / ef);
                p.QB[tb + (size_t)tt * 128 + d] = f2bf(qv * eb); p.KB[tb + (size_t)tt * 128 + d] = f2bf(kv / eb);
            }
            const float hf = kv * expf(allf - gf[i]), hb = kv * expf(allb - gb[i]);
            if (i & 1) { khf[i >> 1] = cvt_pk_bf16(pkf, hf); khb[i >> 1] = cvt_pk_bf16(pkb, hb); } else { pkf = hf; pkb = hb; }
        }
        {
            const size_t o = ((size_t)(bh * 68 + c) * 128 + d) * 64 + 16 * tq;
            *(u32x4*)(p.KHF + o) = (u32x4){khf[0], khf[1], khf[2], khf[3]}; *(u32x4*)(p.KHF + o + 8) = (u32x4){khf[4], khf[5], khf[6], khf[7]};
            *(u32x4*)(p.KHB + o) = (u32x4){khb[0], khb[1], khb[2], khb[3]}; *(u32x4*)(p.KHB + o + 8) = (u32x4){khb[4], khb[5], khb[6], khb[7]};
            if (tq == 0) { p.DF[(size_t)(bh * 68 + c) * 128 + d] = expf(allf); p.DB[(size_t)(bh * 68 + c) * 128 + d] = expf(allb); }
        }
        {
            const int v = t & 255, half = t >> 8;
            unsigned pk[16];
#pragma unroll
            for (int s2 = 0; s2 < 16; ++s2) {
                const float a = p.P[(size_t)(row0 + 32 * half + 2 * s2) * PLD + 4096 + h * 256 + v], bq = p.P[(size_t)(row0 + 32 * half + 2 * s2 + 1) * PLD + 4096 + h * 256 + v];
                pk[s2] = cvt_pk_bf16(a, bq);
            }
            bf16_t* o = p.VT + ((size_t)(bh * 68 + c) * 256 + v) * 64 + 32 * half;
#pragma unroll
            for (int q4 = 0; q4 < 4; ++q4) *(u32x4*)(o + 8 * q4) = (u32x4){pk[4 * q4], pk[4 * q4 + 1], pk[4 * q4 + 2], pk[4 * q4 + 3]};
        }
    }
}

__device__ void ph_glascan(const Params& p) {
    if (blockIdx.x >= 64) return;
    const int t = threadIdx.x, w = t >> 6, lane = t & 63, l31 = lane & 31, hi = lane >> 5;
    const int u = blockIdx.x, vq = u & 3, scan = u >> 2, dir = scan >> 3, bh = scan & 7;
    const int d0 = 32 * (w & 3), v0 = 64 * vq + 32 * (w >> 2);
    const bf16_t* KH = dir ? p.KHB : p.KHF; const float* DV = dir ? p.DB : p.DF;
    f32x16 acc;
#pragma unroll
    for (int r = 0; r < 16; ++r) acc[r] = 0.f;
    bf16x8 a[4], bq[4]; f32x4 dv[4];
    {
        const int c = dir ? 3 : 0;
        const bf16_t* ka = KH + ((size_t)(bh * 68 + c) * 128 + d0 + l31) * 64 + 8 * hi; const bf16_t* vb = p.VT + ((size_t)(bh * 68 + c) * 256 + v0 + l31) * 64 + 8 * hi;
#pragma unroll
        for (int ks = 0; ks < 4; ++ks) { a[ks] = *(const bf16x8*)(ka + 16 * ks); bq[ks] = *(const bf16x8*)(vb + 16 * ks); }
#pragma unroll
        for (int g = 0; g < 4; ++g) dv[g] = *(const f32x4*)(DV + (size_t)(bh * 68 + c) * 128 + d0 + 8 * g + 4 * hi);
    }
#pragma unroll 1
    for (int n = 0; n < 68; ++n) {
        const int c = dir ? (n < 4 ? 3 - n : 71 - n) : n;
        const int n1 = (n + 1 < 68) ? n + 1 : 67;
        const int c1 = dir ? (n1 < 4 ? 3 - n1 : 71 - n1) : n1;
        bf16x8 an[4], bn[4]; f32x4 dn[4];
        {
            const bf16_t* ka = KH + ((size_t)(bh * 68 + c1) * 128 + d0 + l31) * 64 + 8 * hi; const bf16_t* vb = p.VT + ((size_t)(bh * 68 + c1) * 256 + v0 + l31) * 64 + 8 * hi;
#pragma unroll
            for (int ks = 0; ks < 4; ++ks) { an[ks] = *(const bf16x8*)(ka + 16 * ks); bn[ks] = *(const bf16x8*)(vb + 16 * ks); }
#pragma unroll
            for (int g = 0; g < 4; ++g) dn[g] = *(const f32x4*)(DV + (size_t)(bh * 68 + c1) * 128 + d0 + 8 * g + 4 * hi);
        }
        if (c >= 4) {
            bf16_t* so = p.SS + ((((size_t)dir * 8 + bh) * 64 + (c - 4)) * 256 + v0 + l31) * 128 + d0 + 4 * hi;
#pragma unroll
            for (int g = 0; g < 4; ++g) { u32x2 pk; pk.x = cvt_pk_bf16(acc[4 * g], acc[4 * g + 1]); pk.y = cvt_pk_bf16(acc[4 * g + 2], acc[4 * g + 3]); *(u32x2*)(so + 8 * g) = pk; }
        }
#pragma unroll
        for (int g = 0; g < 4; ++g)
#pragma unroll
            for (int e = 0; e < 4; ++e) acc[4 * g + e] *= dv[g][e];
#pragma unroll
        for (int ks = 0; ks < 4; ++ks) acc = __builtin_amdgcn_mfma_f32_32x32x16_bf16(a[ks], bq[ks], acc, 0, 0, 0);
#pragma unroll
        for (int ks = 0; ks < 4; ++ks) { a[ks] = an[ks]; bq[ks] = bn[ks]; dv[ks] = dn[ks]; }
    }
}

__device__ void ph_glaout(const Params& p, unsigned char* smb) {
    const int t = threadIdx.x, w = t >> 6, lane = t & 63, l31 = lane & 31, hi = lane >> 5;
    const int wv = w & 3, wt = w >> 2;
    bf16_t* att = (bf16_t*)smb;
    float* ssq = (float*)(smb + 2 * 64 * 144);
    for (int u = blockIdx.x; u < 512; u += gridDim.x) {
        const int bh = u >> 6, j = u & 63, b = bh >> 2, h = bh & 3;
        const size_t tb = ((size_t)(bh * 64 + j) * 64) * 128;
        {
            const int dir = w >> 2, ts = (w >> 1) & 1, tt = w & 1;
            const bf16_t* Qm = (dir ? p.QB : p.QF) + tb; const bf16_t* Km = (dir ? p.KB : p.KF) + tb;
            const bool zero = dir ? (ts < tt) : (ts > tt);
            f32x16 s;
#pragma unroll
            for (int r = 0; r < 16; ++r) s[r] = 0.f;
            if (!zero) {
#pragma unroll
                for (int ks = 0; ks < 8; ++ks) {
                    const bf16x8 ka = *(const bf16x8*)(Km + (size_t)(32 * ts + l31) * 128 + 16 * ks + 8 * hi);
                    const bf16x8 qb = *(const bf16x8*)(Qm + (size_t)(32 * tt + l31) * 128 + 16 * ks + 8 * hi);
                    s = __builtin_amdgcn_mfma_f32_32x32x16_bf16(ka, qb, s, 0, 0, 0);
                }
            }
            const int tcol = 32 * tt + l31;
#pragma unroll
            for (int g = 0; g < 4; ++g) {
                float vv[4];
#pragma unroll
                for (int e = 0; e < 4; ++e) { const int srow = 32 * ts + 8 * g + 4 * hi + e; const bool keep = dir ? (srow >= tcol) : (srow <= tcol); vv[e] = keep ? s[4 * g + e] : 0.f; }
                u32x2 pk; pk.x = cvt_pk_bf16(vv[0], vv[1]); pk.y = cvt_pk_bf16(vv[2], vv[3]);
                *(u32x2*)(att + ((size_t)dir * 64 + tcol) * 72 + 32 * ts + 8 * g + 4 * hi) = pk;
            }
        }
        __syncthreads();
        f32x16 o0, o1;
#pragma unroll
        for (int r = 0; r < 16; ++r) { o0[r] = 0.f; o1[r] = 0.f; }
        const int tB = 32 * wt + l31;
        const bf16_t* vt0 = p.VT + ((size_t)(bh * 68 + 4 + j) * 256 + 64 * wv + l31) * 64 + 8 * hi;
#pragma unroll
        for (int dir = 0; dir < 2; ++dir) {
#pragma unroll
            for (int ks = 0; ks < 4; ++ks) {
                const bf16x8 bb = *(const bf16x8*)(att + ((size_t)dir * 64 + tB) * 72 + 16 * ks + 8 * hi);
                const bf16x8 a0 = *(const bf16x8*)(vt0 + 16 * ks), a1 = *(const bf16x8*)(vt0 + 32 * 64 + 16 * ks);
                o0 = __builtin_amdgcn_mfma_f32_32x32x16_bf16(a0, bb, o0, 0, 0, 0);
                o1 = __builtin_amdgcn_mfma_f32_32x32x16_bf16(a1, bb, o1, 0, 0, 0);
            }
            const bf16_t* ss0 = p.SS + ((((size_t)dir * 8 + bh) * 64 + j) * 256 + 64 * wv + l31) * 128 + 8 * hi;
            const bf16_t* qm = (dir ? p.QB : p.QF) + tb + (size_t)tB * 128 + 8 * hi;
#pragma unroll
            for (int ks = 0; ks < 8; ++ks) {
                const bf16x8 bb = *(const bf16x8*)(qm + 16 * ks);
                const bf16x8 a0 = *(const bf16x8*)(ss0 + 16 * ks), a1 = *(const bf16x8*)(ss0 + 32 * 128 + 16 * ks);
                o0 = __builtin_amdgcn_mfma_f32_32x32x16_bf16(a0, bb, o0, 0, 0, 0);
                o1 = __builtin_amdgcn_mfma_f32_32x32x16_bf16(a1, bb, o1, 0, 0, 0);
            }
        }
        float ss = 0.f;
#pragma unroll
        for (int r = 0; r < 16; ++r) ss += o0[r] * o0[r] + o1[r] * o1[r];
        ss += __shfl_xor(ss, 32);
        if (hi == 0) ssq[(wt * 4 + wv) * 32 + l31] = ss;
        __syncthreads();
        const float tot = ssq[(wt * 4 + 0) * 32 + l31] + ssq[(wt * 4 + 1) * 32 + l31] + ssq[(wt * 4 + 2) * 32 + l31] + ssq[(wt * 4 + 3) * 32 + l31];
        const float rstd = rsqrtf(tot * (1.f / 256.f) + 1e-6f);
        const int row = b * SEQ + 64 * j + tB;
#pragma unroll
        for (int vt = 0; vt < 2; ++vt)
#pragma unroll
            for (int g = 0; g < 4; ++g) {
                const int v = 64 * wv + 32 * vt + 8 * g + 4 * hi;
                const f32x4 gate = *(const f32x4*)(p.P + (size_t)row * PLD + 5120 + h * 256 + v);
                const f32x4 gn = *(const f32x4*)(p.gla_norm_g + v);
                float ov[4];
#pragma unroll
                for (int e = 0; e < 4; ++e) { const float x = vt ? o1[4 * g + e] : o0[4 * g + e]; ov[e] = x * rstd * gn[e] * siluf(gate[e]); }
                u32x2 pk; pk.x = cvt_pk_bf16(ov[0], ov[1]); pk.y = cvt_pk_bf16(ov[2], ov[3]);
                *(u32x2*)(p.MIX + (size_t)row * D + 1024 + h * 256 + v) = pk;
            }
        __syncthreads();
    }
}

__device__ void ph_norm2_router(const Params& p, float* sm) {
    const int t = threadIdx.x, w = t >> 6, lane = t & 63;
    float* hs = sm;
    float* part = sm + 8 * D;
    for (int rb = blockIdx.x; rb < NLAT / 8; rb += gridDim.x) {
        const int row = rb * 8 + w, b = row / SEQ;
        const float* m = p.mod + (size_t)b * 6 * D;
        const float* src = p.X1 + (size_t)row * D;
        float4 v[8]; float ss = 0.f;
#pragma unroll
        for (int j = 0; j < 8; ++j) { v[j] = *(const float4*)(src + 256 * j + 4 * lane); ss += v[j].x * v[j].x + v[j].y * v[j].y + v[j].z * v[j].z + v[j].w * v[j].w; }
        ss = wave_sum(ss);
        const float rs = rsqrtf(ss * (1.f / D) + 1e-6f);
        __syncthreads();
#pragma unroll
        for (int j = 0; j < 8; ++j) {
            const int col = 256 * j + 4 * lane;
            const float4 g = *(const float4*)(p.norm2_g + col), sh = *(const float4*)(m + 3 * D + col), sc = *(const float4*)(m + 4 * D + col);
            float4 o;
            o.x = v[j].x * rs * g.x * (1.f + sc.x) + sh.x; o.y = v[j].y * rs * g.y * (1.f + sc.y) + sh.y;
            o.z = v[j].z * rs * g.z * (1.f + sc.z) + sh.z; o.w = v[j].w * rs * g.w * (1.f + sc.w) + sh.w;
            *(float4*)(hs + w * D + col) = o;
            u32x2 pk; pk.x = cvt_pk_bf16(o.x, o.y); pk.y = cvt_pk_bf16(o.z, o.w);
            *(u32x2*)(p.H + (size_t)row * D + col) = pk;
        }
        __syncthreads();
        {
            const int e = t & 63, kp = t >> 6;
            float a[8];
#pragma unroll
            for (int r = 0; r < 8; ++r) a[r] = 0.f;
#pragma unroll 8
            for (int k = kp * 256; k < kp * 256 + 256; ++k) {
                const float wv = p.router_w[(size_t)k * NE + e];
#pragma unroll
                for (int r = 0; r < 8; ++r) a[r] += hs[r * D + k] * wv;
            }
#pragma unroll
            for (int r = 0; r < 8; ++r) part[(kp * 8 + r) * 64 + e] = a[r];
        }
        __syncthreads();
        {
            float lgt = 0.f;
#pragma unroll
            for (int i = 0; i < 8; ++i) lgt += part[(i * 8 + w) * 64 + lane];
            const float sc = 1.f / (1.f + expf(-lgt));
            const float bs = sc + p.router_bias[lane];
            float m1 = bs; m1 = fmaxf(m1, __shfl_xor(m1, 1)); m1 = fmaxf(m1, __shfl_xor(m1, 2)); m1 = fmaxf(m1, __shfl_xor(m1, 4));
            int ai = (bs == m1) ? lane : 64; ai = min(ai, __shfl_xor(ai, 1)); ai = min(ai, __shfl_xor(ai, 2)); ai = min(ai, __shfl_xor(ai, 4));
            float m2 = (lane == ai) ? -INFINITY : bs; m2 = fmaxf(m2, __shfl_xor(m2, 1)); m2 = fmaxf(m2, __shfl_xor(m2, 2)); m2 = fmaxf(m2, __shfl_xor(m2, 4));
            const float gs = m1 + m2;
            float g0 = __shfl(gs, 0), g1 = __shfl(gs, 8), g2 = __shfl(gs, 16), g3 = __shfl(gs, 24), g4 = __shfl(gs, 32), g5 = __shfl(gs, 40), g6 = __shfl(gs, 48), g7 = __shfl(gs, 56);
            unsigned selmask = 0u;
#pragma unroll
            for (int it = 0; it < 4; ++it) {
                float best = -INFINITY; int bi = 0;
                if (!(selmask & 1u) && g0 > best) { best = g0; bi = 0; }
                if (!(selmask & 2u) && g1 > best) { best = g1; bi = 1; }
                if (!(selmask & 4u) && g2 > best) { best = g2; bi = 2; }
                if (!(selmask & 8u) && g3 > best) { best = g3; bi = 3; }
                if (!(selmask & 16u) && g4 > best) { best = g4; bi = 4; }
                if (!(selmask & 32u) && g5 > best) { best = g5; bi = 5; }
                if (!(selmask & 64u) && g6 > best) { best = g6; bi = 6; }
                if (!(selmask & 128u) && g7 > best) { best = g7; bi = 7; }
                selmask |= 1u << bi;
            }
            float cand = ((selmask >> (lane >> 3)) & 1u) ? bs : -INFINITY;
            int myslot = -1; float ssum = 0.f;
#pragma unroll
            for (int k = 0; k < TOPK; ++k) {
                const float mv = wave_max(cand);
                const int idx = wave_min_i((cand == mv) ? lane : 64);
                const float sv = __shfl(sc, idx);
                ssum += sv;
                if (lane == idx) { myslot = k; cand = -INFINITY; }
            }
            if (myslot >= 0) {
                p.EIDX[row * TOPK + myslot] = lane;
                p.EW[row * TOPK + myslot] = sc / ssum * 2.5f;
                atomicAdd(&p.CNT[lane], 1);
            }
        }
    }
}

__device__ void ph_lists(const Params& p, int* tp) {
    moe_tables(p, tp);
    for (int i = blockIdx.x * NT + threadIdx.x; i < NPAIR; i += gridDim.x * NT) {
        const int e = p.EIDX[i];
        const int pos = tp[e] * 256 + atomicAdd(&p.CUR[e], 1);
        p.PAIRPOS[i] = pos; p.LIST[pos] = i / TOPK;
    }
    for (int e = blockIdx.x; e < NE; e += gridDim.x) {
        const int c = p.CNT[e], end = (tp[e + 1] - tp[e]) * 256;
        for (int i = c + threadIdx.x; i < end; i += NT) p.LIST[tp[e] * 256 + i] = 0;
    }
}

__global__ void __launch_bounds__(NT, 2) mega(Params p) {
    extern __shared__ __attribute__((aligned(16))) unsigned char dynlds[];
    if (threadIdx.x < 4) ((unsigned*)(dynlds + LDS_BARW))[threadIdx.x] = 0u;
    __syncthreads();
    XcdBarrier bar = xcd_barrier_post(p.bar, (volatile LAS unsigned*)(dynlds + LDS_BARW));
    float* sm = (float*)dynlds;
    int* tp = (int*)(dynlds + LDS_TAB);
    LAS unsigned char* lds = (LAS unsigned char*)dynlds;
    const int G = gridDim.x, c = blockIdx.x;

    ph_prologue(p, sm);                                   xcd_barrier(bar);
    ph_norm1(p, sm);                                      xcd_barrier(bar);
    { SchedDense S{(const char*)p.H, (const char*)p.WinT, D, NROW / 256, PLD / 256, G, c}; EpiInproj E{p.P};
      g8::gemm_phase(lds, D, S, E); }                     xcd_barrier(bar);
    ph_naprep(p); ph_glaprep(p, sm);                       xcd_barrier(bar);
    ph_glascan(p); ph_attn(p, sm);                        xcd_barrier(bar);
    ph_glaout(p, dynlds);                                 xcd_barrier(bar);
    { SchedDense S{(const char*)p.MIX, (const char*)p.WoutT, D, NLAT / 256, D / 256, G, c}; EpiOutproj E{p.x, p.mod, p.X1};
      g8::gemm_phase(lds, D, S, E); }                     xcd_barrier(bar);
    ph_norm2_router(p, sm);                               xcd_barrier(bar);
    ph_lists(p, tp);                                      xcd_barrier(bar);
    { moe_tables(p, tp);
      SchedUp S{tp, (const char*)p.H, p.LIST, (const char*)p.E13T, (const char*)p.S13T, G, c}; EpiUp E{p.HB, p.SHH};
      g8::gemm_phase(lds, D, S, E); }                     xcd_barrier(bar);
    { SchedDown S{tp, (const char*)p.HB, (const char*)p.E2T, G, c}; EpiDown E{p.Y};
      g8::gemm_phase(lds, DE, S, E); }                    xcd_barrier(bar);
    { SchedDense S{(const char*)p.SHH, (const char*)p.S2T, DE, NLAT / 256, D / 256, G, c}; EpiFinal E{p.X1, p.mod, p.Y, p.EW, p.PAIRPOS, p.out};
      g8::gemm_phase(lds, DE, S, E); }
}

extern "C" void kernel_launch(void* const* d_in, const int* in_sizes, int n_in, void* d_out, int out_size, void* d_ws, size_t ws_size, hipStream_t stream) {
    Params p{};
    const float* const* in = (const float* const*)d_in;
    p.x = in[0]; p.c = in[1]; p.ctx = in[2]; p.c_ctx = in[3]; p.w_mod = in[4]; p.b_mod = in[5]; p.norm1_g = in[6]; p.norm2_g = in[7]; p.w_in = in[8];
    p.q_norm_g = in[9]; p.k_norm_g = in[10]; p.na_rpb = in[11]; p.up_f = in[12]; p.bias_f = in[13]; p.up_b = in[14]; p.bias_b = in[15]; p.gla_norm_g = in[16];
    p.w_out = in[17]; p.router_w = in[18]; p.router_bias = in[19]; p.ew1 = in[20]; p.ew3 = in[21]; p.ew2 = in[22]; p.sw1 = in[23]; p.sw3 = in[24]; p.sw2 = in[25];
    p.out = (float*)d_out;
    char* w = (char*)d_ws; size_t o = 0;
    auto take = [&](size_t bytes) { void* r = w + o; o += (bytes + 255) & ~(size_t)255; return r; };
    p.bar = (unsigned*)take((size_t)XCD_BAR_WORDS * 4);
    p.CNT = (int*)take(64 * 4); p.CUR = (int*)take(64 * 4);
    p.mod = (float*)take((size_t)3 * 6 * D * 4); p.RT = (float*)take((size_t)64 * 32 * 2 * 4);
    p.EIDX = (int*)take((size_t)NPAIR * 4); p.EW = (float*)take((size_t)NPAIR * 4); p.PAIRPOS = (int*)take((size_t)NPAIR * 4); p.LIST = (int*)take((size_t)PADROWS * 4);
    p.WinT = (bf16_t*)take((size_t)PLD * D * 2); p.WoutT = (bf16_t*)take((size_t)D * D * 2); p.S13T = (bf16_t*)take((size_t)1024 * D * 2); p.S2T = (bf16_t*)take((size_t)D * DE * 2);
    p.E13T = (bf16_t*)take((size_t)NE * 1024 * D * 2); p.E2T = (bf16_t*)take((size_t)NE * D * DE * 2);
    p.H = (bf16_t*)take((size_t)NROW * D * 2);
    p.X1 = (float*)take((size_t)NLAT * D * 4);
    const size_t big = o;
    p.P = (float*)take((size_t)NROW * PLD * 4); p.DD = (float*)take((size_t)NROW * 32 * 4); p.NQb = (bf16_t*)take((size_t)NLAT * 1024 * 2); p.NKb = (bf16_t*)take((size_t)NROW * 1024 * 2); p.VTn = (bf16_t*)take((size_t)16 * 128 * NTOK * 2);
    p.MIX = (bf16_t*)take((size_t)NLAT * D * 2);
    p.QF = (bf16_t*)take((size_t)8 * 64 * 64 * 128 * 2); p.KF = (bf16_t*)take((size_t)8 * 64 * 64 * 128 * 2); p.QB = (bf16_t*)take((size_t)8 * 64 * 64 * 128 * 2); p.KB = (bf16_t*)take((size_t)8 * 64 * 64 * 128 * 2);
    p.KHF = (bf16_t*)take((size_t)8 * 68 * 128 * 64 * 2); p.KHB = (bf16_t*)take((size_t)8 * 68 * 128 * 64 * 2); p.VT = (bf16_t*)take((size_t)8 * 68 * 256 * 64 * 2);
    p.DF = (float*)take((size_t)8 * 68 * 128 * 4); p.DB = (float*)take((size_t)8 * 68 * 128 * 4); p.SS = (bf16_t*)take((size_t)16 * 64 * 256 * 128 * 2);
    o = big;
    p.HB = (bf16_t*)take((size_t)PADROWS * DE * 2); p.SHH = (bf16_t*)take((size_t)NLAT * DE * 2); p.Y = (bf16_t*)take((size_t)PADROWS * D * 2);
    static int grid = 0;
    if (!grid) {
        int dev = 0, cus = 0, per_cu = 0;
        hipGetDevice(&dev);
        hipDeviceGetAttribute(&cus, hipDeviceAttributeMultiprocessorCount, dev);
        (void)hipFuncSetAttribute((const void*)mega, hipFuncAttributeMaxDynamicSharedMemorySize, LDS_BYTES);
        (void)hipOccupancyMaxActiveBlocksPerMultiprocessor(&per_cu, (const void*)mega, NT, LDS_BYTES);
        (void)hipGetLastError();
        grid = cus;
    }
    (void)hipMemsetAsync(p.bar, 0, (size_t)XCD_BAR_WORDS * 4, stream);
    hipLaunchKernelGGL(mega, dim3(grid), dim3(NT), LDS_BYTES, stream, p);
}
```

```cpp
#include <hip/hip_runtime.h>
#include <stdint.h>

#define XB_TMO      128
#define XB_XCNT(j)  (256  + 64 * (j))
#define XB_XSUB(j)  (1280 + 64 * (j))
#define XB_XGEN(j)  (2304 + 64 * (j))
#define XB_TOP      3328
#define XB_TOPGEN   3392
#define XCD_BAR_WORDS 3456
#define XB_SPIN_CAP (1u << 18)
#define LAS __attribute__((address_space(3)))

__device__ __forceinline__ unsigned xb_ld(unsigned* p)              { return __hip_atomic_load(p, __ATOMIC_RELAXED, __HIP_MEMORY_SCOPE_AGENT); }
__device__ __forceinline__ unsigned xb_add(unsigned* p, unsigned v) { return __hip_atomic_fetch_add(p, v, __ATOMIC_RELAXED, __HIP_MEMORY_SCOPE_AGENT); }
__device__ __forceinline__ unsigned xb_xcc_id() { return (unsigned)__builtin_amdgcn_s_getreg((3 << 11) | 20) & 0xFu; }
#define XB_SPIN(cond, bar) do { unsigned _sp = 0; while (cond) { __builtin_amdgcn_s_sleep(1); \
    if ((++_sp & 255u) == 0u) { if (xb_ld(&(bar)[XB_TMO])) break; if (_sp > XB_SPIN_CAP) { atomicAdd(&(bar)[XB_TMO], 1u); break; } } } } while (0)

__device__ __forceinline__ int xb_lane_id() { return (int)__builtin_amdgcn_mbcnt_hi(~0u, __builtin_amdgcn_mbcnt_lo(~0u, 0u)); }
struct XcdBarrier {
    int wid;
    unsigned* bar; unsigned x;
    volatile LAS unsigned* st;
};

__device__ __forceinline__ XcdBarrier xcd_barrier_post(unsigned* bar, volatile LAS unsigned* st, int wid) {
    XcdBarrier b; b.wid = wid; b.bar = bar; b.x = xb_xcc_id(); b.st = st;
    if (wid == 0 && xb_lane_id() == 0) (void)xb_add(&bar[XB_XCNT(b.x)], 1u);
    return b;
}
__device__ __forceinline__ void xcd_barrier_complete(unsigned* bar, unsigned x, unsigned& nloc, unsigned& nx) {
    const unsigned G = gridDim.x * gridDim.y * gridDim.z;
    unsigned sum, cnt, mine, sp = 0u;
    for (;;) {
        sum = 0u; cnt = 0u; mine = 0u;
#pragma unroll
        for (unsigned j = 0; j < 16; ++j) { const unsigned c = xb_ld(&bar[XB_XCNT(j)]); sum += c; cnt += (c > 0u) ? 1u : 0u; mine = (j == x) ? c : mine; }
        if (sum == G) break;
        __builtin_amdgcn_s_sleep(1);
        if ((++sp & 255u) == 0u) { if (xb_ld(&bar[XB_TMO])) break; if (sp > XB_SPIN_CAP) { atomicAdd(&bar[XB_TMO], 1u); break; } }
    }
    nloc = mine > 0u ? mine : 1u; nx = cnt > 0u ? cnt : 1u;
}

__device__ __forceinline__ void xcd_barrier(const XcdBarrier& b) {
    asm volatile("s_waitcnt vmcnt(0)" ::: "memory");
    __syncthreads();
    if (b.wid == 0 && xb_lane_id() == 0) {
        unsigned* bar = b.bar;
        __builtin_amdgcn_s_waitcnt(0);
        unsigned nloc = b.st[0], nx = b.st[1];
        if (nloc == 0u) { xcd_barrier_complete(bar, b.x, nloc, nx); b.st[0] = nloc; b.st[1] = nx; }
        const unsigned old = xb_add(&bar[XB_XSUB(b.x)], 1u);
        const unsigned gen = old / nloc;
        if (old + 1u == (gen + 1u) * nloc) {
            __builtin_amdgcn_fence(__ATOMIC_RELEASE, "agent");
            asm volatile("s_waitcnt vmcnt(0)" ::: "memory");
            const unsigned og = xb_add(&bar[XB_TOP], 1u);
            const unsigned tg = og / nx;
            if (og + 1u == (tg + 1u) * nx) xb_add(&bar[XB_TOPGEN], 1u);
            else XB_SPIN(xb_ld(&bar[XB_TOPGEN]) == tg, bar);
            __builtin_amdgcn_fence(__ATOMIC_ACQUIRE, "agent");
            xb_add(&bar[XB_XGEN(b.x)], 1u);
            asm volatile("s_waitcnt vmcnt(0)" ::: "memory");
        } else {
            XB_SPIN(xb_ld(&bar[XB_XGEN(b.x)]) == gen, bar);
            __builtin_amdgcn_fence(__ATOMIC_ACQUIRE, "agent");
            asm volatile("s_waitcnt vmcnt(0)" ::: "memory");
        }
    }
    __syncthreads();
}


#define NT 512
typedef unsigned short bf16_t;
typedef short bf16x8 __attribute__((ext_vector_type(8)));
typedef float f32x4 __attribute__((ext_vector_type(4)));
typedef float f32x16 __attribute__((ext_vector_type(16)));
typedef unsigned u32x4 __attribute__((ext_vector_type(4)));
typedef unsigned u32x2 __attribute__((ext_vector_type(2)));

constexpr int D = 2048, SEQ = 4096, CTXL = 256, NB = 2;
constexpr int NLAT = NB * SEQ;
constexpr int NCTX = NB * CTXL;
constexpr int NROW = NLAT + NCTX;
constexpr int INC = 6176;
constexpr int PLD = 6144;
constexpr int NE = 64, TOPK = 6, DE = 512;
constexpr int NPAIR = NLAT * TOPK;
constexpr int PADROWS = NPAIR + NE * 256;
constexpr int LDS_STAGE = 131072;
constexpr int LDS_TAB = LDS_STAGE;
constexpr int LDS_BARW = LDS_STAGE + 4096;
constexpr int LDS_BYTES = LDS_BARW + 16 + 8192;

struct Params {
    const float *x, *c, *ctx, *c_ctx, *w_mod, *b_mod, *norm1_g, *norm2_g, *w_in, *q_norm_g, *k_norm_g, *na_rpb,
        *up_f, *bias_f, *up_b, *bias_b, *gla_norm_g, *w_out, *router_w, *router_bias, *ew1, *ew3, *ew2, *sw1, *sw3, *sw2;
    float* out;
    float *mod, *X1, *P, *DD, *EW, *RT, *DF, *DB;
    bf16_t *H, *MIX, *HB, *SHH, *Y, *WinT, *WoutT, *S13T, *S2T, *E13T, *E2T, *QF, *KF, *QB, *KB, *KHF, *KHB, *VT, *SS, *NQb, *NKb, *VTn, *YS;
    int *EIDX, *PAIRPOS, *LIST, *CNT, *QCTR, *LRANK, *CNTB;
    unsigned* bar;
};

__device__ __forceinline__ int fresh_lane_id() { int l; asm volatile("v_mbcnt_lo_u32_b32 %0, -1, 0\n\tv_mbcnt_hi_u32_b32 %0, -1, %0" : "=v"(l)); return l; }
__device__ __forceinline__ int opaque_tid(int wid0) { return wid0 * 64 + fresh_lane_id(); }
__device__ __forceinline__ float wave_sum(float v) { for (int o = 32; o > 0; o >>= 1) v += __shfl_xor(v, o); return v; }
__device__ __forceinline__ float wave_max(float v) { for (int o = 32; o > 0; o >>= 1) v = fmaxf(v, __shfl_xor(v, o)); return v; }
__device__ __forceinline__ int wave_min_i(int v) { for (int o = 32; o > 0; o >>= 1) v = min(v, __shfl_xor(v, o)); return v; }
__device__ __forceinline__ float siluf(float v) { return v / (1.f + expf(-v)); }
typedef float f32x2 __attribute__((ext_vector_type(2)));
typedef __bf16 bf16x2_t __attribute__((ext_vector_type(2)));
__device__ __forceinline__ unsigned cvt_pk_bf16(float lo, float hi) { const f32x2 v = {lo, hi}; return __builtin_bit_cast(unsigned, __builtin_convertvector(v, bf16x2_t)); }
__device__ __forceinline__ bf16_t f2bf(float f) { return (bf16_t)(cvt_pk_bf16(f, 0.f) & 0xffffu); }
__device__ __forceinline__ float bf2f(unsigned b) { return __uint_as_float(b << 16); }

__device__ __forceinline__ void adaln_item(const Params& p, float* sm, int item, const int wid0) {
    const int t = opaque_tid(wid0), cq = t & 15, kg = t >> 4, n0 = item * 64;
    float* red = sm + 3 * D;
    float a[3][4];
#pragma unroll
    for (int r = 0; r < 3; ++r)
#pragma unroll
        for (int j = 0; j < 4; ++j) a[r][j] = 0.f;
#pragma unroll 4
    for (int k = kg; k < D; k += 32) {
        const float4 w = *(const float4*)(p.w_mod + (size_t)k * (6 * D) + n0 + 4 * cq);
        const float s0 = sm[k], s1 = sm[D + k], s2 = sm[2 * D + k];
        a[0][0] += s0 * w.x; a[0][1] += s0 * w.y; a[0][2] += s0 * w.z; a[0][3] += s0 * w.w;
        a[1][0] += s1 * w.x; a[1][1] += s1 * w.y; a[1][2] += s1 * w.z; a[1][3] += s1 * w.w;
        a[2][0] += s2 * w.x; a[2][1] += s2 * w.y; a[2][2] += s2 * w.z; a[2][3] += s2 * w.w;
    }
    __syncthreads();
#pragma unroll
    for (int r = 0; r < 3; ++r)
#pragma unroll
        for (int j = 0; j < 4; ++j) red[(kg * 3 + r) * 64 + 4 * cq + j] = a[r][j];
    __syncthreads();
    if (t < 192) {
        const int r = t >> 6, cc = t & 63;
        float s = p.b_mod[n0 + cc];
#pragma unroll 8
        for (int g = 0; g < 32; ++g) s += red[(g * 3 + r) * 64 + cc];
        p.mod[(size_t)r * 6 * D + n0 + cc] = s;
    }
    __syncthreads();
}
__device__ __forceinline__ void transpose_item(const float* W, int K, int N, int k0, int n0, bf16_t* WT, int drow0, float* scr, int lane, int maxc = 63) {
    const int cl = lane < maxc ? lane : maxc;
#pragma unroll 8
    for (int kk = 0; kk < 64; ++kk) scr[kk * 65 + lane] = W[(size_t)(k0 + kk) * N + n0 + cl];
    asm volatile("s_waitcnt lgkmcnt(0)" ::: "memory");
    const int c = lane & 7;
#pragma unroll
    for (int j = 0; j < 8; ++j) {
        const int n = (lane >> 3) + 8 * j; const float* s = scr + (8 * c) * 65 + n;
        u32x4 o; o.x = cvt_pk_bf16(s[0], s[65]); o.y = cvt_pk_bf16(s[2 * 65], s[3 * 65]); o.z = cvt_pk_bf16(s[4 * 65], s[5 * 65]); o.w = cvt_pk_bf16(s[6 * 65], s[7 * 65]);
        *(u32x4*)(WT + (size_t)(drow0 + n) * K + k0 + 8 * c) = o;
    }
    asm volatile("s_waitcnt lgkmcnt(0)" ::: "memory");
}
constexpr int CI_WIN = 32 * 97, CI_WOUT = 32 * 32, CI_S13 = 2 * 32 * 8, CI_S2 = 8 * 32, CI_E13 = 64 * 2 * 32 * 8, CI_E2 = 64 * 8 * 32;
constexpr int CI_TOTAL = CI_WIN + CI_WOUT + CI_S13 + CI_S2 + CI_E13 + CI_E2;
__device__ __forceinline__ void convert_item(const Params& p, int it, float* scr, int lane) {
    if (it < CI_WIN) { const int kb = it / 97, nb = it % 97; transpose_item(p.w_in, D, INC, 64 * kb, 64 * nb, p.WinT, 64 * nb, scr, lane, INC - 1 - 64 * nb); return; }
    it -= CI_WIN;
    if (it < CI_WOUT) { const int kb = it / 32, nb = it % 32; transpose_item(p.w_out, D, D, 64 * kb, 64 * nb, p.WoutT, 64 * nb, scr, lane); return; }
    it -= CI_WOUT;
    if (it < CI_S13) {
        const int which = it / 256, r = it % 256, kb = r / 8, nb = r % 8;
        transpose_item(which ? p.sw3 : p.sw1, D, DE, 64 * kb, 64 * nb, p.S13T, (nb >> 1) * 256 + which * 128 + (nb & 1) * 64, scr, lane); return; }
    it -= CI_S13;
    if (it < CI_S2) { const int kb = it / 32, nb = it % 32; transpose_item(p.sw2, DE, D, 64 * kb, 64 * nb, p.S2T, 64 * nb, scr, lane); return; }
    it -= CI_S2;
    if (it < CI_E13) {
        const int e = it / 512, r0 = it % 512, which = r0 / 256, r = r0 % 256, kb = r / 8, nb = r % 8;
        transpose_item((which ? p.ew3 : p.ew1) + (size_t)e * D * DE, D, DE, 64 * kb, 64 * nb, p.E13T + (size_t)e * 1024 * D, (nb >> 1) * 256 + which * 128 + (nb & 1) * 64, scr, lane); return; }
    it -= CI_E13;
    { const int e = it / 256, r = it % 256, kb = r / 32, nb = r % 32;
      transpose_item(p.ew2 + (size_t)e * DE * D, DE, D, 64 * kb, 64 * nb, p.E2T + (size_t)e * D * DE, 64 * nb, scr, lane); }
}
__device__ void ph_prologue(const Params& p, float* sm, const int wid0) {
    const int t = opaque_tid(wid0), w = t >> 6, lane = t & 63;
    if (blockIdx.x == 0 && t == 0) p.QCTR[0] = 0;
    if (blockIdx.x == gridDim.x - 1) {
        for (int i = t; i < 64 * 32; i += NT) { const float ang = (float)(i >> 5) * powf(10000.f, -(float)(i & 31) / 32.f); p.RT[2 * i] = cosf(ang); p.RT[2 * i + 1] = sinf(ang); }
    }
    if (blockIdx.x < 192) {
        for (int i = t; i < 3 * D; i += NT) { const int r = i / D, k = i % D; sm[i] = siluf(r < 2 ? p.c[r * D + k] : p.c_ctx[k]); }
        __syncthreads();
        for (int item = blockIdx.x; item < 192; item += gridDim.x) adaln_item(p, sm, item, wid0);
    }
    __syncthreads();
    float* scr = sm + w * (64 * 65);
    for (int it = blockIdx.x * 8 + w; it < CI_TOTAL; it += gridDim.x * 8) convert_item(p, it, scr, lane);
}

__device__ void ph_norm1(const Params& p, const int wid0) {
    const int t = opaque_tid(wid0), w = t >> 6, lane = t & 63;
    for (int row = blockIdx.x * 8 + w; row < NROW; row += gridDim.x * 8) {
        const float* src; int mr;
        if (row < NLAT) { src = p.x + (size_t)row * D; mr = row / SEQ; } else { src = p.ctx + (size_t)(row - NLAT) * D; mr = 2; }
        const float* m = p.mod + (size_t)mr * 6 * D;
        float4 v[8]; float ss = 0.f;
#pragma unroll
        for (int j = 0; j < 8; ++j) { v[j] = *(const float4*)(src + 256 * j + 4 * lane); ss += v[j].x * v[j].x + v[j].y * v[j].y + v[j].z * v[j].z + v[j].w * v[j].w; }
        ss = wave_sum(ss);
        const float rs = rsqrtf(ss * (1.f / D) + 1e-6f);
#pragma unroll
        for (int j = 0; j < 8; ++j) {
            const int col = 256 * j + 4 * lane;
            const float4 g = *(const float4*)(p.norm1_g + col), sh = *(const float4*)(m + col), sc = *(const float4*)(m + D + col);
            u32x2 pk;
            pk.x = cvt_pk_bf16(v[j].x * rs * g.x * (1.f + sc.x) + sh.x, v[j].y * rs * g.y * (1.f + sc.y) + sh.y);
            pk.y = cvt_pk_bf16(v[j].z * rs * g.z * (1.f + sc.z) + sh.z, v[j].w * rs * g.w * (1.f + sc.w) + sh.w);
            *(u32x2*)(p.H + (size_t)row * D + col) = pk;
        }
    }
}

namespace g8 {
constexpr int BM = 256, BK = 64, HALF = 128, HTB = HALF * BK * 2;
__device__ __forceinline__ int lds_byte(int r, int c) { const int st = (r >> 4) * 2 + (c >> 5), rr = r & 15, cc = c & 31, ob = rr * 64 + cc * 2; return st * 1024 + (ob ^ (((ob >> 9) & 1) << 5)); }
__device__ __forceinline__ void stage_rc(int b, int& R, int& C) { const int st = b / 1024, sb = b % 1024, swz = sb ^ (((sb >> 9) & 1) << 5); R = (st >> 1) * 16 + swz / 64; C = (st & 1) * 32 + (swz % 64) / 2; }
__device__ __forceinline__ int perm32(int rho) { const int n = rho >> 4, i = rho & 15; return 8 * (i >> 2) + 4 * n + (i & 3); }

struct Unit { const char* A; const int* rows; int row0; const char* Bt; int orow, pn, aux; };

__device__ __forceinline__ bool work_id(int i, int G, int c, int nwg, int& wgid) {
    const long L = (long)i * G + c; if (L >= nwg) return false;
    const int l = (int)L, q = nwg / 8, r = nwg % 8, xcd = l % 8, off = l / 8;
    wgid = (xcd < r ? xcd * (q + 1) : r * (q + 1) + (xcd - r) * q) + off; return true;
}

template <class Epi, class Sched>
__device__ __forceinline__ void gemm_phase(LAS unsigned char* lds, const int K, const Sched& S, const Epi& E, const int wid0) {
    const int tid_ = wid0 * 64 + fresh_lane_id();
    const int tid = tid_, wid = __builtin_amdgcn_readfirstlane(tid >> 6), lane = tid & 63, wr = wid >> 2, wc = wid & 3, fr = lane & 15, fq = lane >> 4;
    const int nt = K / BK;
    int sR[2]; unsigned sC2[2], voffB[2];
#pragma unroll
    for (int i = 0; i < 2; ++i) { int R, C; stage_rc(tid * 16 + i * 8192, R, C); const int Rb = Epi::PERM ? ((R & ~31) + perm32(R & 31)) : R;
        sR[i] = R; sC2[i] = (unsigned)C * 2u; voffB[i] = (unsigned)(Rb * K + C) * 2u; }
    const size_t kstep = (size_t)(BK * 2);
    const size_t hstep = (size_t)HALF * K * 2;
    const unsigned ldsw = (unsigned)wid * 1024u;
    const int aoff = lds_byte(wr * 64 + fr, fq * 8), boff = lds_byte(wc * 32 + fr, fq * 8);
#define G8_SA(b, h) (((b) * 2 + (h)) * g8::HTB)
#define G8_SB(b, h) ((4 + (b) * 2 + (h)) * g8::HTB)
#define G8_STAGE(bufoff, gbase, v0, v1) do { \
        __builtin_amdgcn_global_load_lds((const unsigned*)((const char*)(gbase) + (v0)), (LAS unsigned*)(lds + (bufoff) + ldsw), 16, 0, 0); \
        __builtin_amdgcn_global_load_lds((const unsigned*)((const char*)(gbase) + (v1)), (LAS unsigned*)(lds + (bufoff) + ldsw + 8192), 16, 0, 0); } while (0)
#define G8_LDA(dst, b, h) do { _Pragma("unroll") for (int m = 0; m < 4; ++m) _Pragma("unroll") for (int k = 0; k < 2; ++k) dst[m][k] = *(const LAS bf16x8*)(lds + G8_SA(b, h) + aoff + m * 2048 + k * 1024); } while (0)
#define G8_LDB(dst, b, h) do { _Pragma("unroll") for (int n = 0; n < 2; ++n) _Pragma("unroll") for (int k = 0; k < 2; ++k) dst[n][k] = *(const LAS bf16x8*)(lds + G8_SB(b, h) + boff + n * 2048 + k * 1024); } while (0)
#define G8_MMA(ai, bj, At, Bt) do { __builtin_amdgcn_s_setprio(1); _Pragma("unroll") for (int m = 0; m < 4; ++m) _Pragma("unroll") for (int n = 0; n < 2; ++n) _Pragma("unroll") for (int k = 0; k < 2; ++k) \
        acc[ai][bj][m][n] = __builtin_amdgcn_mfma_f32_16x16x32_bf16(Bt[n][k], At[m][k], acc[ai][bj][m][n], 0, 0, 0); __builtin_amdgcn_s_setprio(0); } while (0)
#define G8_WAIT_V(n) asm volatile("s_waitcnt vmcnt(" #n ")" ::: "memory")
#define G8_WAIT_L(n) asm volatile("s_waitcnt lgkmcnt(" #n ")" ::: "memory")
#define G8_BAR __builtin_amdgcn_s_barrier()
#define G8_SCHED __builtin_amdgcn_sched_barrier(0)
    Unit cur, nxt; int ui = 0;
    if (!S.next(0, cur)) return;
    f32x4 acc[2][2][4][2];
#pragma unroll
    for (int a = 0; a < 2; ++a)
#pragma unroll
        for (int b = 0; b < 2; ++b)
#pragma unroll
            for (int m = 0; m < 4; ++m)
#pragma unroll
                for (int n = 0; n < 2; ++n) acc[a][b][m][n] = (f32x4){0.f, 0.f, 0.f, 0.f};
    bf16x8 At[4][2], B0[2][2], B1[2][2];
    unsigned vA00, vA01, vA10, vA11, nA00, nA01, nA10, nA11;
#define G8_MKOFF(u, o00, o01, o10, o11) do { \
        int r00, r01, r10, r11; \
        if ((u).rows) { r00 = (u).rows[sR[0]]; r01 = (u).rows[sR[1]]; r10 = (u).rows[128 + sR[0]]; r11 = (u).rows[128 + sR[1]]; } \
        else { r00 = (u).row0 + sR[0]; r01 = (u).row0 + sR[1]; r10 = (u).row0 + 128 + sR[0]; r11 = (u).row0 + 128 + sR[1]; } \
        o00 = (unsigned)r00 * (unsigned)(K * 2) + sC2[0]; o01 = (unsigned)r01 * (unsigned)(K * 2) + sC2[1]; \
        o10 = (unsigned)r10 * (unsigned)(K * 2) + sC2[0]; o11 = (unsigned)r11 * (unsigned)(K * 2) + sC2[1]; } while (0)
    G8_MKOFF(cur, vA00, vA01, vA10, vA11);
    const char* cA = cur.A; const char* cB = cur.Bt;
    G8_STAGE(G8_SB(0, 0), cB, voffB[0], voffB[1]); G8_STAGE(G8_SA(0, 0), cA, vA00, vA01); G8_STAGE(G8_SB(0, 1), cB + hstep, voffB[0], voffB[1]); G8_STAGE(G8_SA(0, 1), cA, vA10, vA11);
    if (wr == 1) G8_BAR;
    G8_WAIT_V(4); G8_BAR;
    G8_STAGE(G8_SB(1, 0), cB + kstep, voffB[0], voffB[1]); G8_STAGE(G8_SA(1, 0), cA + kstep, vA00, vA01); G8_STAGE(G8_SB(1, 1), cB + hstep + kstep, voffB[0], voffB[1]);
    G8_WAIT_V(6); G8_BAR;
    for (;;) {
        const bool has_next = S.next(ui + 1, nxt);
        const char* nA = has_next ? nxt.A : cA; const char* nB = has_next ? nxt.Bt : cB;
        if (has_next) G8_MKOFF(nxt, nA00, nA01, nA10, nA11); else { nA00 = vA00; nA01 = vA01; nA10 = vA10; nA11 = vA11; }
        for (int t = 0; t < nt; t += 2) {
            const bool last = (t == nt - 2);
            const char* a1 = cA + (size_t)(t + 1) * kstep;
            G8_LDB(B0, 0, 0); G8_SCHED; G8_LDA(At, 0, 0); G8_STAGE(G8_SA(1, 1), a1, vA10, vA11);
            G8_WAIT_L(8); G8_BAR; G8_WAIT_L(0); G8_MMA(0, 0, At, B0); G8_BAR; G8_SCHED;
            if (last) { vA00 = nA00; vA01 = nA01; vA10 = nA10; vA11 = nA11; }
            const char* a2 = last ? nA : cA + (size_t)(t + 2) * kstep; const char* b2 = last ? nB : cB + (size_t)(t + 2) * kstep;
            const char* a3 = a2 + kstep; const char* b3 = b2 + kstep;
            G8_LDB(B1, 0, 1); G8_STAGE(G8_SB(0, 0), b2, voffB[0], voffB[1]);
            G8_BAR; G8_WAIT_L(0); G8_MMA(0, 1, At, B1); G8_BAR;
            G8_LDA(At, 0, 1); G8_STAGE(G8_SA(0, 0), a2, vA00, vA01);
            G8_BAR; G8_WAIT_L(0); G8_MMA(1, 0, At, B0); G8_BAR; G8_SCHED;
            G8_STAGE(G8_SB(0, 1), b2 + hstep, voffB[0], voffB[1]);
            G8_WAIT_V(6); G8_BAR; G8_MMA(1, 1, At, B1); G8_BAR;
            G8_LDB(B0, 1, 0); G8_SCHED; G8_LDA(At, 1, 0); G8_STAGE(G8_SA(0, 1), a2, vA10, vA11);
            G8_WAIT_L(8); G8_BAR; G8_WAIT_L(0); G8_MMA(0, 0, At, B0); G8_BAR; G8_SCHED;
            G8_LDB(B1, 1, 1); G8_STAGE(G8_SB(1, 0), b3, voffB[0], voffB[1]);
            G8_BAR; G8_WAIT_L(0); G8_MMA(0, 1, At, B1); G8_BAR;
            G8_LDA(At, 1, 1); G8_STAGE(G8_SA(1, 0), a3, vA00, vA01);
            G8_BAR; G8_WAIT_L(0); G8_MMA(1, 0, At, B0); G8_BAR; G8_SCHED;
            G8_STAGE(G8_SB(1, 1), b3 + hstep, voffB[0], voffB[1]);
            G8_WAIT_V(6); G8_BAR; G8_MMA(1, 1, At, B1); G8_BAR;
        }
        E(acc, cur, wr, wc, fr, fq);
        if (!has_next) break;
#pragma unroll
        for (int a = 0; a < 2; ++a)
#pragma unroll
            for (int b = 0; b < 2; ++b)
#pragma unroll
                for (int m = 0; m < 4; ++m)
#pragma unroll
                    for (int n = 0; n < 2; ++n) acc[a][b][m][n] = (f32x4){0.f, 0.f, 0.f, 0.f};
        cur = nxt; cA = nA; cB = nB; ++ui;
    }
    G8_WAIT_V(0);
    if (wr == 0) G8_BAR;
    G8_BAR;
}
}

struct EpiInproj {
    static constexpr bool PERM = false;
    float* P; float* DD;
    __device__ __forceinline__ void operator()(const f32x4 (&acc)[2][2][4][2], const g8::Unit& u, int wr, int wc, int fr, int fq) const {
        if (u.pn == PLD / 256) {
            if (wc == 0) {
#pragma unroll
                for (int ai = 0; ai < 2; ++ai)
#pragma unroll
                    for (int m = 0; m < 4; ++m) { float* rowp = DD + (size_t)(u.orow + ai * 128 + wr * 64 + m * 16 + fr) * 32 + 4 * fq;
                        *(f32x4*)(rowp) = acc[ai][0][m][0]; *(f32x4*)(rowp + 16) = acc[ai][0][m][1]; }
            }
            return;
        }
#pragma unroll
        for (int ai = 0; ai < 2; ++ai)
#pragma unroll
            for (int m = 0; m < 4; ++m) { float* rowp = P + (size_t)(u.orow + ai * 128 + wr * 64 + m * 16 + fr) * PLD + u.pn * 256 + wc * 32 + 4 * fq;
#pragma unroll
                for (int bj = 0; bj < 2; ++bj)
#pragma unroll
                    for (int n = 0; n < 2; ++n) *(f32x4*)(rowp + bj * 128 + n * 16) = acc[ai][bj][m][n]; }
    }
};
struct EpiOutproj {
    static constexpr bool PERM = false;
    const float* x; const float* mod; float* X1;
    __device__ __forceinline__ void operator()(const f32x4 (&acc)[2][2][4][2], const g8::Unit& u, int wr, int wc, int fr, int fq) const {
        const int b = u.orow / SEQ; const int col0 = u.pn * 256 + wc * 32 + 4 * fq;
        f32x4 gv[2][2];
#pragma unroll
        for (int bj = 0; bj < 2; ++bj)
#pragma unroll
            for (int n = 0; n < 2; ++n) gv[bj][n] = *(const f32x4*)(mod + (size_t)b * 6 * D + 2 * D + col0 + bj * 128 + n * 16);
#pragma unroll
        for (int ai = 0; ai < 2; ++ai)
#pragma unroll
            for (int m = 0; m < 4; ++m) { const size_t ro = (size_t)(u.orow + ai * 128 + wr * 64 + m * 16 + fr) * D + col0;
#pragma unroll
                for (int bj = 0; bj < 2; ++bj)
#pragma unroll
                    for (int n = 0; n < 2; ++n) { const f32x4 xv = *(const f32x4*)(x + ro + bj * 128 + n * 16);
                        *(f32x4*)(X1 + ro + bj * 128 + n * 16) = xv + gv[bj][n] * acc[ai][bj][m][n]; } }
    }
};
struct EpiUp {
    static constexpr bool PERM = true;
    bf16_t* HB; bf16_t* SHH;
    __device__ __forceinline__ void operator()(const f32x4 (&acc)[2][2][4][2], const g8::Unit& u, int wr, int wc, int fr, int fq) const {
        bf16_t* O = u.aux ? SHH : HB;
#pragma unroll
        for (int ai = 0; ai < 2; ++ai)
#pragma unroll
            for (int m = 0; m < 4; ++m) {
                f32x4 h0, h1;
#pragma unroll
                for (int j = 0; j < 4; ++j) { h0[j] = siluf(acc[ai][0][m][0][j]) * acc[ai][1][m][0][j]; h1[j] = siluf(acc[ai][0][m][1][j]) * acc[ai][1][m][1][j]; }
                u32x4 w; w.x = cvt_pk_bf16(h0[0], h0[1]); w.y = cvt_pk_bf16(h0[2], h0[3]); w.z = cvt_pk_bf16(h1[0], h1[1]); w.w = cvt_pk_bf16(h1[2], h1[3]);
                *(u32x4*)(O + (size_t)(u.orow + ai * 128 + wr * 64 + m * 16 + fr) * DE + u.pn * 128 + wc * 32 + 8 * fq) = w;
            }
    }
};
struct EpiDown {
    static constexpr bool PERM = true;
    bf16_t* Y; bf16_t* YS;
    __device__ __forceinline__ void operator()(const f32x4 (&acc)[2][2][4][2], const g8::Unit& u, int wr, int wc, int fr, int fq) const {
        bf16_t* O = u.aux ? YS : Y;
#pragma unroll
        for (int ai = 0; ai < 2; ++ai)
#pragma unroll
            for (int m = 0; m < 4; ++m) { bf16_t* rowp = O + (size_t)(u.orow + ai * 128 + wr * 64 + m * 16 + fr) * D + u.pn * 256 + wc * 32 + 8 * fq;
#pragma unroll
                for (int bj = 0; bj < 2; ++bj) { const f32x4 v0 = acc[ai][bj][m][0], v1 = acc[ai][bj][m][1];
                    u32x4 w; w.x = cvt_pk_bf16(v0[0], v0[1]); w.y = cvt_pk_bf16(v0[2], v0[3]); w.z = cvt_pk_bf16(v1[0], v1[1]); w.w = cvt_pk_bf16(v1[2], v1[3]);
                    *(u32x4*)(rowp + bj * 128) = w; } }
    }
};
struct SchedDense {
    const char* A; const char* Bt; int K, nM, nN, G, c;
    __device__ __forceinline__ bool next(int i, g8::Unit& u) const {
        int wgid; if (!g8::work_id(i, G, c, nM * nN, wgid)) return false;
        const int nig = 8 * nN, gid = wgid / nig, fm = gid * 8, gsz = (nM - fm) < 8 ? (nM - fm) : 8;
        const int pm = fm + ((wgid % nig) % gsz), pn = (wgid % nig) / gsz;
        u.A = A; u.rows = nullptr; u.row0 = pm * 256; u.Bt = Bt + (size_t)pn * 256 * K * 2; u.orow = pm * 256; u.pn = pn; u.aux = 0; return true;
    }
};
struct SchedUp {
    const int* tp; const char* H2; const int* LIST; const char* E13T; const char* S13T; int G, c;
    __device__ __forceinline__ bool next(int i, g8::Unit& u) const {
        const int T = tp[NE]; int wgid; if (!g8::work_id(i, G, c, 4 * T + 128, wgid)) return false;
        u.A = H2;
        if (wgid < 4 * T) {
            int e = 0; while (e < NE - 1 && 4 * tp[e + 1] <= wgid) ++e;
            const int tc = tp[e + 1] - tp[e], li = wgid - 4 * tp[e], nt = li / tc, mt = li % tc, r0 = (tp[e] + mt) * 256;
            u.rows = LIST + r0; u.row0 = 0; u.Bt = E13T + ((size_t)e * 1024 + nt * 256) * D * 2; u.orow = r0; u.pn = nt; u.aux = 0;
        } else {
            const int s = wgid - 4 * T, pn = s / 32, pm = s % 32;
            u.rows = nullptr; u.row0 = pm * 256; u.Bt = S13T + (size_t)pn * 256 * D * 2; u.orow = pm * 256; u.pn = pn; u.aux = 1;
        }
        return true;
    }
};
struct SchedDown {
    const int* tp; const char* HB; const char* E2T; const char* SHH; const char* S2T; int G, c;
    __device__ __forceinline__ bool next(int i, g8::Unit& u) const {
        const int T = tp[NE]; int wgid; if (!g8::work_id(i, G, c, 8 * T + 256, wgid)) return false;
        u.rows = nullptr;
        if (wgid < 8 * T) {
            int e = 0; while (e < NE - 1 && 8 * tp[e + 1] <= wgid) ++e;
            const int tc = tp[e + 1] - tp[e], li = wgid - 8 * tp[e], nt = li / tc, mt = li % tc, r0 = (tp[e] + mt) * 256;
            u.A = HB; u.row0 = r0; u.Bt = E2T + ((size_t)e * D + nt * 256) * DE * 2; u.orow = r0; u.pn = nt; u.aux = 0;
        } else {
            const int s = wgid - 8 * T, pn = s / 32, pm = s % 32;
            u.A = SHH; u.row0 = pm * 256; u.Bt = S2T + (size_t)pn * 256 * DE * 2; u.orow = pm * 256; u.pn = pn; u.aux = 1;
        }
        return true;
    }
};
__device__ __forceinline__ void moe_tables(const Params& p, int* tp, const int wid0) {
    __syncthreads();
    if (wid0 == 0 && xb_lane_id() == 0) { int tt = 0; for (int e = 0; e < NE; ++e) { tp[e] = tt; tt += (p.CNT[e] + 255) / 256; } tp[NE] = tt; }
    __syncthreads();
}

constexpr int NTOK = SEQ + CTXL;
__device__ void ph_naprep(const Params& p, const int wid0) {
    const int t = opaque_tid(wid0), w = t >> 6, lane = t & 63, l31 = lane & 31;
    for (int u = blockIdx.x; u < 272; u += gridDim.x) {
        const int b = u / 136, s = u % 136; const bool lat = s < 128;
        const int row0 = lat ? (b * SEQ + 32 * s) : (NLAT + b * CTXL + 32 * (s - 128)), tok0 = lat ? 32 * s : (SEQ + 32 * (s - 128));
#pragma unroll 2
        for (int rt = w; rt < 64; rt += 8) {
            const int which = rt & 1, tt = rt >> 1;
            if (which == 0 && !lat) continue;
            const float* src = p.P + (size_t)(row0 + tt) * PLD + which * 1024 + 4 * lane;
            float4 v[4]; float ss[4];
#pragma unroll
            for (int j = 0; j < 4; ++j) { v[j] = *(const float4*)(src + 256 * j); ss[j] = v[j].x * v[j].x + v[j].y * v[j].y + v[j].z * v[j].z + v[j].w * v[j].w; }
#pragma unroll
            for (int o = 1; o < 32; o <<= 1)
#pragma unroll
                for (int j = 0; j < 4; ++j) ss[j] += __shfl_xor(ss[j], o);
            const float4 g = *(const float4*)((which ? p.k_norm_g : p.q_norm_g) + 4 * l31);
            const float sc = which ? 1.f : 0.08838834764831845f * 1.4426950408889634f;
            bf16_t* dst = (which ? p.NKb : p.NQb) + (size_t)(row0 + tt) * 1024 + 4 * lane;
#pragma unroll
            for (int j = 0; j < 4; ++j) {
                const float r = rsqrtf(ss[j] * (1.f / 128.f) + 1e-6f) * sc;
                u32x2 pk; pk.x = cvt_pk_bf16(v[j].x * r * g.x, v[j].y * r * g.y); pk.y = cvt_pk_bf16(v[j].z * r * g.z, v[j].w * r * g.w);
                *(u32x2*)(dst + 256 * j) = pk;
            }
        }
#pragma unroll 1
        for (int i = 0; i < 2; ++i) {
            const int col = t + 512 * i, hh = col >> 7, dv = col & 127;
            unsigned pk[16];
#pragma unroll
            for (int s2 = 0; s2 < 16; ++s2) pk[s2] = cvt_pk_bf16(p.P[(size_t)(row0 + 2 * s2) * PLD + 2048 + col], p.P[(size_t)(row0 + 2 * s2 + 1) * PLD + 2048 + col]);
            bf16_t* o = p.VTn + ((size_t)(b * 8 + hh) * 128 + dv) * NTOK + tok0;
#pragma unroll
            for (int g2 = 0; g2 < 2; ++g2) {
                *(u32x4*)(o + 16 * g2) = (u32x4){pk[8 * g2], pk[8 * g2 + 1], pk[8 * g2 + 4], pk[8 * g2 + 5]};
                *(u32x4*)(o + 16 * g2 + 8) = (u32x4){pk[8 * g2 + 2], pk[8 * g2 + 3], pk[8 * g2 + 6], pk[8 * g2 + 7]};
            }
        }
    }
}

__device__ __forceinline__ void attn_tile(const Params& p, const float* sm, const bf16x8 (&kc)[8], const bf16x8 (&qf)[8], f32x16& o0, f32x16& o1, f32x16& o2, f32x16& o3, float& m, float& l,
                                          const bf16_t* vtb, int tl, int h, int r, int rs, int c, int cs, int hi) {
    const bool loc = tl >= 8; const int li = tl - 8, wi = li >> 1, half = li & 1;
    const int tokb = loc ? ((rs + wi) * 64 + 32 * half) : (SEQ + 32 * tl);
    bf16x8 va[4][2];
#pragma unroll
    for (int n = 0; n < 4; ++n)
#pragma unroll
        for (int s2 = 0; s2 < 2; ++s2) va[n][s2] = *(const bf16x8*)(vtb + (size_t)(32 * n) * NTOK + tokb + 16 * s2);
    f32x16 s;
#pragma unroll
    for (int e = 0; e < 16; ++e) s[e] = 0.f;
#pragma unroll
    for (int ks = 0; ks < 8; ++ks) s = __builtin_amdgcn_mfma_f32_32x32x16_bf16(kc[ks], qf[ks], s, 0, 0, 0);
    if (loc) {
        int rel0 = 32 * half + 4 * hi - cs; asm volatile("" : "+v"(rel0));
        const float* bt = sm + h * 465 + (rs + wi - r + 7) * 31 + cs - c + 15;
#pragma unroll
        for (int e = 0; e < 16; ++e) {
            const int rel = rel0 + (e & 3) + 8 * (e >> 2);
            const bool vis = (unsigned)rel < 16u;
            const float bias = bt[min(max(rel, 0), 15)];
            s[e] = vis ? (s[e] + bias) : -INFINITY;
        }
    }
    float mt = s[0];
#pragma unroll
    for (int e = 1; e < 16; ++e) mt = fmaxf(mt, s[e]);
    mt = fmaxf(mt, __shfl_xor(mt, 32));
    const float mn = fmaxf(m, mt);
    const float alpha = __builtin_amdgcn_exp2f(m - mn);
    m = mn;
    float ps = 0.f;
#pragma unroll
    for (int e = 0; e < 16; ++e) { s[e] = __builtin_amdgcn_exp2f(s[e] - mn); ps += s[e]; }
    l = l * alpha + ps;
#pragma unroll
    for (int e = 0; e < 16; ++e) { o0[e] *= alpha; o1[e] *= alpha; o2[e] *= alpha; o3[e] *= alpha; }
    bf16x8 pb[2];
#pragma unroll
    for (int s2 = 0; s2 < 2; ++s2) {
        const u32x4 cat = (u32x4){cvt_pk_bf16(s[8 * s2], s[8 * s2 + 1]), cvt_pk_bf16(s[8 * s2 + 2], s[8 * s2 + 3]), cvt_pk_bf16(s[8 * s2 + 4], s[8 * s2 + 5]), cvt_pk_bf16(s[8 * s2 + 6], s[8 * s2 + 7])};
        pb[s2] = __builtin_bit_cast(bf16x8, cat);
    }
#pragma unroll
    for (int s2 = 0; s2 < 2; ++s2) {
        o0 = __builtin_amdgcn_mfma_f32_32x32x16_bf16(va[0][s2], pb[s2], o0, 0, 0, 0);
        o1 = __builtin_amdgcn_mfma_f32_32x32x16_bf16(va[1][s2], pb[s2], o1, 0, 0, 0);
        o2 = __builtin_amdgcn_mfma_f32_32x32x16_bf16(va[2][s2], pb[s2], o2, 0, 0, 0);
        o3 = __builtin_amdgcn_mfma_f32_32x32x16_bf16(va[3][s2], pb[s2], o3, 0, 0, 0);
    }
}
__device__ __forceinline__ void glascan_wave(const Params& p, int unit, int dh, int lane);
__device__ void ph_attn(const Params& p, float* sm, const int wid0) {
    const int t = opaque_tid(wid0), lane = t & 63, l31 = lane & 31, hi = lane >> 5;
    __syncthreads();
    for (int i = t; i < 8 * 465; i += NT) sm[i] = p.na_rpb[i] * 1.4426950408889634f;
    __syncthreads();
    if ((t >> 6) < 4) { for (int unit = blockIdx.x; unit < 256; unit += gridDim.x) glascan_wave(p, unit, t >> 6, lane); }
    for (;;) {
        int id = 0;
        if (lane == 0) id = atomicAdd(p.QCTR, 1);
        id = __builtin_amdgcn_readfirstlane(id);
        if (id >= 2048) break;
        const int qt = id & 1, r = (id >> 1) & 63, h = (id >> 7) & 7, b = id >> 10;
        const int c = 32 * qt + l31;
        const int rs = min(max(r - 4, 0), 56), cs = min(max(c - 8, 0), 48);
        const int qrow = b * SEQ + r * 64 + c;
        bf16x8 qf[8];
#pragma unroll
        for (int ks = 0; ks < 8; ++ks) qf[ks] = *(const bf16x8*)(p.NQb + (size_t)qrow * 1024 + h * 128 + 16 * ks + 8 * hi);
        f32x16 o0, o1, o2, o3;
#pragma unroll
        for (int e = 0; e < 16; ++e) { o0[e] = 0.f; o1[e] = 0.f; o2[e] = 0.f; o3[e] = 0.f; }
        float m = -INFINITY, l = 0.f;
        const bf16_t* vtb = p.VTn + ((size_t)(b * 8 + h) * 128 + l31) * NTOK + 8 * hi;
        const bf16_t* kb = p.NKb + h * 128 + 8 * hi;
#define AT_KROW(tl_) ((tl_) < 8 ? (NLAT + b * CTXL + 32 * (tl_) + l31) : (b * SEQ + (rs + (((tl_) - 8) >> 1)) * 64 + 32 * (((tl_) - 8) & 1) + l31))
#define AT_LOADK(K_, tl_) do { const int t1_ = (tl_) < 24 ? (tl_) : 23; const bf16_t* kp_ = kb + (size_t)AT_KROW(t1_) * 1024; \
        _Pragma("unroll") for (int ks = 0; ks < 8; ++ks) K_[ks] = *(const bf16x8*)(kp_ + 16 * ks); } while (0)
        bf16x8 kA[8], kB[8];
        AT_LOADK(kA, 0);
#pragma unroll 1
        for (int tl = 0; tl < 24; tl += 2) {
            AT_LOADK(kB, tl + 1);
            attn_tile(p, sm, kA, qf, o0, o1, o2, o3, m, l, vtb, tl, h, r, rs, c, cs, hi);
            AT_LOADK(kA, tl + 2);
            attn_tile(p, sm, kB, qf, o0, o1, o2, o3, m, l, vtb, tl + 1, h, r, rs, c, cs, hi);
        }
#undef AT_KROW
#undef AT_LOADK
        l += __shfl_xor(l, 32);
        const float inv = 1.f / l;
        bf16_t* orow = p.MIX + (size_t)qrow * D + h * 128 + 4 * hi;
#pragma unroll
        for (int g = 0; g < 4; ++g) {
            u32x2 pk;
            pk.x = cvt_pk_bf16(o0[4 * g] * inv, o0[4 * g + 1] * inv); pk.y = cvt_pk_bf16(o0[4 * g + 2] * inv, o0[4 * g + 3] * inv); *(u32x2*)(orow + 0 + 8 * g) = pk;
            pk.x = cvt_pk_bf16(o1[4 * g] * inv, o1[4 * g + 1] * inv); pk.y = cvt_pk_bf16(o1[4 * g + 2] * inv, o1[4 * g + 3] * inv); *(u32x2*)(orow + 32 + 8 * g) = pk;
            pk.x = cvt_pk_bf16(o2[4 * g] * inv, o2[4 * g + 1] * inv); pk.y = cvt_pk_bf16(o2[4 * g + 2] * inv, o2[4 * g + 3] * inv); *(u32x2*)(orow + 64 + 8 * g) = pk;
            pk.x = cvt_pk_bf16(o3[4 * g] * inv, o3[4 * g + 1] * inv); pk.y = cvt_pk_bf16(o3[4 * g + 2] * inv, o3[4 * g + 3] * inv); *(u32x2*)(orow + 96 + 8 * g) = pk;
        }
    }
}

__device__ __forceinline__ float logsigf(float z) { return fminf(z, 0.f) - log1pf(expf(-fabsf(z))); }

__device__ __forceinline__ float fexp2(float x) { return __builtin_amdgcn_exp2f(x); }
__device__ __forceinline__ float logsig2_16(float z) { return (fminf(z, 0.f) * 1.4426950408889634f - __builtin_amdgcn_logf(1.f + fexp2(-fabsf(z) * 1.4426950408889634f))) * (1.f / 16.f); }

__device__ void ph_glaprep(const Params& p, float* sm, const int wid0) {
    const int t = opaque_tid(wid0), d2 = t & 63, tq = t >> 6, d = 2 * d2;
    float* qs = sm;
    float* ksm = sm + 8192;
    float* dds = sm + 16384;
    float* tot = sm + 16384 + 2048;
    for (int u = blockIdx.x; u < 8 * 68; u += gridDim.x) {
        const int bh = u / 68, c = u % 68, b = bh >> 2, h = bh & 3;
        const bool lat = c >= 4; const int j = c - 4;
        const int row0 = lat ? (b * SEQ + 64 * j) : (NLAT + b * CTXL + 64 * c);
        __syncthreads();
        {
            const int cq = t & 31, tr = t >> 5;
#pragma unroll
            for (int i = 0; i < 4; ++i) { const int tt = tr + 16 * i;
                *(float4*)(qs + tt * 128 + 4 * cq) = *(const float4*)(p.P + (size_t)(row0 + tt) * PLD + 3072 + h * 128 + 4 * cq);
                *(float4*)(ksm + tt * 128 + 4 * cq) = *(const float4*)(p.P + (size_t)(row0 + tt) * PLD + 3584 + h * 128 + 4 * cq); }
            *(float4*)(dds + 4 * t) = *(const float4*)(p.DD + (size_t)row0 * 32 + 4 * t);
        }
        __syncthreads();
        float gf0[8], gf1[8], gb0[8], gb1[8];
        {
            float uf0[16], uf1[16], ub0[16], ub1[16];
#pragma unroll
            for (int r = 0; r < 16; ++r) { const float2 a = *(const float2*)(p.up_f + r * 512 + h * 128 + d), bq = *(const float2*)(p.up_b + r * 512 + h * 128 + d); uf0[r] = a.x; uf1[r] = a.y; ub0[r] = bq.x; ub1[r] = bq.y; }
            const float2 bf = *(const float2*)(p.bias_f + h * 128 + d), bb = *(const float2*)(p.bias_b + h * 128 + d);
            float sf0 = 0.f, sf1 = 0.f, sb0 = 0.f, sb1 = 0.f;
#pragma unroll
            for (int i = 0; i < 8; ++i) {
                const float* dr = dds + (8 * tq + i) * 32; float zf0 = bf.x, zf1 = bf.y, zb0 = bb.x, zb1 = bb.y;
#pragma unroll
                for (int r = 0; r < 16; ++r) { const float x = dr[r], y = dr[16 + r]; zf0 += x * uf0[r]; zf1 += x * uf1[r]; zb0 += y * ub0[r]; zb1 += y * ub1[r]; }
                gf0[i] = logsig2_16(zf0); gf1[i] = logsig2_16(zf1); gb0[i] = logsig2_16(zb0); gb1[i] = logsig2_16(zb1);
                sf0 += gf0[i]; sf1 += gf1[i]; sb0 += gb0[i]; sb1 += gb1[i];
            }
            *(float2*)(tot + tq * 128 + d) = make_float2(sf0, sf1); *(float2*)(tot + (8 + tq) * 128 + d) = make_float2(sb0, sb1);
        }
        __syncthreads();
        float2 basef = make_float2(0.f, 0.f), baseb = basef, allf = basef, allb = basef;
#pragma unroll
        for (int q8 = 0; q8 < 8; ++q8) { const float2 a = *(const float2*)(tot + q8 * 128 + d), bq = *(const float2*)(tot + (8 + q8) * 128 + d);
            allf.x += a.x; allf.y += a.y; allb.x += bq.x; allb.y += bq.y;
            if (q8 < tq) { basef.x += a.x; basef.y += a.y; } if (q8 > tq) { baseb.x += bq.x; baseb.y += bq.y; } }
        { float r0 = basef.x, r1 = basef.y;
#pragma unroll
          for (int i = 0; i < 8; ++i) { r0 += gf0[i]; gf0[i] = r0; r1 += gf1[i]; gf1[i] = r1; }
          r0 = baseb.x; r1 = baseb.y;
#pragma unroll
          for (int i = 7; i >= 0; --i) { r0 += gb0[i]; gb0[i] = r0; r1 += gb1[i]; gb1[i] = r1; } }
        const int dd2 = d & 63, ii = dd2 & 31, partner = (dd2 < 32) ? (d + 32) : (d - 32);
        const float sgn = (dd2 < 32) ? -1.f : 1.f;
        unsigned khf0[4], khf1[4], khb0[4], khb1[4]; float pf0 = 0.f, pf1 = 0.f, pb0 = 0.f, pb1 = 0.f;
        const size_t tb = ((size_t)(bh * 64 + j) * 64) * 128;
#pragma unroll
        for (int i = 0; i < 8; ++i) {
            const int tt = 8 * tq + i;
            float2 qv = *(const float2*)(qs + tt * 128 + d), kv = *(const float2*)(ksm + tt * 128 + d);
            if (lat) {
                const int pos = (d < 64) ? j : tt;
                const float4 cssn = *(const float4*)(p.RT + (pos * 32 + ii) * 2);
                const float2 qp = *(const float2*)(qs + tt * 128 + partner), kp = *(const float2*)(ksm + tt * 128 + partner);
                qv.x = qv.x * cssn.x + sgn * qp.x * cssn.y; qv.y = qv.y * cssn.z + sgn * qp.y * cssn.w;
                kv.x = kv.x * cssn.x + sgn * kp.x * cssn.y; kv.y = kv.y * cssn.z + sgn * kp.y * cssn.w;
            }
            qv.x *= 0.08838834764831845f; qv.y *= 0.08838834764831845f;
            if (lat) {
                const float ef0 = fexp2(gf0[i]), ef1 = fexp2(gf1[i]), eb0 = fexp2(gb0[i]), eb1 = fexp2(gb1[i]);
                const float nf0 = fexp2(-gf0[i]), nf1 = fexp2(-gf1[i]), nb0 = fexp2(-gb0[i]), nb1 = fexp2(-gb1[i]);
                const size_t o = tb + (size_t)tt * 128 + d;
                *(unsigned*)(p.QF + o) = cvt_pk_bf16(qv.x * ef0, qv.y * ef1); *(unsigned*)(p.KF + o) = cvt_pk_bf16(kv.x * nf0, kv.y * nf1);
                *(unsigned*)(p.QB + o) = cvt_pk_bf16(qv.x * eb0, qv.y * eb1); *(unsigned*)(p.KB + o) = cvt_pk_bf16(kv.x * nb0, kv.y * nb1);
            }
            const float hf0 = kv.x * fexp2(allf.x - gf0[i]), hf1 = kv.y * fexp2(allf.y - gf1[i]), hb0 = kv.x * fexp2(allb.x - gb0[i]), hb1 = kv.y * fexp2(allb.y - gb1[i]);
            if (i & 1) { khf0[i >> 1] = cvt_pk_bf16(pf0, hf0); khf1[i >> 1] = cvt_pk_bf16(pf1, hf1); khb0[i >> 1] = cvt_pk_bf16(pb0, hb0); khb1[i >> 1] = cvt_pk_bf16(pb1, hb1); }
            else { pf0 = hf0; pf1 = hf1; pb0 = hb0; pb1 = hb1; }
        }
        {
            const size_t o = ((size_t)(bh * 68 + c) * 128 + d) * 64 + 8 * tq;
            *(u32x4*)(p.KHF + o) = (u32x4){khf0[0], khf0[1], khf0[2], khf0[3]}; *(u32x4*)(p.KHF + o + 64) = (u32x4){khf1[0], khf1[1], khf1[2], khf1[3]};
            *(u32x4*)(p.KHB + o) = (u32x4){khb0[0], khb0[1], khb0[2], khb0[3]}; *(u32x4*)(p.KHB + o + 64) = (u32x4){khb1[0], khb1[1], khb1[2], khb1[3]};
            if (tq == 0) { *(float2*)(p.DF + (size_t)(bh * 68 + c) * 128 + d) = make_float2(fexp2(allf.x), fexp2(allf.y)); *(float2*)(p.DB + (size_t)(bh * 68 + c) * 128 + d) = make_float2(fexp2(allb.x), fexp2(allb.y)); }
        }
        {
            const int v = t & 255, half = t >> 8;
            unsigned pk[16];
#pragma unroll
            for (int s2 = 0; s2 < 16; ++s2) {
                const float a = p.P[(size_t)(row0 + 32 * half + 2 * s2) * PLD + 4096 + h * 256 + v], bq = p.P[(size_t)(row0 + 32 * half + 2 * s2 + 1) * PLD + 4096 + h * 256 + v];
                pk[s2] = cvt_pk_bf16(a, bq);
            }
            bf16_t* o = p.VT + ((size_t)(bh * 68 + c) * 256 + v) * 64 + 32 * half;
#pragma unroll
            for (int q4 = 0; q4 < 4; ++q4) *(u32x4*)(o + 8 * q4) = (u32x4){pk[4 * q4], pk[4 * q4 + 1], pk[4 * q4 + 2], pk[4 * q4 + 3]};
        }
    }
}

__device__ __forceinline__ void glascan_wave(const Params& p, int unit, int dh, int lane) {
    const int fr = lane & 15, fq = lane >> 4;
    const int v16 = unit & 15, scan = unit >> 4, dir = scan >> 3, bh = scan & 7;
    const int d0 = 32 * dh, v0 = 16 * v16;
    const bf16_t* KH = (dir ? p.KHB : p.KHF) + ((size_t)bh * 68 * 128 + d0 + fr) * 64 + 8 * fq;
    const bf16_t* VTp = p.VT + ((size_t)bh * 68 * 256 + v0 + fr) * 64 + 8 * fq;
    const float* DV = (dir ? p.DB : p.DF) + (size_t)bh * 68 * 128 + d0 + 4 * fq;
    bf16_t* SSp = p.SS + ((((size_t)dir * 8 + bh) * 65) * 256 + v0 + fr) * 128 + d0 + 4 * fq;
    f32x4 acc[2];
#pragma unroll
    for (int i = 0; i < 2; ++i) acc[i] = (f32x4){0.f, 0.f, 0.f, 0.f};
#define SC_CHUNK(n) (dir ? ((n) < 4 ? 3 - (n) : 71 - (n)) : (n))
#define SC_LOAD(A_, B_, D_, n) do { const int nn_ = (n) < 68 ? (n) : 67; const int c_ = SC_CHUNK(nn_); \
        _Pragma("unroll") for (int i = 0; i < 2; ++i) { A_[i][0] = *(const bf16x8*)(KH + (size_t)c_ * 128 * 64 + i * 16 * 64); A_[i][1] = *(const bf16x8*)(KH + (size_t)c_ * 128 * 64 + i * 16 * 64 + 32); \
            D_[i] = *(const f32x4*)(DV + (size_t)c_ * 128 + 16 * i); } \
        B_[0] = *(const bf16x8*)(VTp + (size_t)c_ * 256 * 64); B_[1] = *(const bf16x8*)(VTp + (size_t)c_ * 256 * 64 + 32); } while (0)
#define SC_STEP(A_, B_, D_, n) do { const int c_ = SC_CHUNK(n); bf16_t* so = SSp + (size_t)(c_ >= 4 ? c_ - 4 : 64) * 256 * 128; \
        _Pragma("unroll") for (int i = 0; i < 2; ++i) { u32x2 pk; pk.x = cvt_pk_bf16(acc[i][0], acc[i][1]); pk.y = cvt_pk_bf16(acc[i][2], acc[i][3]); *(u32x2*)(so + 16 * i) = pk; \
            acc[i] = acc[i] * D_[i]; \
            acc[i] = __builtin_amdgcn_mfma_f32_16x16x32_bf16(A_[i][0], B_[0], acc[i], 0, 0, 0); acc[i] = __builtin_amdgcn_mfma_f32_16x16x32_bf16(A_[i][1], B_[1], acc[i], 0, 0, 0); } } while (0)
    bf16x8 aA[2][2], aB[2][2], aC[2][2], bA[2], bB[2], bC[2]; f32x4 dA[2], dB[2], dC[2];
    SC_LOAD(aA, bA, dA, 0); SC_LOAD(aB, bB, dB, 1);
#pragma unroll 1
    for (int n = 0; n < 66; n += 3) {
        SC_LOAD(aC, bC, dC, n + 2); SC_STEP(aA, bA, dA, n);
        SC_LOAD(aA, bA, dA, n + 3); SC_STEP(aB, bB, dB, n + 1);
        SC_LOAD(aB, bB, dB, n + 4); SC_STEP(aC, bC, dC, n + 2);
    }
    SC_STEP(aA, bA, dA, 66); SC_STEP(aB, bB, dB, 67);
#undef SC_CHUNK
#undef SC_LOAD
#undef SC_STEP
}

__device__ void ph_glaout(const Params& p, unsigned char* smb, const int wid0) {
    const int t = opaque_tid(wid0), w = t >> 6, lane = t & 63, l31 = lane & 31, hi = lane >> 5;
    const int wv = w & 3, wt = w >> 2;
    bf16_t* att = (bf16_t*)smb;
    float* ssq = (float*)(smb + 2 * 64 * 144);
    for (int u = blockIdx.x; u < 512; u += gridDim.x) {
        const int bh = u >> 6, j = u & 63, b = bh >> 2, h = bh & 3;
        const size_t tb = ((size_t)(bh * 64 + j) * 64) * 128;
        {
            const int dir = w >> 2, ts = (w >> 1) & 1, tt = w & 1;
            const bf16_t* Qm = (dir ? p.QB : p.QF) + tb; const bf16_t* Km = (dir ? p.KB : p.KF) + tb;
            const bool zero = dir ? (ts < tt) : (ts > tt);
            f32x16 s;
#pragma unroll
            for (int r = 0; r < 16; ++r) s[r] = 0.f;
            if (!zero) {
#pragma unroll
                for (int ks = 0; ks < 8; ++ks) {
                    const bf16x8 ka = *(const bf16x8*)(Km + (size_t)(32 * ts + l31) * 128 + 16 * ks + 8 * hi);
                    const bf16x8 qb = *(const bf16x8*)(Qm + (size_t)(32 * tt + l31) * 128 + 16 * ks + 8 * hi);
                    s = __builtin_amdgcn_mfma_f32_32x32x16_bf16(ka, qb, s, 0, 0, 0);
                }
            }
            const int tcol = 32 * tt + l31;
#pragma unroll
            for (int g = 0; g < 4; ++g) {
                float vv[4];
#pragma unroll
                for (int e = 0; e < 4; ++e) { const int srow = 32 * ts + 8 * g + 4 * hi + e; const bool keep = dir ? (srow >= tcol) : (srow <= tcol); vv[e] = keep ? s[4 * g + e] : 0.f; }
                u32x2 pk; pk.x = cvt_pk_bf16(vv[0], vv[1]); pk.y = cvt_pk_bf16(vv[2], vv[3]);
                *(u32x2*)(att + ((size_t)dir * 64 + tcol) * 72 + 32 * ts + 8 * g + 4 * hi) = pk;
            }
        }
        __syncthreads();
        f32x16 o0, o1;
#pragma unroll
        for (int r = 0; r < 16; ++r) { o0[r] = 0.f; o1[r] = 0.f; }
        const int tB = 32 * wt + l31;
        const bf16_t* vt0 = p.VT + ((size_t)(bh * 68 + 4 + j) * 256 + 64 * wv + l31) * 64 + 8 * hi;
#pragma unroll
        for (int dir = 0; dir < 2; ++dir) {
#pragma unroll
            for (int ks = 0; ks < 4; ++ks) {
                const bf16x8 bb = *(const bf16x8*)(att + ((size_t)dir * 64 + tB) * 72 + 16 * ks + 8 * hi);
                const bf16x8 a0 = *(const bf16x8*)(vt0 + 16 * ks), a1 = *(const bf16x8*)(vt0 + 32 * 64 + 16 * ks);
                o0 = __builtin_amdgcn_mfma_f32_32x32x16_bf16(a0, bb, o0, 0, 0, 0);
                o1 = __builtin_amdgcn_mfma_f32_32x32x16_bf16(a1, bb, o1, 0, 0, 0);
            }
            const bf16_t* ss0 = p.SS + ((((size_t)dir * 8 + bh) * 65 + j) * 256 + 64 * wv + l31) * 128 + 8 * hi;
            const bf16_t* qm = (dir ? p.QB : p.QF) + tb + (size_t)tB * 128 + 8 * hi;
#pragma unroll
            for (int ks = 0; ks < 8; ++ks) {
                const bf16x8 bb = *(const bf16x8*)(qm + 16 * ks);
                const bf16x8 a0 = *(const bf16x8*)(ss0 + 16 * ks), a1 = *(const bf16x8*)(ss0 + 32 * 128 + 16 * ks);
                o0 = __builtin_amdgcn_mfma_f32_32x32x16_bf16(a0, bb, o0, 0, 0, 0);
                o1 = __builtin_amdgcn_mfma_f32_32x32x16_bf16(a1, bb, o1, 0, 0, 0);
            }
        }
        float ss = 0.f;
#pragma unroll
        for (int r = 0; r < 16; ++r) ss += o0[r] * o0[r] + o1[r] * o1[r];
        ss += __shfl_xor(ss, 32);
        if (hi == 0) ssq[(wt * 4 + wv) * 32 + l31] = ss;
        __syncthreads();
        const float tot = ssq[(wt * 4 + 0) * 32 + l31] + ssq[(wt * 4 + 1) * 32 + l31] + ssq[(wt * 4 + 2) * 32 + l31] + ssq[(wt * 4 + 3) * 32 + l31];
        const float rstd = rsqrtf(tot * (1.f / 256.f) + 1e-6f);
        const int row = b * SEQ + 64 * j + tB;
#pragma unroll
        for (int vt = 0; vt < 2; ++vt)
#pragma unroll
            for (int g = 0; g < 4; ++g) {
                const int v = 64 * wv + 32 * vt + 8 * g + 4 * hi;
                const f32x4 gate = *(const f32x4*)(p.P + (size_t)row * PLD + 5120 + h * 256 + v);
                const f32x4 gn = *(const f32x4*)(p.gla_norm_g + v);
                float ov[4];
#pragma unroll
                for (int e = 0; e < 4; ++e) { const float x = vt ? o1[4 * g + e] : o0[4 * g + e]; ov[e] = x * rstd * gn[e] * siluf(gate[e]); }
                u32x2 pk; pk.x = cvt_pk_bf16(ov[0], ov[1]); pk.y = cvt_pk_bf16(ov[2], ov[3]);
                *(u32x2*)(p.MIX + (size_t)row * D + 1024 + h * 256 + v) = pk;
            }
        __syncthreads();
    }
}

__device__ void ph_norm2_router(const Params& p, float* sm, const int wid0) {
    const int t = opaque_tid(wid0), w = t >> 6, lane = t & 63;
    float* hs = sm;
    float* part = sm + 8 * D;
    int* hist = (int*)(sm + 8 * D + 8 * 8 * 64);
    const int G = gridDim.x, gpb = (NLAT / 8 + G - 1) / G;
    if (t < 64) hist[t] = 0;
    __syncthreads();
    for (int gi = 0; gi < gpb; ++gi) {
        const int rb = blockIdx.x * gpb + gi;
        if (rb >= NLAT / 8) break;
        const int row = rb * 8 + w, b = row / SEQ;
        const float* m = p.mod + (size_t)b * 6 * D;
        const float* src = p.X1 + (size_t)row * D;
        float4 v[8]; float ss = 0.f;
#pragma unroll
        for (int j = 0; j < 8; ++j) { v[j] = *(const float4*)(src + 256 * j + 4 * lane); ss += v[j].x * v[j].x + v[j].y * v[j].y + v[j].z * v[j].z + v[j].w * v[j].w; }
        ss = wave_sum(ss);
        const float rs = rsqrtf(ss * (1.f / D) + 1e-6f);
        __syncthreads();
#pragma unroll
        for (int j = 0; j < 8; ++j) {
            const int col = 256 * j + 4 * lane;
            const float4 g = *(const float4*)(p.norm2_g + col), sh = *(const float4*)(m + 3 * D + col), sc = *(const float4*)(m + 4 * D + col);
            float4 o;
            o.x = v[j].x * rs * g.x * (1.f + sc.x) + sh.x; o.y = v[j].y * rs * g.y * (1.f + sc.y) + sh.y;
            o.z = v[j].z * rs * g.z * (1.f + sc.z) + sh.z; o.w = v[j].w * rs * g.w * (1.f + sc.w) + sh.w;
            *(float4*)(hs + w * D + col) = o;
            u32x2 pk; pk.x = cvt_pk_bf16(o.x, o.y); pk.y = cvt_pk_bf16(o.z, o.w);
            *(u32x2*)(p.H + (size_t)row * D + col) = pk;
        }
        __syncthreads();
        {
            const int e = t & 63, kp = t >> 6;
            float a[8];
#pragma unroll
            for (int r = 0; r < 8; ++r) a[r] = 0.f;
#pragma unroll 8
            for (int k = kp * 256; k < kp * 256 + 256; ++k) {
                const float wv = p.router_w[(size_t)k * NE + e];
#pragma unroll
                for (int r = 0; r < 8; ++r) a[r] += hs[r * D + k] * wv;
            }
#pragma unroll
            for (int r = 0; r < 8; ++r) part[(kp * 8 + r) * 64 + e] = a[r];
        }
        __syncthreads();
        {
            float lgt = 0.f;
#pragma unroll
            for (int i = 0; i < 8; ++i) lgt += part[(i * 8 + w) * 64 + lane];
            const float sc = 1.f / (1.f + expf(-lgt));
            const float bs = sc + p.router_bias[lane];
            float m1 = bs; m1 = fmaxf(m1, __shfl_xor(m1, 1)); m1 = fmaxf(m1, __shfl_xor(m1, 2)); m1 = fmaxf(m1, __shfl_xor(m1, 4));
            int ai = (bs == m1) ? lane : 64; ai = min(ai, __shfl_xor(ai, 1)); ai = min(ai, __shfl_xor(ai, 2)); ai = min(ai, __shfl_xor(ai, 4));
            float m2 = (lane == ai) ? -INFINITY : bs; m2 = fmaxf(m2, __shfl_xor(m2, 1)); m2 = fmaxf(m2, __shfl_xor(m2, 2)); m2 = fmaxf(m2, __shfl_xor(m2, 4));
            const float gs = m1 + m2;
            float g0 = __shfl(gs, 0), g1 = __shfl(gs, 8), g2 = __shfl(gs, 16), g3 = __shfl(gs, 24), g4 = __shfl(gs, 32), g5 = __shfl(gs, 40), g6 = __shfl(gs, 48), g7 = __shfl(gs, 56);
            unsigned selmask = 0u;
#pragma unroll
            for (int it = 0; it < 4; ++it) {
                float best = -INFINITY; int bi = 0;
                if (!(selmask & 1u) && g0 > best) { best = g0; bi = 0; }
                if (!(selmask & 2u) && g1 > best) { best = g1; bi = 1; }
                if (!(selmask & 4u) && g2 > best) { best = g2; bi = 2; }
                if (!(selmask & 8u) && g3 > best) { best = g3; bi = 3; }
                if (!(selmask & 16u) && g4 > best) { best = g4; bi = 4; }
                if (!(selmask & 32u) && g5 > best) { best = g5; bi = 5; }
                if (!(selmask & 64u) && g6 > best) { best = g6; bi = 6; }
                if (!(selmask & 128u) && g7 > best) { best = g7; bi = 7; }
                selmask |= 1u << bi;
            }
            float cand = ((selmask >> (lane >> 3)) & 1u) ? bs : -INFINITY;
            int myslot = -1; float ssum = 0.f;
#pragma unroll
            for (int k = 0; k < TOPK; ++k) {
                const float mv = wave_max(cand);
                const int idx = wave_min_i((cand == mv) ? lane : 64);
                const float sv = __shfl(sc, idx);
                ssum += sv;
                if (lane == idx) { myslot = k; cand = -INFINITY; }
            }
            if (myslot >= 0) {
                p.EIDX[row * TOPK + myslot] = lane;
                p.EW[row * TOPK + myslot] = sc / ssum * 2.5f;
                p.LRANK[row * TOPK + myslot] = atomicAdd(&hist[lane], 1);
            }
        }
    }
    __syncthreads();
    if (t < 64) p.CNTB[blockIdx.x * 64 + t] = hist[t];
}

__device__ void ph_lists(const Params& p, int* smi, const int wid0) {
    const int t = opaque_tid(wid0);
    const int G = gridDim.x, gpb = (NLAT / 8 + G - 1) / G;
    int* tp = smi + 128; int* tot = smi + 64;
    __syncthreads();
    if (t < 64) {
        int before = 0, all = 0;
        for (int bb = 0; bb < G; ++bb) { const int cnt = p.CNTB[bb * 64 + t]; all += cnt; if (bb < (int)blockIdx.x) before += cnt; }
        smi[t] = before; tot[t] = all;
        if (blockIdx.x == 0) p.CNT[t] = all;
    }
    __syncthreads();
    if (t == 0) { int tt = 0; for (int e = 0; e < NE; ++e) { tp[e] = tt; tt += (tot[e] + 255) / 256; } tp[NE] = tt; }
    __syncthreads();
    const int r0 = blockIdx.x * gpb * 8, r1 = min(NLAT, r0 + gpb * 8);
    for (int i = r0 * TOPK + t; i < r1 * TOPK; i += NT) {
        const int e = p.EIDX[i];
        const int pos = tp[e] * 256 + smi[e] + p.LRANK[i];
        p.PAIRPOS[i] = pos; p.LIST[pos] = i / TOPK;
    }
    for (int e = blockIdx.x; e < NE; e += G) {
        const int cn = tot[e], end = (tp[e + 1] - tp[e]) * 256;
        for (int i = cn + t; i < end; i += NT) p.LIST[tp[e] * 256 + i] = 0;
    }
}

__device__ void ph_combine(const Params& p, const int wid0) {
    const int t = opaque_tid(wid0), w = t >> 6, lane = t & 63;
    for (int row = blockIdx.x * 8 + w; row < NLAT; row += gridDim.x * 8) {
        const int b = row / SEQ;
        float wk[TOPK]; const bf16_t* yr[TOPK];
#pragma unroll
        for (int k = 0; k < TOPK; ++k) { wk[k] = p.EW[row * TOPK + k]; yr[k] = p.Y + (size_t)p.PAIRPOS[row * TOPK + k] * D + 8 * lane; }
        const bf16_t* ys = p.YS + (size_t)row * D + 8 * lane;
        const float* x1 = p.X1 + (size_t)row * D + 8 * lane;
        const float* g2 = p.mod + (size_t)b * 6 * D + 5 * D + 8 * lane;
        float* o = p.out + (size_t)row * D + 8 * lane;
#pragma unroll
        for (int j = 0; j < 4; ++j) {
            float s[8];
            { const u32x4 v = *(const u32x4*)(ys + 512 * j);
              s[0] = bf2f(v.x & 0xffffu); s[1] = bf2f(v.x >> 16); s[2] = bf2f(v.y & 0xffffu); s[3] = bf2f(v.y >> 16); s[4] = bf2f(v.z & 0xffffu); s[5] = bf2f(v.z >> 16); s[6] = bf2f(v.w & 0xffffu); s[7] = bf2f(v.w >> 16); }
#pragma unroll
            for (int k = 0; k < TOPK; ++k) {
                const u32x4 v = *(const u32x4*)(yr[k] + 512 * j); const float wv = wk[k];
                s[0] += wv * bf2f(v.x & 0xffffu); s[1] += wv * bf2f(v.x >> 16); s[2] += wv * bf2f(v.y & 0xffffu); s[3] += wv * bf2f(v.y >> 16);
                s[4] += wv * bf2f(v.z & 0xffffu); s[5] += wv * bf2f(v.z >> 16); s[6] += wv * bf2f(v.w & 0xffffu); s[7] += wv * bf2f(v.w >> 16);
            }
            const f32x4 xa = *(const f32x4*)(x1 + 512 * j), xb = *(const f32x4*)(x1 + 512 * j + 4), ga = *(const f32x4*)(g2 + 512 * j), gb = *(const f32x4*)(g2 + 512 * j + 4);
            *(f32x4*)(o + 512 * j) = (f32x4){xa[0] + ga[0] * s[0], xa[1] + ga[1] * s[1], xa[2] + ga[2] * s[2], xa[3] + ga[3] * s[3]};
            *(f32x4*)(o + 512 * j + 4) = (f32x4){xb[0] + gb[0] * s[4], xb[1] + gb[1] * s[5], xb[2] + gb[2] * s[6], xb[3] + gb[3] * s[7]};
        }
    }
}

__global__ void __launch_bounds__(NT, 2) mega(Params p) {
    extern __shared__ __attribute__((aligned(16))) unsigned char dynlds[];
    int wid0;
    wid0 = __builtin_amdgcn_readfirstlane((int)threadIdx.x >> 6); asm volatile("" : "+s"(wid0));
    if (wid0 == 0 && xb_lane_id() < 4) ((unsigned*)(dynlds + LDS_BARW))[xb_lane_id()] = 0u;
    __syncthreads();
    XcdBarrier bar = xcd_barrier_post(p.bar, (volatile LAS unsigned*)(dynlds + LDS_BARW), wid0);
    float* sm = (float*)dynlds;
    int* tp = (int*)(dynlds + LDS_TAB);
    LAS unsigned char* lds = (LAS unsigned char*)dynlds;
    const int G = gridDim.x, c = blockIdx.x;

#ifndef REP
#define REP 0
#endif
#define PH(bit, ...) do { __VA_ARGS__; if (REP & (1 << (bit))) { xcd_barrier(bar); __VA_ARGS__; } } while (0)
    PH(0, ph_prologue(p, sm, wid0));                            xcd_barrier(bar);
    PH(1, ph_norm1(p, wid0));                               xcd_barrier(bar);
    PH(2, { SchedDense S{(const char*)p.H, (const char*)p.WinT, D, NROW / 256, PLD / 256 + 1, G, c}; EpiInproj E{p.P, p.DD};
      g8::gemm_phase(lds, D, S, E, wid0); });                   xcd_barrier(bar);
    PH(3, ph_naprep(p, wid0)); PH(4, ph_glaprep(p, sm, wid0));        xcd_barrier(bar);
    ph_attn(p, sm, wid0);                                       xcd_barrier(bar);
    PH(7, ph_glaout(p, dynlds, wid0));                          xcd_barrier(bar);
    PH(8, { SchedDense S{(const char*)p.MIX, (const char*)p.WoutT, D, NLAT / 256, D / 256, G, c}; EpiOutproj E{p.x, p.mod, p.X1};
      g8::gemm_phase(lds, D, S, E, wid0); });                   xcd_barrier(bar);
    PH(12, ph_norm2_router(p, sm, wid0));                       xcd_barrier(bar);
    PH(13, ph_lists(p, tp, wid0));                              xcd_barrier(bar);
    moe_tables(p, tp, wid0);
    PH(9, { SchedUp S{tp, (const char*)p.H, p.LIST, (const char*)p.E13T, (const char*)p.S13T, G, c}; EpiUp E{p.HB, p.SHH};
      g8::gemm_phase(lds, D, S, E, wid0); });                   xcd_barrier(bar);
    PH(10, { SchedDown S{tp, (const char*)p.HB, (const char*)p.E2T, (const char*)p.SHH, (const char*)p.S2T, G, c}; EpiDown E{p.Y, p.YS};
      g8::gemm_phase(lds, DE, S, E, wid0); });                  xcd_barrier(bar);
    PH(11, ph_combine(p, wid0));
}

extern "C" void kernel_launch(void* const* d_in, const int* in_sizes, int n_in, void* d_out, int out_size, void* d_ws, size_t ws_size, hipStream_t stream) {
    Params p{};
    const float* const* in = (const float* const*)d_in;
    p.x = in[0]; p.c = in[1]; p.ctx = in[2]; p.c_ctx = in[3]; p.w_mod = in[4]; p.b_mod = in[5]; p.norm1_g = in[6]; p.norm2_g = in[7]; p.w_in = in[8];
    p.q_norm_g = in[9]; p.k_norm_g = in[10]; p.na_rpb = in[11]; p.up_f = in[12]; p.bias_f = in[13]; p.up_b = in[14]; p.bias_b = in[15]; p.gla_norm_g = in[16];
    p.w_out = in[17]; p.router_w = in[18]; p.router_bias = in[19]; p.ew1 = in[20]; p.ew3 = in[21]; p.ew2 = in[22]; p.sw1 = in[23]; p.sw3 = in[24]; p.sw2 = in[25];
    p.out = (float*)d_out;
    char* w = (char*)d_ws; size_t o = 0;
    auto take = [&](size_t bytes) { void* r = w + o; o += (bytes + 255) & ~(size_t)255; return r; };
    p.bar = (unsigned*)take((size_t)XCD_BAR_WORDS * 4);
    p.CNT = (int*)take(64 * 4); p.QCTR = (int*)take(64 * 4); p.LRANK = (int*)take((size_t)NPAIR * 4); p.CNTB = (int*)take((size_t)1024 * 64 * 4);
    p.mod = (float*)take((size_t)3 * 6 * D * 4); p.RT = (float*)take((size_t)64 * 32 * 2 * 4);
    p.EIDX = (int*)take((size_t)NPAIR * 4); p.EW = (float*)take((size_t)NPAIR * 4); p.PAIRPOS = (int*)take((size_t)NPAIR * 4); p.LIST = (int*)take((size_t)PADROWS * 4);
    p.WinT = (bf16_t*)take((size_t)(PLD + 256) * D * 2); p.WoutT = (bf16_t*)take((size_t)D * D * 2); p.S13T = (bf16_t*)take((size_t)1024 * D * 2); p.S2T = (bf16_t*)take((size_t)D * DE * 2);
    p.E13T = (bf16_t*)take((size_t)NE * 1024 * D * 2); p.E2T = (bf16_t*)take((size_t)NE * D * DE * 2);
    p.H = (bf16_t*)take((size_t)NROW * D * 2);
    p.X1 = (float*)take((size_t)NLAT * D * 4);
    const size_t big = o;
    p.P = (float*)take((size_t)NROW * PLD * 4); p.DD = (float*)take((size_t)NROW * 32 * 4); p.NQb = (bf16_t*)take((size_t)NLAT * 1024 * 2); p.NKb = (bf16_t*)take((size_t)NROW * 1024 * 2); p.VTn = (bf16_t*)take((size_t)16 * 128 * NTOK * 2);
    p.MIX = (bf16_t*)take((size_t)NLAT * D * 2);
    p.QF = (bf16_t*)take((size_t)8 * 64 * 64 * 128 * 2); p.KF = (bf16_t*)take((size_t)8 * 64 * 64 * 128 * 2); p.QB = (bf16_t*)take((size_t)8 * 64 * 64 * 128 * 2); p.KB = (bf16_t*)take((size_t)8 * 64 * 64 * 128 * 2);
    p.KHF = (bf16_t*)take((size_t)8 * 68 * 128 * 64 * 2); p.KHB = (bf16_t*)take((size_t)8 * 68 * 128 * 64 * 2); p.VT = (bf16_t*)take((size_t)8 * 68 * 256 * 64 * 2);
    p.DF = (float*)take((size_t)8 * 68 * 128 * 4); p.DB = (float*)take((size_t)8 * 68 * 128 * 4); p.SS = (bf16_t*)take((size_t)16 * 65 * 256 * 128 * 2);
    o = big;
    p.HB = (bf16_t*)take((size_t)PADROWS * DE * 2); p.SHH = (bf16_t*)take((size_t)NLAT * DE * 2); p.Y = (bf16_t*)take((size_t)PADROWS * D * 2); p.YS = (bf16_t*)take((size_t)NLAT * D * 2);
    static int grid = 0;
    if (!grid) {
        int dev = 0, cus = 0, per_cu = 0;
        hipGetDevice(&dev);
        hipDeviceGetAttribute(&cus, hipDeviceAttributeMultiprocessorCount, dev);
        (void)hipFuncSetAttribute((const void*)mega, hipFuncAttributeMaxDynamicSharedMemorySize, LDS_BYTES);
        (void)hipOccupancyMaxActiveBlocksPerMultiprocessor(&per_cu, (const void*)mega, NT, LDS_BYTES);
        (void)hipGetLastError();
        grid = cus;
    }
    (void)hipMemsetAsync(p.bar, 0, (size_t)XCD_BAR_WORDS * 4, stream);
    hipLaunchKernelGGL(mega, dim3(grid), dim3(NT), LDS_BYTES, stream, p);
}
```

```cpp
#include <hip/hip_runtime.h>
#include <stdint.h>

#define XB_TMO      128
#define XB_XCNT(j)  (256  + 64 * (j))
#define XB_XSUB(j)  (1280 + 64 * (j))
#define XB_XGEN(j)  (2304 + 64 * (j))
#define XB_TOP      3328
#define XB_TOPGEN   3392
#define XCD_BAR_WORDS 3456
#define XB_SPIN_CAP (1u << 18)
#define LAS __attribute__((address_space(3)))

__device__ __forceinline__ unsigned xb_ld(unsigned* p)              { return __hip_atomic_load(p, __ATOMIC_RELAXED, __HIP_MEMORY_SCOPE_AGENT); }
__device__ __forceinline__ unsigned xb_add(unsigned* p, unsigned v) { return __hip_atomic_fetch_add(p, v, __ATOMIC_RELAXED, __HIP_MEMORY_SCOPE_AGENT); }
__device__ __forceinline__ unsigned xb_xcc_id() { return (unsigned)__builtin_amdgcn_s_getreg((3 << 11) | 20) & 0xFu; }
#define XB_SPIN(cond, bar) do { unsigned _sp = 0; while (cond) { __builtin_amdgcn_s_sleep(1); \
    if ((++_sp & 255u) == 0u) { if (xb_ld(&(bar)[XB_TMO])) break; if (_sp > XB_SPIN_CAP) { atomicAdd(&(bar)[XB_TMO], 1u); break; } } } } while (0)

__device__ __forceinline__ int xb_lane_id() { return (int)__builtin_amdgcn_mbcnt_hi(~0u, __builtin_amdgcn_mbcnt_lo(~0u, 0u)); }
struct XcdBarrier {
    int wid;
    unsigned* bar; unsigned x;
    volatile LAS unsigned* st;
};

__device__ __forceinline__ XcdBarrier xcd_barrier_post(unsigned* bar, volatile LAS unsigned* st, int wid) {
    XcdBarrier b; b.wid = wid; b.bar = bar; b.x = xb_xcc_id(); b.st = st;
    if (wid == 0 && xb_lane_id() == 0) (void)xb_add(&bar[XB_XCNT(b.x)], 1u);
    return b;
}
__device__ __forceinline__ void xcd_barrier_complete(unsigned* bar, unsigned x, unsigned& nloc, unsigned& nx) {
    const unsigned G = gridDim.x * gridDim.y * gridDim.z;
    unsigned sum, cnt, mine, sp = 0u;
    for (;;) {
        sum = 0u; cnt = 0u; mine = 0u;
#pragma unroll
        for (unsigned j = 0; j < 16; ++j) { const unsigned c = xb_ld(&bar[XB_XCNT(j)]); sum += c; cnt += (c > 0u) ? 1u : 0u; mine = (j == x) ? c : mine; }
        if (sum == G) break;
        __builtin_amdgcn_s_sleep(1);
        if ((++sp & 255u) == 0u) { if (xb_ld(&bar[XB_TMO])) break; if (sp > XB_SPIN_CAP) { atomicAdd(&bar[XB_TMO], 1u); break; } }
    }
    nloc = mine > 0u ? mine : 1u; nx = cnt > 0u ? cnt : 1u;
}

__device__ __forceinline__ void xcd_barrier(const XcdBarrier& b) {
    asm volatile("s_waitcnt vmcnt(0)" ::: "memory");
    __syncthreads();
    if (b.wid == 0 && xb_lane_id() == 0) {
        unsigned* bar = b.bar;
        __builtin_amdgcn_s_waitcnt(0);
        unsigned nloc = b.st[0], nx = b.st[1];
        if (nloc == 0u) { xcd_barrier_complete(bar, b.x, nloc, nx); b.st[0] = nloc; b.st[1] = nx; }
        const unsigned old = xb_add(&bar[XB_XSUB(b.x)], 1u);
        const unsigned gen = old / nloc;
        if (old + 1u == (gen + 1u) * nloc) {
            __builtin_amdgcn_fence(__ATOMIC_RELEASE, "agent");
            asm volatile("s_waitcnt vmcnt(0)" ::: "memory");
            const unsigned og = xb_add(&bar[XB_TOP], 1u);
            const unsigned tg = og / nx;
            if (og + 1u == (tg + 1u) * nx) xb_add(&bar[XB_TOPGEN], 1u);
            else XB_SPIN(xb_ld(&bar[XB_TOPGEN]) == tg, bar);
            __builtin_amdgcn_fence(__ATOMIC_ACQUIRE, "agent");
            xb_add(&bar[XB_XGEN(b.x)], 1u);
            asm volatile("s_waitcnt vmcnt(0)" ::: "memory");
        } else {
            XB_SPIN(xb_ld(&bar[XB_XGEN(b.x)]) == gen, bar);
            __builtin_amdgcn_fence(__ATOMIC_ACQUIRE, "agent");
            asm volatile("s_waitcnt vmcnt(0)" ::: "memory");
        }
    }
    __syncthreads();
}


#define NT 512
typedef unsigned short bf16_t;
typedef short bf16x8 __attribute__((ext_vector_type(8)));
typedef float f32x4 __attribute__((ext_vector_type(4)));
typedef float f32x16 __attribute__((ext_vector_type(16)));
typedef unsigned u32x4 __attribute__((ext_vector_type(4)));
typedef unsigned u32x2 __attribute__((ext_vector_type(2)));

constexpr int D = 2048, SEQ = 4096, CTXL = 256, NB = 2;
constexpr int NLAT = NB * SEQ;
constexpr int NCTX = NB * CTXL;
constexpr int NROW = NLAT + NCTX;
constexpr int INC = 6176;
constexpr int PLD = 6144;
constexpr int NE = 64, TOPK = 6, DE = 512;
constexpr int NPAIR = NLAT * TOPK;
constexpr int PADROWS = NPAIR + NE * 256;
constexpr int LDS_STAGE = 131072;
constexpr int LDS_TAB = LDS_STAGE;
constexpr int LDS_BARW = LDS_STAGE + 4096;
constexpr int LDS_BYTES = LDS_BARW + 16 + 8192;

struct Params {
    const float *x, *c, *ctx, *c_ctx, *w_mod, *b_mod, *norm1_g, *norm2_g, *w_in, *q_norm_g, *k_norm_g, *na_rpb,
        *up_f, *bias_f, *up_b, *bias_b, *gla_norm_g, *w_out, *router_w, *router_bias, *ew1, *ew3, *ew2, *sw1, *sw3, *sw2;
    float* out;
    float *mod, *X1, *P, *DD, *EW, *RT, *DF, *DB;
    bf16_t *H, *MIX, *HB, *SHH, *Y, *WinT, *WoutT, *S13T, *S2T, *E13T, *E2T, *QF, *KF, *QB, *KB, *KHF, *KHB, *VT, *SS, *NQb, *NKf, *VTf, *YS, *VTS;
    int *EIDX, *PAIRPOS, *LIST, *CNT, *QCTR, *LRANK, *CNTB;
    unsigned* bar;
};

__device__ __forceinline__ int fresh_lane_id() { int l; asm volatile("v_mbcnt_lo_u32_b32 %0, -1, 0\n\tv_mbcnt_hi_u32_b32 %0, -1, %0" : "=v"(l)); return l; }
__device__ __forceinline__ int opaque_tid(int wid0) { return wid0 * 64 + fresh_lane_id(); }
__device__ __forceinline__ float wave_sum(float v) { for (int o = 32; o > 0; o >>= 1) v += __shfl_xor(v, o); return v; }
__device__ __forceinline__ float wave_max(float v) { for (int o = 32; o > 0; o >>= 1) v = fmaxf(v, __shfl_xor(v, o)); return v; }
__device__ __forceinline__ int wave_min_i(int v) { for (int o = 32; o > 0; o >>= 1) v = min(v, __shfl_xor(v, o)); return v; }
__device__ __forceinline__ float siluf(float v) { return v / (1.f + expf(-v)); }
typedef float f32x2 __attribute__((ext_vector_type(2)));
typedef __bf16 bf16x2_t __attribute__((ext_vector_type(2)));
__device__ __forceinline__ unsigned cvt_pk_bf16(float lo, float hi) { const f32x2 v = {lo, hi}; return __builtin_bit_cast(unsigned, __builtin_convertvector(v, bf16x2_t)); }
__device__ __forceinline__ bf16_t f2bf(float f) { return (bf16_t)(cvt_pk_bf16(f, 0.f) & 0xffffu); }
__device__ __forceinline__ float bf2f(unsigned b) { return __uint_as_float(b << 16); }

__device__ __forceinline__ void adaln_item(const Params& p, float* sm, int item, const int wid0) {
    const int t = opaque_tid(wid0), cq = t & 15, kg = t >> 4, n0 = item * 64;
    float* red = sm + 3 * D;
    float a[3][4];
#pragma unroll
    for (int r = 0; r < 3; ++r)
#pragma unroll
        for (int j = 0; j < 4; ++j) a[r][j] = 0.f;
#pragma unroll 4
    for (int k = kg; k < D; k += 32) {
        const float4 w = *(const float4*)(p.w_mod + (size_t)k * (6 * D) + n0 + 4 * cq);
        const float s0 = sm[k], s1 = sm[D + k], s2 = sm[2 * D + k];
        a[0][0] += s0 * w.x; a[0][1] += s0 * w.y; a[0][2] += s0 * w.z; a[0][3] += s0 * w.w;
        a[1][0] += s1 * w.x; a[1][1] += s1 * w.y; a[1][2] += s1 * w.z; a[1][3] += s1 * w.w;
        a[2][0] += s2 * w.x; a[2][1] += s2 * w.y; a[2][2] += s2 * w.z; a[2][3] += s2 * w.w;
    }
    __syncthreads();
#pragma unroll
    for (int r = 0; r < 3; ++r)
#pragma unroll
        for (int j = 0; j < 4; ++j) red[(kg * 3 + r) * 64 + 4 * cq + j] = a[r][j];
    __syncthreads();
    if (t < 192) {
        const int r = t >> 6, cc = t & 63;
        float s = p.b_mod[n0 + cc];
#pragma unroll 8
        for (int g = 0; g < 32; ++g) s += red[(g * 3 + r) * 64 + cc];
        p.mod[(size_t)r * 6 * D + n0 + cc] = s;
    }
    __syncthreads();
}
__device__ __forceinline__ void transpose_item(const float* W, int K, int N, int k0, int n0, bf16_t* WT, int drow0, float* scr, int lane, int maxc = 63) {
    const int cl = lane < maxc ? lane : maxc;
#pragma unroll 8
    for (int kk = 0; kk < 64; ++kk) scr[kk * 65 + lane] = W[(size_t)(k0 + kk) * N + n0 + cl];
    asm volatile("s_waitcnt lgkmcnt(0)" ::: "memory");
    const int c = lane & 7;
#pragma unroll
    for (int j = 0; j < 8; ++j) {
        const int n = (lane >> 3) + 8 * j; const float* s = scr + (8 * c) * 65 + n;
        u32x4 o; o.x = cvt_pk_bf16(s[0], s[65]); o.y = cvt_pk_bf16(s[2 * 65], s[3 * 65]); o.z = cvt_pk_bf16(s[4 * 65], s[5 * 65]); o.w = cvt_pk_bf16(s[6 * 65], s[7 * 65]);
        *(u32x4*)(WT + (size_t)(drow0 + n) * K + k0 + 8 * c) = o;
    }
    asm volatile("s_waitcnt lgkmcnt(0)" ::: "memory");
}
constexpr int CI_WIN = 32 * 97, CI_WOUT = 32 * 32, CI_S13 = 2 * 32 * 8, CI_S2 = 8 * 32, CI_E13 = 64 * 2 * 32 * 8, CI_E2 = 64 * 8 * 32;
constexpr int CI_TOTAL = CI_WIN + CI_WOUT + CI_S13 + CI_S2 + CI_E13 + CI_E2;
__device__ __forceinline__ void convert_item(const Params& p, int it, float* scr, int lane) {
    if (it < CI_WIN) { const int kb = it / 97, nb = it % 97; transpose_item(p.w_in, D, INC, 64 * kb, 64 * nb, p.WinT, 64 * nb, scr, lane, INC - 1 - 64 * nb); return; }
    it -= CI_WIN;
    if (it < CI_WOUT) { const int kb = it / 32, nb = it % 32; transpose_item(p.w_out, D, D, 64 * kb, 64 * nb, p.WoutT, 64 * nb, scr, lane); return; }
    it -= CI_WOUT;
    if (it < CI_S13) {
        const int which = it / 256, r = it % 256, kb = r / 8, nb = r % 8;
        transpose_item(which ? p.sw3 : p.sw1, D, DE, 64 * kb, 64 * nb, p.S13T, (nb >> 1) * 256 + which * 128 + (nb & 1) * 64, scr, lane); return; }
    it -= CI_S13;
    if (it < CI_S2) { const int kb = it / 32, nb = it % 32; transpose_item(p.sw2, DE, D, 64 * kb, 64 * nb, p.S2T, 64 * nb, scr, lane); return; }
    it -= CI_S2;
    if (it < CI_E13) {
        const int e = it / 512, r0 = it % 512, which = r0 / 256, r = r0 % 256, kb = r / 8, nb = r % 8;
        transpose_item((which ? p.ew3 : p.ew1) + (size_t)e * D * DE, D, DE, 64 * kb, 64 * nb, p.E13T + (size_t)e * 1024 * D, (nb >> 1) * 256 + which * 128 + (nb & 1) * 64, scr, lane); return; }
    it -= CI_E13;
    { const int e = it / 256, r = it % 256, kb = r / 32, nb = r % 32;
      transpose_item(p.ew2 + (size_t)e * DE * D, DE, D, 64 * kb, 64 * nb, p.E2T + (size_t)e * D * DE, 64 * nb, scr, lane); }
}
__device__ void ph_prologue(const Params& p, float* sm, const int wid0) {
    const int t = opaque_tid(wid0), w = t >> 6, lane = t & 63;
    if (blockIdx.x == 0 && t == 0) { p.QCTR[0] = 0; p.QCTR[32] = 0; }
    if (blockIdx.x == gridDim.x - 1) {
        for (int i = t; i < 64 * 32; i += NT) { const float ang = (float)(i >> 5) * powf(10000.f, -(float)(i & 31) / 32.f); p.RT[2 * i] = cosf(ang); p.RT[2 * i + 1] = sinf(ang); }
    }
    if (blockIdx.x < 192) {
        for (int i = t; i < 3 * D; i += NT) { const int r = i / D, k = i % D; sm[i] = siluf(r < 2 ? p.c[r * D + k] : p.c_ctx[k]); }
        __syncthreads();
        for (int item = blockIdx.x; item < 192; item += gridDim.x) adaln_item(p, sm, item, wid0);
    }
    __syncthreads();
    float* scr = sm + w * (64 * 65);
    for (int it = blockIdx.x * 8 + w; it < CI_TOTAL; it += gridDim.x * 8) convert_item(p, it, scr, lane);
}

__device__ void ph_norm1(const Params& p, const int wid0) {
    const int t = opaque_tid(wid0), w = t >> 6, lane = t & 63;
    for (int row = blockIdx.x * 8 + w; row < NROW; row += gridDim.x * 8) {
        const float* src; int mr;
        if (row < NLAT) { src = p.x + (size_t)row * D; mr = row / SEQ; } else { src = p.ctx + (size_t)(row - NLAT) * D; mr = 2; }
        const float* m = p.mod + (size_t)mr * 6 * D;
        float4 v[8]; float ss = 0.f;
#pragma unroll
        for (int j = 0; j < 8; ++j) { v[j] = *(const float4*)(src + 256 * j + 4 * lane); ss += v[j].x * v[j].x + v[j].y * v[j].y + v[j].z * v[j].z + v[j].w * v[j].w; }
        ss = wave_sum(ss);
        const float rs = rsqrtf(ss * (1.f / D) + 1e-6f);
#pragma unroll
        for (int j = 0; j < 8; ++j) {
            const int col = 256 * j + 4 * lane;
            const float4 g = *(const float4*)(p.norm1_g + col), sh = *(const float4*)(m + col), sc = *(const float4*)(m + D + col);
            u32x2 pk;
            pk.x = cvt_pk_bf16(v[j].x * rs * g.x * (1.f + sc.x) + sh.x, v[j].y * rs * g.y * (1.f + sc.y) + sh.y);
            pk.y = cvt_pk_bf16(v[j].z * rs * g.z * (1.f + sc.z) + sh.z, v[j].w * rs * g.w * (1.f + sc.w) + sh.w);
            *(u32x2*)(p.H + (size_t)row * D + col) = pk;
        }
    }
}

namespace g8 {
constexpr int BM = 256, BK = 64, HALF = 128, HTB = HALF * BK * 2;
__device__ __forceinline__ int lds_byte(int r, int c) { const int st = (r >> 4) * 2 + (c >> 5), rr = r & 15, cc = c & 31, ob = rr * 64 + cc * 2; return st * 1024 + (ob ^ (((ob >> 9) & 1) << 5)); }
__device__ __forceinline__ void stage_rc(int b, int& R, int& C) { const int st = b / 1024, sb = b % 1024, swz = sb ^ (((sb >> 9) & 1) << 5); R = (st >> 1) * 16 + swz / 64; C = (st & 1) * 32 + (swz % 64) / 2; }
__device__ __forceinline__ int perm32(int rho) { const int n = rho >> 4, i = rho & 15; return 8 * (i >> 2) + 4 * n + (i & 3); }

struct Unit { const char* A; const int* rows; int row0; const char* Bt; int orow, pn, aux; };

__device__ __forceinline__ bool work_id(int i, int G, int c, int nwg, int& wgid) {
    const long L = (long)i * G + c; if (L >= nwg) return false;
    const int l = (int)L, q = nwg / 8, r = nwg % 8, xcd = l % 8, off = l / 8;
    wgid = (xcd < r ? xcd * (q + 1) : r * (q + 1) + (xcd - r) * q) + off; return true;
}

template <class Epi, class Sched>
__device__ __forceinline__ void gemm_phase(LAS unsigned char* lds, const int K, const Sched& S, const Epi& E, const int wid0) {
    const int tid_ = wid0 * 64 + fresh_lane_id();
    const int tid = tid_, wid = __builtin_amdgcn_readfirstlane(tid >> 6), lane = tid & 63, wr = wid >> 2, wc = wid & 3, fr = lane & 15, fq = lane >> 4;
    const int nt = K / BK;
    int sR[2]; unsigned sC2[2], voffB[2];
#pragma unroll
    for (int i = 0; i < 2; ++i) { int R, C; stage_rc(tid * 16 + i * 8192, R, C); const int Rb = Epi::PERM ? ((R & ~31) + perm32(R & 31)) : R;
        sR[i] = R; sC2[i] = (unsigned)C * 2u; voffB[i] = (unsigned)(Rb * K + C) * 2u; }
    const size_t kstep = (size_t)(BK * 2);
    const size_t hstep = (size_t)HALF * K * 2;
    const unsigned ldsw = (unsigned)wid * 1024u;
    const int aoff = lds_byte(wr * 64 + fr, fq * 8), boff = lds_byte(wc * 32 + fr, fq * 8);
#define G8_SA(b, h) (((b) * 2 + (h)) * g8::HTB)
#define G8_SB(b, h) ((4 + (b) * 2 + (h)) * g8::HTB)
#define G8_STAGE(bufoff, gbase, v0, v1) do { \
        __builtin_amdgcn_global_load_lds((const unsigned*)((const char*)(gbase) + (v0)), (LAS unsigned*)(lds + (bufoff) + ldsw), 16, 0, 0); \
        __builtin_amdgcn_global_load_lds((const unsigned*)((const char*)(gbase) + (v1)), (LAS unsigned*)(lds + (bufoff) + ldsw + 8192), 16, 0, 0); } while (0)
#define G8_LDA(dst, b, h) do { _Pragma("unroll") for (int m = 0; m < 4; ++m) _Pragma("unroll") for (int k = 0; k < 2; ++k) dst[m][k] = *(const LAS bf16x8*)(lds + G8_SA(b, h) + aoff + m * 2048 + k * 1024); } while (0)
#define G8_LDB(dst, b, h) do { _Pragma("unroll") for (int n = 0; n < 2; ++n) _Pragma("unroll") for (int k = 0; k < 2; ++k) dst[n][k] = *(const LAS bf16x8*)(lds + G8_SB(b, h) + boff + n * 2048 + k * 1024); } while (0)
#define G8_MMA(ai, bj, At, Bt) do { __builtin_amdgcn_s_setprio(1); _Pragma("unroll") for (int m = 0; m < 4; ++m) _Pragma("unroll") for (int n = 0; n < 2; ++n) _Pragma("unroll") for (int k = 0; k < 2; ++k) \
        acc[ai][bj][m][n] = __builtin_amdgcn_mfma_f32_16x16x32_bf16(Bt[n][k], At[m][k], acc[ai][bj][m][n], 0, 0, 0); __builtin_amdgcn_s_setprio(0); } while (0)
#define G8_WAIT_V(n) asm volatile("s_waitcnt vmcnt(" #n ")" ::: "memory")
#define G8_WAIT_L(n) asm volatile("s_waitcnt lgkmcnt(" #n ")" ::: "memory")
#define G8_BAR __builtin_amdgcn_s_barrier()
#define G8_SCHED __builtin_amdgcn_sched_barrier(0)
    Unit cur, nxt; int ui = 0;
    if (!S.next(0, cur)) return;
    f32x4 acc[2][2][4][2];
#pragma unroll
    for (int a = 0; a < 2; ++a)
#pragma unroll
        for (int b = 0; b < 2; ++b)
#pragma unroll
            for (int m = 0; m < 4; ++m)
#pragma unroll
                for (int n = 0; n < 2; ++n) acc[a][b][m][n] = (f32x4){0.f, 0.f, 0.f, 0.f};
    bf16x8 At[4][2], B0[2][2], B1[2][2];
    unsigned vA00, vA01, vA10, vA11, nA00, nA01, nA10, nA11;
#define G8_MKOFF(u, o00, o01, o10, o11) do { \
        int r00, r01, r10, r11; \
        if ((u).rows) { r00 = (u).rows[sR[0]]; r01 = (u).rows[sR[1]]; r10 = (u).rows[128 + sR[0]]; r11 = (u).rows[128 + sR[1]]; } \
        else { r00 = (u).row0 + sR[0]; r01 = (u).row0 + sR[1]; r10 = (u).row0 + 128 + sR[0]; r11 = (u).row0 + 128 + sR[1]; } \
        o00 = (unsigned)r00 * (unsigned)(K * 2) + sC2[0]; o01 = (unsigned)r01 * (unsigned)(K * 2) + sC2[1]; \
        o10 = (unsigned)r10 * (unsigned)(K * 2) + sC2[0]; o11 = (unsigned)r11 * (unsigned)(K * 2) + sC2[1]; } while (0)
    G8_MKOFF(cur, vA00, vA01, vA10, vA11);
    const char* cA = cur.A; const char* cB = cur.Bt;
    G8_STAGE(G8_SB(0, 0), cB, voffB[0], voffB[1]); G8_STAGE(G8_SA(0, 0), cA, vA00, vA01); G8_STAGE(G8_SB(0, 1), cB + hstep, voffB[0], voffB[1]); G8_STAGE(G8_SA(0, 1), cA, vA10, vA11);
    if (wr == 1) G8_BAR;
    G8_WAIT_V(4); G8_BAR;
    G8_STAGE(G8_SB(1, 0), cB + kstep, voffB[0], voffB[1]); G8_STAGE(G8_SA(1, 0), cA + kstep, vA00, vA01); G8_STAGE(G8_SB(1, 1), cB + hstep + kstep, voffB[0], voffB[1]);
    G8_WAIT_V(6); G8_BAR;
    for (;;) {
        const bool has_next = S.next(ui + 1, nxt);
        const char* nA = has_next ? nxt.A : cA; const char* nB = has_next ? nxt.Bt : cB;
        if (has_next) G8_MKOFF(nxt, nA00, nA01, nA10, nA11); else { nA00 = vA00; nA01 = vA01; nA10 = vA10; nA11 = vA11; }
        for (int t = 0; t < nt; t += 2) {
            const bool last = (t == nt - 2);
            const char* a1 = cA + (size_t)(t + 1) * kstep;
            G8_LDB(B0, 0, 0); G8_SCHED; G8_LDA(At, 0, 0); G8_STAGE(G8_SA(1, 1), a1, vA10, vA11);
            G8_WAIT_L(8); G8_BAR; G8_WAIT_L(0); G8_MMA(0, 0, At, B0); G8_BAR; G8_SCHED;
            if (last) { vA00 = nA00; vA01 = nA01; vA10 = nA10; vA11 = nA11; }
            const char* a2 = last ? nA : cA + (size_t)(t + 2) * kstep; const char* b2 = last ? nB : cB + (size_t)(t + 2) * kstep;
            const char* a3 = a2 + kstep; const char* b3 = b2 + kstep;
            G8_LDB(B1, 0, 1); G8_STAGE(G8_SB(0, 0), b2, voffB[0], voffB[1]);
            G8_BAR; G8_WAIT_L(0); G8_MMA(0, 1, At, B1); G8_BAR;
            G8_LDA(At, 0, 1); G8_STAGE(G8_SA(0, 0), a2, vA00, vA01);
            G8_BAR; G8_WAIT_L(0); G8_MMA(1, 0, At, B0); G8_BAR; G8_SCHED;
            G8_STAGE(G8_SB(0, 1), b2 + hstep, voffB[0], voffB[1]);
            G8_WAIT_V(6); G8_BAR; G8_MMA(1, 1, At, B1); G8_BAR;
            G8_LDB(B0, 1, 0); G8_SCHED; G8_LDA(At, 1, 0); G8_STAGE(G8_SA(0, 1), a2, vA10, vA11);
            G8_WAIT_L(8); G8_BAR; G8_WAIT_L(0); G8_MMA(0, 0, At, B0); G8_BAR; G8_SCHED;
            G8_LDB(B1, 1, 1); G8_STAGE(G8_SB(1, 0), b3, voffB[0], voffB[1]);
            G8_BAR; G8_WAIT_L(0); G8_MMA(0, 1, At, B1); G8_BAR;
            G8_LDA(At, 1, 1); G8_STAGE(G8_SA(1, 0), a3, vA00, vA01);
            G8_BAR; G8_WAIT_L(0); G8_MMA(1, 0, At, B0); G8_BAR; G8_SCHED;
            G8_STAGE(G8_SB(1, 1), b3 + hstep, voffB[0], voffB[1]);
            G8_WAIT_V(6); G8_BAR; G8_MMA(1, 1, At, B1); G8_BAR;
        }
        E(acc, cur, wr, wc, fr, fq);
        if (!has_next) break;
#pragma unroll
        for (int a = 0; a < 2; ++a)
#pragma unroll
            for (int b = 0; b < 2; ++b)
#pragma unroll
                for (int m = 0; m < 4; ++m)
#pragma unroll
                    for (int n = 0; n < 2; ++n) acc[a][b][m][n] = (f32x4){0.f, 0.f, 0.f, 0.f};
        cur = nxt; cA = nA; cB = nB; ++ui;
    }
    G8_WAIT_V(0);
    if (wr == 0) G8_BAR;
    G8_BAR;
}
}

struct EpiInproj {
    static constexpr bool PERM = false;
    float* P; float* DD;
    __device__ __forceinline__ void operator()(const f32x4 (&acc)[2][2][4][2], const g8::Unit& u, int wr, int wc, int fr, int fq) const {
        if (u.pn == PLD / 256) {
            if (wc == 0) {
#pragma unroll
                for (int ai = 0; ai < 2; ++ai)
#pragma unroll
                    for (int m = 0; m < 4; ++m) { float* rowp = DD + (size_t)(u.orow + ai * 128 + wr * 64 + m * 16 + fr) * 32 + 4 * fq;
                        *(f32x4*)(rowp) = acc[ai][0][m][0]; *(f32x4*)(rowp + 16) = acc[ai][0][m][1]; }
            }
            return;
        }
#pragma unroll
        for (int ai = 0; ai < 2; ++ai)
#pragma unroll
            for (int m = 0; m < 4; ++m) { float* rowp = P + (size_t)(u.orow + ai * 128 + wr * 64 + m * 16 + fr) * PLD + u.pn * 256 + wc * 32 + 4 * fq;
#pragma unroll
                for (int bj = 0; bj < 2; ++bj)
#pragma unroll
                    for (int n = 0; n < 2; ++n) *(f32x4*)(rowp + bj * 128 + n * 16) = acc[ai][bj][m][n]; }
    }
};
struct EpiOutproj {
    static constexpr bool PERM = false;
    const float* x; const float* mod; float* X1;
    __device__ __forceinline__ void operator()(const f32x4 (&acc)[2][2][4][2], const g8::Unit& u, int wr, int wc, int fr, int fq) const {
        const int b = u.orow / SEQ; const int col0 = u.pn * 256 + wc * 32 + 4 * fq;
        f32x4 gv[2][2];
#pragma unroll
        for (int bj = 0; bj < 2; ++bj)
#pragma unroll
            for (int n = 0; n < 2; ++n) gv[bj][n] = *(const f32x4*)(mod + (size_t)b * 6 * D + 2 * D + col0 + bj * 128 + n * 16);
#pragma unroll
        for (int ai = 0; ai < 2; ++ai)
#pragma unroll
            for (int m = 0; m < 4; ++m) { const size_t ro = (size_t)(u.orow + ai * 128 + wr * 64 + m * 16 + fr) * D + col0;
#pragma unroll
                for (int bj = 0; bj < 2; ++bj)
#pragma unroll
                    for (int n = 0; n < 2; ++n) { const f32x4 xv = *(const f32x4*)(x + ro + bj * 128 + n * 16);
                        *(f32x4*)(X1 + ro + bj * 128 + n * 16) = xv + gv[bj][n] * acc[ai][bj][m][n]; } }
    }
};
struct EpiUp {
    static constexpr bool PERM = true;
    bf16_t* HB; bf16_t* SHH;
    __device__ __forceinline__ void operator()(const f32x4 (&acc)[2][2][4][2], const g8::Unit& u, int wr, int wc, int fr, int fq) const {
        bf16_t* O = u.aux ? SHH : HB;
#pragma unroll
        for (int ai = 0; ai < 2; ++ai)
#pragma unroll
            for (int m = 0; m < 4; ++m) {
                f32x4 h0, h1;
#pragma unroll
                for (int j = 0; j < 4; ++j) { h0[j] = siluf(acc[ai][0][m][0][j]) * acc[ai][1][m][0][j]; h1[j] = siluf(acc[ai][0][m][1][j]) * acc[ai][1][m][1][j]; }
                u32x4 w; w.x = cvt_pk_bf16(h0[0], h0[1]); w.y = cvt_pk_bf16(h0[2], h0[3]); w.z = cvt_pk_bf16(h1[0], h1[1]); w.w = cvt_pk_bf16(h1[2], h1[3]);
                *(u32x4*)(O + (size_t)(u.orow + ai * 128 + wr * 64 + m * 16 + fr) * DE + u.pn * 128 + wc * 32 + 8 * fq) = w;
            }
    }
};
struct EpiDown {
    static constexpr bool PERM = true;
    bf16_t* Y; bf16_t* YS;
    __device__ __forceinline__ void operator()(const f32x4 (&acc)[2][2][4][2], const g8::Unit& u, int wr, int wc, int fr, int fq) const {
        bf16_t* O = u.aux ? YS : Y;
#pragma unroll
        for (int ai = 0; ai < 2; ++ai)
#pragma unroll
            for (int m = 0; m < 4; ++m) { bf16_t* rowp = O + (size_t)(u.orow + ai * 128 + wr * 64 + m * 16 + fr) * D + u.pn * 256 + wc * 32 + 8 * fq;
#pragma unroll
                for (int bj = 0; bj < 2; ++bj) { const f32x4 v0 = acc[ai][bj][m][0], v1 = acc[ai][bj][m][1];
                    u32x4 w; w.x = cvt_pk_bf16(v0[0], v0[1]); w.y = cvt_pk_bf16(v0[2], v0[3]); w.z = cvt_pk_bf16(v1[0], v1[1]); w.w = cvt_pk_bf16(v1[2], v1[3]);
                    *(u32x4*)(rowp + bj * 128) = w; } }
    }
};
struct SchedDense {
    const char* A; const char* Bt; int K, nM, nN, G, c;
    __device__ __forceinline__ bool next(int i, g8::Unit& u) const {
        int wgid; if (!g8::work_id(i, G, c, nM * nN, wgid)) return false;
        const int nig = 8 * nN, gid = wgid / nig, fm = gid * 8, gsz = (nM - fm) < 8 ? (nM - fm) : 8;
        const int pm = fm + ((wgid % nig) % gsz), pn = (wgid % nig) / gsz;
        u.A = A; u.rows = nullptr; u.row0 = pm * 256; u.Bt = Bt + (size_t)pn * 256 * K * 2; u.orow = pm * 256; u.pn = pn; u.aux = 0; return true;
    }
};
struct SchedUp {
    const int* tp; const char* H2; const int* LIST; const char* E13T; const char* S13T; int G, c;
    __device__ __forceinline__ bool next(int i, g8::Unit& u) const {
        const int T = tp[NE]; int wgid; if (!g8::work_id(i, G, c, 4 * T + 128, wgid)) return false;
        u.A = H2;
        if (wgid < 4 * T) {
            int e = 0;
#pragma unroll
            for (int s = 32; s > 0; s >>= 1) if (4 * tp[e + s] <= wgid) e += s;
            const int tc = tp[e + 1] - tp[e], li = wgid - 4 * tp[e], nt = li / tc, mt = li % tc, r0 = (tp[e] + mt) * 256;
            u.rows = LIST + r0; u.row0 = 0; u.Bt = E13T + ((size_t)e * 1024 + nt * 256) * D * 2; u.orow = r0; u.pn = nt; u.aux = 0;
        } else {
            const int s = wgid - 4 * T, pn = s / 32, pm = s % 32;
            u.rows = nullptr; u.row0 = pm * 256; u.Bt = S13T + (size_t)pn * 256 * D * 2; u.orow = pm * 256; u.pn = pn; u.aux = 1;
        }
        return true;
    }
};
struct SchedDown {
    const int* tp; const char* HB; const char* E2T; const char* SHH; const char* S2T; int G, c;
    __device__ __forceinline__ bool next(int i, g8::Unit& u) const {
        const int T = tp[NE]; int wgid; if (!g8::work_id(i, G, c, 8 * T + 256, wgid)) return false;
        u.rows = nullptr;
        if (wgid < 8 * T) {
            int e = 0;
#pragma unroll
            for (int s = 32; s > 0; s >>= 1) if (8 * tp[e + s] <= wgid) e += s;
            const int tc = tp[e + 1] - tp[e], li = wgid - 8 * tp[e], nt = li / tc, mt = li % tc, r0 = (tp[e] + mt) * 256;
            u.A = HB; u.row0 = r0; u.Bt = E2T + ((size_t)e * D + nt * 256) * DE * 2; u.orow = r0; u.pn = nt; u.aux = 0;
        } else {
            const int s = wgid - 8 * T, pn = s / 32, pm = s % 32;
            u.A = SHH; u.row0 = pm * 256; u.Bt = S2T + (size_t)pn * 256 * DE * 2; u.orow = pm * 256; u.pn = pn; u.aux = 1;
        }
        return true;
    }
};
__device__ __forceinline__ void moe_tables(const Params& p, int* tp, const int wid0) {
    __syncthreads();
    if (wid0 == 0 && xb_lane_id() == 0) { int tt = 0; for (int e = 0; e < NE; ++e) { tp[e] = tt; tt += (p.CNT[e] + 255) / 256; } tp[NE] = tt; }
    __syncthreads();
}

constexpr int NTILE = 136;
__device__ void ph_naprep(const Params& p, const int wid0) {
    const int t = opaque_tid(wid0), w = t >> 6, lane = t & 63, kk = lane >> 4, pc = lane & 15;
    for (int u = blockIdx.x; u < 2 * NTILE; u += gridDim.x) {
        const int b = u / NTILE, T = u % NTILE; const bool lat = T < 128;
        const int row0 = lat ? (b * SEQ + 32 * T) : (NLAT + b * CTXL + 32 * (T - 128));
#pragma unroll 2
        for (int it = w; it < 128; it += 8) {
            const int which = it & 1, hh = (it >> 1) & 7, tt = 4 * (it >> 4) + kk;
            if (which == 0 && !lat) continue;
            const float* src = p.P + (size_t)(row0 + tt) * PLD + which * 1024 + hh * 128 + 8 * pc;
            const float4 v0 = *(const float4*)src, v1 = *(const float4*)(src + 4);
            float ss = v0.x * v0.x + v0.y * v0.y + v0.z * v0.z + v0.w * v0.w + v1.x * v1.x + v1.y * v1.y + v1.z * v1.z + v1.w * v1.w;
            ss += __shfl_xor(ss, 1); ss += __shfl_xor(ss, 2); ss += __shfl_xor(ss, 4); ss += __shfl_xor(ss, 8);
            const float* gp = (which ? p.k_norm_g : p.q_norm_g) + 8 * pc;
            const float4 g0 = *(const float4*)gp, g1 = *(const float4*)(gp + 4);
            const float r = rsqrtf(ss * (1.f / 128.f) + 1e-6f) * (which ? 1.f : 0.08838834764831845f * 1.4426950408889634f);
            u32x4 o;
            o.x = cvt_pk_bf16(v0.x * r * g0.x, v0.y * r * g0.y); o.y = cvt_pk_bf16(v0.z * r * g0.z, v0.w * r * g0.w);
            o.z = cvt_pk_bf16(v1.x * r * g1.x, v1.y * r * g1.y); o.w = cvt_pk_bf16(v1.z * r * g1.z, v1.w * r * g1.w);
            if (which) *(u32x4*)(p.NKf + (((size_t)((b * 8 + hh) * NTILE + T) * 8 + (pc >> 1)) * 64 + tt + 32 * (pc & 1)) * 8) = o;
            else *(u32x4*)(p.NQb + (size_t)(row0 + tt) * 1024 + hh * 128 + 8 * pc) = o;
        }
#pragma unroll 1
        for (int i = 0; i < 2; ++i) {
            const int col = t + 512 * i, hh = col >> 7, dv = col & 127;
            unsigned pk[16];
#pragma unroll
            for (int s2 = 0; s2 < 16; ++s2) pk[s2] = cvt_pk_bf16(p.P[(size_t)(row0 + 2 * s2) * PLD + 2048 + col], p.P[(size_t)(row0 + 2 * s2 + 1) * PLD + 2048 + col]);
            bf16_t* o = p.VTf + ((((size_t)((b * 8 + hh) * NTILE + T) * 4 + (dv >> 5)) * 2) * 64 + (dv & 31)) * 8;
#pragma unroll
            for (int g2 = 0; g2 < 2; ++g2) {
                *(u32x4*)(o + (g2 * 64) * 8) = (u32x4){pk[8 * g2], pk[8 * g2 + 1], pk[8 * g2 + 4], pk[8 * g2 + 5]};
                *(u32x4*)(o + (g2 * 64 + 32) * 8) = (u32x4){pk[8 * g2 + 2], pk[8 * g2 + 3], pk[8 * g2 + 6], pk[8 * g2 + 7]};
            }
        }
    }
}

__device__ __forceinline__ void attn_tile(const LAS unsigned char* sb, const float* bt0, const bf16x8 (&qf)[8], f32x16& o0, f32x16& o1, f32x16& o2, f32x16& o3, float& m, float& l,
                                          bool loc, int half, int dr, int c, int cs, int hi) {
    bf16x8 kc[8], va[8];
#pragma unroll
    for (int ks = 0; ks < 8; ++ks) kc[ks] = *(const LAS bf16x8*)(sb + ks * 1024);
#pragma unroll
    for (int q = 0; q < 8; ++q) va[q] = *(const LAS bf16x8*)(sb + 8192 + q * 1024);
    f32x16 s;
#pragma unroll
    for (int e = 0; e < 16; ++e) s[e] = 0.f;
#pragma unroll
    for (int ks = 0; ks < 8; ++ks) s = __builtin_amdgcn_mfma_f32_32x32x16_bf16(kc[ks], qf[ks], s, 0, 0, 0);
    if (loc) {
        int rel0 = 32 * half + 4 * hi - cs; asm volatile("" : "+v"(rel0));
        const float* bt = bt0 + dr * 31 + cs - c + 15;
#pragma unroll
        for (int e = 0; e < 16; ++e) {
            const int rel = rel0 + (e & 3) + 8 * (e >> 2);
            const bool vis = (unsigned)rel < 16u;
            const float bias = bt[rel];
            s[e] = vis ? (s[e] + bias) : -INFINITY;
        }
    }
    float mt = s[0];
#pragma unroll
    for (int e = 1; e < 16; ++e) mt = fmaxf(mt, s[e]);
    mt = fmaxf(mt, __shfl_xor(mt, 32));
    if (__any(mt > m)) {
        const float mn = fmaxf(m, mt);
        const float alpha = __builtin_amdgcn_exp2f(m - mn);
        m = mn; l *= alpha;
#pragma unroll
        for (int e = 0; e < 16; ++e) { o0[e] *= alpha; o1[e] *= alpha; o2[e] *= alpha; o3[e] *= alpha; }
    }
    float ps = 0.f;
#pragma unroll
    for (int e = 0; e < 16; ++e) { s[e] = __builtin_amdgcn_exp2f(s[e] - m); ps += s[e]; }
    l += ps;
    bf16x8 pb[2];
#pragma unroll
    for (int s2 = 0; s2 < 2; ++s2) {
        const u32x4 cat = (u32x4){cvt_pk_bf16(s[8 * s2], s[8 * s2 + 1]), cvt_pk_bf16(s[8 * s2 + 2], s[8 * s2 + 3]), cvt_pk_bf16(s[8 * s2 + 4], s[8 * s2 + 5]), cvt_pk_bf16(s[8 * s2 + 6], s[8 * s2 + 7])};
        pb[s2] = __builtin_bit_cast(bf16x8, cat);
    }
#pragma unroll
    for (int s2 = 0; s2 < 2; ++s2) {
        o0 = __builtin_amdgcn_mfma_f32_32x32x16_bf16(va[0 + s2], pb[s2], o0, 0, 0, 0);
        o1 = __builtin_amdgcn_mfma_f32_32x32x16_bf16(va[2 + s2], pb[s2], o1, 0, 0, 0);
        o2 = __builtin_amdgcn_mfma_f32_32x32x16_bf16(va[4 + s2], pb[s2], o2, 0, 0, 0);
        o3 = __builtin_amdgcn_mfma_f32_32x32x16_bf16(va[6 + s2], pb[s2], o3, 0, 0, 0);
    }
}
__device__ __forceinline__ void glascan_wave(const Params& p, int unit, int dh, int lane, LAS unsigned char* ldsw);
__device__ void ph_attn(const Params& p, unsigned char* smb, const int wid0) {
    const int t = opaque_tid(wid0), lane = t & 63, l31 = lane & 31, hi = lane >> 5;
    const int w = __builtin_amdgcn_readfirstlane(t >> 6);
    LAS unsigned char* lds = (LAS unsigned char*)smb;
    for (int u0 = blockIdx.x; u0 < 256; u0 += gridDim.x) { const int unit = (((u0 & 7) + 8 * (u0 >> 7)) << 4) | ((u0 >> 3) & 15); glascan_wave(p, unit, w, lane, lds + w * 8192); }
    float* tab = (float*)(smb + 4 * 16384);
    for (int u0 = blockIdx.x; u0 < 256; u0 += gridDim.x) {
        const int u = (((u0 & 7) + 8 * (u0 >> 7)) << 4) | ((u0 >> 3) & 15);
        const int rg = u & 15, h = (u >> 4) & 7, b = u >> 7, bh8 = b * 8 + h;
        asm volatile("s_waitcnt vmcnt(0)" ::: "memory");
        __syncthreads();
        for (int i = t; i < 465; i += NT) tab[i] = p.na_rpb[h * 465 + i] * 1.4426950408889634f;
        const int r = 4 * rg + (w >> 1), qt = w & 1, c = 32 * qt + l31;
        const int rs = min(max(r - 4, 0), 56), cs = min(max(c - 8, 0), 48);
        const int Rlo = min(max(4 * rg - 4, 0), 56), Rhi = min(max(4 * rg - 1, 0), 56) + 7, nt = 8 + 2 * (Rhi - Rlo + 1);
        const int qrow = b * SEQ + r * 64 + c;
        bf16x8 qf[8];
#pragma unroll
        for (int ks = 0; ks < 8; ++ks) qf[ks] = *(const bf16x8*)(p.NQb + (size_t)qrow * 1024 + h * 128 + 16 * ks + 8 * hi);
#pragma unroll
        for (int ks = 0; ks < 8; ++ks) asm volatile("" : "+v"(qf[ks]));
        f32x16 o0, o1, o2, o3;
#pragma unroll
        for (int e = 0; e < 16; ++e) { o0[e] = 0.f; o1[e] = 0.f; o2[e] = 0.f; o3[e] = 0.f; }
        float m = -INFINITY, l = 0.f;
        const bf16_t* kg = p.NKf + ((size_t)bh8 * NTILE * 8 + w) * 512 + lane * 8;
        const bf16_t* vg = p.VTf + ((size_t)bh8 * NTILE * 8 + w) * 512 + lane * 8;
#define AT_T(i_) ((i_) < 8 ? (128 + (i_)) : (2 * Rlo + ((i_) - 8)))
#define AT_DMA(i_, st_) do { const int ii_ = (i_) < nt ? (i_) : nt - 1; const size_t to_ = (size_t)AT_T(ii_) * 4096; \
        __builtin_amdgcn_global_load_lds((const unsigned*)(kg + to_), (LAS unsigned*)(lds + (st_) * 16384 + w * 1024), 16, 0, 0); \
        __builtin_amdgcn_global_load_lds((const unsigned*)(vg + to_), (LAS unsigned*)(lds + (st_) * 16384 + 8192 + w * 1024), 16, 0, 0); } while (0)
        asm volatile("s_waitcnt vmcnt(0)" ::: "memory");
        __syncthreads();
        AT_DMA(0, 0); AT_DMA(1, 1); AT_DMA(2, 2);
        int st = 0;
#pragma unroll 1
        for (int i = 0; i < nt; ++i) {
            asm volatile("s_waitcnt vmcnt(4)" ::: "memory");
            __builtin_amdgcn_s_barrier();
            asm volatile("" ::: "memory");
            const int st2 = (st + 3) & 3;
            AT_DMA(i + 3, st2);
            const bool loc = i >= 8; const int R = Rlo + ((i - 8) >> 1), half = (i - 8) & 1;
            if (!loc || (unsigned)(R - rs) < 8u)
                attn_tile(lds + st * 16384 + lane * 16, tab, qf, o0, o1, o2, o3, m, l, loc, half, R - r + 7, c, cs, hi);
            st = (st + 1) & 3;
        }
#undef AT_T
#undef AT_DMA
        l += __shfl_xor(l, 32);
        const float inv = 1.f / l;
        bf16_t* orow = p.MIX + (size_t)qrow * D + h * 128 + 4 * hi;
#pragma unroll
        for (int g = 0; g < 4; ++g) {
            u32x2 pk;
            pk.x = cvt_pk_bf16(o0[4 * g] * inv, o0[4 * g + 1] * inv); pk.y = cvt_pk_bf16(o0[4 * g + 2] * inv, o0[4 * g + 3] * inv); *(u32x2*)(orow + 0 + 8 * g) = pk;
            pk.x = cvt_pk_bf16(o1[4 * g] * inv, o1[4 * g + 1] * inv); pk.y = cvt_pk_bf16(o1[4 * g + 2] * inv, o1[4 * g + 3] * inv); *(u32x2*)(orow + 32 + 8 * g) = pk;
            pk.x = cvt_pk_bf16(o2[4 * g] * inv, o2[4 * g + 1] * inv); pk.y = cvt_pk_bf16(o2[4 * g + 2] * inv, o2[4 * g + 3] * inv); *(u32x2*)(orow + 64 + 8 * g) = pk;
            pk.x = cvt_pk_bf16(o3[4 * g] * inv, o3[4 * g + 1] * inv); pk.y = cvt_pk_bf16(o3[4 * g + 2] * inv, o3[4 * g + 3] * inv); *(u32x2*)(orow + 96 + 8 * g) = pk;
        }
    }
    asm volatile("s_waitcnt vmcnt(0)" ::: "memory");
}

__device__ __forceinline__ float logsigf(float z) { return fminf(z, 0.f) - log1pf(expf(-fabsf(z))); }

__device__ __forceinline__ float fexp2(float x) { return __builtin_amdgcn_exp2f(x); }
__device__ __forceinline__ float logsig2_16(float z) { return (fminf(z, 0.f) * 1.4426950408889634f - __builtin_amdgcn_logf(1.f + fexp2(-fabsf(z) * 1.4426950408889634f))) * (1.f / 16.f); }

__device__ void ph_glaprep(const Params& p, float* sm, const int wid0) {
    const int t = opaque_tid(wid0), d2 = t & 63, tq = t >> 6, d = 2 * d2;
    float* qs = sm;
    float* ksm = sm + 8192;
    float* dds = sm + 16384;
    float* tot = sm + 16384 + 2048;
    for (int u = blockIdx.x; u < 8 * 68; u += gridDim.x) {
        const int bh = u / 68, c = u % 68, b = bh >> 2, h = bh & 3;
        const bool lat = c >= 4; const int j = c - 4;
        const int row0 = lat ? (b * SEQ + 64 * j) : (NLAT + b * CTXL + 64 * c);
        __syncthreads();
        {
            const int cq = t & 31, tr = t >> 5;
#pragma unroll
            for (int i = 0; i < 4; ++i) { const int tt = tr + 16 * i;
                *(float4*)(qs + tt * 128 + 4 * cq) = *(const float4*)(p.P + (size_t)(row0 + tt) * PLD + 3072 + h * 128 + 4 * cq);
                *(float4*)(ksm + tt * 128 + 4 * cq) = *(const float4*)(p.P + (size_t)(row0 + tt) * PLD + 3584 + h * 128 + 4 * cq); }
            *(float4*)(dds + 4 * t) = *(const float4*)(p.DD + (size_t)row0 * 32 + 4 * t);
        }
        __syncthreads();
        float gf0[8], gf1[8], gb0[8], gb1[8];
        {
            float uf0[16], uf1[16], ub0[16], ub1[16];
#pragma unroll
            for (int r = 0; r < 16; ++r) { const float2 a = *(const float2*)(p.up_f + r * 512 + h * 128 + d), bq = *(const float2*)(p.up_b + r * 512 + h * 128 + d); uf0[r] = a.x; uf1[r] = a.y; ub0[r] = bq.x; ub1[r] = bq.y; }
            const float2 bf = *(const float2*)(p.bias_f + h * 128 + d), bb = *(const float2*)(p.bias_b + h * 128 + d);
            float sf0 = 0.f, sf1 = 0.f, sb0 = 0.f, sb1 = 0.f;
#pragma unroll
            for (int i = 0; i < 8; ++i) {
                const float* dr = dds + (8 * tq + i) * 32; float zf0 = bf.x, zf1 = bf.y, zb0 = bb.x, zb1 = bb.y;
#pragma unroll
                for (int r = 0; r < 16; ++r) { const float x = dr[r], y = dr[16 + r]; zf0 += x * uf0[r]; zf1 += x * uf1[r]; zb0 += y * ub0[r]; zb1 += y * ub1[r]; }
                gf0[i] = logsig2_16(zf0); gf1[i] = logsig2_16(zf1); gb0[i] = logsig2_16(zb0); gb1[i] = logsig2_16(zb1);
                sf0 += gf0[i]; sf1 += gf1[i]; sb0 += gb0[i]; sb1 += gb1[i];
            }
            *(float2*)(tot + tq * 128 + d) = make_float2(sf0, sf1); *(float2*)(tot + (8 + tq) * 128 + d) = make_float2(sb0, sb1);
        }
        __syncthreads();
        float2 basef = make_float2(0.f, 0.f), baseb = basef, allf = basef, allb = basef;
#pragma unroll
        for (int q8 = 0; q8 < 8; ++q8) { const float2 a = *(const float2*)(tot + q8 * 128 + d), bq = *(const float2*)(tot + (8 + q8) * 128 + d);
            allf.x += a.x; allf.y += a.y; allb.x += bq.x; allb.y += bq.y;
            if (q8 < tq) { basef.x += a.x; basef.y += a.y; } if (q8 > tq) { baseb.x += bq.x; baseb.y += bq.y; } }
        { float r0 = basef.x, r1 = basef.y;
#pragma unroll
          for (int i = 0; i < 8; ++i) { r0 += gf0[i]; gf0[i] = r0; r1 += gf1[i]; gf1[i] = r1; }
          r0 = baseb.x; r1 = baseb.y;
#pragma unroll
          for (int i = 7; i >= 0; --i) { r0 += gb0[i]; gb0[i] = r0; r1 += gb1[i]; gb1[i] = r1; } }
        const int dd2 = d & 63, ii = dd2 & 31, partner = (dd2 < 32) ? (d + 32) : (d - 32);
        const float sgn = (dd2 < 32) ? -1.f : 1.f;
        unsigned khf0[4], khf1[4], khb0[4], khb1[4]; float pf0 = 0.f, pf1 = 0.f, pb0 = 0.f, pb1 = 0.f;
        const size_t tb = ((size_t)(bh * 64 + j) * 64) * 128;
#pragma unroll
        for (int i = 0; i < 8; ++i) {
            const int tt = 8 * tq + i;
            float2 qv = *(const float2*)(qs + tt * 128 + d), kv = *(const float2*)(ksm + tt * 128 + d);
            if (lat) {
                const int pos = (d < 64) ? j : tt;
                const float4 cssn = *(const float4*)(p.RT + (pos * 32 + ii) * 2);
                const float2 qp = *(const float2*)(qs + tt * 128 + partner), kp = *(const float2*)(ksm + tt * 128 + partner);
                qv.x = qv.x * cssn.x + sgn * qp.x * cssn.y; qv.y = qv.y * cssn.z + sgn * qp.y * cssn.w;
                kv.x = kv.x * cssn.x + sgn * kp.x * cssn.y; kv.y = kv.y * cssn.z + sgn * kp.y * cssn.w;
            }
            qv.x *= 0.08838834764831845f; qv.y *= 0.08838834764831845f;
            if (lat) {
                const float ef0 = fexp2(gf0[i]), ef1 = fexp2(gf1[i]), eb0 = fexp2(gb0[i]), eb1 = fexp2(gb1[i]);
                const float nf0 = fexp2(-gf0[i]), nf1 = fexp2(-gf1[i]), nb0 = fexp2(-gb0[i]), nb1 = fexp2(-gb1[i]);
                const size_t o = tb + (size_t)tt * 128 + d;
                *(unsigned*)(p.QF + o) = cvt_pk_bf16(qv.x * ef0, qv.y * ef1); *(unsigned*)(p.KF + o) = cvt_pk_bf16(kv.x * nf0, kv.y * nf1);
                *(unsigned*)(p.QB + o) = cvt_pk_bf16(qv.x * eb0, qv.y * eb1); *(unsigned*)(p.KB + o) = cvt_pk_bf16(kv.x * nb0, kv.y * nb1);
            }
            const float hf0 = kv.x * fexp2(allf.x - gf0[i]), hf1 = kv.y * fexp2(allf.y - gf1[i]), hb0 = kv.x * fexp2(allb.x - gb0[i]), hb1 = kv.y * fexp2(allb.y - gb1[i]);
            if (i & 1) { khf0[i >> 1] = cvt_pk_bf16(pf0, hf0); khf1[i >> 1] = cvt_pk_bf16(pf1, hf1); khb0[i >> 1] = cvt_pk_bf16(pb0, hb0); khb1[i >> 1] = cvt_pk_bf16(pb1, hb1); }
            else { pf0 = hf0; pf1 = hf1; pb0 = hb0; pb1 = hb1; }
        }
        {
            const size_t o = ((((size_t)(bh * 68 + c) * 8 + (d >> 4)) * 2 + (tq >> 2)) * 64 + (d & 15) + 16 * (tq & 3)) * 8;
            *(u32x4*)(p.KHF + o) = (u32x4){khf0[0], khf0[1], khf0[2], khf0[3]}; *(u32x4*)(p.KHF + o + 8) = (u32x4){khf1[0], khf1[1], khf1[2], khf1[3]};
            *(u32x4*)(p.KHB + o) = (u32x4){khb0[0], khb0[1], khb0[2], khb0[3]}; *(u32x4*)(p.KHB + o + 8) = (u32x4){khb1[0], khb1[1], khb1[2], khb1[3]};
            if (tq == 0) { *(float2*)(p.DF + (size_t)(bh * 68 + c) * 128 + d) = make_float2(fexp2(allf.x), fexp2(allf.y)); *(float2*)(p.DB + (size_t)(bh * 68 + c) * 128 + d) = make_float2(fexp2(allb.x), fexp2(allb.y)); }
        }
        {
            const int v = t & 255, half = t >> 8;
            unsigned pk[16];
#pragma unroll
            for (int s2 = 0; s2 < 16; ++s2) {
                const float a = p.P[(size_t)(row0 + 32 * half + 2 * s2) * PLD + 4096 + h * 256 + v], bq = p.P[(size_t)(row0 + 32 * half + 2 * s2 + 1) * PLD + 4096 + h * 256 + v];
                pk[s2] = cvt_pk_bf16(a, bq);
            }
            bf16_t* o = p.VT + ((size_t)(bh * 68 + c) * 256 + v) * 64 + 32 * half;
            bf16_t* o2 = p.VTS + ((((size_t)(bh * 68 + c) * 16 + (v >> 4)) * 2 + half) * 64 + (v & 15)) * 8;
#pragma unroll
            for (int q4 = 0; q4 < 4; ++q4) { const u32x4 pv = (u32x4){pk[4 * q4], pk[4 * q4 + 1], pk[4 * q4 + 2], pk[4 * q4 + 3]}; *(u32x4*)(o + 8 * q4) = pv; *(u32x4*)(o2 + (16 * q4) * 8) = pv; }
        }
    }
}

__device__ __forceinline__ void glascan_wave(const Params& p, int unit, int dh, int lane, LAS unsigned char* ldsw) {
    const int v16 = unit & 15, scan = unit >> 4, dir = scan >> 3, bh = scan & 7;
    const int fr = lane & 15, fq = lane >> 4, d0 = 16 * dh, v0 = 16 * v16;
    const bf16_t* KH = (dir ? p.KHB : p.KHF) + (((size_t)bh * 68 * 8 + dh) * 2) * 512 + lane * 8;
    const bf16_t* VTp = p.VTS + (((size_t)bh * 68 * 16 + v16) * 2) * 512 + lane * 8;
    const float* DV = (dir ? p.DB : p.DF) + (size_t)bh * 68 * 128 + d0 + 4 * fq;
    bf16_t* SSp = p.SS + ((((size_t)dir * 8 + bh) * 65) * 256 + v0 + fr) * 128 + d0 + 4 * fq;
    LAS u32x2* sl = (LAS u32x2*)ldsw + lane;
    f32x4 acc = (f32x4){0.f, 0.f, 0.f, 0.f};
#define SC_CHUNK(n) (dir ? ((n) < 4 ? 3 - (n) : 71 - (n)) : (n))
#define SC_LOAD(S_, n) do { const int nn_ = (n) < 68 ? (n) : 67; const int c_ = SC_CHUNK(nn_); \
        S_##a0 = *(const bf16x8*)(KH + (size_t)c_ * 8192); S_##a1 = *(const bf16x8*)(KH + (size_t)c_ * 8192 + 512); \
        S_##b0 = *(const bf16x8*)(VTp + (size_t)c_ * 16384); S_##b1 = *(const bf16x8*)(VTp + (size_t)c_ * 16384 + 512); \
        S_##d = *(const f32x4*)(DV + (size_t)c_ * 128); } while (0)
#define SC_STEP(S_, k) do { u32x2 pk; pk.x = cvt_pk_bf16(acc[0], acc[1]); pk.y = cvt_pk_bf16(acc[2], acc[3]); sl[(k) * 64] = pk; \
        acc = acc * S_##d; \
        acc = __builtin_amdgcn_mfma_f32_16x16x32_bf16(S_##a0, S_##b0, acc, 0, 0, 0); acc = __builtin_amdgcn_mfma_f32_16x16x32_bf16(S_##a1, S_##b1, acc, 0, 0, 0); } while (0)
    bf16x8 Aa0, Aa1, Ab0, Ab1, Ba0, Ba1, Bb0, Bb1, Ca0, Ca1, Cb0, Cb1, Da0, Da1, Db0, Db1; f32x4 Ad, Bd, Cd, Dd;
    SC_LOAD(A, 0); SC_LOAD(B, 1); SC_LOAD(C, 2);
#pragma unroll 1
    for (int nb = 0; nb < 68; nb += 16) {
        const int iters = (nb + 16 <= 68) ? 4 : 1;
#pragma unroll 1
        for (int it = 0; it < iters; ++it) {
            const int n = nb + 4 * it;
            SC_LOAD(D, n + 3); SC_STEP(A, 4 * it);
            SC_LOAD(A, n + 4); SC_STEP(B, 4 * it + 1);
            SC_LOAD(B, n + 5); SC_STEP(C, 4 * it + 2);
            SC_LOAD(C, n + 6); SC_STEP(D, 4 * it + 3);
        }
#pragma unroll 1
        for (int k = 0; k < 4 * iters; ++k) { const int c_ = SC_CHUNK(nb + k); *(u32x2*)(SSp + (size_t)(c_ >= 4 ? c_ - 4 : 64) * 256 * 128) = sl[k * 64]; }
    }
#undef SC_CHUNK
#undef SC_LOAD
#undef SC_STEP
}

__device__ void ph_glaout(const Params& p, unsigned char* smb, const int wid0) {
    const int t = opaque_tid(wid0), w = t >> 6, lane = t & 63, l31 = lane & 31, hi = lane >> 5;
    const int wv = w & 3, wt = w >> 2;
    bf16_t* att = (bf16_t*)smb;
    float* ssq = (float*)(smb + 2 * 64 * 144);
    for (int u = blockIdx.x; u < 512; u += gridDim.x) {
        const int bh = u >> 6, j = u & 63, b = bh >> 2, h = bh & 3;
        const size_t tb = ((size_t)(bh * 64 + j) * 64) * 128;
        {
            const int dir = w >> 2, ts = (w >> 1) & 1, tt = w & 1;
            const bf16_t* Qm = (dir ? p.QB : p.QF) + tb; const bf16_t* Km = (dir ? p.KB : p.KF) + tb;
            const bool zero = dir ? (ts < tt) : (ts > tt);
            f32x16 s;
#pragma unroll
            for (int r = 0; r < 16; ++r) s[r] = 0.f;
            if (!zero) {
#pragma unroll
                for (int ks = 0; ks < 8; ++ks) {
                    const bf16x8 ka = *(const bf16x8*)(Km + (size_t)(32 * ts + l31) * 128 + 16 * ks + 8 * hi);
                    const bf16x8 qb = *(const bf16x8*)(Qm + (size_t)(32 * tt + l31) * 128 + 16 * ks + 8 * hi);
                    s = __builtin_amdgcn_mfma_f32_32x32x16_bf16(ka, qb, s, 0, 0, 0);
                }
            }
            const int tcol = 32 * tt + l31;
#pragma unroll
            for (int g = 0; g < 4; ++g) {
                float vv[4];
#pragma unroll
                for (int e = 0; e < 4; ++e) { const int srow = 32 * ts + 8 * g + 4 * hi + e; const bool keep = dir ? (srow >= tcol) : (srow <= tcol); vv[e] = keep ? s[4 * g + e] : 0.f; }
                u32x2 pk; pk.x = cvt_pk_bf16(vv[0], vv[1]); pk.y = cvt_pk_bf16(vv[2], vv[3]);
                *(u32x2*)(att + ((size_t)dir * 64 + tcol) * 72 + 32 * ts + 8 * g + 4 * hi) = pk;
            }
        }
        __syncthreads();
        f32x16 o0, o1;
#pragma unroll
        for (int r = 0; r < 16; ++r) { o0[r] = 0.f; o1[r] = 0.f; }
        const int tB = 32 * wt + l31;
        const bf16_t* vt0 = p.VT + ((size_t)(bh * 68 + 4 + j) * 256 + 64 * wv + l31) * 64 + 8 * hi;
#pragma unroll
        for (int dir = 0; dir < 2; ++dir) {
#pragma unroll
            for (int ks = 0; ks < 4; ++ks) {
                const bf16x8 bb = *(const bf16x8*)(att + ((size_t)dir * 64 + tB) * 72 + 16 * ks + 8 * hi);
                const bf16x8 a0 = *(const bf16x8*)(vt0 + 16 * ks), a1 = *(const bf16x8*)(vt0 + 32 * 64 + 16 * ks);
                o0 = __builtin_amdgcn_mfma_f32_32x32x16_bf16(a0, bb, o0, 0, 0, 0);
                o1 = __builtin_amdgcn_mfma_f32_32x32x16_bf16(a1, bb, o1, 0, 0, 0);
            }
            const bf16_t* ss0 = p.SS + ((((size_t)dir * 8 + bh) * 65 + j) * 256 + 64 * wv + l31) * 128 + 8 * hi;
            const bf16_t* qm = (dir ? p.QB : p.QF) + tb + (size_t)tB * 128 + 8 * hi;
#pragma unroll
            for (int ks = 0; ks < 8; ++ks) {
                const bf16x8 bb = *(const bf16x8*)(qm + 16 * ks);
                const bf16x8 a0 = *(const bf16x8*)(ss0 + 16 * ks), a1 = *(const bf16x8*)(ss0 + 32 * 128 + 16 * ks);
                o0 = __builtin_amdgcn_mfma_f32_32x32x16_bf16(a0, bb, o0, 0, 0, 0);
                o1 = __builtin_amdgcn_mfma_f32_32x32x16_bf16(a1, bb, o1, 0, 0, 0);
            }
        }
        float ss = 0.f;
#pragma unroll
        for (int r = 0; r < 16; ++r) ss += o0[r] * o0[r] + o1[r] * o1[r];
        ss += __shfl_xor(ss, 32);
        if (hi == 0) ssq[(wt * 4 + wv) * 32 + l31] = ss;
        __syncthreads();
        const float tot = ssq[(wt * 4 + 0) * 32 + l31] + ssq[(wt * 4 + 1) * 32 + l31] + ssq[(wt * 4 + 2) * 32 + l31] + ssq[(wt * 4 + 3) * 32 + l31];
        const float rstd = rsqrtf(tot * (1.f / 256.f) + 1e-6f);
        const int row = b * SEQ + 64 * j + tB;
        f32x4 gateA[2][4], gnA[2][4];
#pragma unroll
        for (int vt = 0; vt < 2; ++vt)
#pragma unroll
            for (int g = 0; g < 4; ++g) { const int v = 64 * wv + 32 * vt + 8 * g + 4 * hi;
                gateA[vt][g] = *(const f32x4*)(p.P + (size_t)row * PLD + 5120 + h * 256 + v); gnA[vt][g] = *(const f32x4*)(p.gla_norm_g + v); }
#pragma unroll
        for (int vt = 0; vt < 2; ++vt)
#pragma unroll
            for (int g = 0; g < 4; ++g) {
                const int v = 64 * wv + 32 * vt + 8 * g + 4 * hi;
                const f32x4 gate = gateA[vt][g], gn = gnA[vt][g];
                float ov[4];
#pragma unroll
                for (int e = 0; e < 4; ++e) { const float x = vt ? o1[4 * g + e] : o0[4 * g + e];
                    ov[e] = x * rstd * gn[e] * gate[e] * __builtin_amdgcn_rcpf(1.f + __builtin_amdgcn_exp2f(-1.4426950408889634f * gate[e])); }
                u32x2 pk; pk.x = cvt_pk_bf16(ov[0], ov[1]); pk.y = cvt_pk_bf16(ov[2], ov[3]);
                *(u32x2*)(p.MIX + (size_t)row * D + 1024 + h * 256 + v) = pk;
            }
        __syncthreads();
    }
}

__device__ void ph_norm2_router(const Params& p, float* sm, const int wid0) {
    const int t = opaque_tid(wid0), w = t >> 6, lane = t & 63;
    float* hs = sm;
    float* part = sm + 8 * D;
    int* hist = (int*)(sm + 8 * D + 8 * 8 * 64);
    const int G = gridDim.x, gpb = (NLAT / 8 + G - 1) / G;
    if (t < 64) hist[t] = 0;
    const int rb0 = blockIdx.x * gpb, rb1 = min(NLAT / 8, rb0 + gpb);
    float4 v[8];
    if (rb0 < rb1) {
#pragma unroll
        for (int j = 0; j < 8; ++j) v[j] = *(const float4*)(p.X1 + (size_t)(rb0 * 8 + w) * D + 256 * j + 4 * lane);
    }
    for (int rb = rb0; rb < rb1; ++rb) {
        const int row = rb * 8 + w, b = row / SEQ;
        const float* m = p.mod + (size_t)b * 6 * D;
        float ss = 0.f;
#pragma unroll
        for (int j = 0; j < 8; ++j) ss += v[j].x * v[j].x + v[j].y * v[j].y + v[j].z * v[j].z + v[j].w * v[j].w;
        ss = wave_sum(ss);
        const float rs = rsqrtf(ss * (1.f / D) + 1e-6f);
        __syncthreads();
#pragma unroll
        for (int j = 0; j < 8; ++j) {
            const int col = 256 * j + 4 * lane;
            const float4 g = *(const float4*)(p.norm2_g + col), sh = *(const float4*)(m + 3 * D + col), sc = *(const float4*)(m + 4 * D + col);
            float4 o;
            o.x = v[j].x * rs * g.x * (1.f + sc.x) + sh.x; o.y = v[j].y * rs * g.y * (1.f + sc.y) + sh.y;
            o.z = v[j].z * rs * g.z * (1.f + sc.z) + sh.z; o.w = v[j].w * rs * g.w * (1.f + sc.w) + sh.w;
            *(float4*)(hs + w * D + col) = o;
            u32x2 pk; pk.x = cvt_pk_bf16(o.x, o.y); pk.y = cvt_pk_bf16(o.z, o.w);
            *(u32x2*)(p.H + (size_t)row * D + col) = pk;
        }
        if (rb + 1 < rb1) {
#pragma unroll
            for (int j = 0; j < 8; ++j) v[j] = *(const float4*)(p.X1 + (size_t)(row + 8) * D + 256 * j + 4 * lane);
        }
        __syncthreads();
        {
            const int e4 = t & 15, kp = t >> 4;
            float a[8][4];
#pragma unroll
            for (int r = 0; r < 8; ++r)
#pragma unroll
                for (int j = 0; j < 4; ++j) a[r][j] = 0.f;
#pragma unroll 4
            for (int kk = 0; kk < 64; ++kk) {
                const int k = kk * 32 + kp;
                const float4 wv = *(const float4*)(p.router_w + (size_t)k * NE + 4 * e4);
#pragma unroll
                for (int r = 0; r < 8; ++r) { const float hv = hs[r * D + k]; a[r][0] += hv * wv.x; a[r][1] += hv * wv.y; a[r][2] += hv * wv.z; a[r][3] += hv * wv.w; }
            }
#pragma unroll
            for (int r = 0; r < 8; ++r)
#pragma unroll
                for (int j = 0; j < 4; ++j) { float x = a[r][j]; x += __shfl_xor(x, 16); x += __shfl_xor(x, 32); a[r][j] = x; }
            if (lane < 16) {
#pragma unroll
                for (int r = 0; r < 8; ++r) *(float4*)(part + (w * 8 + r) * 64 + 4 * lane) = make_float4(a[r][0], a[r][1], a[r][2], a[r][3]);
            }
        }
        __syncthreads();
        {
            float lgt = 0.f;
#pragma unroll
            for (int i = 0; i < 8; ++i) lgt += part[(i * 8 + w) * 64 + lane];
            const float sc = 1.f / (1.f + expf(-lgt));
            const float bs = sc + p.router_bias[lane];
            float m1 = bs; m1 = fmaxf(m1, __shfl_xor(m1, 1)); m1 = fmaxf(m1, __shfl_xor(m1, 2)); m1 = fmaxf(m1, __shfl_xor(m1, 4));
            int ai = (bs == m1) ? lane : 64; ai = min(ai, __shfl_xor(ai, 1)); ai = min(ai, __shfl_xor(ai, 2)); ai = min(ai, __shfl_xor(ai, 4));
            float m2 = (lane == ai) ? -INFINITY : bs; m2 = fmaxf(m2, __shfl_xor(m2, 1)); m2 = fmaxf(m2, __shfl_xor(m2, 2)); m2 = fmaxf(m2, __shfl_xor(m2, 4));
            const float gs = m1 + m2;
            float g0 = __shfl(gs, 0), g1 = __shfl(gs, 8), g2 = __shfl(gs, 16), g3 = __shfl(gs, 24), g4 = __shfl(gs, 32), g5 = __shfl(gs, 40), g6 = __shfl(gs, 48), g7 = __shfl(gs, 56);
            unsigned selmask = 0u;
#pragma unroll
            for (int it = 0; it < 4; ++it) {
                float best = -INFINITY; int bi = 0;
                if (!(selmask & 1u) && g0 > best) { best = g0; bi = 0; }
                if (!(selmask & 2u) && g1 > best) { best = g1; bi = 1; }
                if (!(selmask & 4u) && g2 > best) { best = g2; bi = 2; }
                if (!(selmask & 8u) && g3 > best) { best = g3; bi = 3; }
                if (!(selmask & 16u) && g4 > best) { best = g4; bi = 4; }
                if (!(selmask & 32u) && g5 > best) { best = g5; bi = 5; }
                if (!(selmask & 64u) && g6 > best) { best = g6; bi = 6; }
                if (!(selmask & 128u) && g7 > best) { best = g7; bi = 7; }
                selmask |= 1u << bi;
            }
            float cand = ((selmask >> (lane >> 3)) & 1u) ? bs : -INFINITY;
            int myslot = -1; float ssum = 0.f;
#pragma unroll
            for (int k = 0; k < TOPK; ++k) {
                const float mv = wave_max(cand);
                const int idx = wave_min_i((cand == mv) ? lane : 64);
                const float sv = __shfl(sc, idx);
                ssum += sv;
                if (lane == idx) { myslot = k; cand = -INFINITY; }
            }
            if (myslot >= 0) {
                p.EIDX[row * TOPK + myslot] = lane;
                p.EW[row * TOPK + myslot] = sc / ssum * 2.5f;
                p.LRANK[row * TOPK + myslot] = atomicAdd(&hist[lane], 1);
            }
        }
    }
    __syncthreads();
    if (t < 64) p.CNTB[blockIdx.x * 64 + t] = hist[t];
}

__device__ void ph_lists(const Params& p, int* smi, const int wid0) {
    const int t = opaque_tid(wid0);
    const int G = gridDim.x, gpb = (NLAT / 8 + G - 1) / G;
    int* tp = smi + 128; int* tot = smi + 64;
    __syncthreads();
    if (t < 64) {
        int before = 0, all = 0;
        for (int bb = 0; bb < G; ++bb) { const int cnt = p.CNTB[bb * 64 + t]; all += cnt; if (bb < (int)blockIdx.x) before += cnt; }
        smi[t] = before; tot[t] = all;
        if (blockIdx.x == 0) p.CNT[t] = all;
    }
    __syncthreads();
    if (t == 0) { int tt = 0; for (int e = 0; e < NE; ++e) { tp[e] = tt; tt += (tot[e] + 255) / 256; } tp[NE] = tt; }
    __syncthreads();
    const int r0 = blockIdx.x * gpb * 8, r1 = min(NLAT, r0 + gpb * 8);
    for (int i = r0 * TOPK + t; i < r1 * TOPK; i += NT) {
        const int e = p.EIDX[i];
        const int pos = tp[e] * 256 + smi[e] + p.LRANK[i];
        p.PAIRPOS[i] = pos; p.LIST[pos] = i / TOPK;
    }
    for (int e = blockIdx.x; e < NE; e += G) {
        const int cn = tot[e], end = (tp[e + 1] - tp[e]) * 256;
        for (int i = cn + t; i < end; i += NT) p.LIST[tp[e] * 256 + i] = 0;
    }
}

__device__ void ph_combine(const Params& p, const int wid0) {
    const int t = opaque_tid(wid0), w = t >> 6, lane = t & 63;
    for (int row = blockIdx.x * 8 + w; row < NLAT; row += gridDim.x * 8) {
        const int b = row / SEQ;
        float wk[TOPK]; const bf16_t* yr[TOPK];
#pragma unroll
        for (int k = 0; k < TOPK; ++k) { wk[k] = p.EW[row * TOPK + k]; yr[k] = p.Y + (size_t)p.PAIRPOS[row * TOPK + k] * D + 8 * lane; }
        const bf16_t* ys = p.YS + (size_t)row * D + 8 * lane;
        const float* x1 = p.X1 + (size_t)row * D + 8 * lane;
        const float* g2 = p.mod + (size_t)b * 6 * D + 5 * D + 8 * lane;
        float* o = p.out + (size_t)row * D + 8 * lane;
#pragma unroll
        for (int j = 0; j < 4; ++j) {
            float s[8];
            { const u32x4 v = *(const u32x4*)(ys + 512 * j);
              s[0] = bf2f(v.x & 0xffffu); s[1] = bf2f(v.x >> 16); s[2] = bf2f(v.y & 0xffffu); s[3] = bf2f(v.y >> 16); s[4] = bf2f(v.z & 0xffffu); s[5] = bf2f(v.z >> 16); s[6] = bf2f(v.w & 0xffffu); s[7] = bf2f(v.w >> 16); }
#pragma unroll
            for (int k = 0; k < TOPK; ++k) {
                const u32x4 v = *(const u32x4*)(yr[k] + 512 * j); const float wv = wk[k];
                s[0] += wv * bf2f(v.x & 0xffffu); s[1] += wv * bf2f(v.x >> 16); s[2] += wv * bf2f(v.y & 0xffffu); s[3] += wv * bf2f(v.y >> 16);
                s[4] += wv * bf2f(v.z & 0xffffu); s[5] += wv * bf2f(v.z >> 16); s[6] += wv * bf2f(v.w & 0xffffu); s[7] += wv * bf2f(v.w >> 16);
            }
            const f32x4 xa = *(const f32x4*)(x1 + 512 * j), xb = *(const f32x4*)(x1 + 512 * j + 4), ga = *(const f32x4*)(g2 + 512 * j), gb = *(const f32x4*)(g2 + 512 * j + 4);
            *(f32x4*)(o + 512 * j) = (f32x4){xa[0] + ga[0] * s[0], xa[1] + ga[1] * s[1], xa[2] + ga[2] * s[2], xa[3] + ga[3] * s[3]};
            *(f32x4*)(o + 512 * j + 4) = (f32x4){xb[0] + gb[0] * s[4], xb[1] + gb[1] * s[5], xb[2] + gb[2] * s[6], xb[3] + gb[3] * s[7]};
        }
    }
}

__global__ void __launch_bounds__(NT, 2) mega(Params p) {
    extern __shared__ __attribute__((aligned(16))) unsigned char dynlds[];
    int wid0;
    wid0 = __builtin_amdgcn_readfirstlane((int)threadIdx.x >> 6); asm volatile("" : "+s"(wid0));
    if (wid0 == 0 && xb_lane_id() < 4) ((unsigned*)(dynlds + LDS_BARW))[xb_lane_id()] = 0u;
    __syncthreads();
    XcdBarrier bar = xcd_barrier_post(p.bar, (volatile LAS unsigned*)(dynlds + LDS_BARW), wid0);
    float* sm = (float*)dynlds;
    int* tp = (int*)(dynlds + LDS_TAB);
    LAS unsigned char* lds = (LAS unsigned char*)dynlds;
    const int G = gridDim.x, c = blockIdx.x;

#ifndef REP
#define REP 0
#endif
#define PH(bit, ...) do { __VA_ARGS__; if (REP & (1 << (bit))) { xcd_barrier(bar); __VA_ARGS__; } } while (0)
    PH(0, ph_prologue(p, sm, wid0));                            xcd_barrier(bar);
    PH(1, ph_norm1(p, wid0));                               xcd_barrier(bar);
    PH(2, { SchedDense S{(const char*)p.H, (const char*)p.WinT, D, NROW / 256, PLD / 256 + 1, G, c}; EpiInproj E{p.P, p.DD};
      g8::gemm_phase(lds, D, S, E, wid0); });                   xcd_barrier(bar);
    PH(3, ph_naprep(p, wid0)); PH(4, ph_glaprep(p, sm, wid0));        xcd_barrier(bar);
    PH(6, ph_attn(p, dynlds, wid0));                            xcd_barrier(bar);
    PH(7, ph_glaout(p, dynlds, wid0));                          xcd_barrier(bar);
    PH(8, { SchedDense S{(const char*)p.MIX, (const char*)p.WoutT, D, NLAT / 256, D / 256, G, c}; EpiOutproj E{p.x, p.mod, p.X1};
      g8::gemm_phase(lds, D, S, E, wid0); });                   xcd_barrier(bar);
    PH(12, ph_norm2_router(p, sm, wid0));                       xcd_barrier(bar);
    PH(13, ph_lists(p, tp, wid0));                              xcd_barrier(bar);
    moe_tables(p, tp, wid0);
    PH(9, { SchedUp S{tp, (const char*)p.H, p.LIST, (const char*)p.E13T, (const char*)p.S13T, G, c}; EpiUp E{p.HB, p.SHH};
      g8::gemm_phase(lds, D, S, E, wid0); });                   xcd_barrier(bar);
    PH(10, { SchedDown S{tp, (const char*)p.HB, (const char*)p.E2T, (const char*)p.SHH, (const char*)p.S2T, G, c}; EpiDown E{p.Y, p.YS};
      g8::gemm_phase(lds, DE, S, E, wid0); });                  xcd_barrier(bar);
    PH(11, ph_combine(p, wid0));
}

extern "C" void kernel_launch(void* const* d_in, const int* in_sizes, int n_in, void* d_out, int out_size, void* d_ws, size_t ws_size, hipStream_t stream) {
    Params p{};
    const float* const* in = (const float* const*)d_in;
    p.x = in[0]; p.c = in[1]; p.ctx = in[2]; p.c_ctx = in[3]; p.w_mod = in[4]; p.b_mod = in[5]; p.norm1_g = in[6]; p.norm2_g = in[7]; p.w_in = in[8];
    p.q_norm_g = in[9]; p.k_norm_g = in[10]; p.na_rpb = in[11]; p.up_f = in[12]; p.bias_f = in[13]; p.up_b = in[14]; p.bias_b = in[15]; p.gla_norm_g = in[16];
    p.w_out = in[17]; p.router_w = in[18]; p.router_bias = in[19]; p.ew1 = in[20]; p.ew3 = in[21]; p.ew2 = in[22]; p.sw1 = in[23]; p.sw3 = in[24]; p.sw2 = in[25];
    p.out = (float*)d_out;
    char* w = (char*)d_ws; size_t o = 0;
    auto take = [&](size_t bytes) { void* r = w + o; o += (bytes + 255) & ~(size_t)255; return r; };
    p.bar = (unsigned*)take((size_t)XCD_BAR_WORDS * 4);
    p.CNT = (int*)take(64 * 4); p.QCTR = (int*)take(64 * 4); p.LRANK = (int*)take((size_t)NPAIR * 4); p.CNTB = (int*)take((size_t)1024 * 64 * 4);
    p.mod = (float*)take((size_t)3 * 6 * D * 4); p.RT = (float*)take((size_t)64 * 32 * 2 * 4);
    p.EIDX = (int*)take((size_t)NPAIR * 4); p.EW = (float*)take((size_t)NPAIR * 4); p.PAIRPOS = (int*)take((size_t)NPAIR * 4); p.LIST = (int*)take((size_t)PADROWS * 4);
    p.WinT = (bf16_t*)take((size_t)(PLD + 256) * D * 2); p.WoutT = (bf16_t*)take((size_t)D * D * 2); p.S13T = (bf16_t*)take((size_t)1024 * D * 2); p.S2T = (bf16_t*)take((size_t)D * DE * 2);
    p.E13T = (bf16_t*)take((size_t)NE * 1024 * D * 2); p.E2T = (bf16_t*)take((size_t)NE * D * DE * 2);
    p.H = (bf16_t*)take((size_t)NROW * D * 2);
    p.X1 = (float*)take((size_t)NLAT * D * 4);
    const size_t big = o;
    p.P = (float*)take((size_t)NROW * PLD * 4); p.DD = (float*)take((size_t)NROW * 32 * 4); p.NQb = (bf16_t*)take((size_t)NLAT * 1024 * 2); p.NKf = (bf16_t*)take((size_t)16 * NTILE * 4096 * 2); p.VTf = (bf16_t*)take((size_t)16 * NTILE * 4096 * 2);
    p.MIX = (bf16_t*)take((size_t)NLAT * D * 2);
    p.QF = (bf16_t*)take((size_t)8 * 64 * 64 * 128 * 2); p.KF = (bf16_t*)take((size_t)8 * 64 * 64 * 128 * 2); p.QB = (bf16_t*)take((size_t)8 * 64 * 64 * 128 * 2); p.KB = (bf16_t*)take((size_t)8 * 64 * 64 * 128 * 2);
    p.KHF = (bf16_t*)take((size_t)8 * 68 * 128 * 64 * 2); p.KHB = (bf16_t*)take((size_t)8 * 68 * 128 * 64 * 2); p.VT = (bf16_t*)take((size_t)8 * 68 * 256 * 64 * 2); p.VTS = (bf16_t*)take((size_t)8 * 68 * 256 * 64 * 2);
    p.DF = (float*)take((size_t)8 * 68 * 128 * 4); p.DB = (float*)take((size_t)8 * 68 * 128 * 4); p.SS = (bf16_t*)take((size_t)16 * 65 * 256 * 128 * 2);
    o = big;
    p.HB = (bf16_t*)take((size_t)PADROWS * DE * 2); p.SHH = (bf16_t*)take((size_t)NLAT * DE * 2); p.Y = (bf16_t*)take((size_t)PADROWS * D * 2); p.YS = (bf16_t*)take((size_t)NLAT * D * 2);
    static int grid = 0;
    if (!grid) {
        int dev = 0, cus = 0, per_cu = 0;
        hipGetDevice(&dev);
        hipDeviceGetAttribute(&cus, hipDeviceAttributeMultiprocessorCount, dev);
        (void)hipFuncSetAttribute((const void*)mega, hipFuncAttributeMaxDynamicSharedMemorySize, LDS_BYTES);
        (void)hipOccupancyMaxActiveBlocksPerMultiprocessor(&per_cu, (const void*)mega, NT, LDS_BYTES);
        (void)hipGetLastError();
        grid = cus;
    }
    (void)hipMemsetAsync(p.bar, 0, (size_t)XCD_BAR_WORDS * 4, stream);
    hipLaunchKernelGGL(mega, dim3(grid), dim3(NT), LDS_BYTES, stream, p);
}
```

```cpp
#include <hip/hip_runtime.h>
#include <stdint.h>

#define XB_TMO      128
#define XB_XCNT(j)  (256  + 64 * (j))
#define XB_XSUB(j)  (1280 + 64 * (j))
#define XB_XGEN(j)  (2304 + 64 * (j))
#define XB_TOP      3328
#define XB_TOPGEN   3392
#define XCD_BAR_WORDS 3456
#define XB_SPIN_CAP (1u << 18)
#define LAS __attribute__((address_space(3)))

__device__ __forceinline__ unsigned xb_ld(unsigned* p)              { return __hip_atomic_load(p, __ATOMIC_RELAXED, __HIP_MEMORY_SCOPE_AGENT); }
__device__ __forceinline__ unsigned xb_add(unsigned* p, unsigned v) { return __hip_atomic_fetch_add(p, v, __ATOMIC_RELAXED, __HIP_MEMORY_SCOPE_AGENT); }
__device__ __forceinline__ unsigned xb_xcc_id() { return (unsigned)__builtin_amdgcn_s_getreg((3 << 11) | 20) & 0xFu; }
#define XB_SPIN(cond, bar) do { unsigned _sp = 0; while (cond) { __builtin_amdgcn_s_sleep(1); \
    if ((++_sp & 255u) == 0u) { if (xb_ld(&(bar)[XB_TMO])) break; if (_sp > XB_SPIN_CAP) { atomicAdd(&(bar)[XB_TMO], 1u); break; } } } } while (0)

__device__ __forceinline__ int xb_lane_id() { return (int)__builtin_amdgcn_mbcnt_hi(~0u, __builtin_amdgcn_mbcnt_lo(~0u, 0u)); }
struct XcdBarrier {
    int wid;
    unsigned* bar; unsigned x;
    volatile LAS unsigned* st;
};

__device__ __forceinline__ XcdBarrier xcd_barrier_post(unsigned* bar, volatile LAS unsigned* st, int wid) {
    XcdBarrier b; b.wid = wid; b.bar = bar; b.x = xb_xcc_id(); b.st = st;
    if (wid == 0 && xb_lane_id() == 0) (void)xb_add(&bar[XB_XCNT(b.x)], 1u);
    return b;
}
__device__ __forceinline__ void xcd_barrier_complete(unsigned* bar, unsigned x, unsigned& nloc, unsigned& nx) {
    const unsigned G = gridDim.x * gridDim.y * gridDim.z;
    unsigned sum, cnt, mine, sp = 0u;
    for (;;) {
        sum = 0u; cnt = 0u; mine = 0u;
#pragma unroll
        for (unsigned j = 0; j < 16; ++j) { const unsigned c = xb_ld(&bar[XB_XCNT(j)]); sum += c; cnt += (c > 0u) ? 1u : 0u; mine = (j == x) ? c : mine; }
        if (sum == G) break;
        __builtin_amdgcn_s_sleep(1);
        if ((++sp & 255u) == 0u) { if (xb_ld(&bar[XB_TMO])) break; if (sp > XB_SPIN_CAP) { atomicAdd(&bar[XB_TMO], 1u); break; } }
    }
    nloc = mine > 0u ? mine : 1u; nx = cnt > 0u ? cnt : 1u;
}

__device__ __forceinline__ void xcd_barrier(const XcdBarrier& b) {
    asm volatile("s_waitcnt vmcnt(0)" ::: "memory");
    __syncthreads();
    if (b.wid == 0 && xb_lane_id() == 0) {
        unsigned* bar = b.bar;
        __builtin_amdgcn_s_waitcnt(0);
        unsigned nloc = b.st[0], nx = b.st[1];
        if (nloc == 0u) { xcd_barrier_complete(bar, b.x, nloc, nx); b.st[0] = nloc; b.st[1] = nx; }
        const unsigned old = xb_add(&bar[XB_XSUB(b.x)], 1u);
        const unsigned gen = old / nloc;
        if (old + 1u == (gen + 1u) * nloc) {
            __builtin_amdgcn_fence(__ATOMIC_RELEASE, "agent");
            asm volatile("s_waitcnt vmcnt(0)" ::: "memory");
            const unsigned og = xb_add(&bar[XB_TOP], 1u);
            const unsigned tg = og / nx;
            if (og + 1u == (tg + 1u) * nx) xb_add(&bar[XB_TOPGEN], 1u);
            else XB_SPIN(xb_ld(&bar[XB_TOPGEN]) == tg, bar);
            __builtin_amdgcn_fence(__ATOMIC_ACQUIRE, "agent");
            xb_add(&bar[XB_XGEN(b.x)], 1u);
            asm volatile("s_waitcnt vmcnt(0)" ::: "memory");
        } else {
            XB_SPIN(xb_ld(&bar[XB_XGEN(b.x)]) == gen, bar);
            __builtin_amdgcn_fence(__ATOMIC_ACQUIRE, "agent");
            asm volatile("s_waitcnt vmcnt(0)" ::: "memory");
        }
    }
    __syncthreads();
}


#define NT 512
typedef unsigned short bf16_t;
typedef short bf16x8 __attribute__((ext_vector_type(8)));
typedef float f32x4 __attribute__((ext_vector_type(4)));
typedef float f32x16 __attribute__((ext_vector_type(16)));
typedef unsigned u32x4 __attribute__((ext_vector_type(4)));
typedef unsigned u32x2 __attribute__((ext_vector_type(2)));

constexpr int D = 2048, SEQ = 4096, CTXL = 256, NB = 2;
constexpr int NLAT = NB * SEQ;
constexpr int NCTX = NB * CTXL;
constexpr int NROW = NLAT + NCTX;
constexpr int INC = 6176;
constexpr int PLD = 6144;
constexpr int PSLD = 3584;
constexpr size_t PS_SLAB = (size_t)512 * 3584, DD_SLAB = (size_t)8704 * 32;
constexpr int NE = 64, TOPK = 6, DE = 512;
constexpr int NPAIR = NLAT * TOPK;
constexpr int PADROWS = NPAIR + NE * 256;
constexpr int LDS_STAGE = 131072;
constexpr int LDS_TAB = LDS_STAGE;
constexpr int LDS_BARW = LDS_STAGE + 4096;
constexpr int LDS_BYTES = LDS_BARW + 16 + 8192;

struct Params {
    const float *x, *c, *ctx, *c_ctx, *w_mod, *b_mod, *norm1_g, *norm2_g, *w_in, *q_norm_g, *k_norm_g, *na_rpb,
        *up_f, *bias_f, *up_b, *bias_b, *gla_norm_g, *w_out, *router_w, *router_bias, *ew1, *ew3, *ew2, *sw1, *sw3, *sw2;
    float* out;
    float *mod, *X1, *PS, *DDS, *EW, *RT, *DF, *DB;
    bf16_t *P, *H, *MIX, *HB, *SHH, *Y, *WinT, *WoutT, *S13T, *S2T, *E13T, *E2T, *QF, *KF, *QB, *KB, *KHF, *KHB, *VT, *SS, *NQb, *NKf, *VTf, *YS, *VTS;
    int *EIDX, *PAIRPOS, *LIST, *CNT, *QCTR, *LRANK, *CNTB;
    unsigned* bar;
};

__device__ __forceinline__ int fresh_lane_id() { int l; asm volatile("v_mbcnt_lo_u32_b32 %0, -1, 0\n\tv_mbcnt_hi_u32_b32 %0, -1, %0" : "=v"(l)); return l; }
__device__ __forceinline__ int opaque_tid(int wid0) { return wid0 * 64 + fresh_lane_id(); }
__device__ __forceinline__ float wave_sum(float v) { for (int o = 32; o > 0; o >>= 1) v += __shfl_xor(v, o); return v; }
__device__ __forceinline__ float wave_max(float v) { for (int o = 32; o > 0; o >>= 1) v = fmaxf(v, __shfl_xor(v, o)); return v; }
__device__ __forceinline__ int wave_min_i(int v) { for (int o = 32; o > 0; o >>= 1) v = min(v, __shfl_xor(v, o)); return v; }
__device__ __forceinline__ float siluf(float v) { return v / (1.f + expf(-v)); }
typedef float f32x2 __attribute__((ext_vector_type(2)));
typedef __bf16 bf16x2_t __attribute__((ext_vector_type(2)));
__device__ __forceinline__ unsigned cvt_pk_bf16(float lo, float hi) { const f32x2 v = {lo, hi}; return __builtin_bit_cast(unsigned, __builtin_convertvector(v, bf16x2_t)); }
__device__ __forceinline__ bf16_t f2bf(float f) { return (bf16_t)(cvt_pk_bf16(f, 0.f) & 0xffffu); }
__device__ __forceinline__ float bf2f(unsigned b) { return __uint_as_float(b << 16); }

__device__ __forceinline__ void adaln_item(const Params& p, float* sm, int item, const int wid0) {
    const int t = opaque_tid(wid0), cq = t & 15, kg = t >> 4, n0 = item * 64;
    float* red = sm + 3 * D;
    float a[3][4];
#pragma unroll
    for (int r = 0; r < 3; ++r)
#pragma unroll
        for (int j = 0; j < 4; ++j) a[r][j] = 0.f;
#pragma unroll 4
    for (int k = kg; k < D; k += 32) {
        const float4 w = *(const float4*)(p.w_mod + (size_t)k * (6 * D) + n0 + 4 * cq);
        const float s0 = sm[k], s1 = sm[D + k], s2 = sm[2 * D + k];
        a[0][0] += s0 * w.x; a[0][1] += s0 * w.y; a[0][2] += s0 * w.z; a[0][3] += s0 * w.w;
        a[1][0] += s1 * w.x; a[1][1] += s1 * w.y; a[1][2] += s1 * w.z; a[1][3] += s1 * w.w;
        a[2][0] += s2 * w.x; a[2][1] += s2 * w.y; a[2][2] += s2 * w.z; a[2][3] += s2 * w.w;
    }
    __syncthreads();
#pragma unroll
    for (int r = 0; r < 3; ++r)
#pragma unroll
        for (int j = 0; j < 4; ++j) red[(kg * 3 + r) * 64 + 4 * cq + j] = a[r][j];
    __syncthreads();
    if (t < 192) {
        const int r = t >> 6, cc = t & 63;
        float s = p.b_mod[n0 + cc];
#pragma unroll 8
        for (int g = 0; g < 32; ++g) s += red[(g * 3 + r) * 64 + cc];
        p.mod[(size_t)r * 6 * D + n0 + cc] = s;
    }
    __syncthreads();
}
__device__ __forceinline__ void transpose_item(const float* W, int K, int N, int k0, int n0, bf16_t* WT, int drow0, float* scr, int lane, int maxc = 63) {
    const int cl = lane < maxc ? lane : maxc;
#pragma unroll 8
    for (int kk = 0; kk < 64; ++kk) scr[kk * 65 + lane] = W[(size_t)(k0 + kk) * N + n0 + cl];
    asm volatile("s_waitcnt lgkmcnt(0)" ::: "memory");
    const int c = lane & 7;
#pragma unroll
    for (int j = 0; j < 8; ++j) {
        const int n = (lane >> 3) + 8 * j; const float* s = scr + (8 * c) * 65 + n;
        u32x4 o; o.x = cvt_pk_bf16(s[0], s[65]); o.y = cvt_pk_bf16(s[2 * 65], s[3 * 65]); o.z = cvt_pk_bf16(s[4 * 65], s[5 * 65]); o.w = cvt_pk_bf16(s[6 * 65], s[7 * 65]);
        *(u32x4*)(WT + (size_t)(drow0 + n) * K + k0 + 8 * c) = o;
    }
    asm volatile("s_waitcnt lgkmcnt(0)" ::: "memory");
}
constexpr int CI_WIN = 32 * 97, CI_WOUT = 32 * 32, CI_S13 = 2 * 32 * 8, CI_S2 = 8 * 32, CI_E13 = 64 * 2 * 32 * 8, CI_E2 = 64 * 8 * 32;
constexpr int CI_TOTAL = CI_WIN + CI_WOUT + CI_S13 + CI_S2 + CI_E13 + CI_E2;
__device__ __forceinline__ void convert_item(const Params& p, int it, float* scr, int lane) {
    if (it < CI_WIN) { const int kb = it / 97, nb = it % 97; transpose_item(p.w_in, D, INC, 64 * kb, 64 * nb, p.WinT, 64 * nb, scr, lane, INC - 1 - 64 * nb); return; }
    it -= CI_WIN;
    if (it < CI_WOUT) { const int kb = it / 32, nb = it % 32; transpose_item(p.w_out, D, D, 64 * kb, 64 * nb, p.WoutT, 64 * nb, scr, lane); return; }
    it -= CI_WOUT;
    if (it < CI_S13) {
        const int which = it / 256, r = it % 256, kb = r / 8, nb = r % 8;
        transpose_item(which ? p.sw3 : p.sw1, D, DE, 64 * kb, 64 * nb, p.S13T, (nb >> 1) * 256 + which * 128 + (nb & 1) * 64, scr, lane); return; }
    it -= CI_S13;
    if (it < CI_S2) { const int kb = it / 32, nb = it % 32; transpose_item(p.sw2, DE, D, 64 * kb, 64 * nb, p.S2T, 64 * nb, scr, lane); return; }
    it -= CI_S2;
    if (it < CI_E13) {
        const int e = it / 512, r0 = it % 512, which = r0 / 256, r = r0 % 256, kb = r / 8, nb = r % 8;
        transpose_item((which ? p.ew3 : p.ew1) + (size_t)e * D * DE, D, DE, 64 * kb, 64 * nb, p.E13T + (size_t)e * 1024 * D, (nb >> 1) * 256 + which * 128 + (nb & 1) * 64, scr, lane); return; }
    it -= CI_E13;
    { const int e = it / 256, r = it % 256, kb = r / 32, nb = r % 32;
      transpose_item(p.ew2 + (size_t)e * DE * D, DE, D, 64 * kb, 64 * nb, p.E2T + (size_t)e * D * DE, 64 * nb, scr, lane); }
}
__device__ void ph_prologue(const Params& p, float* sm, const int wid0) {
    const int t = opaque_tid(wid0), w = t >> 6, lane = t & 63;
    if (blockIdx.x == 0 && t == 0) { p.QCTR[0] = 0; p.QCTR[32] = 0; }
    if (blockIdx.x == gridDim.x - 1) {
        for (int i = t; i < 64 * 32; i += NT) { const float ang = (float)(i >> 5) * powf(10000.f, -(float)(i & 31) / 32.f); p.RT[2 * i] = cosf(ang); p.RT[2 * i + 1] = sinf(ang); }
    }
    if (blockIdx.x < 192) {
        for (int i = t; i < 3 * D; i += NT) { const int r = i / D, k = i % D; sm[i] = siluf(r < 2 ? p.c[r * D + k] : p.c_ctx[k]); }
        __syncthreads();
        for (int item = blockIdx.x; item < 192; item += gridDim.x) adaln_item(p, sm, item, wid0);
    }
    __syncthreads();
    float* scr = sm + w * (64 * 65);
    for (int it = blockIdx.x * 8 + w; it < CI_TOTAL; it += gridDim.x * 8) convert_item(p, it, scr, lane);
}

__device__ void ph_norm1(const Params& p, const int wid0) {
    const int t = opaque_tid(wid0), w = t >> 6, lane = t & 63;
    for (int row = blockIdx.x * 8 + w; row < NROW; row += gridDim.x * 8) {
        const float* src; int mr;
        if (row < NLAT) { src = p.x + (size_t)row * D; mr = row / SEQ; } else { src = p.ctx + (size_t)(row - NLAT) * D; mr = 2; }
        const float* m = p.mod + (size_t)mr * 6 * D;
        float4 v[8]; float ss = 0.f;
#pragma unroll
        for (int j = 0; j < 8; ++j) { v[j] = *(const float4*)(src + 256 * j + 4 * lane); ss += v[j].x * v[j].x + v[j].y * v[j].y + v[j].z * v[j].z + v[j].w * v[j].w; }
        ss = wave_sum(ss);
        const float rs = rsqrtf(ss * (1.f / D) + 1e-6f);
#pragma unroll
        for (int j = 0; j < 8; ++j) {
            const int col = 256 * j + 4 * lane;
            const float4 g = *(const float4*)(p.norm1_g + col), sh = *(const float4*)(m + col), sc = *(const float4*)(m + D + col);
            u32x2 pk;
            pk.x = cvt_pk_bf16(v[j].x * rs * g.x * (1.f + sc.x) + sh.x, v[j].y * rs * g.y * (1.f + sc.y) + sh.y);
            pk.y = cvt_pk_bf16(v[j].z * rs * g.z * (1.f + sc.z) + sh.z, v[j].w * rs * g.w * (1.f + sc.w) + sh.w);
            *(u32x2*)(p.H + (size_t)row * D + col) = pk;
        }
    }
}

namespace g8 {
constexpr int BM = 256, BK = 64, HALF = 128, HTB = HALF * BK * 2;
__device__ __forceinline__ int lds_byte(int r, int c) { const int st = (r >> 4) * 2 + (c >> 5), rr = r & 15, cc = c & 31, ob = rr * 64 + cc * 2; return st * 1024 + (ob ^ (((ob >> 9) & 1) << 5)); }
__device__ __forceinline__ void stage_rc(int b, int& R, int& C) { const int st = b / 1024, sb = b % 1024, swz = sb ^ (((sb >> 9) & 1) << 5); R = (st >> 1) * 16 + swz / 64; C = (st & 1) * 32 + (swz % 64) / 2; }
__device__ __forceinline__ int perm32(int rho) { const int n = rho >> 4, i = rho & 15; return 8 * (i >> 2) + 4 * n + (i & 3); }

struct Unit { const char* A; const int* rows; int row0; const char* Bt; int orow, pn, aux; };

__device__ __forceinline__ bool work_id(int i, int G, int c, int nwg, int& wgid) {
    const long L = (long)i * G + c; if (L >= nwg) return false;
    const int l = (int)L, q = nwg / 8, r = nwg % 8, xcd = l % 8, off = l / 8;
    wgid = (xcd < r ? xcd * (q + 1) : r * (q + 1) + (xcd - r) * q) + off; return true;
}

template <class Epi, class Sched>
__device__ __forceinline__ void gemm_phase(LAS unsigned char* lds, const int K, const Sched& S, const Epi& E, const int wid0, const int kloop = 0) {
    const int tid_ = wid0 * 64 + fresh_lane_id();
    const int tid = tid_, wid = __builtin_amdgcn_readfirstlane(tid >> 6), lane = tid & 63, wr = wid >> 2, wc = wid & 3, fr = lane & 15, fq = lane >> 4;
    const int nt = (kloop ? kloop : K) / BK;
    int sR[2]; unsigned sC2[2], voffB[2];
#pragma unroll
    for (int i = 0; i < 2; ++i) { int R, C; stage_rc(tid * 16 + i * 8192, R, C); const int Rb = Epi::PERM ? ((R & ~31) + perm32(R & 31)) : R;
        sR[i] = R; sC2[i] = (unsigned)C * 2u; voffB[i] = (unsigned)(Rb * K + C) * 2u; }
    const size_t kstep = (size_t)(BK * 2);
    const size_t hstep = (size_t)HALF * K * 2;
    const unsigned ldsw = (unsigned)wid * 1024u;
    const int aoff = lds_byte(wr * 64 + fr, fq * 8), boff = lds_byte(wc * 32 + fr, fq * 8);
#define G8_SA(b, h) (((b) * 2 + (h)) * g8::HTB)
#define G8_SB(b, h) ((4 + (b) * 2 + (h)) * g8::HTB)
#define G8_STAGE(bufoff, gbase, v0, v1) do { \
        __builtin_amdgcn_global_load_lds((const unsigned*)((const char*)(gbase) + (v0)), (LAS unsigned*)(lds + (bufoff) + ldsw), 16, 0, 0); \
        __builtin_amdgcn_global_load_lds((const unsigned*)((const char*)(gbase) + (v1)), (LAS unsigned*)(lds + (bufoff) + ldsw + 8192), 16, 0, 0); } while (0)
#define G8_LDA(dst, b, h) do { _Pragma("unroll") for (int m = 0; m < 4; ++m) _Pragma("unroll") for (int k = 0; k < 2; ++k) dst[m][k] = *(const LAS bf16x8*)(lds + G8_SA(b, h) + aoff + m * 2048 + k * 1024); } while (0)
#define G8_LDB(dst, b, h) do { _Pragma("unroll") for (int n = 0; n < 2; ++n) _Pragma("unroll") for (int k = 0; k < 2; ++k) dst[n][k] = *(const LAS bf16x8*)(lds + G8_SB(b, h) + boff + n * 2048 + k * 1024); } while (0)
#define G8_MMA(ai, bj, At, Bt) do { __builtin_amdgcn_s_setprio(1); _Pragma("unroll") for (int m = 0; m < 4; ++m) _Pragma("unroll") for (int n = 0; n < 2; ++n) _Pragma("unroll") for (int k = 0; k < 2; ++k) \
        acc[ai][bj][m][n] = __builtin_amdgcn_mfma_f32_16x16x32_bf16(Bt[n][k], At[m][k], acc[ai][bj][m][n], 0, 0, 0); __builtin_amdgcn_s_setprio(0); } while (0)
#define G8_WAIT_V(n) asm volatile("s_waitcnt vmcnt(" #n ")" ::: "memory")
#define G8_WAIT_L(n) asm volatile("s_waitcnt lgkmcnt(" #n ")" ::: "memory")
#define G8_BAR __builtin_amdgcn_s_barrier()
#define G8_SCHED __builtin_amdgcn_sched_barrier(0)
    Unit cur, nxt; int ui = 0;
    if (!S.next(0, cur)) return;
    f32x4 acc[2][2][4][2];
#pragma unroll
    for (int a = 0; a < 2; ++a)
#pragma unroll
        for (int b = 0; b < 2; ++b)
#pragma unroll
            for (int m = 0; m < 4; ++m)
#pragma unroll
                for (int n = 0; n < 2; ++n) acc[a][b][m][n] = (f32x4){0.f, 0.f, 0.f, 0.f};
    bf16x8 At[4][2], B0[2][2], B1[2][2];
    unsigned vA00, vA01, vA10, vA11, nA00, nA01, nA10, nA11;
#define G8_MKOFF(u, o00, o01, o10, o11) do { \
        int r00, r01, r10, r11; \
        if ((u).rows) { r00 = (u).rows[sR[0]]; r01 = (u).rows[sR[1]]; r10 = (u).rows[128 + sR[0]]; r11 = (u).rows[128 + sR[1]]; } \
        else { r00 = (u).row0 + sR[0]; r01 = (u).row0 + sR[1]; r10 = (u).row0 + 128 + sR[0]; r11 = (u).row0 + 128 + sR[1]; } \
        o00 = (unsigned)r00 * (unsigned)(K * 2) + sC2[0]; o01 = (unsigned)r01 * (unsigned)(K * 2) + sC2[1]; \
        o10 = (unsigned)r10 * (unsigned)(K * 2) + sC2[0]; o11 = (unsigned)r11 * (unsigned)(K * 2) + sC2[1]; } while (0)
    G8_MKOFF(cur, vA00, vA01, vA10, vA11);
    const char* cA = cur.A; const char* cB = cur.Bt;
    G8_STAGE(G8_SB(0, 0), cB, voffB[0], voffB[1]); G8_STAGE(G8_SA(0, 0), cA, vA00, vA01); G8_STAGE(G8_SB(0, 1), cB + hstep, voffB[0], voffB[1]); G8_STAGE(G8_SA(0, 1), cA, vA10, vA11);
    if (wr == 1) G8_BAR;
    G8_WAIT_V(4); G8_BAR;
    G8_STAGE(G8_SB(1, 0), cB + kstep, voffB[0], voffB[1]); G8_STAGE(G8_SA(1, 0), cA + kstep, vA00, vA01); G8_STAGE(G8_SB(1, 1), cB + hstep + kstep, voffB[0], voffB[1]);
    G8_WAIT_V(6); G8_BAR;
    for (;;) {
        const bool has_next = S.next(ui + 1, nxt);
        const char* nA = has_next ? nxt.A : cA; const char* nB = has_next ? nxt.Bt : cB;
        if (has_next) G8_MKOFF(nxt, nA00, nA01, nA10, nA11); else { nA00 = vA00; nA01 = vA01; nA10 = vA10; nA11 = vA11; }
        for (int t = 0; t < nt; t += 2) {
            const bool last = (t == nt - 2);
            const char* a1 = cA + (size_t)(t + 1) * kstep;
            G8_LDB(B0, 0, 0); G8_SCHED; G8_LDA(At, 0, 0); G8_STAGE(G8_SA(1, 1), a1, vA10, vA11);
            G8_WAIT_L(8); G8_BAR; G8_WAIT_L(0); G8_MMA(0, 0, At, B0); G8_BAR; G8_SCHED;
            if (last) { vA00 = nA00; vA01 = nA01; vA10 = nA10; vA11 = nA11; }
            const char* a2 = last ? nA : cA + (size_t)(t + 2) * kstep; const char* b2 = last ? nB : cB + (size_t)(t + 2) * kstep;
            const char* a3 = a2 + kstep; const char* b3 = b2 + kstep;
            G8_LDB(B1, 0, 1); G8_STAGE(G8_SB(0, 0), b2, voffB[0], voffB[1]);
            G8_BAR; G8_WAIT_L(0); G8_MMA(0, 1, At, B1); G8_BAR;
            G8_LDA(At, 0, 1); G8_STAGE(G8_SA(0, 0), a2, vA00, vA01);
            G8_BAR; G8_WAIT_L(0); G8_MMA(1, 0, At, B0); G8_BAR; G8_SCHED;
            G8_STAGE(G8_SB(0, 1), b2 + hstep, voffB[0], voffB[1]);
            G8_WAIT_V(6); G8_BAR; G8_MMA(1, 1, At, B1); G8_BAR;
            G8_LDB(B0, 1, 0); G8_SCHED; G8_LDA(At, 1, 0); G8_STAGE(G8_SA(0, 1), a2, vA10, vA11);
            G8_WAIT_L(8); G8_BAR; G8_WAIT_L(0); G8_MMA(0, 0, At, B0); G8_BAR; G8_SCHED;
            G8_LDB(B1, 1, 1); G8_STAGE(G8_SB(1, 0), b3, voffB[0], voffB[1]);
            G8_BAR; G8_WAIT_L(0); G8_MMA(0, 1, At, B1); G8_BAR;
            G8_LDA(At, 1, 1); G8_STAGE(G8_SA(1, 0), a3, vA00, vA01);
            G8_BAR; G8_WAIT_L(0); G8_MMA(1, 0, At, B0); G8_BAR; G8_SCHED;
            G8_STAGE(G8_SB(1, 1), b3 + hstep, voffB[0], voffB[1]);
            G8_WAIT_V(6); G8_BAR; G8_MMA(1, 1, At, B1); G8_BAR;
        }
        E(acc, cur, wr, wc, fr, fq);
        if (!has_next) break;
#pragma unroll
        for (int a = 0; a < 2; ++a)
#pragma unroll
            for (int b = 0; b < 2; ++b)
#pragma unroll
                for (int m = 0; m < 4; ++m)
#pragma unroll
                    for (int n = 0; n < 2; ++n) acc[a][b][m][n] = (f32x4){0.f, 0.f, 0.f, 0.f};
        cur = nxt; cA = nA; cB = nB; ++ui;
    }
    G8_WAIT_V(0);
    if (wr == 0) G8_BAR;
    G8_BAR;
}
}

struct EpiInproj {
    static constexpr bool PERM = true;
    bf16_t* P;
    __device__ __forceinline__ void operator()(const f32x4 (&acc)[2][2][4][2], const g8::Unit& u, int wr, int wc, int fr, int fq) const {
#pragma unroll
        for (int ai = 0; ai < 2; ++ai)
#pragma unroll
            for (int m = 0; m < 4; ++m) { bf16_t* rowp = P + (size_t)(u.orow + ai * 128 + wr * 64 + m * 16 + fr) * PLD + u.pn * 256 + wc * 32 + 8 * fq;
#pragma unroll
                for (int bj = 0; bj < 2; ++bj) { const f32x4 v0 = acc[ai][bj][m][0], v1 = acc[ai][bj][m][1];
                    u32x4 w; w.x = cvt_pk_bf16(v0[0], v0[1]); w.y = cvt_pk_bf16(v0[2], v0[3]); w.z = cvt_pk_bf16(v1[0], v1[1]); w.w = cvt_pk_bf16(v1[2], v1[3]);
                    *(u32x4*)(rowp + bj * 128) = w; } }
    }
};
struct EpiInprojSplit {
    static constexpr bool PERM = false;
    float* PS; float* DDS;
    __device__ __forceinline__ void operator()(const f32x4 (&acc)[2][2][4][2], const g8::Unit& u, int wr, int wc, int fr, int fq) const {
        if (u.pn == PLD / 256) {
            if (wc == 0) {
#pragma unroll
                for (int ai = 0; ai < 2; ++ai)
#pragma unroll
                    for (int m = 0; m < 4; ++m) { float* rowp = DDS + (size_t)u.aux * DD_SLAB + (size_t)(u.orow + ai * 128 + wr * 64 + m * 16 + fr) * 32 + 4 * fq;
                        *(f32x4*)(rowp) = acc[ai][0][m][0]; *(f32x4*)(rowp + 16) = acc[ai][0][m][1]; }
            }
            return;
        }
        const int ccol = (u.pn < 12 ? u.pn - 4 : u.pn - 6) * 256;
#pragma unroll
        for (int ai = 0; ai < 2; ++ai)
#pragma unroll
            for (int m = 0; m < 4; ++m) { float* rowp = PS + (size_t)u.aux * PS_SLAB + (size_t)(u.orow - NLAT + ai * 128 + wr * 64 + m * 16 + fr) * PSLD + ccol + wc * 32 + 4 * fq;
#pragma unroll
                for (int bj = 0; bj < 2; ++bj)
#pragma unroll
                    for (int n = 0; n < 2; ++n) *(f32x4*)(rowp + bj * 128 + n * 16) = acc[ai][bj][m][n]; }
    }
};
struct SchedInprojSplit {
    const char* A; const char* Bt; int G, c;
    static constexpr int NITEM = 4 * (28 + 34);
    __device__ __forceinline__ bool next(int i, g8::Unit& u) const {
        int it; if (!g8::work_id(i, G, c, NITEM, it)) return false;
        int pm, pn; const int ks = it & 3, q = it >> 2;
        if (q < 28) { const int j = q % 14; pm = 32 + q / 14; pn = j < 8 ? 4 + j : (j < 10 ? 6 + j : 6 + j); }
        else { pm = q - 28; pn = PLD / 256; }
        u.A = A + ks * 1024; u.rows = nullptr; u.row0 = pm * 256; u.Bt = Bt + (size_t)pn * 256 * D * 2 + ks * 1024; u.orow = pm * 256; u.pn = pn; u.aux = ks; return true;
    }
};
struct EpiOutproj {
    static constexpr bool PERM = false;
    const float* x; const float* mod; float* X1;
    __device__ __forceinline__ void operator()(const f32x4 (&acc)[2][2][4][2], const g8::Unit& u, int wr, int wc, int fr, int fq) const {
        const int b = u.orow / SEQ; const int col0 = u.pn * 256 + wc * 32 + 4 * fq;
        f32x4 gv[2][2];
#pragma unroll
        for (int bj = 0; bj < 2; ++bj)
#pragma unroll
            for (int n = 0; n < 2; ++n) gv[bj][n] = *(const f32x4*)(mod + (size_t)b * 6 * D + 2 * D + col0 + bj * 128 + n * 16);
#pragma unroll
        for (int ai = 0; ai < 2; ++ai)
#pragma unroll
            for (int m = 0; m < 4; ++m) { const size_t ro = (size_t)(u.orow + ai * 128 + wr * 64 + m * 16 + fr) * D + col0;
#pragma unroll
                for (int bj = 0; bj < 2; ++bj)
#pragma unroll
                    for (int n = 0; n < 2; ++n) { const f32x4 xv = *(const f32x4*)(x + ro + bj * 128 + n * 16);
                        *(f32x4*)(X1 + ro + bj * 128 + n * 16) = xv + gv[bj][n] * acc[ai][bj][m][n]; } }
    }
};
struct EpiUp {
    static constexpr bool PERM = true;
    bf16_t* HB; bf16_t* SHH;
    __device__ __forceinline__ void operator()(const f32x4 (&acc)[2][2][4][2], const g8::Unit& u, int wr, int wc, int fr, int fq) const {
        bf16_t* O = u.aux ? SHH : HB;
#pragma unroll
        for (int ai = 0; ai < 2; ++ai)
#pragma unroll
            for (int m = 0; m < 4; ++m) {
                f32x4 h0, h1;
#pragma unroll
                for (int j = 0; j < 4; ++j) { h0[j] = siluf(acc[ai][0][m][0][j]) * acc[ai][1][m][0][j]; h1[j] = siluf(acc[ai][0][m][1][j]) * acc[ai][1][m][1][j]; }
                u32x4 w; w.x = cvt_pk_bf16(h0[0], h0[1]); w.y = cvt_pk_bf16(h0[2], h0[3]); w.z = cvt_pk_bf16(h1[0], h1[1]); w.w = cvt_pk_bf16(h1[2], h1[3]);
                *(u32x4*)(O + (size_t)(u.orow + ai * 128 + wr * 64 + m * 16 + fr) * DE + u.pn * 128 + wc * 32 + 8 * fq) = w;
            }
    }
};
struct EpiDown {
    static constexpr bool PERM = true;
    bf16_t* Y; bf16_t* YS;
    __device__ __forceinline__ void operator()(const f32x4 (&acc)[2][2][4][2], const g8::Unit& u, int wr, int wc, int fr, int fq) const {
        bf16_t* O = u.aux ? YS : Y;
#pragma unroll
        for (int ai = 0; ai < 2; ++ai)
#pragma unroll
            for (int m = 0; m < 4; ++m) { bf16_t* rowp = O + (size_t)(u.orow + ai * 128 + wr * 64 + m * 16 + fr) * D + u.pn * 256 + wc * 32 + 8 * fq;
#pragma unroll
                for (int bj = 0; bj < 2; ++bj) { const f32x4 v0 = acc[ai][bj][m][0], v1 = acc[ai][bj][m][1];
                    u32x4 w; w.x = cvt_pk_bf16(v0[0], v0[1]); w.y = cvt_pk_bf16(v0[2], v0[3]); w.z = cvt_pk_bf16(v1[0], v1[1]); w.w = cvt_pk_bf16(v1[2], v1[3]);
                    *(u32x4*)(rowp + bj * 128) = w; } }
    }
};
struct SchedDense {
    const char* A; const char* Bt; int K, nM, nN, G, c;
    __device__ __forceinline__ bool next(int i, g8::Unit& u) const {
        int wgid; if (!g8::work_id(i, G, c, nM * nN, wgid)) return false;
        const int nig = 8 * nN, gid = wgid / nig, fm = gid * 8, gsz = (nM - fm) < 8 ? (nM - fm) : 8;
        const int pm = fm + ((wgid % nig) % gsz), pn = (wgid % nig) / gsz;
        u.A = A; u.rows = nullptr; u.row0 = pm * 256; u.Bt = Bt + (size_t)pn * 256 * K * 2; u.orow = pm * 256; u.pn = pn; u.aux = 0; return true;
    }
};
struct SchedUp {
    const int* tp; const char* H2; const int* LIST; const char* E13T; const char* S13T; int G, c;
    __device__ __forceinline__ bool next(int i, g8::Unit& u) const {
        const int T = tp[NE]; int wgid; if (!g8::work_id(i, G, c, 4 * T + 128, wgid)) return false;
        u.A = H2;
        if (wgid < 4 * T) {
            int e = 0;
#pragma unroll
            for (int s = 32; s > 0; s >>= 1) if (4 * tp[e + s] <= wgid) e += s;
            const int tc = tp[e + 1] - tp[e], li = wgid - 4 * tp[e], nt = li / tc, mt = li % tc, r0 = (tp[e] + mt) * 256;
            u.rows = LIST + r0; u.row0 = 0; u.Bt = E13T + ((size_t)e * 1024 + nt * 256) * D * 2; u.orow = r0; u.pn = nt; u.aux = 0;
        } else {
            const int s = wgid - 4 * T, pn = s / 32, pm = s % 32;
            u.rows = nullptr; u.row0 = pm * 256; u.Bt = S13T + (size_t)pn * 256 * D * 2; u.orow = pm * 256; u.pn = pn; u.aux = 1;
        }
        return true;
    }
};
struct SchedDown {
    const int* tp; const char* HB; const char* E2T; const char* SHH; const char* S2T; int G, c;
    __device__ __forceinline__ bool next(int i, g8::Unit& u) const {
        const int T = tp[NE]; int wgid; if (!g8::work_id(i, G, c, 8 * T + 256, wgid)) return false;
        u.rows = nullptr;
        if (wgid < 8 * T) {
            int e = 0;
#pragma unroll
            for (int s = 32; s > 0; s >>= 1) if (8 * tp[e + s] <= wgid) e += s;
            const int tc = tp[e + 1] - tp[e], li = wgid - 8 * tp[e], nt = li / tc, mt = li % tc, r0 = (tp[e] + mt) * 256;
            u.A = HB; u.row0 = r0; u.Bt = E2T + ((size_t)e * D + nt * 256) * DE * 2; u.orow = r0; u.pn = nt; u.aux = 0;
        } else {
            const int s = wgid - 8 * T, pn = s / 32, pm = s % 32;
            u.A = SHH; u.row0 = pm * 256; u.Bt = S2T + (size_t)pn * 256 * DE * 2; u.orow = pm * 256; u.pn = pn; u.aux = 1;
        }
        return true;
    }
};
__device__ __forceinline__ void moe_tables(const Params& p, int* tp, const int wid0) {
    __syncthreads();
    if (wid0 == 0 && xb_lane_id() == 0) { int tt = 0; for (int e = 0; e < NE; ++e) { tp[e] = tt; tt += (p.CNT[e] + 255) / 256; } tp[NE] = tt; }
    __syncthreads();
}

constexpr int NTILE = 136;
__device__ void ph_naprep(const Params& p, const int wid0) {
    const int t = opaque_tid(wid0), w = t >> 6, lane = t & 63, kk = lane >> 4, pc = lane & 15;
    for (int u = blockIdx.x; u < 2 * NTILE; u += gridDim.x) {
        const int b = u / NTILE, T = u % NTILE; const bool lat = T < 128;
        const int row0 = lat ? (b * SEQ + 32 * T) : (NLAT + b * CTXL + 32 * (T - 128));
#pragma unroll 2
        for (int it = w; it < 128; it += 8) {
            const int which = it & 1, hh = (it >> 1) & 7, tt = 4 * (it >> 4) + kk;
            if (which == 0 && !lat) continue;
            float4 v0, v1;
            if (lat) { const u32x4 r8 = *(const u32x4*)(p.P + (size_t)(row0 + tt) * PLD + which * 1024 + hh * 128 + 8 * pc);
                v0 = make_float4(bf2f(r8.x & 0xffffu), bf2f(r8.x >> 16), bf2f(r8.y & 0xffffu), bf2f(r8.y >> 16)); v1 = make_float4(bf2f(r8.z & 0xffffu), bf2f(r8.z >> 16), bf2f(r8.w & 0xffffu), bf2f(r8.w >> 16)); }
            else {
                const float* src = p.PS + (size_t)(row0 - NLAT + tt) * PSLD + hh * 128 + 8 * pc;
                v0 = *(const float4*)src; v1 = *(const float4*)(src + 4);
#pragma unroll
                for (int s = 1; s < 4; ++s) { const float4 a0 = *(const float4*)(src + s * PS_SLAB), a1 = *(const float4*)(src + s * PS_SLAB + 4);
                    v0.x += a0.x; v0.y += a0.y; v0.z += a0.z; v0.w += a0.w; v1.x += a1.x; v1.y += a1.y; v1.z += a1.z; v1.w += a1.w; }
            }
            float ss = v0.x * v0.x + v0.y * v0.y + v0.z * v0.z + v0.w * v0.w + v1.x * v1.x + v1.y * v1.y + v1.z * v1.z + v1.w * v1.w;
            ss += __shfl_xor(ss, 1); ss += __shfl_xor(ss, 2); ss += __shfl_xor(ss, 4); ss += __shfl_xor(ss, 8);
            const float* gp = (which ? p.k_norm_g : p.q_norm_g) + 8 * pc;
            const float4 g0 = *(const float4*)gp, g1 = *(const float4*)(gp + 4);
            const float r = rsqrtf(ss * (1.f / 128.f) + 1e-6f) * (which ? 1.f : 0.08838834764831845f * 1.4426950408889634f);
            u32x4 o;
            o.x = cvt_pk_bf16(v0.x * r * g0.x, v0.y * r * g0.y); o.y = cvt_pk_bf16(v0.z * r * g0.z, v0.w * r * g0.w);
            o.z = cvt_pk_bf16(v1.x * r * g1.x, v1.y * r * g1.y); o.w = cvt_pk_bf16(v1.z * r * g1.z, v1.w * r * g1.w);
            if (which) *(u32x4*)(p.NKf + (((size_t)((b * 8 + hh) * NTILE + T) * 8 + (pc >> 1)) * 64 + tt + 32 * (pc & 1)) * 8) = o;
            else *(u32x4*)(p.NQb + (size_t)(row0 + tt) * 1024 + hh * 128 + 8 * pc) = o;
        }
#pragma unroll 1
        for (int i = 0; i < 2; ++i) {
            const int col = t + 512 * i, hh = col >> 7, dv = col & 127;
            unsigned pk[16];
#pragma unroll
            for (int s2 = 0; s2 < 16; ++s2) {
                float x0, x1;
                if (lat) { x0 = bf2f(p.P[(size_t)(row0 + 2 * s2) * PLD + 2048 + col]); x1 = bf2f(p.P[(size_t)(row0 + 2 * s2 + 1) * PLD + 2048 + col]); }
                else { const float* s0 = p.PS + (size_t)(row0 - NLAT + 2 * s2) * PSLD + 1024 + col;
                    x0 = s0[0] + s0[PS_SLAB] + s0[2 * PS_SLAB] + s0[3 * PS_SLAB]; x1 = s0[PSLD] + s0[PS_SLAB + PSLD] + s0[2 * PS_SLAB + PSLD] + s0[3 * PS_SLAB + PSLD]; }
                pk[s2] = cvt_pk_bf16(x0, x1);
            }
            bf16_t* o = p.VTf + ((((size_t)((b * 8 + hh) * NTILE + T) * 4 + (dv >> 5)) * 2) * 64 + (dv & 31)) * 8;
#pragma unroll
            for (int g2 = 0; g2 < 2; ++g2) {
                *(u32x4*)(o + (g2 * 64) * 8) = (u32x4){pk[8 * g2], pk[8 * g2 + 1], pk[8 * g2 + 4], pk[8 * g2 + 5]};
                *(u32x4*)(o + (g2 * 64 + 32) * 8) = (u32x4){pk[8 * g2 + 2], pk[8 * g2 + 3], pk[8 * g2 + 6], pk[8 * g2 + 7]};
            }
        }
    }
}

__device__ __forceinline__ void attn_tile(const LAS unsigned char* sb, const float* bt0, const bf16x8 (&qf)[8], f32x16& o0, f32x16& o1, f32x16& o2, f32x16& o3, float& m, float& l,
                                          bool loc, int half, int dr, int c, int cs, int hi) {
    bf16x8 kc[8], va[8];
#pragma unroll
    for (int ks = 0; ks < 8; ++ks) kc[ks] = *(const LAS bf16x8*)(sb + ks * 1024);
#pragma unroll
    for (int q = 0; q < 8; ++q) va[q] = *(const LAS bf16x8*)(sb + 8192 + q * 1024);
    f32x16 s;
#pragma unroll
    for (int e = 0; e < 16; ++e) s[e] = 0.f;
#pragma unroll
    for (int ks = 0; ks < 8; ++ks) s = __builtin_amdgcn_mfma_f32_32x32x16_bf16(kc[ks], qf[ks], s, 0, 0, 0);
    if (loc) {
        int rel0 = 32 * half + 4 * hi - cs; asm volatile("" : "+v"(rel0));
        const float* bt = bt0 + dr * 31 + cs - c + 15;
#pragma unroll
        for (int e = 0; e < 16; ++e) {
            const int rel = rel0 + (e & 3) + 8 * (e >> 2);
            const bool vis = (unsigned)rel < 16u;
            const float bias = bt[rel];
            s[e] = vis ? (s[e] + bias) : -INFINITY;
        }
    }
    float mt = s[0];
#pragma unroll
    for (int e = 1; e < 16; ++e) mt = fmaxf(mt, s[e]);
    mt = fmaxf(mt, __shfl_xor(mt, 32));
    if (__any(mt > m)) {
        const float mn = fmaxf(m, mt);
        const float alpha = __builtin_amdgcn_exp2f(m - mn);
        m = mn; l *= alpha;
#pragma unroll
        for (int e = 0; e < 16; ++e) { o0[e] *= alpha; o1[e] *= alpha; o2[e] *= alpha; o3[e] *= alpha; }
    }
    float ps = 0.f;
#pragma unroll
    for (int e = 0; e < 16; ++e) { s[e] = __builtin_amdgcn_exp2f(s[e] - m); ps += s[e]; }
    l += ps;
    bf16x8 pb[2];
#pragma unroll
    for (int s2 = 0; s2 < 2; ++s2) {
        const u32x4 cat = (u32x4){cvt_pk_bf16(s[8 * s2], s[8 * s2 + 1]), cvt_pk_bf16(s[8 * s2 + 2], s[8 * s2 + 3]), cvt_pk_bf16(s[8 * s2 + 4], s[8 * s2 + 5]), cvt_pk_bf16(s[8 * s2 + 6], s[8 * s2 + 7])};
        pb[s2] = __builtin_bit_cast(bf16x8, cat);
    }
#pragma unroll
    for (int s2 = 0; s2 < 2; ++s2) {
        o0 = __builtin_amdgcn_mfma_f32_32x32x16_bf16(va[0 + s2], pb[s2], o0, 0, 0, 0);
        o1 = __builtin_amdgcn_mfma_f32_32x32x16_bf16(va[2 + s2], pb[s2], o1, 0, 0, 0);
        o2 = __builtin_amdgcn_mfma_f32_32x32x16_bf16(va[4 + s2], pb[s2], o2, 0, 0, 0);
        o3 = __builtin_amdgcn_mfma_f32_32x32x16_bf16(va[6 + s2], pb[s2], o3, 0, 0, 0);
    }
}
__device__ __forceinline__ void glascan_wave(const Params& p, int unit, int dh, int lane, LAS unsigned char* ldsw);
__device__ void ph_attn(const Params& p, unsigned char* smb, const int wid0) {
    const int t = opaque_tid(wid0), lane = t & 63, l31 = lane & 31, hi = lane >> 5;
    const int w = __builtin_amdgcn_readfirstlane(t >> 6);
    LAS unsigned char* lds = (LAS unsigned char*)smb;
    for (int u0 = blockIdx.x; u0 < 256; u0 += gridDim.x) { const int unit = (((u0 & 7) + 8 * (u0 >> 7)) << 4) | ((u0 >> 3) & 15); glascan_wave(p, unit, w, lane, lds + w * 8192); }
    float* tab = (float*)(smb + 4 * 16384);
    for (int u0 = blockIdx.x; u0 < 256; u0 += gridDim.x) {
        const int u = (((u0 & 7) + 8 * (u0 >> 7)) << 4) | ((u0 >> 3) & 15);
        const int rg = u & 15, h = (u >> 4) & 7, b = u >> 7, bh8 = b * 8 + h;
        asm volatile("s_waitcnt vmcnt(0)" ::: "memory");
        __syncthreads();
        for (int i = t; i < 465; i += NT) tab[i] = p.na_rpb[h * 465 + i] * 1.4426950408889634f;
        const int r = 4 * rg + (w >> 1), qt = w & 1, c = 32 * qt + l31;
        const int rs = min(max(r - 4, 0), 56), cs = min(max(c - 8, 0), 48);
        const int Rlo = min(max(4 * rg - 4, 0), 56), Rhi = min(max(4 * rg - 1, 0), 56) + 7, nt = 8 + 2 * (Rhi - Rlo + 1);
        const int qrow = b * SEQ + r * 64 + c;
        bf16x8 qf[8];
#pragma unroll
        for (int ks = 0; ks < 8; ++ks) qf[ks] = *(const bf16x8*)(p.NQb + (size_t)qrow * 1024 + h * 128 + 16 * ks + 8 * hi);
#pragma unroll
        for (int ks = 0; ks < 8; ++ks) asm volatile("" : "+v"(qf[ks]));
        f32x16 o0, o1, o2, o3;
#pragma unroll
        for (int e = 0; e < 16; ++e) { o0[e] = 0.f; o1[e] = 0.f; o2[e] = 0.f; o3[e] = 0.f; }
        float m = -INFINITY, l = 0.f;
        const bf16_t* kg = p.NKf + ((size_t)bh8 * NTILE * 8 + w) * 512 + lane * 8;
        const bf16_t* vg = p.VTf + ((size_t)bh8 * NTILE * 8 + w) * 512 + lane * 8;
#define AT_T(i_) ((i_) < 8 ? (128 + (i_)) : (2 * Rlo + ((i_) - 8)))
#define AT_DMA(i_, st_) do { const int ii_ = (i_) < nt ? (i_) : nt - 1; const size_t to_ = (size_t)AT_T(ii_) * 4096; \
        __builtin_amdgcn_global_load_lds((const unsigned*)(kg + to_), (LAS unsigned*)(lds + (st_) * 16384 + w * 1024), 16, 0, 0); \
        __builtin_amdgcn_global_load_lds((const unsigned*)(vg + to_), (LAS unsigned*)(lds + (st_) * 16384 + 8192 + w * 1024), 16, 0, 0); } while (0)
        asm volatile("s_waitcnt vmcnt(0)" ::: "memory");
        __syncthreads();
        AT_DMA(0, 0); AT_DMA(1, 1); AT_DMA(2, 2);
        int st = 0;
#pragma unroll 1
        for (int i = 0; i < nt; ++i) {
            asm volatile("s_waitcnt vmcnt(4)" ::: "memory");
            __builtin_amdgcn_s_barrier();
            asm volatile("" ::: "memory");
            const int st2 = (st + 3) & 3;
            AT_DMA(i + 3, st2);
            const bool loc = i >= 8; const int R = Rlo + ((i - 8) >> 1), half = (i - 8) & 1;
            if (!loc || (unsigned)(R - rs) < 8u)
                attn_tile(lds + st * 16384 + lane * 16, tab, qf, o0, o1, o2, o3, m, l, loc, half, R - r + 7, c, cs, hi);
            st = (st + 1) & 3;
        }
#undef AT_T
#undef AT_DMA
        l += __shfl_xor(l, 32);
        const float inv = 1.f / l;
        bf16_t* orow = p.MIX + (size_t)qrow * D + h * 128 + 4 * hi;
#pragma unroll
        for (int g = 0; g < 4; ++g) {
            u32x2 pk;
            pk.x = cvt_pk_bf16(o0[4 * g] * inv, o0[4 * g + 1] * inv); pk.y = cvt_pk_bf16(o0[4 * g + 2] * inv, o0[4 * g + 3] * inv); *(u32x2*)(orow + 0 + 8 * g) = pk;
            pk.x = cvt_pk_bf16(o1[4 * g] * inv, o1[4 * g + 1] * inv); pk.y = cvt_pk_bf16(o1[4 * g + 2] * inv, o1[4 * g + 3] * inv); *(u32x2*)(orow + 32 + 8 * g) = pk;
            pk.x = cvt_pk_bf16(o2[4 * g] * inv, o2[4 * g + 1] * inv); pk.y = cvt_pk_bf16(o2[4 * g + 2] * inv, o2[4 * g + 3] * inv); *(u32x2*)(orow + 64 + 8 * g) = pk;
            pk.x = cvt_pk_bf16(o3[4 * g] * inv, o3[4 * g + 1] * inv); pk.y = cvt_pk_bf16(o3[4 * g + 2] * inv, o3[4 * g + 3] * inv); *(u32x2*)(orow + 96 + 8 * g) = pk;
        }
    }
    asm volatile("s_waitcnt vmcnt(0)" ::: "memory");
}

__device__ __forceinline__ float logsigf(float z) { return fminf(z, 0.f) - log1pf(expf(-fabsf(z))); }

__device__ __forceinline__ float fexp2(float x) { return __builtin_amdgcn_exp2f(x); }
__device__ __forceinline__ float logsig2_16(float z) { return (fminf(z, 0.f) * 1.4426950408889634f - __builtin_amdgcn_logf(1.f + fexp2(-fabsf(z) * 1.4426950408889634f))) * (1.f / 16.f); }

__device__ void ph_glaprep(const Params& p, float* sm, const int wid0) {
    const int t = opaque_tid(wid0), d2 = t & 63, tq = t >> 6, d = 2 * d2;
    float* qs = sm;
    float* ksm = sm + 8192;
    float* dds = sm + 16384;
    float* tot = sm + 16384 + 2048;
    for (int u = blockIdx.x; u < 8 * 68; u += gridDim.x) {
        const int bh = u / 68, c = u % 68, b = bh >> 2, h = bh & 3;
        const bool lat = c >= 4; const int j = c - 4;
        const int row0 = lat ? (b * SEQ + 64 * j) : (NLAT + b * CTXL + 64 * c);
        __syncthreads();
        {
            const int cq = t & 31, tr = t >> 5;
#pragma unroll
            for (int i = 0; i < 4; ++i) { const int tt = tr + 16 * i;
                if (lat) {
                    const u32x2 q4 = *(const u32x2*)(p.P + (size_t)(row0 + tt) * PLD + 3072 + h * 128 + 4 * cq), k4 = *(const u32x2*)(p.P + (size_t)(row0 + tt) * PLD + 3584 + h * 128 + 4 * cq);
                    *(float4*)(qs + tt * 128 + 4 * cq) = make_float4(bf2f(q4.x & 0xffffu), bf2f(q4.x >> 16), bf2f(q4.y & 0xffffu), bf2f(q4.y >> 16));
                    *(float4*)(ksm + tt * 128 + 4 * cq) = make_float4(bf2f(k4.x & 0xffffu), bf2f(k4.x >> 16), bf2f(k4.y & 0xffffu), bf2f(k4.y >> 16));
                } else {
                    const float* src = p.PS + (size_t)(row0 - NLAT + tt) * PSLD + 2048 + h * 128 + 4 * cq;
                    float4 kv = *(const float4*)src;
#pragma unroll
                    for (int s = 1; s < 4; ++s) { const float4 a0 = *(const float4*)(src + s * PS_SLAB); kv.x += a0.x; kv.y += a0.y; kv.z += a0.z; kv.w += a0.w; }
                    *(float4*)(qs + tt * 128 + 4 * cq) = make_float4(0.f, 0.f, 0.f, 0.f); *(float4*)(ksm + tt * 128 + 4 * cq) = kv;
                } }
            { const float* src = p.DDS + (size_t)row0 * 32 + 4 * t; float4 dv = *(const float4*)src;
#pragma unroll
              for (int s = 1; s < 4; ++s) { const float4 a0 = *(const float4*)(src + s * DD_SLAB); dv.x += a0.x; dv.y += a0.y; dv.z += a0.z; dv.w += a0.w; }
              *(float4*)(dds + 4 * t) = dv; }
        }
        __syncthreads();
        float gf0[8], gf1[8], gb0[8], gb1[8];
        {
            float uf0[16], uf1[16], ub0[16], ub1[16];
#pragma unroll
            for (int r = 0; r < 16; ++r) { const float2 a = *(const float2*)(p.up_f + r * 512 + h * 128 + d), bq = *(const float2*)(p.up_b + r * 512 + h * 128 + d); uf0[r] = a.x; uf1[r] = a.y; ub0[r] = bq.x; ub1[r] = bq.y; }
            const float2 bf = *(const float2*)(p.bias_f + h * 128 + d), bb = *(const float2*)(p.bias_b + h * 128 + d);
            float sf0 = 0.f, sf1 = 0.f, sb0 = 0.f, sb1 = 0.f;
#pragma unroll
            for (int i = 0; i < 8; ++i) {
                const float* dr = dds + (8 * tq + i) * 32; float zf0 = bf.x, zf1 = bf.y, zb0 = bb.x, zb1 = bb.y;
#pragma unroll
                for (int r = 0; r < 16; ++r) { const float x = dr[r], y = dr[16 + r]; zf0 += x * uf0[r]; zf1 += x * uf1[r]; zb0 += y * ub0[r]; zb1 += y * ub1[r]; }
                gf0[i] = logsig2_16(zf0); gf1[i] = logsig2_16(zf1); gb0[i] = logsig2_16(zb0); gb1[i] = logsig2_16(zb1);
                sf0 += gf0[i]; sf1 += gf1[i]; sb0 += gb0[i]; sb1 += gb1[i];
            }
            *(float2*)(tot + tq * 128 + d) = make_float2(sf0, sf1); *(float2*)(tot + (8 + tq) * 128 + d) = make_float2(sb0, sb1);
        }
        __syncthreads();
        float2 basef = make_float2(0.f, 0.f), baseb = basef, allf = basef, allb = basef;
#pragma unroll
        for (int q8 = 0; q8 < 8; ++q8) { const float2 a = *(const float2*)(tot + q8 * 128 + d), bq = *(const float2*)(tot + (8 + q8) * 128 + d);
            allf.x += a.x; allf.y += a.y; allb.x += bq.x; allb.y += bq.y;
            if (q8 < tq) { basef.x += a.x; basef.y += a.y; } if (q8 > tq) { baseb.x += bq.x; baseb.y += bq.y; } }
        { float r0 = basef.x, r1 = basef.y;
#pragma unroll
          for (int i = 0; i < 8; ++i) { r0 += gf0[i]; gf0[i] = r0; r1 += gf1[i]; gf1[i] = r1; }
          r0 = baseb.x; r1 = baseb.y;
#pragma unroll
          for (int i = 7; i >= 0; --i) { r0 += gb0[i]; gb0[i] = r0; r1 += gb1[i]; gb1[i] = r1; } }
        const int dd2 = d & 63, ii = dd2 & 31, partner = (dd2 < 32) ? (d + 32) : (d - 32);
        const float sgn = (dd2 < 32) ? -1.f : 1.f;
        unsigned khf0[4], khf1[4], khb0[4], khb1[4]; float pf0 = 0.f, pf1 = 0.f, pb0 = 0.f, pb1 = 0.f;
        const size_t tb = ((size_t)(bh * 64 + j) * 64) * 128;
#pragma unroll
        for (int i = 0; i < 8; ++i) {
            const int tt = 8 * tq + i;
            float2 qv = *(const float2*)(qs + tt * 128 + d), kv = *(const float2*)(ksm + tt * 128 + d);
            if (lat) {
                const int pos = (d < 64) ? j : tt;
                const float4 cssn = *(const float4*)(p.RT + (pos * 32 + ii) * 2);
                const float2 qp = *(const float2*)(qs + tt * 128 + partner), kp = *(const float2*)(ksm + tt * 128 + partner);
                qv.x = qv.x * cssn.x + sgn * qp.x * cssn.y; qv.y = qv.y * cssn.z + sgn * qp.y * cssn.w;
                kv.x = kv.x * cssn.x + sgn * kp.x * cssn.y; kv.y = kv.y * cssn.z + sgn * kp.y * cssn.w;
            }
            qv.x *= 0.08838834764831845f; qv.y *= 0.08838834764831845f;
            if (lat) {
                const float ef0 = fexp2(gf0[i]), ef1 = fexp2(gf1[i]), eb0 = fexp2(gb0[i]), eb1 = fexp2(gb1[i]);
                const float nf0 = fexp2(-gf0[i]), nf1 = fexp2(-gf1[i]), nb0 = fexp2(-gb0[i]), nb1 = fexp2(-gb1[i]);
                const size_t o = tb + (size_t)tt * 128 + d;
                *(unsigned*)(p.QF + o) = cvt_pk_bf16(qv.x * ef0, qv.y * ef1); *(unsigned*)(p.KF + o) = cvt_pk_bf16(kv.x * nf0, kv.y * nf1);
                *(unsigned*)(p.QB + o) = cvt_pk_bf16(qv.x * eb0, qv.y * eb1); *(unsigned*)(p.KB + o) = cvt_pk_bf16(kv.x * nb0, kv.y * nb1);
            }
            const float hf0 = kv.x * fexp2(allf.x - gf0[i]), hf1 = kv.y * fexp2(allf.y - gf1[i]), hb0 = kv.x * fexp2(allb.x - gb0[i]), hb1 = kv.y * fexp2(allb.y - gb1[i]);
            if (i & 1) { khf0[i >> 1] = cvt_pk_bf16(pf0, hf0); khf1[i >> 1] = cvt_pk_bf16(pf1, hf1); khb0[i >> 1] = cvt_pk_bf16(pb0, hb0); khb1[i >> 1] = cvt_pk_bf16(pb1, hb1); }
            else { pf0 = hf0; pf1 = hf1; pb0 = hb0; pb1 = hb1; }
        }
        {
            const size_t o = ((((size_t)(bh * 68 + c) * 8 + (d >> 4)) * 2 + (tq >> 2)) * 64 + (d & 15) + 16 * (tq & 3)) * 8;
            *(u32x4*)(p.KHF + o) = (u32x4){khf0[0], khf0[1], khf0[2], khf0[3]}; *(u32x4*)(p.KHF + o + 8) = (u32x4){khf1[0], khf1[1], khf1[2], khf1[3]};
            *(u32x4*)(p.KHB + o) = (u32x4){khb0[0], khb0[1], khb0[2], khb0[3]}; *(u32x4*)(p.KHB + o + 8) = (u32x4){khb1[0], khb1[1], khb1[2], khb1[3]};
            if (tq == 0) { *(float2*)(p.DF + (size_t)(bh * 68 + c) * 128 + d) = make_float2(fexp2(allf.x), fexp2(allf.y)); *(float2*)(p.DB + (size_t)(bh * 68 + c) * 128 + d) = make_float2(fexp2(allb.x), fexp2(allb.y)); }
        }
        {
            const int v = t & 255, half = t >> 8;
            unsigned pk[16];
#pragma unroll
            for (int s2 = 0; s2 < 16; ++s2) {
                float a, bq;
                if (lat) { a = bf2f(p.P[(size_t)(row0 + 32 * half + 2 * s2) * PLD + 4096 + h * 256 + v]); bq = bf2f(p.P[(size_t)(row0 + 32 * half + 2 * s2 + 1) * PLD + 4096 + h * 256 + v]); }
                else { const float* s0 = p.PS + (size_t)(row0 - NLAT + 32 * half + 2 * s2) * PSLD + 2560 + h * 256 + v;
                    a = s0[0] + s0[PS_SLAB] + s0[2 * PS_SLAB] + s0[3 * PS_SLAB]; bq = s0[PSLD] + s0[PS_SLAB + PSLD] + s0[2 * PS_SLAB + PSLD] + s0[3 * PS_SLAB + PSLD]; }
                pk[s2] = cvt_pk_bf16(a, bq);
            }
            bf16_t* o = p.VT + ((size_t)(bh * 68 + c) * 256 + v) * 64 + 32 * half;
            bf16_t* o2 = p.VTS + ((((size_t)(bh * 68 + c) * 16 + (v >> 4)) * 2 + half) * 64 + (v & 15)) * 8;
#pragma unroll
            for (int q4 = 0; q4 < 4; ++q4) { const u32x4 pv = (u32x4){pk[4 * q4], pk[4 * q4 + 1], pk[4 * q4 + 2], pk[4 * q4 + 3]}; *(u32x4*)(o + 8 * q4) = pv; *(u32x4*)(o2 + (16 * q4) * 8) = pv; }
        }
    }
}

__device__ __forceinline__ void glascan_wave(const Params& p, int unit, int dh, int lane, LAS unsigned char* ldsw) {
    const int v16 = unit & 15, scan = unit >> 4, dir = scan >> 3, bh = scan & 7;
    const int fr = lane & 15, fq = lane >> 4, d0 = 16 * dh, v0 = 16 * v16;
    const bf16_t* KH = (dir ? p.KHB : p.KHF) + (((size_t)bh * 68 * 8 + dh) * 2) * 512 + lane * 8;
    const bf16_t* VTp = p.VTS + (((size_t)bh * 68 * 16 + v16) * 2) * 512 + lane * 8;
    const float* DV = (dir ? p.DB : p.DF) + (size_t)bh * 68 * 128 + d0 + 4 * fq;
    bf16_t* SSp = p.SS + ((((size_t)dir * 8 + bh) * 65) * 256 + v0 + fr) * 128 + d0 + 4 * fq;
    LAS u32x2* sl = (LAS u32x2*)ldsw + lane;
    f32x4 acc = (f32x4){0.f, 0.f, 0.f, 0.f};
#define SC_CHUNK(n) (dir ? ((n) < 4 ? 3 - (n) : 71 - (n)) : (n))
#define SC_LOAD(S_, n) do { const int nn_ = (n) < 68 ? (n) : 67; const int c_ = SC_CHUNK(nn_); \
        S_##a0 = *(const bf16x8*)(KH + (size_t)c_ * 8192); S_##a1 = *(const bf16x8*)(KH + (size_t)c_ * 8192 + 512); \
        S_##b0 = *(const bf16x8*)(VTp + (size_t)c_ * 16384); S_##b1 = *(const bf16x8*)(VTp + (size_t)c_ * 16384 + 512); \
        S_##d = *(const f32x4*)(DV + (size_t)c_ * 128); } while (0)
#define SC_STEP(S_, k) do { u32x2 pk; pk.x = cvt_pk_bf16(acc[0], acc[1]); pk.y = cvt_pk_bf16(acc[2], acc[3]); sl[(k) * 64] = pk; \
        acc = acc * S_##d; \
        acc = __builtin_amdgcn_mfma_f32_16x16x32_bf16(S_##a0, S_##b0, acc, 0, 0, 0); acc = __builtin_amdgcn_mfma_f32_16x16x32_bf16(S_##a1, S_##b1, acc, 0, 0, 0); } while (0)
    bf16x8 Aa0, Aa1, Ab0, Ab1, Ba0, Ba1, Bb0, Bb1, Ca0, Ca1, Cb0, Cb1, Da0, Da1, Db0, Db1; f32x4 Ad, Bd, Cd, Dd;
    SC_LOAD(A, 0); SC_LOAD(B, 1); SC_LOAD(C, 2);
#pragma unroll 1
    for (int nb = 0; nb < 68; nb += 16) {
        const int iters = (nb + 16 <= 68) ? 4 : 1;
#pragma unroll 1
        for (int it = 0; it < iters; ++it) {
            const int n = nb + 4 * it;
            SC_LOAD(D, n + 3); SC_STEP(A, 4 * it);
            SC_LOAD(A, n + 4); SC_STEP(B, 4 * it + 1);
            SC_LOAD(B, n + 5); SC_STEP(C, 4 * it + 2);
            SC_LOAD(C, n + 6); SC_STEP(D, 4 * it + 3);
        }
#pragma unroll 1
        for (int k = 0; k < 4 * iters; ++k) { const int c_ = SC_CHUNK(nb + k); *(u32x2*)(SSp + (size_t)(c_ >= 4 ? c_ - 4 : 64) * 256 * 128) = sl[k * 64]; }
    }
#undef SC_CHUNK
#undef SC_LOAD
#undef SC_STEP
}

__device__ void ph_glaout(const Params& p, unsigned char* smb, const int wid0) {
    const int t = opaque_tid(wid0), w = t >> 6, lane = t & 63, l31 = lane & 31, hi = lane >> 5;
    const int wv = w & 3, wt = w >> 2;
    bf16_t* att = (bf16_t*)smb;
    float* ssq = (float*)(smb + 2 * 64 * 144);
    for (int u = blockIdx.x; u < 512; u += gridDim.x) {
        const int bh = u >> 6, j = u & 63, b = bh >> 2, h = bh & 3;
        const size_t tb = ((size_t)(bh * 64 + j) * 64) * 128;
        {
            const int dir = w >> 2, ts = (w >> 1) & 1, tt = w & 1;
            const bf16_t* Qm = (dir ? p.QB : p.QF) + tb; const bf16_t* Km = (dir ? p.KB : p.KF) + tb;
            const bool zero = dir ? (ts < tt) : (ts > tt);
            f32x16 s;
#pragma unroll
            for (int r = 0; r < 16; ++r) s[r] = 0.f;
            if (!zero) {
#pragma unroll
                for (int ks = 0; ks < 8; ++ks) {
                    const bf16x8 ka = *(const bf16x8*)(Km + (size_t)(32 * ts + l31) * 128 + 16 * ks + 8 * hi);
                    const bf16x8 qb = *(const bf16x8*)(Qm + (size_t)(32 * tt + l31) * 128 + 16 * ks + 8 * hi);
                    s = __builtin_amdgcn_mfma_f32_32x32x16_bf16(ka, qb, s, 0, 0, 0);
                }
            }
            const int tcol = 32 * tt + l31;
#pragma unroll
            for (int g = 0; g < 4; ++g) {
                float vv[4];
#pragma unroll
                for (int e = 0; e < 4; ++e) { const int srow = 32 * ts + 8 * g + 4 * hi + e; const bool keep = dir ? (srow >= tcol) : (srow <= tcol); vv[e] = keep ? s[4 * g + e] : 0.f; }
                u32x2 pk; pk.x = cvt_pk_bf16(vv[0], vv[1]); pk.y = cvt_pk_bf16(vv[2], vv[3]);
                *(u32x2*)(att + ((size_t)dir * 64 + tcol) * 72 + 32 * ts + 8 * g + 4 * hi) = pk;
            }
        }
        __syncthreads();
        f32x16 o0, o1;
#pragma unroll
        for (int r = 0; r < 16; ++r) { o0[r] = 0.f; o1[r] = 0.f; }
        const int tB = 32 * wt + l31;
        const bf16_t* vt0 = p.VT + ((size_t)(bh * 68 + 4 + j) * 256 + 64 * wv + l31) * 64 + 8 * hi;
#pragma unroll
        for (int dir = 0; dir < 2; ++dir) {
#pragma unroll
            for (int ks = 0; ks < 4; ++ks) {
                const bf16x8 bb = *(const bf16x8*)(att + ((size_t)dir * 64 + tB) * 72 + 16 * ks + 8 * hi);
                const bf16x8 a0 = *(const bf16x8*)(vt0 + 16 * ks), a1 = *(const bf16x8*)(vt0 + 32 * 64 + 16 * ks);
                o0 = __builtin_amdgcn_mfma_f32_32x32x16_bf16(a0, bb, o0, 0, 0, 0);
                o1 = __builtin_amdgcn_mfma_f32_32x32x16_bf16(a1, bb, o1, 0, 0, 0);
            }
            const bf16_t* ss0 = p.SS + ((((size_t)dir * 8 + bh) * 65 + j) * 256 + 64 * wv + l31) * 128 + 8 * hi;
            const bf16_t* qm = (dir ? p.QB : p.QF) + tb + (size_t)tB * 128 + 8 * hi;
#pragma unroll
            for (int ks = 0; ks < 8; ++ks) {
                const bf16x8 bb = *(const bf16x8*)(qm + 16 * ks);
                const bf16x8 a0 = *(const bf16x8*)(ss0 + 16 * ks), a1 = *(const bf16x8*)(ss0 + 32 * 128 + 16 * ks);
                o0 = __builtin_amdgcn_mfma_f32_32x32x16_bf16(a0, bb, o0, 0, 0, 0);
                o1 = __builtin_amdgcn_mfma_f32_32x32x16_bf16(a1, bb, o1, 0, 0, 0);
            }
        }
        float ss = 0.f;
#pragma unroll
        for (int r = 0; r < 16; ++r) ss += o0[r] * o0[r] + o1[r] * o1[r];
        ss += __shfl_xor(ss, 32);
        if (hi == 0) ssq[(wt * 4 + wv) * 32 + l31] = ss;
        __syncthreads();
        const float tot = ssq[(wt * 4 + 0) * 32 + l31] + ssq[(wt * 4 + 1) * 32 + l31] + ssq[(wt * 4 + 2) * 32 + l31] + ssq[(wt * 4 + 3) * 32 + l31];
        const float rstd = rsqrtf(tot * (1.f / 256.f) + 1e-6f);
        const int row = b * SEQ + 64 * j + tB;
        f32x4 gateA[2][4], gnA[2][4];
#pragma unroll
        for (int vt = 0; vt < 2; ++vt)
#pragma unroll
            for (int g = 0; g < 4; ++g) { const int v = 64 * wv + 32 * vt + 8 * g + 4 * hi;
                const u32x2 g4 = *(const u32x2*)(p.P + (size_t)row * PLD + 5120 + h * 256 + v);
                gateA[vt][g] = (f32x4){bf2f(g4.x & 0xffffu), bf2f(g4.x >> 16), bf2f(g4.y & 0xffffu), bf2f(g4.y >> 16)}; gnA[vt][g] = *(const f32x4*)(p.gla_norm_g + v); }
#pragma unroll
        for (int vt = 0; vt < 2; ++vt)
#pragma unroll
            for (int g = 0; g < 4; ++g) {
                const int v = 64 * wv + 32 * vt + 8 * g + 4 * hi;
                const f32x4 gate = gateA[vt][g], gn = gnA[vt][g];
                float ov[4];
#pragma unroll
                for (int e = 0; e < 4; ++e) { const float x = vt ? o1[4 * g + e] : o0[4 * g + e];
                    ov[e] = x * rstd * gn[e] * gate[e] * __builtin_amdgcn_rcpf(1.f + __builtin_amdgcn_exp2f(-1.4426950408889634f * gate[e])); }
                u32x2 pk; pk.x = cvt_pk_bf16(ov[0], ov[1]); pk.y = cvt_pk_bf16(ov[2], ov[3]);
                *(u32x2*)(p.MIX + (size_t)row * D + 1024 + h * 256 + v) = pk;
            }
        __syncthreads();
    }
}

__device__ void ph_norm2_router(const Params& p, float* sm, const int wid0) {
    const int t = opaque_tid(wid0), w = t >> 6, lane = t & 63;
    float* hs = sm;
    float* part = sm + 8 * D;
    int* hist = (int*)(sm + 8 * D + 8 * 8 * 64);
    const int G = gridDim.x, gpb = (NLAT / 8 + G - 1) / G;
    if (t < 64) hist[t] = 0;
    const int rb0 = blockIdx.x * gpb, rb1 = min(NLAT / 8, rb0 + gpb);
    float4 v[8];
    if (rb0 < rb1) {
#pragma unroll
        for (int j = 0; j < 8; ++j) v[j] = *(const float4*)(p.X1 + (size_t)(rb0 * 8 + w) * D + 256 * j + 4 * lane);
    }
    for (int rb = rb0; rb < rb1; ++rb) {
        const int row = rb * 8 + w, b = row / SEQ;
        const float* m = p.mod + (size_t)b * 6 * D;
        float ss = 0.f;
#pragma unroll
        for (int j = 0; j < 8; ++j) ss += v[j].x * v[j].x + v[j].y * v[j].y + v[j].z * v[j].z + v[j].w * v[j].w;
        ss = wave_sum(ss);
        const float rs = rsqrtf(ss * (1.f / D) + 1e-6f);
        __syncthreads();
#pragma unroll
        for (int j = 0; j < 8; ++j) {
            const int col = 256 * j + 4 * lane;
            const float4 g = *(const float4*)(p.norm2_g + col), sh = *(const float4*)(m + 3 * D + col), sc = *(const float4*)(m + 4 * D + col);
            float4 o;
            o.x = v[j].x * rs * g.x * (1.f + sc.x) + sh.x; o.y = v[j].y * rs * g.y * (1.f + sc.y) + sh.y;
            o.z = v[j].z * rs * g.z * (1.f + sc.z) + sh.z; o.w = v[j].w * rs * g.w * (1.f + sc.w) + sh.w;
            *(float4*)(hs + w * D + col) = o;
            u32x2 pk; pk.x = cvt_pk_bf16(o.x, o.y); pk.y = cvt_pk_bf16(o.z, o.w);
            *(u32x2*)(p.H + (size_t)row * D + col) = pk;
        }
        if (rb + 1 < rb1) {
#pragma unroll
            for (int j = 0; j < 8; ++j) v[j] = *(const float4*)(p.X1 + (size_t)(row + 8) * D + 256 * j + 4 * lane);
        }
        __syncthreads();
        {
            const int e4 = t & 15, kp = t >> 4;
            float a[8][4];
#pragma unroll
            for (int r = 0; r < 8; ++r)
#pragma unroll
                for (int j = 0; j < 4; ++j) a[r][j] = 0.f;
#pragma unroll 4
            for (int kk = 0; kk < 64; ++kk) {
                const int k = kk * 32 + kp;
                const float4 wv = *(const float4*)(p.router_w + (size_t)k * NE + 4 * e4);
#pragma unroll
                for (int r = 0; r < 8; ++r) { const float hv = hs[r * D + k]; a[r][0] += hv * wv.x; a[r][1] += hv * wv.y; a[r][2] += hv * wv.z; a[r][3] += hv * wv.w; }
            }
#pragma unroll
            for (int r = 0; r < 8; ++r)
#pragma unroll
                for (int j = 0; j < 4; ++j) { float x = a[r][j]; x += __shfl_xor(x, 16); x += __shfl_xor(x, 32); a[r][j] = x; }
            if (lane < 16) {
#pragma unroll
                for (int r = 0; r < 8; ++r) *(float4*)(part + (w * 8 + r) * 64 + 4 * lane) = make_float4(a[r][0], a[r][1], a[r][2], a[r][3]);
            }
        }
        __syncthreads();
        {
            float lgt = 0.f;
#pragma unroll
            for (int i = 0; i < 8; ++i) lgt += part[(i * 8 + w) * 64 + lane];
            const float sc = 1.f / (1.f + expf(-lgt));
            const float bs = sc + p.router_bias[lane];
            float m1 = bs; m1 = fmaxf(m1, __shfl_xor(m1, 1)); m1 = fmaxf(m1, __shfl_xor(m1, 2)); m1 = fmaxf(m1, __shfl_xor(m1, 4));
            int ai = (bs == m1) ? lane : 64; ai = min(ai, __shfl_xor(ai, 1)); ai = min(ai, __shfl_xor(ai, 2)); ai = min(ai, __shfl_xor(ai, 4));
            float m2 = (lane == ai) ? -INFINITY : bs; m2 = fmaxf(m2, __shfl_xor(m2, 1)); m2 = fmaxf(m2, __shfl_xor(m2, 2)); m2 = fmaxf(m2, __shfl_xor(m2, 4));
            const float gs = m1 + m2;
            float g0 = __shfl(gs, 0), g1 = __shfl(gs, 8), g2 = __shfl(gs, 16), g3 = __shfl(gs, 24), g4 = __shfl(gs, 32), g5 = __shfl(gs, 40), g6 = __shfl(gs, 48), g7 = __shfl(gs, 56);
            unsigned selmask = 0u;
#pragma unroll
            for (int it = 0; it < 4; ++it) {
                float best = -INFINITY; int bi = 0;
                if (!(selmask & 1u) && g0 > best) { best = g0; bi = 0; }
                if (!(selmask & 2u) && g1 > best) { best = g1; bi = 1; }
                if (!(selmask & 4u) && g2 > best) { best = g2; bi = 2; }
                if (!(selmask & 8u) && g3 > best) { best = g3; bi = 3; }
                if (!(selmask & 16u) && g4 > best) { best = g4; bi = 4; }
                if (!(selmask & 32u) && g5 > best) { best = g5; bi = 5; }
                if (!(selmask & 64u) && g6 > best) { best = g6; bi = 6; }
                if (!(selmask & 128u) && g7 > best) { best = g7; bi = 7; }
                selmask |= 1u << bi;
            }
            float cand = ((selmask >> (lane >> 3)) & 1u) ? bs : -INFINITY;
            int myslot = -1; float ssum = 0.f;
#pragma unroll
            for (int k = 0; k < TOPK; ++k) {
                const float mv = wave_max(cand);
                const int idx = wave_min_i((cand == mv) ? lane : 64);
                const float sv = __shfl(sc, idx);
                ssum += sv;
                if (lane == idx) { myslot = k; cand = -INFINITY; }
            }
            if (myslot >= 0) {
                p.EIDX[row * TOPK + myslot] = lane;
                p.EW[row * TOPK + myslot] = sc / ssum * 2.5f;
                p.LRANK[row * TOPK + myslot] = atomicAdd(&hist[lane], 1);
            }
        }
    }
    __syncthreads();
    if (t < 64) p.CNTB[blockIdx.x * 64 + t] = hist[t];
}

__device__ void ph_lists(const Params& p, int* smi, const int wid0) {
    const int t = opaque_tid(wid0);
    const int G = gridDim.x, gpb = (NLAT / 8 + G - 1) / G;
    int* tp = smi + 128; int* tot = smi + 64;
    __syncthreads();
    if (t < 64) {
        int before = 0, all = 0;
        for (int bb = 0; bb < G; ++bb) { const int cnt = p.CNTB[bb * 64 + t]; all += cnt; if (bb < (int)blockIdx.x) before += cnt; }
        smi[t] = before; tot[t] = all;
        if (blockIdx.x == 0) p.CNT[t] = all;
    }
    __syncthreads();
    if (t == 0) { int tt = 0; for (int e = 0; e < NE; ++e) { tp[e] = tt; tt += (tot[e] + 255) / 256; } tp[NE] = tt; }
    __syncthreads();
    const int r0 = blockIdx.x * gpb * 8, r1 = min(NLAT, r0 + gpb * 8);
    for (int i = r0 * TOPK + t; i < r1 * TOPK; i += NT) {
        const int e = p.EIDX[i];
        const int pos = tp[e] * 256 + smi[e] + p.LRANK[i];
        p.PAIRPOS[i] = pos; p.LIST[pos] = i / TOPK;
    }
    for (int e = blockIdx.x; e < NE; e += G) {
        const int cn = tot[e], end = (tp[e + 1] - tp[e]) * 256;
        for (int i = cn + t; i < end; i += NT) p.LIST[tp[e] * 256 + i] = 0;
    }
}

__device__ void ph_combine(const Params& p, const int wid0) {
    const int t = opaque_tid(wid0), w = t >> 6, lane = t & 63;
    for (int row = blockIdx.x * 8 + w; row < NLAT; row += gridDim.x * 8) {
        const int b = row / SEQ;
        float wk[TOPK]; const bf16_t* yr[TOPK];
#pragma unroll
        for (int k = 0; k < TOPK; ++k) { wk[k] = p.EW[row * TOPK + k]; yr[k] = p.Y + (size_t)p.PAIRPOS[row * TOPK + k] * D + 8 * lane; }
        const bf16_t* ys = p.YS + (size_t)row * D + 8 * lane;
        const float* x1 = p.X1 + (size_t)row * D + 8 * lane;
        const float* g2 = p.mod + (size_t)b * 6 * D + 5 * D + 8 * lane;
        float* o = p.out + (size_t)row * D + 8 * lane;
#pragma unroll
        for (int j = 0; j < 4; ++j) {
            float s[8];
            { const u32x4 v = *(const u32x4*)(ys + 512 * j);
              s[0] = bf2f(v.x & 0xffffu); s[1] = bf2f(v.x >> 16); s[2] = bf2f(v.y & 0xffffu); s[3] = bf2f(v.y >> 16); s[4] = bf2f(v.z & 0xffffu); s[5] = bf2f(v.z >> 16); s[6] = bf2f(v.w & 0xffffu); s[7] = bf2f(v.w >> 16); }
#pragma unroll
            for (int k = 0; k < TOPK; ++k) {
                const u32x4 v = *(const u32x4*)(yr[k] + 512 * j); const float wv = wk[k];
                s[0] += wv * bf2f(v.x & 0xffffu); s[1] += wv * bf2f(v.x >> 16); s[2] += wv * bf2f(v.y & 0xffffu); s[3] += wv * bf2f(v.y >> 16);
                s[4] += wv * bf2f(v.z & 0xffffu); s[5] += wv * bf2f(v.z >> 16); s[6] += wv * bf2f(v.w & 0xffffu); s[7] += wv * bf2f(v.w >> 16);
            }
            const f32x4 xa = *(const f32x4*)(x1 + 512 * j), xb = *(const f32x4*)(x1 + 512 * j + 4), ga = *(const f32x4*)(g2 + 512 * j), gb = *(const f32x4*)(g2 + 512 * j + 4);
            *(f32x4*)(o + 512 * j) = (f32x4){xa[0] + ga[0] * s[0], xa[1] + ga[1] * s[1], xa[2] + ga[2] * s[2], xa[3] + ga[3] * s[3]};
            *(f32x4*)(o + 512 * j + 4) = (f32x4){xb[0] + gb[0] * s[4], xb[1] + gb[1] * s[5], xb[2] + gb[2] * s[6], xb[3] + gb[3] * s[7]};
        }
    }
}

__global__ void __launch_bounds__(NT, 2) mega(Params p) {
    extern __shared__ __attribute__((aligned(16))) unsigned char dynlds[];
    int wid0;
    wid0 = __builtin_amdgcn_readfirstlane((int)threadIdx.x >> 6); asm volatile("" : "+s"(wid0));
    if (wid0 == 0 && xb_lane_id() < 4) ((unsigned*)(dynlds + LDS_BARW))[xb_lane_id()] = 0u;
    __syncthreads();
    XcdBarrier bar = xcd_barrier_post(p.bar, (volatile LAS unsigned*)(dynlds + LDS_BARW), wid0);
    float* sm = (float*)dynlds;
    int* tp = (int*)(dynlds + LDS_TAB);
    LAS unsigned char* lds = (LAS unsigned char*)dynlds;
    const int G = gridDim.x, c = blockIdx.x;

#ifndef REP
#define REP 0
#endif
#define PH(bit, ...) do { __VA_ARGS__; if (REP & (1 << (bit))) { xcd_barrier(bar); __VA_ARGS__; } } while (0)
    PH(0, ph_prologue(p, sm, wid0));                            xcd_barrier(bar);
    PH(1, ph_norm1(p, wid0));                               xcd_barrier(bar);
    { SchedDense S{(const char*)p.H, (const char*)p.WinT, D, NLAT / 256, PLD / 256, G, c}; EpiInproj E{p.P};
      g8::gemm_phase(lds, D, S, E, wid0); }
    { SchedInprojSplit S{(const char*)p.H, (const char*)p.WinT, G, c}; EpiInprojSplit E{p.PS, p.DDS};
      g8::gemm_phase(lds, D, S, E, wid0, 512); }                xcd_barrier(bar);
    PH(3, ph_naprep(p, wid0)); PH(4, ph_glaprep(p, sm, wid0));        xcd_barrier(bar);
    PH(6, ph_attn(p, dynlds, wid0));                            xcd_barrier(bar);
    PH(7, ph_glaout(p, dynlds, wid0));                          xcd_barrier(bar);
    PH(8, { SchedDense S{(const char*)p.MIX, (const char*)p.WoutT, D, NLAT / 256, D / 256, G, c}; EpiOutproj E{p.x, p.mod, p.X1};
      g8::gemm_phase(lds, D, S, E, wid0); });                   xcd_barrier(bar);
    PH(12, ph_norm2_router(p, sm, wid0));                       xcd_barrier(bar);
    PH(13, ph_lists(p, tp, wid0));                              xcd_barrier(bar);
    moe_tables(p, tp, wid0);
    PH(9, { SchedUp S{tp, (const char*)p.H, p.LIST, (const char*)p.E13T, (const char*)p.S13T, G, c}; EpiUp E{p.HB, p.SHH};
      g8::gemm_phase(lds, D, S, E, wid0); });                   xcd_barrier(bar);
    PH(10, { SchedDown S{tp, (const char*)p.HB, (const char*)p.E2T, (const char*)p.SHH, (const char*)p.S2T, G, c}; EpiDown E{p.Y, p.YS};
      g8::gemm_phase(lds, DE, S, E, wid0); });                  xcd_barrier(bar);
    PH(11, ph_combine(p, wid0));
}

extern "C" void kernel_launch(void* const* d_in, const int* in_sizes, int n_in, void* d_out, int out_size, void* d_ws, size_t ws_size, hipStream_t stream) {
    Params p{};
    const float* const* in = (const float* const*)d_in;
    p.x = in[0]; p.c = in[1]; p.ctx = in[2]; p.c_ctx = in[3]; p.w_mod = in[4]; p.b_mod = in[5]; p.norm1_g = in[6]; p.norm2_g = in[7]; p.w_in = in[8];
    p.q_norm_g = in[9]; p.k_norm_g = in[10]; p.na_rpb = in[11]; p.up_f = in[12]; p.bias_f = in[13]; p.up_b = in[14]; p.bias_b = in[15]; p.gla_norm_g = in[16];
    p.w_out = in[17]; p.router_w = in[18]; p.router_bias = in[19]; p.ew1 = in[20]; p.ew3 = in[21]; p.ew2 = in[22]; p.sw1 = in[23]; p.sw3 = in[24]; p.sw2 = in[25];
    p.out = (float*)d_out;
    char* w = (char*)d_ws; size_t o = 0;
    auto take = [&](size_t bytes) { void* r = w + o; o += (bytes + 255) & ~(size_t)255; return r; };
    p.bar = (unsigned*)take((size_t)XCD_BAR_WORDS * 4);
    p.CNT = (int*)take(64 * 4); p.QCTR = (int*)take(64 * 4); p.LRANK = (int*)take((size_t)NPAIR * 4); p.CNTB = (int*)take((size_t)1024 * 64 * 4);
    p.mod = (float*)take((size_t)3 * 6 * D * 4); p.RT = (float*)take((size_t)64 * 32 * 2 * 4);
    p.EIDX = (int*)take((size_t)NPAIR * 4); p.EW = (float*)take((size_t)NPAIR * 4); p.PAIRPOS = (int*)take((size_t)NPAIR * 4); p.LIST = (int*)take((size_t)PADROWS * 4);
    p.WinT = (bf16_t*)take((size_t)(PLD + 256) * D * 2); p.WoutT = (bf16_t*)take((size_t)D * D * 2); p.S13T = (bf16_t*)take((size_t)1024 * D * 2); p.S2T = (bf16_t*)take((size_t)D * DE * 2);
    p.E13T = (bf16_t*)take((size_t)NE * 1024 * D * 2); p.E2T = (bf16_t*)take((size_t)NE * D * DE * 2);
    p.H = (bf16_t*)take((size_t)NROW * D * 2);
    p.X1 = (float*)take((size_t)NLAT * D * 4);
    const size_t big = o;
    p.P = (bf16_t*)take((size_t)NLAT * PLD * 2); p.PS = (float*)take(4 * PS_SLAB * 4); p.DDS = (float*)take(4 * DD_SLAB * 4); p.NQb = (bf16_t*)take((size_t)NLAT * 1024 * 2); p.NKf = (bf16_t*)take((size_t)16 * NTILE * 4096 * 2); p.VTf = (bf16_t*)take((size_t)16 * NTILE * 4096 * 2);
    p.MIX = (bf16_t*)take((size_t)NLAT * D * 2);
    p.QF = (bf16_t*)take((size_t)8 * 64 * 64 * 128 * 2); p.KF = (bf16_t*)take((size_t)8 * 64 * 64 * 128 * 2); p.QB = (bf16_t*)take((size_t)8 * 64 * 64 * 128 * 2); p.KB = (bf16_t*)take((size_t)8 * 64 * 64 * 128 * 2);
    p.KHF = (bf16_t*)take((size_t)8 * 68 * 128 * 64 * 2); p.KHB = (bf16_t*)take((size_t)8 * 68 * 128 * 64 * 2); p.VT = (bf16_t*)take((size_t)8 * 68 * 256 * 64 * 2); p.VTS = (bf16_t*)take((size_t)8 * 68 * 256 * 64 * 2);
    p.DF = (float*)take((size_t)8 * 68 * 128 * 4); p.DB = (float*)take((size_t)8 * 68 * 128 * 4); p.SS = (bf16_t*)take((size_t)16 * 65 * 256 * 128 * 2);
    o = big;
    p.HB = (bf16_t*)take((size_t)PADROWS * DE * 2); p.SHH = (bf16_t*)take((size_t)NLAT * DE * 2); p.Y = (bf16_t*)take((size_t)PADROWS * D * 2); p.YS = (bf16_t*)take((size_t)NLAT * D * 2);
    static int grid = 0;
    if (!grid) {
        int dev = 0, cus = 0, per_cu = 0;
        hipGetDevice(&dev);
        hipDeviceGetAttribute(&cus, hipDeviceAttributeMultiprocessorCount, dev);
        (void)hipFuncSetAttribute((const void*)mega, hipFuncAttributeMaxDynamicSharedMemorySize, LDS_BYTES);
        (void)hipOccupancyMaxActiveBlocksPerMultiprocessor(&per_cu, (const void*)mega, NT, LDS_BYTES);
        (void)hipGetLastError();
        grid = cus;
    }
    (void)hipMemsetAsync(p.bar, 0, (size_t)XCD_BAR_WORDS * 4, stream);
    hipLaunchKernelGGL(mega, dim3(grid), dim3(NT), LDS_BYTES, stream, p);
}
```

```cpp
#include <hip/hip_runtime.h>
#include <stdint.h>

#define XB_TMO      128
#define XB_XCNT(j)  (256  + 64 * (j))
#define XB_XSUB(j)  (1280 + 64 * (j))
#define XB_XGEN(j)  (2304 + 64 * (j))
#define XB_TOP      3328
#define XB_TOPGEN   3392
#define XCD_BAR_WORDS 3456
#define XB_SPIN_CAP (1u << 18)
#define LAS __attribute__((address_space(3)))

__device__ __forceinline__ unsigned xb_ld(unsigned* p)              { return __hip_atomic_load(p, __ATOMIC_RELAXED, __HIP_MEMORY_SCOPE_AGENT); }
__device__ __forceinline__ unsigned xb_add(unsigned* p, unsigned v) { return __hip_atomic_fetch_add(p, v, __ATOMIC_RELAXED, __HIP_MEMORY_SCOPE_AGENT); }
__device__ __forceinline__ unsigned xb_xcc_id() { return (unsigned)__builtin_amdgcn_s_getreg((3 << 11) | 20) & 0xFu; }
#define XB_SPIN(cond, bar) do { unsigned _sp = 0; while (cond) { __builtin_amdgcn_s_sleep(1); \
    if ((++_sp & 255u) == 0u) { if (xb_ld(&(bar)[XB_TMO])) break; if (_sp > XB_SPIN_CAP) { atomicAdd(&(bar)[XB_TMO], 1u); break; } } } } while (0)

__device__ __forceinline__ int xb_lane_id() { return (int)__builtin_amdgcn_mbcnt_hi(~0u, __builtin_amdgcn_mbcnt_lo(~0u, 0u)); }
struct XcdBarrier {
    int wid;
    unsigned* bar; unsigned x;
    volatile LAS unsigned* st;
};

__device__ __forceinline__ XcdBarrier xcd_barrier_post(unsigned* bar, volatile LAS unsigned* st, int wid) {
    XcdBarrier b; b.wid = wid; b.bar = bar; b.x = xb_xcc_id(); b.st = st;
    if (wid == 0 && xb_lane_id() == 0) (void)xb_add(&bar[XB_XCNT(b.x)], 1u);
    return b;
}
__device__ __forceinline__ void xcd_barrier_complete(unsigned* bar, unsigned x, unsigned& nloc, unsigned& nx) {
    const unsigned G = gridDim.x * gridDim.y * gridDim.z;
    unsigned sum, cnt, mine, sp = 0u;
    for (;;) {
        sum = 0u; cnt = 0u; mine = 0u;
#pragma unroll
        for (unsigned j = 0; j < 16; ++j) { const unsigned c = xb_ld(&bar[XB_XCNT(j)]); sum += c; cnt += (c > 0u) ? 1u : 0u; mine = (j == x) ? c : mine; }
        if (sum == G) break;
        __builtin_amdgcn_s_sleep(1);
        if ((++sp & 255u) == 0u) { if (xb_ld(&bar[XB_TMO])) break; if (sp > XB_SPIN_CAP) { atomicAdd(&bar[XB_TMO], 1u); break; } }
    }
    nloc = mine > 0u ? mine : 1u; nx = cnt > 0u ? cnt : 1u;
}

__device__ __forceinline__ void xcd_barrier(const XcdBarrier& b) {
    asm volatile("s_waitcnt vmcnt(0)" ::: "memory");
    __syncthreads();
    if (b.wid == 0 && xb_lane_id() == 0) {
        unsigned* bar = b.bar;
        __builtin_amdgcn_s_waitcnt(0);
        unsigned nloc = b.st[0], nx = b.st[1];
        if (nloc == 0u) { xcd_barrier_complete(bar, b.x, nloc, nx); b.st[0] = nloc; b.st[1] = nx; }
        const unsigned old = xb_add(&bar[XB_XSUB(b.x)], 1u);
        const unsigned gen = old / nloc;
        if (old + 1u == (gen + 1u) * nloc) {
            __builtin_amdgcn_fence(__ATOMIC_RELEASE, "agent");
            asm volatile("s_waitcnt vmcnt(0)" ::: "memory");
            const unsigned og = xb_add(&bar[XB_TOP], 1u);
            const unsigned tg = og / nx;
            if (og + 1u == (tg + 1u) * nx) xb_add(&bar[XB_TOPGEN], 1u);
            else XB_SPIN(xb_ld(&bar[XB_TOPGEN]) == tg, bar);
            __builtin_amdgcn_fence(__ATOMIC_ACQUIRE, "agent");
            xb_add(&bar[XB_XGEN(b.x)], 1u);
            asm volatile("s_waitcnt vmcnt(0)" ::: "memory");
        } else {
            XB_SPIN(xb_ld(&bar[XB_XGEN(b.x)]) == gen, bar);
            __builtin_amdgcn_fence(__ATOMIC_ACQUIRE, "agent");
            asm volatile("s_waitcnt vmcnt(0)" ::: "memory");
        }
    }
    __syncthreads();
}


#define NT 512
typedef unsigned short bf16_t;
typedef short bf16x8 __attribute__((ext_vector_type(8)));
typedef float f32x4 __attribute__((ext_vector_type(4)));
typedef float f32x16 __attribute__((ext_vector_type(16)));
typedef unsigned u32x4 __attribute__((ext_vector_type(4)));
typedef unsigned u32x2 __attribute__((ext_vector_type(2)));

constexpr int D = 2048, SEQ = 4096, CTXL = 256, NB = 2;
constexpr int NLAT = NB * SEQ;
constexpr int NCTX = NB * CTXL;
constexpr int NROW = NLAT + NCTX;
constexpr int INC = 6176;
constexpr int PLD = 6144;
constexpr int PSLD = 3584;
constexpr size_t PS_SLAB = (size_t)512 * 3584, DD_SLAB = (size_t)8704 * 32;
constexpr int NE = 64, TOPK = 6, DE = 512;
constexpr int NPAIR = NLAT * TOPK;
constexpr int PADROWS = NPAIR + NE * 256;
constexpr int LDS_STAGE = 131072;
constexpr int LDS_TAB = LDS_STAGE;
constexpr int LDS_BARW = LDS_STAGE + 4096;
constexpr int LDS_BYTES = LDS_BARW + 16 + 8192;

struct Params {
    const float *x, *c, *ctx, *c_ctx, *w_mod, *b_mod, *norm1_g, *norm2_g, *w_in, *q_norm_g, *k_norm_g, *na_rpb,
        *up_f, *bias_f, *up_b, *bias_b, *gla_norm_g, *w_out, *router_w, *router_bias, *ew1, *ew3, *ew2, *sw1, *sw3, *sw2;
    float* out;
    float *mod, *X1, *PS, *DDS, *EW, *RT, *DF, *DB;
    bf16_t *P, *H, *MIX, *HB, *SHH, *Y, *WinT, *WoutT, *S13T, *S2T, *E13T, *E2T, *QF, *KF, *QB, *KB, *KHF, *KHB, *VT, *SS, *NQb, *NKf, *VTf, *YS, *VTS;
    int *EIDX, *PAIRPOS, *LIST, *CNT, *QCTR, *LRANK, *CNTB;
    unsigned* bar;
};

__device__ __forceinline__ int fresh_lane_id() { int l; asm volatile("v_mbcnt_lo_u32_b32 %0, -1, 0\n\tv_mbcnt_hi_u32_b32 %0, -1, %0" : "=v"(l)); return l; }
__device__ __forceinline__ int opaque_tid(int wid0) { return wid0 * 64 + fresh_lane_id(); }
__device__ __forceinline__ float wave_sum(float v) { for (int o = 32; o > 0; o >>= 1) v += __shfl_xor(v, o); return v; }
__device__ __forceinline__ float wave_max(float v) { for (int o = 32; o > 0; o >>= 1) v = fmaxf(v, __shfl_xor(v, o)); return v; }
__device__ __forceinline__ int wave_min_i(int v) { for (int o = 32; o > 0; o >>= 1) v = min(v, __shfl_xor(v, o)); return v; }
__device__ __forceinline__ float siluf(float v) { return v / (1.f + expf(-v)); }
typedef float f32x2 __attribute__((ext_vector_type(2)));
typedef __bf16 bf16x2_t __attribute__((ext_vector_type(2)));
__device__ __forceinline__ unsigned cvt_pk_bf16(float lo, float hi) { const f32x2 v = {lo, hi}; return __builtin_bit_cast(unsigned, __builtin_convertvector(v, bf16x2_t)); }
__device__ __forceinline__ bf16_t f2bf(float f) { return (bf16_t)(cvt_pk_bf16(f, 0.f) & 0xffffu); }
__device__ __forceinline__ float bf2f(unsigned b) { return __uint_as_float(b << 16); }

__device__ __forceinline__ void adaln_item(const Params& p, float* sm, int item, const int wid0) {
    const int t = opaque_tid(wid0), cq = t & 15, kg = t >> 4, n0 = item * 64;
    float* red = sm + 3 * D;
    float a[3][4];
#pragma unroll
    for (int r = 0; r < 3; ++r)
#pragma unroll
        for (int j = 0; j < 4; ++j) a[r][j] = 0.f;
#pragma unroll 4
    for (int k = kg; k < D; k += 32) {
        const f32x4 w4 = __builtin_nontemporal_load((const f32x4*)(p.w_mod + (size_t)k * (6 * D) + n0 + 4 * cq)); const float4 w = make_float4(w4[0], w4[1], w4[2], w4[3]);
        const float s0 = sm[k], s1 = sm[D + k], s2 = sm[2 * D + k];
        a[0][0] += s0 * w.x; a[0][1] += s0 * w.y; a[0][2] += s0 * w.z; a[0][3] += s0 * w.w;
        a[1][0] += s1 * w.x; a[1][1] += s1 * w.y; a[1][2] += s1 * w.z; a[1][3] += s1 * w.w;
        a[2][0] += s2 * w.x; a[2][1] += s2 * w.y; a[2][2] += s2 * w.z; a[2][3] += s2 * w.w;
    }
    __syncthreads();
#pragma unroll
    for (int r = 0; r < 3; ++r)
#pragma unroll
        for (int j = 0; j < 4; ++j) red[(kg * 3 + r) * 64 + 4 * cq + j] = a[r][j];
    __syncthreads();
    if (t < 192) {
        const int r = t >> 6, cc = t & 63;
        float s = p.b_mod[n0 + cc];
#pragma unroll 8
        for (int g = 0; g < 32; ++g) s += red[(g * 3 + r) * 64 + cc];
        p.mod[(size_t)r * 6 * D + n0 + cc] = s;
    }
    __syncthreads();
}
__device__ __forceinline__ void transpose_item(const float* W, int K, int N, int k0, int n0, bf16_t* WT, int drow0, float* scr, int lane, int maxc = 63) {
    if (maxc >= 63) {
        const int kr = lane >> 4, nq = lane & 15;
        f32x4 v[16];
#pragma unroll
        for (int q = 0; q < 16; ++q) v[q] = __builtin_nontemporal_load((const f32x4*)(W + (size_t)(k0 + 4 * q + kr) * N + n0 + 4 * nq));
#pragma unroll
        for (int q = 0; q < 16; ++q) { float* d = scr + (4 * q + kr) * 65 + 4 * nq; d[0] = v[q][0]; d[1] = v[q][1]; d[2] = v[q][2]; d[3] = v[q][3]; }
    } else {
        const int cl = lane < maxc ? lane : maxc;
#pragma unroll 8
        for (int kk = 0; kk < 64; ++kk) scr[kk * 65 + lane] = W[(size_t)(k0 + kk) * N + n0 + cl];
    }
    asm volatile("s_waitcnt lgkmcnt(0)" ::: "memory");
    const int c = lane & 7;
#pragma unroll
    for (int j = 0; j < 8; ++j) {
        const int n = (lane >> 3) + 8 * j; const float* s = scr + (8 * c) * 65 + n;
        u32x4 o; o.x = cvt_pk_bf16(s[0], s[65]); o.y = cvt_pk_bf16(s[2 * 65], s[3 * 65]); o.z = cvt_pk_bf16(s[4 * 65], s[5 * 65]); o.w = cvt_pk_bf16(s[6 * 65], s[7 * 65]);
        *(u32x4*)(WT + (size_t)(drow0 + n) * K + k0 + 8 * c) = o;
    }
    asm volatile("s_waitcnt lgkmcnt(0)" ::: "memory");
}
constexpr int CI_WIN = 32 * 97, CI_WOUT = 32 * 32, CI_S13 = 2 * 32 * 8, CI_S2 = 8 * 32, CI_E13 = 64 * 2 * 32 * 8, CI_E2 = 64 * 8 * 32;
constexpr int CI_TOTAL = CI_WIN + CI_WOUT + CI_S13 + CI_S2 + CI_E13 + CI_E2;
__device__ __forceinline__ void convert_item(const Params& p, int it, float* scr, int lane) {
    if (it < CI_WIN) { const int kb = it / 97, nb = it % 97; transpose_item(p.w_in, D, INC, 64 * kb, 64 * nb, p.WinT, 64 * nb, scr, lane, INC - 1 - 64 * nb); return; }
    it -= CI_WIN;
    if (it < CI_WOUT) { const int kb = it / 32, nb = it % 32; transpose_item(p.w_out, D, D, 64 * kb, 64 * nb, p.WoutT, 64 * nb, scr, lane); return; }
    it -= CI_WOUT;
    if (it < CI_S13) {
        const int which = it / 256, r = it % 256, kb = r / 8, nb = r % 8;
        transpose_item(which ? p.sw3 : p.sw1, D, DE, 64 * kb, 64 * nb, p.S13T, (nb >> 1) * 256 + which * 128 + (nb & 1) * 64, scr, lane); return; }
    it -= CI_S13;
    if (it < CI_S2) { const int kb = it / 32, nb = it % 32; transpose_item(p.sw2, DE, D, 64 * kb, 64 * nb, p.S2T, 64 * nb, scr, lane); return; }
    it -= CI_S2;
    if (it < CI_E13) {
        const int e = it / 512, r0 = it % 512, which = r0 / 256, r = r0 % 256, kb = r / 8, nb = r % 8;
        transpose_item((which ? p.ew3 : p.ew1) + (size_t)e * D * DE, D, DE, 64 * kb, 64 * nb, p.E13T + (size_t)e * 1024 * D, (nb >> 1) * 256 + which * 128 + (nb & 1) * 64, scr, lane); return; }
    it -= CI_E13;
    { const int e = it / 256, r = it % 256, kb = r / 32, nb = r % 32;
      transpose_item(p.ew2 + (size_t)e * DE * D, DE, D, 64 * kb, 64 * nb, p.E2T + (size_t)e * D * DE, 64 * nb, scr, lane); }
}
__device__ void ph_prologue(const Params& p, float* sm, const int wid0) {
    const int t = opaque_tid(wid0), w = t >> 6, lane = t & 63;
    if (blockIdx.x == 0 && t == 0) { p.QCTR[0] = 0; p.QCTR[32] = 0; }
    if (blockIdx.x == gridDim.x - 1) {
        for (int i = t; i < 64 * 32; i += NT) { const float ang = (float)(i >> 5) * powf(10000.f, -(float)(i & 31) / 32.f); p.RT[2 * i] = cosf(ang); p.RT[2 * i + 1] = sinf(ang); }
    }
    if (blockIdx.x < 192) {
        for (int i = t; i < 3 * D; i += NT) { const int r = i / D, k = i % D; sm[i] = siluf(r < 2 ? p.c[r * D + k] : p.c_ctx[k]); }
        __syncthreads();
        for (int item = blockIdx.x; item < 192; item += gridDim.x) adaln_item(p, sm, item, wid0);
    }
    __syncthreads();
    float* scr = sm + w * (64 * 65);
    for (int it = blockIdx.x * 8 + w; it < CI_TOTAL; it += gridDim.x * 8) convert_item(p, it, scr, lane);
}

__device__ void ph_norm1(const Params& p, const int wid0) {
    const int t = opaque_tid(wid0), w = t >> 6, lane = t & 63;
    for (int row = blockIdx.x * 8 + w; row < NROW; row += gridDim.x * 8) {
        const float* src; int mr;
        if (row < NLAT) { src = p.x + (size_t)row * D; mr = row / SEQ; } else { src = p.ctx + (size_t)(row - NLAT) * D; mr = 2; }
        const float* m = p.mod + (size_t)mr * 6 * D;
        float4 v[8]; float ss = 0.f;
#pragma unroll
        for (int j = 0; j < 8; ++j) { v[j] = *(const float4*)(src + 256 * j + 4 * lane); ss += v[j].x * v[j].x + v[j].y * v[j].y + v[j].z * v[j].z + v[j].w * v[j].w; }
        ss = wave_sum(ss);
        const float rs = rsqrtf(ss * (1.f / D) + 1e-6f);
#pragma unroll
        for (int j = 0; j < 8; ++j) {
            const int col = 256 * j + 4 * lane;
            const float4 g = *(const float4*)(p.norm1_g + col), sh = *(const float4*)(m + col), sc = *(const float4*)(m + D + col);
            u32x2 pk;
            pk.x = cvt_pk_bf16(v[j].x * rs * g.x * (1.f + sc.x) + sh.x, v[j].y * rs * g.y * (1.f + sc.y) + sh.y);
            pk.y = cvt_pk_bf16(v[j].z * rs * g.z * (1.f + sc.z) + sh.z, v[j].w * rs * g.w * (1.f + sc.w) + sh.w);
            *(u32x2*)(p.H + (size_t)row * D + col) = pk;
        }
    }
}

namespace g8 {
constexpr int BM = 256, BK = 64, HALF = 128, HTB = HALF * BK * 2;
__device__ __forceinline__ int lds_byte(int r, int c) { const int st = (r >> 4) * 2 + (c >> 5), rr = r & 15, cc = c & 31, ob = rr * 64 + cc * 2; return st * 1024 + (ob ^ (((ob >> 9) & 1) << 5)); }
__device__ __forceinline__ void stage_rc(int b, int& R, int& C) { const int st = b / 1024, sb = b % 1024, swz = sb ^ (((sb >> 9) & 1) << 5); R = (st >> 1) * 16 + swz / 64; C = (st & 1) * 32 + (swz % 64) / 2; }
__device__ __forceinline__ int perm32(int rho) { const int n = rho >> 4, i = rho & 15; return 8 * (i >> 2) + 4 * n + (i & 3); }

struct Unit { const char* A; const int* rows; int row0; const char* Bt; int orow, pn, aux; int nv = 256; };

__device__ __forceinline__ bool work_id(int i, int G, int c, int nwg, int& wgid) {
    const long L = (long)i * G + c; if (L >= nwg) return false;
    const int l = (int)L, q = nwg / 8, r = nwg % 8, xcd = l % 8, off = l / 8;
    wgid = (xcd < r ? xcd * (q + 1) : r * (q + 1) + (xcd - r) * q) + off; return true;
}

template <class Epi, class Sched>
__device__ __forceinline__ void gemm_phase(LAS unsigned char* lds, const int K, const Sched& S, const Epi& E, const int wid0, const int kloop = 0) {
    const int tid_ = wid0 * 64 + fresh_lane_id();
    const int tid = tid_, wid = __builtin_amdgcn_readfirstlane(tid >> 6), lane = tid & 63, wr = wid >> 2, wc = wid & 3, fr = lane & 15, fq = lane >> 4;
    const int nt = (kloop ? kloop : K) / BK;
    int sR[2]; unsigned sC2[2], voffB[2];
#pragma unroll
    for (int i = 0; i < 2; ++i) { int R, C; stage_rc(tid * 16 + i * 8192, R, C); const int Rb = Epi::PERM ? ((R & ~31) + perm32(R & 31)) : R;
        sR[i] = R; sC2[i] = (unsigned)C * 2u; voffB[i] = (unsigned)(Rb * K + C) * 2u; }
    const size_t kstep = (size_t)(BK * 2);
    const size_t hstep = (size_t)HALF * K * 2;
    const unsigned ldsw = (unsigned)wid * 1024u;
    const int aoff = lds_byte(wr * 64 + fr, fq * 8), boff = lds_byte(wc * 32 + fr, fq * 8);
#define G8_SA(b, h) (((b) * 2 + (h)) * g8::HTB)
#define G8_SB(b, h) ((4 + (b) * 2 + (h)) * g8::HTB)
#define G8_STAGE(bufoff, gbase, v0, v1) do { \
        __builtin_amdgcn_global_load_lds((const unsigned*)((const char*)(gbase) + (v0)), (LAS unsigned*)(lds + (bufoff) + ldsw), 16, 0, 0); \
        __builtin_amdgcn_global_load_lds((const unsigned*)((const char*)(gbase) + (v1)), (LAS unsigned*)(lds + (bufoff) + ldsw + 8192), 16, 0, 0); } while (0)
#define G8_LDA(dst, b, h) do { _Pragma("unroll") for (int m = 0; m < 4; ++m) _Pragma("unroll") for (int k = 0; k < 2; ++k) dst[m][k] = *(const LAS bf16x8*)(lds + G8_SA(b, h) + aoff + m * 2048 + k * 1024); } while (0)
#define G8_LDB(dst, b, h) do { _Pragma("unroll") for (int n = 0; n < 2; ++n) _Pragma("unroll") for (int k = 0; k < 2; ++k) dst[n][k] = *(const LAS bf16x8*)(lds + G8_SB(b, h) + boff + n * 2048 + k * 1024); } while (0)
#define G8_MMA(ai, bj, At, Bt) do { __builtin_amdgcn_s_setprio(1); _Pragma("unroll") for (int m = 0; m < 4; ++m) _Pragma("unroll") for (int n = 0; n < 2; ++n) _Pragma("unroll") for (int k = 0; k < 2; ++k) \
        acc[ai][bj][m][n] = __builtin_amdgcn_mfma_f32_16x16x32_bf16(Bt[n][k], At[m][k], acc[ai][bj][m][n], 0, 0, 0); __builtin_amdgcn_s_setprio(0); } while (0)
#define G8_WAIT_V(n) asm volatile("s_waitcnt vmcnt(" #n ")" ::: "memory")
#define G8_WAIT_L(n) asm volatile("s_waitcnt lgkmcnt(" #n ")" ::: "memory")
#define G8_BAR __builtin_amdgcn_s_barrier()
#define G8_SCHED __builtin_amdgcn_sched_barrier(0)
    Unit cur, nxt; int ui = 0;
    if (!S.next(0, cur)) return;
    f32x4 acc[2][2][4][2];
#pragma unroll
    for (int a = 0; a < 2; ++a)
#pragma unroll
        for (int b = 0; b < 2; ++b)
#pragma unroll
            for (int m = 0; m < 4; ++m)
#pragma unroll
                for (int n = 0; n < 2; ++n) acc[a][b][m][n] = (f32x4){0.f, 0.f, 0.f, 0.f};
    bf16x8 At[4][2], B0[2][2], B1[2][2];
    unsigned vA00, vA01, vA10, vA11, nA00, nA01, nA10, nA11;
#define G8_MKOFF(u, o00, o01, o10, o11) do { \
        int r00, r01, r10, r11; \
        if ((u).rows) { r00 = (u).rows[sR[0]]; r01 = (u).rows[sR[1]]; r10 = (u).rows[128 + sR[0]]; r11 = (u).rows[128 + sR[1]]; } \
        else { r00 = (u).row0 + sR[0]; r01 = (u).row0 + sR[1]; r10 = (u).row0 + 128 + sR[0]; r11 = (u).row0 + 128 + sR[1]; } \
        o00 = (unsigned)r00 * (unsigned)(K * 2) + sC2[0]; o01 = (unsigned)r01 * (unsigned)(K * 2) + sC2[1]; \
        o10 = (unsigned)r10 * (unsigned)(K * 2) + sC2[0]; o11 = (unsigned)r11 * (unsigned)(K * 2) + sC2[1]; } while (0)
    G8_MKOFF(cur, vA00, vA01, vA10, vA11);
    const char* cA = cur.A; const char* cB = cur.Bt;
    G8_STAGE(G8_SB(0, 0), cB, voffB[0], voffB[1]); G8_STAGE(G8_SA(0, 0), cA, vA00, vA01); G8_STAGE(G8_SB(0, 1), cB + hstep, voffB[0], voffB[1]); G8_STAGE(G8_SA(0, 1), cA, vA10, vA11);
    if (wr == 1) G8_BAR;
    G8_WAIT_V(4); G8_BAR;
    G8_STAGE(G8_SB(1, 0), cB + kstep, voffB[0], voffB[1]); G8_STAGE(G8_SA(1, 0), cA + kstep, vA00, vA01); G8_STAGE(G8_SB(1, 1), cB + hstep + kstep, voffB[0], voffB[1]);
    G8_WAIT_V(6); G8_BAR;
    for (;;) {
        const bool h1 = cur.nv > 128;
        const bool has_next = S.next(ui + 1, nxt);
        const char* nA = has_next ? nxt.A : cA; const char* nB = has_next ? nxt.Bt : cB;
        if (has_next) G8_MKOFF(nxt, nA00, nA01, nA10, nA11); else { nA00 = vA00; nA01 = vA01; nA10 = vA10; nA11 = vA11; }
        for (int t = 0; t < nt; t += 2) {
            const bool last = (t == nt - 2);
            const char* a1 = cA + (size_t)(t + 1) * kstep;
            G8_LDB(B0, 0, 0); G8_SCHED; G8_LDA(At, 0, 0); G8_STAGE(G8_SA(1, 1), a1, vA10, vA11);
            G8_WAIT_L(8); G8_BAR; G8_WAIT_L(0); G8_MMA(0, 0, At, B0); G8_BAR; G8_SCHED;
            if (last) { vA00 = nA00; vA01 = nA01; vA10 = nA10; vA11 = nA11; }
            const char* a2 = last ? nA : cA + (size_t)(t + 2) * kstep; const char* b2 = last ? nB : cB + (size_t)(t + 2) * kstep;
            const char* a3 = a2 + kstep; const char* b3 = b2 + kstep;
            G8_LDB(B1, 0, 1); G8_STAGE(G8_SB(0, 0), b2, voffB[0], voffB[1]);
            G8_BAR; G8_WAIT_L(0); G8_MMA(0, 1, At, B1); G8_BAR;
            G8_LDA(At, 0, 1); G8_STAGE(G8_SA(0, 0), a2, vA00, vA01);
            G8_BAR; G8_WAIT_L(0); if (h1) G8_MMA(1, 0, At, B0); G8_BAR; G8_SCHED;
            G8_STAGE(G8_SB(0, 1), b2 + hstep, voffB[0], voffB[1]);
            G8_WAIT_V(6); G8_BAR; if (h1) G8_MMA(1, 1, At, B1); G8_BAR;
            G8_LDB(B0, 1, 0); G8_SCHED; G8_LDA(At, 1, 0); G8_STAGE(G8_SA(0, 1), a2, vA10, vA11);
            G8_WAIT_L(8); G8_BAR; G8_WAIT_L(0); G8_MMA(0, 0, At, B0); G8_BAR; G8_SCHED;
            G8_LDB(B1, 1, 1); G8_STAGE(G8_SB(1, 0), b3, voffB[0], voffB[1]);
            G8_BAR; G8_WAIT_L(0); G8_MMA(0, 1, At, B1); G8_BAR;
            G8_LDA(At, 1, 1); G8_STAGE(G8_SA(1, 0), a3, vA00, vA01);
            G8_BAR; G8_WAIT_L(0); if (h1) G8_MMA(1, 0, At, B0); G8_BAR; G8_SCHED;
            G8_STAGE(G8_SB(1, 1), b3 + hstep, voffB[0], voffB[1]);
            G8_WAIT_V(6); G8_BAR; if (h1) G8_MMA(1, 1, At, B1); G8_BAR;
        }
        E(acc, cur, wr, wc, fr, fq);
        if (!has_next) break;
#pragma unroll
        for (int a = 0; a < 2; ++a)
#pragma unroll
            for (int b = 0; b < 2; ++b)
#pragma unroll
                for (int m = 0; m < 4; ++m)
#pragma unroll
                    for (int n = 0; n < 2; ++n) acc[a][b][m][n] = (f32x4){0.f, 0.f, 0.f, 0.f};
        cur = nxt; cA = nA; cB = nB; ++ui;
    }
    G8_WAIT_V(0);
    if (wr == 0) G8_BAR;
    G8_BAR;
}
}

struct EpiInproj {
    static constexpr bool PERM = true;
    bf16_t* P;
    __device__ __forceinline__ void operator()(const f32x4 (&acc)[2][2][4][2], const g8::Unit& u, int wr, int wc, int fr, int fq) const {
#pragma unroll
        for (int ai = 0; ai < 2; ++ai)
#pragma unroll
            for (int m = 0; m < 4; ++m) { bf16_t* rowp = P + (size_t)(u.orow + ai * 128 + wr * 64 + m * 16 + fr) * PLD + u.pn * 256 + wc * 32 + 8 * fq;
#pragma unroll
                for (int bj = 0; bj < 2; ++bj) { const f32x4 v0 = acc[ai][bj][m][0], v1 = acc[ai][bj][m][1];
                    u32x4 w; w.x = cvt_pk_bf16(v0[0], v0[1]); w.y = cvt_pk_bf16(v0[2], v0[3]); w.z = cvt_pk_bf16(v1[0], v1[1]); w.w = cvt_pk_bf16(v1[2], v1[3]);
                    *(u32x4*)(rowp + bj * 128) = w; } }
    }
};
struct EpiInprojSplit {
    static constexpr bool PERM = false;
    float* PS; float* DDS;
    __device__ __forceinline__ void operator()(const f32x4 (&acc)[2][2][4][2], const g8::Unit& u, int wr, int wc, int fr, int fq) const {
        if (u.pn == PLD / 256) {
            if (wc == 0) {
#pragma unroll
                for (int ai = 0; ai < 2; ++ai)
#pragma unroll
                    for (int m = 0; m < 4; ++m) { float* rowp = DDS + (size_t)u.aux * DD_SLAB + (size_t)(u.orow + ai * 128 + wr * 64 + m * 16 + fr) * 32 + 4 * fq;
                        *(f32x4*)(rowp) = acc[ai][0][m][0]; *(f32x4*)(rowp + 16) = acc[ai][0][m][1]; }
            }
            return;
        }
        const int ccol = (u.pn < 12 ? u.pn - 4 : u.pn - 6) * 256;
#pragma unroll
        for (int ai = 0; ai < 2; ++ai)
#pragma unroll
            for (int m = 0; m < 4; ++m) { float* rowp = PS + (size_t)u.aux * PS_SLAB + (size_t)(u.orow - NLAT + ai * 128 + wr * 64 + m * 16 + fr) * PSLD + ccol + wc * 32 + 4 * fq;
#pragma unroll
                for (int bj = 0; bj < 2; ++bj)
#pragma unroll
                    for (int n = 0; n < 2; ++n) *(f32x4*)(rowp + bj * 128 + n * 16) = acc[ai][bj][m][n]; }
    }
};
struct SchedInprojSplit {
    const char* A; const char* Bt; int G, c;
    static constexpr int NITEM = 4 * (28 + 34);
    __device__ __forceinline__ bool next(int i, g8::Unit& u) const {
        int it; if (!g8::work_id(i, G, c, NITEM, it)) return false;
        int pm, pn; const int ks = it & 3, q = it >> 2;
        if (q < 28) { const int j = q % 14; pm = 32 + q / 14; pn = j < 8 ? 4 + j : (j < 10 ? 6 + j : 6 + j); }
        else { pm = q - 28; pn = PLD / 256; }
        u.A = A + ks * 1024; u.rows = nullptr; u.row0 = pm * 256; u.Bt = Bt + (size_t)pn * 256 * D * 2 + ks * 1024; u.orow = pm * 256; u.pn = pn; u.aux = ks; return true;
    }
};
struct EpiOutproj {
    static constexpr bool PERM = false;
    const float* x; const float* mod; float* X1;
    __device__ __forceinline__ void operator()(const f32x4 (&acc)[2][2][4][2], const g8::Unit& u, int wr, int wc, int fr, int fq) const {
        const int b = u.orow / SEQ; const int col0 = u.pn * 256 + wc * 32 + 4 * fq;
        f32x4 gv[2][2];
#pragma unroll
        for (int bj = 0; bj < 2; ++bj)
#pragma unroll
            for (int n = 0; n < 2; ++n) gv[bj][n] = *(const f32x4*)(mod + (size_t)b * 6 * D + 2 * D + col0 + bj * 128 + n * 16);
#pragma unroll
        for (int ai = 0; ai < 2; ++ai)
#pragma unroll
            for (int m = 0; m < 4; ++m) { const size_t ro = (size_t)(u.orow + ai * 128 + wr * 64 + m * 16 + fr) * D + col0;
#pragma unroll
                for (int bj = 0; bj < 2; ++bj)
#pragma unroll
                    for (int n = 0; n < 2; ++n) { const f32x4 xv = *(const f32x4*)(x + ro + bj * 128 + n * 16);
                        *(f32x4*)(X1 + ro + bj * 128 + n * 16) = xv + gv[bj][n] * acc[ai][bj][m][n]; } }
    }
};
struct EpiUp {
    static constexpr bool PERM = true;
    bf16_t* HB; bf16_t* SHH;
    __device__ __forceinline__ void operator()(const f32x4 (&acc)[2][2][4][2], const g8::Unit& u, int wr, int wc, int fr, int fq) const {
        bf16_t* O = u.aux ? SHH : HB;
#pragma unroll
        for (int ai = 0; ai < 2; ++ai)
#pragma unroll
            for (int m = 0; m < 4; ++m) {
                if (ai * 128 + wr * 64 + m * 16 + fr >= u.nv) continue;
                f32x4 h0, h1;
#pragma unroll
                for (int j = 0; j < 4; ++j) { h0[j] = siluf(acc[ai][0][m][0][j]) * acc[ai][1][m][0][j]; h1[j] = siluf(acc[ai][0][m][1][j]) * acc[ai][1][m][1][j]; }
                u32x4 w; w.x = cvt_pk_bf16(h0[0], h0[1]); w.y = cvt_pk_bf16(h0[2], h0[3]); w.z = cvt_pk_bf16(h1[0], h1[1]); w.w = cvt_pk_bf16(h1[2], h1[3]);
                *(u32x4*)(O + (size_t)(u.orow + ai * 128 + wr * 64 + m * 16 + fr) * DE + u.pn * 128 + wc * 32 + 8 * fq) = w;
            }
    }
};
struct EpiDown {
    static constexpr bool PERM = true;
    bf16_t* Y; bf16_t* YS;
    __device__ __forceinline__ void operator()(const f32x4 (&acc)[2][2][4][2], const g8::Unit& u, int wr, int wc, int fr, int fq) const {
        bf16_t* O = u.aux ? YS : Y;
#pragma unroll
        for (int ai = 0; ai < 2; ++ai)
#pragma unroll
            for (int m = 0; m < 4; ++m) { if (ai * 128 + wr * 64 + m * 16 + fr >= u.nv) continue;
                bf16_t* rowp = O + (size_t)(u.orow + ai * 128 + wr * 64 + m * 16 + fr) * D + u.pn * 256 + wc * 32 + 8 * fq;
#pragma unroll
                for (int bj = 0; bj < 2; ++bj) { const f32x4 v0 = acc[ai][bj][m][0], v1 = acc[ai][bj][m][1];
                    u32x4 w; w.x = cvt_pk_bf16(v0[0], v0[1]); w.y = cvt_pk_bf16(v0[2], v0[3]); w.z = cvt_pk_bf16(v1[0], v1[1]); w.w = cvt_pk_bf16(v1[2], v1[3]);
                    *(u32x4*)(rowp + bj * 128) = w; } }
    }
};
struct SchedDense {
    const char* A; const char* Bt; int K, nM, nN, G, c;
    __device__ __forceinline__ bool next(int i, g8::Unit& u) const {
        int wgid; if (!g8::work_id(i, G, c, nM * nN, wgid)) return false;
        const int nig = 8 * nN, gid = wgid / nig, fm = gid * 8, gsz = (nM - fm) < 8 ? (nM - fm) : 8;
        const int pm = fm + ((wgid % nig) % gsz), pn = (wgid % nig) / gsz;
        u.A = A; u.rows = nullptr; u.row0 = pm * 256; u.Bt = Bt + (size_t)pn * 256 * K * 2; u.orow = pm * 256; u.pn = pn; u.aux = 0; return true;
    }
};
struct SchedUp {
    const int* tp; const char* H2; const int* LIST; const char* E13T; const char* S13T; int G, c;
    __device__ __forceinline__ bool next(int i, g8::Unit& u) const {
        const int T = tp[NE]; int wgid; if (!g8::work_id(i, G, c, 4 * T + 128, wgid)) return false;
        u.A = H2;
        if (wgid < 4 * T) {
            int e = 0;
#pragma unroll
            for (int s = 32; s > 0; s >>= 1) if (4 * tp[e + s] <= wgid) e += s;
            const int tc = tp[e + 1] - tp[e], li = wgid - 4 * tp[e], nt = li / tc, mt = li % tc, r0 = (tp[e] + mt) * 256;
            u.rows = LIST + r0; u.row0 = 0; u.Bt = E13T + ((size_t)e * 1024 + nt * 256) * D * 2; u.orow = r0; u.pn = nt; u.aux = 0; u.nv = min(256, tp[80 + e] - mt * 256);
        } else {
            const int s = wgid - 4 * T, pn = s / 32, pm = s % 32;
            u.rows = nullptr; u.row0 = pm * 256; u.Bt = S13T + (size_t)pn * 256 * D * 2; u.orow = pm * 256; u.pn = pn; u.aux = 1; u.nv = 256;
        }
        return true;
    }
};
struct SchedDown {
    const int* tp; const char* HB; const char* E2T; const char* SHH; const char* S2T; int G, c;
    __device__ __forceinline__ bool next(int i, g8::Unit& u) const {
        const int T = tp[NE]; int wgid; if (!g8::work_id(i, G, c, 8 * T + 256, wgid)) return false;
        u.rows = nullptr;
        if (wgid < 8 * T) {
            int e = 0;
#pragma unroll
            for (int s = 32; s > 0; s >>= 1) if (8 * tp[e + s] <= wgid) e += s;
            const int tc = tp[e + 1] - tp[e], li = wgid - 8 * tp[e], nt = li / tc, mt = li % tc, r0 = (tp[e] + mt) * 256;
            u.A = HB; u.row0 = r0; u.Bt = E2T + ((size_t)e * D + nt * 256) * DE * 2; u.orow = r0; u.pn = nt; u.aux = 0; u.nv = min(256, tp[80 + e] - mt * 256);
        } else {
            const int s = wgid - 8 * T, pn = s / 32, pm = s % 32;
            u.A = SHH; u.row0 = pm * 256; u.Bt = S2T + (size_t)pn * 256 * DE * 2; u.orow = pm * 256; u.pn = pn; u.aux = 1; u.nv = 256;
        }
        return true;
    }
};
__device__ __forceinline__ void moe_tables(const Params& p, int* tp, const int wid0) {
    __syncthreads();
    if (wid0 == 0 && xb_lane_id() == 0) { int tt = 0; for (int e = 0; e < NE; ++e) { const int cn = p.CNT[e]; tp[e] = tt; tp[80 + e] = cn; tt += (cn + 255) / 256; } tp[NE] = tt; }
    __syncthreads();
}

constexpr int NTILE = 136;
__device__ void ph_naprep(const Params& p, const int wid0) {
    const int t = opaque_tid(wid0), w = t >> 6, lane = t & 63, kk = lane >> 4, pc = lane & 15;
    for (int u = blockIdx.x; u < 2 * NTILE; u += gridDim.x) {
        const int b = u / NTILE, T = u % NTILE; const bool lat = T < 128;
        const int row0 = lat ? (b * SEQ + 32 * T) : (NLAT + b * CTXL + 32 * (T - 128));
#pragma unroll 2
        for (int it = w; it < 128; it += 8) {
            const int which = it & 1, hh = (it >> 1) & 7, tt = 4 * (it >> 4) + kk;
            if (which == 0 && !lat) continue;
            float4 v0, v1;
            if (lat) { const u32x4 r8 = *(const u32x4*)(p.P + (size_t)(row0 + tt) * PLD + which * 1024 + hh * 128 + 8 * pc);
                v0 = make_float4(bf2f(r8.x & 0xffffu), bf2f(r8.x >> 16), bf2f(r8.y & 0xffffu), bf2f(r8.y >> 16)); v1 = make_float4(bf2f(r8.z & 0xffffu), bf2f(r8.z >> 16), bf2f(r8.w & 0xffffu), bf2f(r8.w >> 16)); }
            else {
                const float* src = p.PS + (size_t)(row0 - NLAT + tt) * PSLD + hh * 128 + 8 * pc;
                v0 = *(const float4*)src; v1 = *(const float4*)(src + 4);
#pragma unroll
                for (int s = 1; s < 4; ++s) { const float4 a0 = *(const float4*)(src + s * PS_SLAB), a1 = *(const float4*)(src + s * PS_SLAB + 4);
                    v0.x += a0.x; v0.y += a0.y; v0.z += a0.z; v0.w += a0.w; v1.x += a1.x; v1.y += a1.y; v1.z += a1.z; v1.w += a1.w; }
            }
            float ss = v0.x * v0.x + v0.y * v0.y + v0.z * v0.z + v0.w * v0.w + v1.x * v1.x + v1.y * v1.y + v1.z * v1.z + v1.w * v1.w;
            ss += __shfl_xor(ss, 1); ss += __shfl_xor(ss, 2); ss += __shfl_xor(ss, 4); ss += __shfl_xor(ss, 8);
            const float* gp = (which ? p.k_norm_g : p.q_norm_g) + 8 * pc;
            const float4 g0 = *(const float4*)gp, g1 = *(const float4*)(gp + 4);
            const float r = rsqrtf(ss * (1.f / 128.f) + 1e-6f) * (which ? 1.f : 0.08838834764831845f * 1.4426950408889634f);
            u32x4 o;
            o.x = cvt_pk_bf16(v0.x * r * g0.x, v0.y * r * g0.y); o.y = cvt_pk_bf16(v0.z * r * g0.z, v0.w * r * g0.w);
            o.z = cvt_pk_bf16(v1.x * r * g1.x, v1.y * r * g1.y); o.w = cvt_pk_bf16(v1.z * r * g1.z, v1.w * r * g1.w);
            if (which) *(u32x4*)(p.NKf + (((size_t)((b * 8 + hh) * NTILE + T) * 8 + (pc >> 1)) * 64 + tt + 32 * (pc & 1)) * 8) = o;
            else *(u32x4*)(p.NQb + (size_t)(row0 + tt) * 1024 + hh * 128 + 8 * pc) = o;
        }
        if (lat) {
            const int col = 2 * t, hh = col >> 7, dv = col & 127;
            unsigned wv[32];
#pragma unroll
            for (int s = 0; s < 32; ++s) wv[s] = *(const unsigned*)(p.P + (size_t)(row0 + s) * PLD + 2048 + col);
            unsigned pk0[16], pk1[16];
#pragma unroll
            for (int s2 = 0; s2 < 16; ++s2) { pk0[s2] = (wv[2 * s2] & 0xffffu) | (wv[2 * s2 + 1] << 16); pk1[s2] = (wv[2 * s2] >> 16) | (wv[2 * s2 + 1] & 0xffff0000u); }
            bf16_t* o = p.VTf + ((((size_t)((b * 8 + hh) * NTILE + T) * 4 + (dv >> 5)) * 2) * 64 + (dv & 31)) * 8;
#pragma unroll
            for (int g2 = 0; g2 < 2; ++g2) {
                *(u32x4*)(o + (g2 * 64) * 8) = (u32x4){pk0[8 * g2], pk0[8 * g2 + 1], pk0[8 * g2 + 4], pk0[8 * g2 + 5]};
                *(u32x4*)(o + (g2 * 64 + 32) * 8) = (u32x4){pk0[8 * g2 + 2], pk0[8 * g2 + 3], pk0[8 * g2 + 6], pk0[8 * g2 + 7]};
                *(u32x4*)(o + (g2 * 64 + 1) * 8) = (u32x4){pk1[8 * g2], pk1[8 * g2 + 1], pk1[8 * g2 + 4], pk1[8 * g2 + 5]};
                *(u32x4*)(o + (g2 * 64 + 33) * 8) = (u32x4){pk1[8 * g2 + 2], pk1[8 * g2 + 3], pk1[8 * g2 + 6], pk1[8 * g2 + 7]};
            }
        } else {
#pragma unroll 1
        for (int i = 0; i < 2; ++i) {
            const int col = t + 512 * i, hh = col >> 7, dv = col & 127;
            unsigned pk[16];
#pragma unroll
            for (int s2 = 0; s2 < 16; ++s2) {
                const float* s0 = p.PS + (size_t)(row0 - NLAT + 2 * s2) * PSLD + 1024 + col;
                const float x0 = s0[0] + s0[PS_SLAB] + s0[2 * PS_SLAB] + s0[3 * PS_SLAB], x1 = s0[PSLD] + s0[PS_SLAB + PSLD] + s0[2 * PS_SLAB + PSLD] + s0[3 * PS_SLAB + PSLD];
                pk[s2] = cvt_pk_bf16(x0, x1);
            }
            bf16_t* o = p.VTf + ((((size_t)((b * 8 + hh) * NTILE + T) * 4 + (dv >> 5)) * 2) * 64 + (dv & 31)) * 8;
#pragma unroll
            for (int g2 = 0; g2 < 2; ++g2) {
                *(u32x4*)(o + (g2 * 64) * 8) = (u32x4){pk[8 * g2], pk[8 * g2 + 1], pk[8 * g2 + 4], pk[8 * g2 + 5]};
                *(u32x4*)(o + (g2 * 64 + 32) * 8) = (u32x4){pk[8 * g2 + 2], pk[8 * g2 + 3], pk[8 * g2 + 6], pk[8 * g2 + 7]};
            }
        }
        }
    }
}

__device__ __forceinline__ void attn_tile(const LAS unsigned char* sb, const float* bt0, const bf16x8 (&qf)[8], f32x16& o0, f32x16& o1, f32x16& o2, f32x16& o3, float& m, float& l,
                                          bool loc, int half, int dr, int c, int cs, int hi) {
    bf16x8 kc[8], va[8];
#pragma unroll
    for (int ks = 0; ks < 8; ++ks) kc[ks] = *(const LAS bf16x8*)(sb + ks * 1024);
#pragma unroll
    for (int q = 0; q < 8; ++q) va[q] = *(const LAS bf16x8*)(sb + 8192 + q * 1024);
    f32x16 s;
#pragma unroll
    for (int e = 0; e < 16; ++e) s[e] = 0.f;
#pragma unroll
    for (int ks = 0; ks < 8; ++ks) s = __builtin_amdgcn_mfma_f32_32x32x16_bf16(kc[ks], qf[ks], s, 0, 0, 0);
    if (loc) {
        int rel0 = 32 * half + 4 * hi - cs; asm volatile("" : "+v"(rel0));
        const float* bt = bt0 + dr * 31 + cs - c + 15;
#pragma unroll
        for (int e = 0; e < 16; ++e) {
            const int rel = rel0 + (e & 3) + 8 * (e >> 2);
            const bool vis = (unsigned)rel < 16u;
            const float bias = bt[rel];
            s[e] = vis ? (s[e] + bias) : -INFINITY;
        }
    }
    float mt = s[0];
#pragma unroll
    for (int e = 1; e < 16; ++e) mt = fmaxf(mt, s[e]);
    mt = fmaxf(mt, __shfl_xor(mt, 32));
    if (__any(mt > m)) {
        const float mn = fmaxf(m, mt);
        const float alpha = __builtin_amdgcn_exp2f(m - mn);
        m = mn; l *= alpha;
#pragma unroll
        for (int e = 0; e < 16; ++e) { o0[e] *= alpha; o1[e] *= alpha; o2[e] *= alpha; o3[e] *= alpha; }
    }
    float ps = 0.f;
#pragma unroll
    for (int e = 0; e < 16; ++e) { s[e] = __builtin_amdgcn_exp2f(s[e] - m); ps += s[e]; }
    l += ps;
    bf16x8 pb[2];
#pragma unroll
    for (int s2 = 0; s2 < 2; ++s2) {
        const u32x4 cat = (u32x4){cvt_pk_bf16(s[8 * s2], s[8 * s2 + 1]), cvt_pk_bf16(s[8 * s2 + 2], s[8 * s2 + 3]), cvt_pk_bf16(s[8 * s2 + 4], s[8 * s2 + 5]), cvt_pk_bf16(s[8 * s2 + 6], s[8 * s2 + 7])};
        pb[s2] = __builtin_bit_cast(bf16x8, cat);
    }
#pragma unroll
    for (int s2 = 0; s2 < 2; ++s2) {
        o0 = __builtin_amdgcn_mfma_f32_32x32x16_bf16(va[0 + s2], pb[s2], o0, 0, 0, 0);
        o1 = __builtin_amdgcn_mfma_f32_32x32x16_bf16(va[2 + s2], pb[s2], o1, 0, 0, 0);
        o2 = __builtin_amdgcn_mfma_f32_32x32x16_bf16(va[4 + s2], pb[s2], o2, 0, 0, 0);
        o3 = __builtin_amdgcn_mfma_f32_32x32x16_bf16(va[6 + s2], pb[s2], o3, 0, 0, 0);
    }
}
__device__ __forceinline__ void glascan_wave(const Params& p, int unit, int dh, int lane, LAS unsigned char* ldsw);
__device__ void ph_attn(const Params& p, unsigned char* smb, const int wid0) {
    const int t = opaque_tid(wid0), lane = t & 63, l31 = lane & 31, hi = lane >> 5;
    const int w = __builtin_amdgcn_readfirstlane(t >> 6);
    LAS unsigned char* lds = (LAS unsigned char*)smb;
    for (int u0 = blockIdx.x; u0 < 256; u0 += gridDim.x) { const int unit = (((u0 & 7) + 8 * (u0 >> 7)) << 4) | ((u0 >> 3) & 15); glascan_wave(p, unit, w, lane, lds + w * 8192); }
    float* tab = (float*)(smb + 4 * 16384);
    for (int u0 = blockIdx.x; u0 < 256; u0 += gridDim.x) {
        const int u = (((u0 & 7) + 8 * (u0 >> 7)) << 4) | ((u0 >> 3) & 15);
        const int rg = u & 15, h = (u >> 4) & 7, b = u >> 7, bh8 = b * 8 + h;
        asm volatile("s_waitcnt vmcnt(0)" ::: "memory");
        __syncthreads();
        for (int i = t; i < 465; i += NT) tab[i] = p.na_rpb[h * 465 + i] * 1.4426950408889634f;
        const int r = 4 * rg + (w >> 1), qt = w & 1, c = 32 * qt + l31;
        const int rs = min(max(r - 4, 0), 56), cs = min(max(c - 8, 0), 48);
        const int Rlo = min(max(4 * rg - 4, 0), 56), Rhi = min(max(4 * rg - 1, 0), 56) + 7, nt = 8 + 2 * (Rhi - Rlo + 1);
        const int qrow = b * SEQ + r * 64 + c;
        bf16x8 qf[8];
#pragma unroll
        for (int ks = 0; ks < 8; ++ks) qf[ks] = *(const bf16x8*)(p.NQb + (size_t)qrow * 1024 + h * 128 + 16 * ks + 8 * hi);
#pragma unroll
        for (int ks = 0; ks < 8; ++ks) asm volatile("" : "+v"(qf[ks]));
        f32x16 o0, o1, o2, o3;
#pragma unroll
        for (int e = 0; e < 16; ++e) { o0[e] = 0.f; o1[e] = 0.f; o2[e] = 0.f; o3[e] = 0.f; }
        float m = -INFINITY, l = 0.f;
        const bf16_t* kg = p.NKf + ((size_t)bh8 * NTILE * 8 + w) * 512 + lane * 8;
        const bf16_t* vg = p.VTf + ((size_t)bh8 * NTILE * 8 + w) * 512 + lane * 8;
#define AT_T(i_) ((i_) < 8 ? (128 + (i_)) : (2 * Rlo + ((i_) - 8)))
#define AT_DMA(i_, st_) do { const int ii_ = (i_) < nt ? (i_) : nt - 1; const size_t to_ = (size_t)AT_T(ii_) * 4096; \
        __builtin_amdgcn_global_load_lds((const unsigned*)(kg + to_), (LAS unsigned*)(lds + (st_) * 16384 + w * 1024), 16, 0, 0); \
        __builtin_amdgcn_global_load_lds((const unsigned*)(vg + to_), (LAS unsigned*)(lds + (st_) * 16384 + 8192 + w * 1024), 16, 0, 0); } while (0)
        asm volatile("s_waitcnt vmcnt(0)" ::: "memory");
        __syncthreads();
        AT_DMA(0, 0); AT_DMA(1, 1); AT_DMA(2, 2);
        int st = 0;
#pragma unroll 1
        for (int i = 0; i < nt; ++i) {
            asm volatile("s_waitcnt vmcnt(4)" ::: "memory");
            __builtin_amdgcn_s_barrier();
            asm volatile("" ::: "memory");
            const int st2 = (st + 3) & 3;
            AT_DMA(i + 3, st2);
            const bool loc = i >= 8; const int R = Rlo + ((i - 8) >> 1), half = (i - 8) & 1;
            if (!loc || (unsigned)(R - rs) < 8u)
                attn_tile(lds + st * 16384 + lane * 16, tab, qf, o0, o1, o2, o3, m, l, loc, half, R - r + 7, c, cs, hi);
            st = (st + 1) & 3;
        }
#undef AT_T
#undef AT_DMA
        l += __shfl_xor(l, 32);
        const float inv = 1.f / l;
        bf16_t* orow = p.MIX + (size_t)qrow * D + h * 128 + 4 * hi;
#pragma unroll
        for (int g = 0; g < 4; ++g) {
            u32x2 pk;
            pk.x = cvt_pk_bf16(o0[4 * g] * inv, o0[4 * g + 1] * inv); pk.y = cvt_pk_bf16(o0[4 * g + 2] * inv, o0[4 * g + 3] * inv); *(u32x2*)(orow + 0 + 8 * g) = pk;
            pk.x = cvt_pk_bf16(o1[4 * g] * inv, o1[4 * g + 1] * inv); pk.y = cvt_pk_bf16(o1[4 * g + 2] * inv, o1[4 * g + 3] * inv); *(u32x2*)(orow + 32 + 8 * g) = pk;
            pk.x = cvt_pk_bf16(o2[4 * g] * inv, o2[4 * g + 1] * inv); pk.y = cvt_pk_bf16(o2[4 * g + 2] * inv, o2[4 * g + 3] * inv); *(u32x2*)(orow + 64 + 8 * g) = pk;
            pk.x = cvt_pk_bf16(o3[4 * g] * inv, o3[4 * g + 1] * inv); pk.y = cvt_pk_bf16(o3[4 * g + 2] * inv, o3[4 * g + 3] * inv); *(u32x2*)(orow + 96 + 8 * g) = pk;
        }
    }
    asm volatile("s_waitcnt vmcnt(0)" ::: "memory");
}

__device__ __forceinline__ float logsigf(float z) { return fminf(z, 0.f) - log1pf(expf(-fabsf(z))); }

__device__ __forceinline__ float fexp2(float x) { return __builtin_amdgcn_exp2f(x); }
__device__ __forceinline__ float logsig2_16(float z) { return (fminf(z, 0.f) * 1.4426950408889634f - __builtin_amdgcn_logf(1.f + fexp2(-fabsf(z) * 1.4426950408889634f))) * (1.f / 16.f); }

__device__ void ph_glaprep(const Params& p, float* sm, const int wid0) {
    const int t = opaque_tid(wid0), d2 = t & 63, tq = t >> 6, d = 2 * d2;
    float* qs = sm;
    float* ksm = sm + 8192;
    float* dds = sm + 16384;
    float* tot = sm + 16384 + 2048;
    for (int u = blockIdx.x; u < 8 * 68; u += gridDim.x) {
        const int bh = u / 68, c = u % 68, b = bh >> 2, h = bh & 3;
        const bool lat = c >= 4; const int j = c - 4;
        const int row0 = lat ? (b * SEQ + 64 * j) : (NLAT + b * CTXL + 64 * c);
        __syncthreads();
        {
            const int cq = t & 31, tr = t >> 5;
#pragma unroll
            for (int i = 0; i < 4; ++i) { const int tt = tr + 16 * i;
                if (lat) {
                    const u32x2 q4 = *(const u32x2*)(p.P + (size_t)(row0 + tt) * PLD + 3072 + h * 128 + 4 * cq), k4 = *(const u32x2*)(p.P + (size_t)(row0 + tt) * PLD + 3584 + h * 128 + 4 * cq);
                    *(float4*)(qs + tt * 128 + 4 * cq) = make_float4(bf2f(q4.x & 0xffffu), bf2f(q4.x >> 16), bf2f(q4.y & 0xffffu), bf2f(q4.y >> 16));
                    *(float4*)(ksm + tt * 128 + 4 * cq) = make_float4(bf2f(k4.x & 0xffffu), bf2f(k4.x >> 16), bf2f(k4.y & 0xffffu), bf2f(k4.y >> 16));
                } else {
                    const float* src = p.PS + (size_t)(row0 - NLAT + tt) * PSLD + 2048 + h * 128 + 4 * cq;
                    float4 kv = *(const float4*)src;
#pragma unroll
                    for (int s = 1; s < 4; ++s) { const float4 a0 = *(const float4*)(src + s * PS_SLAB); kv.x += a0.x; kv.y += a0.y; kv.z += a0.z; kv.w += a0.w; }
                    *(float4*)(qs + tt * 128 + 4 * cq) = make_float4(0.f, 0.f, 0.f, 0.f); *(float4*)(ksm + tt * 128 + 4 * cq) = kv;
                } }
            { const float* src = p.DDS + (size_t)row0 * 32 + 4 * t; float4 dv = *(const float4*)src;
#pragma unroll
              for (int s = 1; s < 4; ++s) { const float4 a0 = *(const float4*)(src + s * DD_SLAB); dv.x += a0.x; dv.y += a0.y; dv.z += a0.z; dv.w += a0.w; }
              *(float4*)(dds + 4 * t) = dv; }
        }
        __syncthreads();
        float gf0[8], gf1[8], gb0[8], gb1[8];
        {
            float uf0[16], uf1[16], ub0[16], ub1[16];
#pragma unroll
            for (int r = 0; r < 16; ++r) { const float2 a = *(const float2*)(p.up_f + r * 512 + h * 128 + d), bq = *(const float2*)(p.up_b + r * 512 + h * 128 + d); uf0[r] = a.x; uf1[r] = a.y; ub0[r] = bq.x; ub1[r] = bq.y; }
            const float2 bf = *(const float2*)(p.bias_f + h * 128 + d), bb = *(const float2*)(p.bias_b + h * 128 + d);
            float sf0 = 0.f, sf1 = 0.f, sb0 = 0.f, sb1 = 0.f;
#pragma unroll
            for (int i = 0; i < 8; ++i) {
                const float* dr = dds + (8 * tq + i) * 32; float zf0 = bf.x, zf1 = bf.y, zb0 = bb.x, zb1 = bb.y;
#pragma unroll
                for (int r = 0; r < 16; ++r) { const float x = dr[r], y = dr[16 + r]; zf0 += x * uf0[r]; zf1 += x * uf1[r]; zb0 += y * ub0[r]; zb1 += y * ub1[r]; }
                gf0[i] = logsig2_16(zf0); gf1[i] = logsig2_16(zf1); gb0[i] = logsig2_16(zb0); gb1[i] = logsig2_16(zb1);
                sf0 += gf0[i]; sf1 += gf1[i]; sb0 += gb0[i]; sb1 += gb1[i];
            }
            *(float2*)(tot + tq * 128 + d) = make_float2(sf0, sf1); *(float2*)(tot + (8 + tq) * 128 + d) = make_float2(sb0, sb1);
        }
        __syncthreads();
        float2 basef = make_float2(0.f, 0.f), baseb = basef, allf = basef, allb = basef;
#pragma unroll
        for (int q8 = 0; q8 < 8; ++q8) { const float2 a = *(const float2*)(tot + q8 * 128 + d), bq = *(const float2*)(tot + (8 + q8) * 128 + d);
            allf.x += a.x; allf.y += a.y; allb.x += bq.x; allb.y += bq.y;
            if (q8 < tq) { basef.x += a.x; basef.y += a.y; } if (q8 > tq) { baseb.x += bq.x; baseb.y += bq.y; } }
        { float r0 = basef.x, r1 = basef.y;
#pragma unroll
          for (int i = 0; i < 8; ++i) { r0 += gf0[i]; gf0[i] = r0; r1 += gf1[i]; gf1[i] = r1; }
          r0 = baseb.x; r1 = baseb.y;
#pragma unroll
          for (int i = 7; i >= 0; --i) { r0 += gb0[i]; gb0[i] = r0; r1 += gb1[i]; gb1[i] = r1; } }
        const int dd2 = d & 63, ii = dd2 & 31, partner = (dd2 < 32) ? (d + 32) : (d - 32);
        const float sgn = (dd2 < 32) ? -1.f : 1.f;
        unsigned khf0[4], khf1[4], khb0[4], khb1[4]; float pf0 = 0.f, pf1 = 0.f, pb0 = 0.f, pb1 = 0.f;
        const size_t tb = ((size_t)(bh * 64 + j) * 64) * 128;
#pragma unroll
        for (int i = 0; i < 8; ++i) {
            const int tt = 8 * tq + i;
            float2 qv = *(const float2*)(qs + tt * 128 + d), kv = *(const float2*)(ksm + tt * 128 + d);
            if (lat) {
                const int pos = (d < 64) ? j : tt;
                const float4 cssn = *(const float4*)(p.RT + (pos * 32 + ii) * 2);
                const float2 qp = *(const float2*)(qs + tt * 128 + partner), kp = *(const float2*)(ksm + tt * 128 + partner);
                qv.x = qv.x * cssn.x + sgn * qp.x * cssn.y; qv.y = qv.y * cssn.z + sgn * qp.y * cssn.w;
                kv.x = kv.x * cssn.x + sgn * kp.x * cssn.y; kv.y = kv.y * cssn.z + sgn * kp.y * cssn.w;
            }
            qv.x *= 0.08838834764831845f; qv.y *= 0.08838834764831845f;
            if (lat) {
                const float ef0 = fexp2(gf0[i]), ef1 = fexp2(gf1[i]), eb0 = fexp2(gb0[i]), eb1 = fexp2(gb1[i]);
                const float nf0 = fexp2(-gf0[i]), nf1 = fexp2(-gf1[i]), nb0 = fexp2(-gb0[i]), nb1 = fexp2(-gb1[i]);
                const size_t o = tb + (size_t)tt * 128 + d;
                *(unsigned*)(p.QF + o) = cvt_pk_bf16(qv.x * ef0, qv.y * ef1); *(unsigned*)(p.KF + o) = cvt_pk_bf16(kv.x * nf0, kv.y * nf1);
                *(unsigned*)(p.QB + o) = cvt_pk_bf16(qv.x * eb0, qv.y * eb1); *(unsigned*)(p.KB + o) = cvt_pk_bf16(kv.x * nb0, kv.y * nb1);
            }
            const float hf0 = kv.x * fexp2(allf.x - gf0[i]), hf1 = kv.y * fexp2(allf.y - gf1[i]), hb0 = kv.x * fexp2(allb.x - gb0[i]), hb1 = kv.y * fexp2(allb.y - gb1[i]);
            if (i & 1) { khf0[i >> 1] = cvt_pk_bf16(pf0, hf0); khf1[i >> 1] = cvt_pk_bf16(pf1, hf1); khb0[i >> 1] = cvt_pk_bf16(pb0, hb0); khb1[i >> 1] = cvt_pk_bf16(pb1, hb1); }
            else { pf0 = hf0; pf1 = hf1; pb0 = hb0; pb1 = hb1; }
        }
        {
            const size_t o = ((((size_t)(bh * 68 + c) * 8 + (d >> 4)) * 2 + (tq >> 2)) * 64 + (d & 15) + 16 * (tq & 3)) * 8;
            *(u32x4*)(p.KHF + o) = (u32x4){khf0[0], khf0[1], khf0[2], khf0[3]}; *(u32x4*)(p.KHF + o + 8) = (u32x4){khf1[0], khf1[1], khf1[2], khf1[3]};
            *(u32x4*)(p.KHB + o) = (u32x4){khb0[0], khb0[1], khb0[2], khb0[3]}; *(u32x4*)(p.KHB + o + 8) = (u32x4){khb1[0], khb1[1], khb1[2], khb1[3]};
            if (tq == 0) { *(float2*)(p.DF + (size_t)(bh * 68 + c) * 128 + d) = make_float2(fexp2(allf.x), fexp2(allf.y)); *(float2*)(p.DB + (size_t)(bh * 68 + c) * 128 + d) = make_float2(fexp2(allb.x), fexp2(allb.y)); }
        }
        if (lat) {
            const int v = 2 * (t & 127), qr = t >> 7;
            unsigned wv[16];
#pragma unroll
            for (int s = 0; s < 16; ++s) wv[s] = *(const unsigned*)(p.P + (size_t)(row0 + 16 * qr + s) * PLD + 4096 + h * 256 + v);
            unsigned pk0[8], pk1[8];
#pragma unroll
            for (int s2 = 0; s2 < 8; ++s2) { pk0[s2] = (wv[2 * s2] & 0xffffu) | (wv[2 * s2 + 1] << 16); pk1[s2] = (wv[2 * s2] >> 16) | (wv[2 * s2 + 1] & 0xffff0000u); }
            bf16_t* o = p.VT + ((size_t)(bh * 68 + c) * 256 + v) * 64 + 16 * qr;
#pragma unroll
            for (int q8 = 0; q8 < 2; ++q8) {
                const u32x4 a0 = (u32x4){pk0[4 * q8], pk0[4 * q8 + 1], pk0[4 * q8 + 2], pk0[4 * q8 + 3]}, a1 = (u32x4){pk1[4 * q8], pk1[4 * q8 + 1], pk1[4 * q8 + 2], pk1[4 * q8 + 3]};
                *(u32x4*)(o + 8 * q8) = a0; *(u32x4*)(o + 64 + 8 * q8) = a1;
                bf16_t* o2 = p.VTS + ((((size_t)(bh * 68 + c) * 16 + (v >> 4)) * 2 + (qr >> 1)) * 64 + (v & 15) + 16 * ((2 * qr + q8) & 3)) * 8;
                *(u32x4*)o2 = a0; *(u32x4*)(o2 + 8) = a1;
            }
        } else {
            const int v = t & 255, half = t >> 8;
            unsigned pk[16];
#pragma unroll
            for (int s2 = 0; s2 < 16; ++s2) {
                const float* s0 = p.PS + (size_t)(row0 - NLAT + 32 * half + 2 * s2) * PSLD + 2560 + h * 256 + v;
                const float a = s0[0] + s0[PS_SLAB] + s0[2 * PS_SLAB] + s0[3 * PS_SLAB], bq = s0[PSLD] + s0[PS_SLAB + PSLD] + s0[2 * PS_SLAB + PSLD] + s0[3 * PS_SLAB + PSLD];
                pk[s2] = cvt_pk_bf16(a, bq);
            }
            bf16_t* o = p.VT + ((size_t)(bh * 68 + c) * 256 + v) * 64 + 32 * half;
            bf16_t* o2 = p.VTS + ((((size_t)(bh * 68 + c) * 16 + (v >> 4)) * 2 + half) * 64 + (v & 15)) * 8;
#pragma unroll
            for (int q4 = 0; q4 < 4; ++q4) { const u32x4 pv = (u32x4){pk[4 * q4], pk[4 * q4 + 1], pk[4 * q4 + 2], pk[4 * q4 + 3]}; *(u32x4*)(o + 8 * q4) = pv; *(u32x4*)(o2 + (16 * q4) * 8) = pv; }
        }
    }
}

__device__ __forceinline__ void glascan_wave(const Params& p, int unit, int dh, int lane, LAS unsigned char* ldsw) {
    const int v16 = unit & 15, scan = unit >> 4, dir = scan >> 3, bh = scan & 7;
    const int fr = lane & 15, fq = lane >> 4, d0 = 16 * dh, v0 = 16 * v16;
    const bf16_t* KH = (dir ? p.KHB : p.KHF) + (((size_t)bh * 68 * 8 + dh) * 2) * 512 + lane * 8;
    const bf16_t* VTp = p.VTS + (((size_t)bh * 68 * 16 + v16) * 2) * 512 + lane * 8;
    const float* DV = (dir ? p.DB : p.DF) + (size_t)bh * 68 * 128 + d0 + 4 * fq;
    bf16_t* SSp = p.SS + ((((size_t)dir * 8 + bh) * 65) * 256 + v0 + fr) * 128 + d0 + 4 * fq;
    LAS u32x2* sl = (LAS u32x2*)ldsw + lane;
    f32x4 acc = (f32x4){0.f, 0.f, 0.f, 0.f};
#define SC_CHUNK(n) (dir ? ((n) < 4 ? 3 - (n) : 71 - (n)) : (n))
#define SC_LOAD(S_, n) do { const int nn_ = (n) < 68 ? (n) : 67; const int c_ = SC_CHUNK(nn_); \
        S_##a0 = *(const bf16x8*)(KH + (size_t)c_ * 8192); S_##a1 = *(const bf16x8*)(KH + (size_t)c_ * 8192 + 512); \
        S_##b0 = *(const bf16x8*)(VTp + (size_t)c_ * 16384); S_##b1 = *(const bf16x8*)(VTp + (size_t)c_ * 16384 + 512); \
        S_##d = *(const f32x4*)(DV + (size_t)c_ * 128); } while (0)
#define SC_STEP(S_, k) do { u32x2 pk; pk.x = cvt_pk_bf16(acc[0], acc[1]); pk.y = cvt_pk_bf16(acc[2], acc[3]); sl[(k) * 64] = pk; \
        acc = acc * S_##d; \
        acc = __builtin_amdgcn_mfma_f32_16x16x32_bf16(S_##a0, S_##b0, acc, 0, 0, 0); acc = __builtin_amdgcn_mfma_f32_16x16x32_bf16(S_##a1, S_##b1, acc, 0, 0, 0); } while (0)
    bf16x8 Aa0, Aa1, Ab0, Ab1, Ba0, Ba1, Bb0, Bb1, Ca0, Ca1, Cb0, Cb1, Da0, Da1, Db0, Db1; f32x4 Ad, Bd, Cd, Dd;
    SC_LOAD(A, 0); SC_LOAD(B, 1); SC_LOAD(C, 2);
#pragma unroll 1
    for (int nb = 0; nb < 68; nb += 16) {
        const int iters = (nb + 16 <= 68) ? 4 : 1;
#pragma unroll 1
        for (int it = 0; it < iters; ++it) {
            const int n = nb + 4 * it;
            SC_LOAD(D, n + 3); SC_STEP(A, 4 * it);
            SC_LOAD(A, n + 4); SC_STEP(B, 4 * it + 1);
            SC_LOAD(B, n + 5); SC_STEP(C, 4 * it + 2);
            SC_LOAD(C, n + 6); SC_STEP(D, 4 * it + 3);
        }
#pragma unroll 1
        for (int k = 0; k < 4 * iters; ++k) { const int c_ = SC_CHUNK(nb + k); *(u32x2*)(SSp + (size_t)(c_ >= 4 ? c_ - 4 : 64) * 256 * 128) = sl[k * 64]; }
    }
#undef SC_CHUNK
#undef SC_LOAD
#undef SC_STEP
}

__device__ void ph_glaout(const Params& p, unsigned char* smb, const int wid0) {
    const int t = opaque_tid(wid0), w = t >> 6, lane = t & 63, l31 = lane & 31, hi = lane >> 5;
    const int wv = w & 3, wt = w >> 2;
    bf16_t* att = (bf16_t*)smb;
    float* ssq = (float*)(smb + 2 * 64 * 144);
    for (int u = blockIdx.x; u < 512; u += gridDim.x) {
        const int bh = u >> 6, j = u & 63, b = bh >> 2, h = bh & 3;
        const size_t tb = ((size_t)(bh * 64 + j) * 64) * 128;
        {
            const int dir = w >> 2, ts = (w >> 1) & 1, tt = w & 1;
            const bf16_t* Qm = (dir ? p.QB : p.QF) + tb; const bf16_t* Km = (dir ? p.KB : p.KF) + tb;
            const bool zero = dir ? (ts < tt) : (ts > tt);
            f32x16 s;
#pragma unroll
            for (int r = 0; r < 16; ++r) s[r] = 0.f;
            if (!zero) {
#pragma unroll
                for (int ks = 0; ks < 8; ++ks) {
                    const bf16x8 ka = *(const bf16x8*)(Km + (size_t)(32 * ts + l31) * 128 + 16 * ks + 8 * hi);
                    const bf16x8 qb = *(const bf16x8*)(Qm + (size_t)(32 * tt + l31) * 128 + 16 * ks + 8 * hi);
                    s = __builtin_amdgcn_mfma_f32_32x32x16_bf16(ka, qb, s, 0, 0, 0);
                }
            }
            const int tcol = 32 * tt + l31;
#pragma unroll
            for (int g = 0; g < 4; ++g) {
                float vv[4];
#pragma unroll
                for (int e = 0; e < 4; ++e) { const int srow = 32 * ts + 8 * g + 4 * hi + e; const bool keep = dir ? (srow >= tcol) : (srow <= tcol); vv[e] = keep ? s[4 * g + e] : 0.f; }
                u32x2 pk; pk.x = cvt_pk_bf16(vv[0], vv[1]); pk.y = cvt_pk_bf16(vv[2], vv[3]);
                *(u32x2*)(att + ((size_t)dir * 64 + tcol) * 72 + 32 * ts + 8 * g + 4 * hi) = pk;
            }
        }
        __syncthreads();
        f32x16 o0, o1;
#pragma unroll
        for (int r = 0; r < 16; ++r) { o0[r] = 0.f; o1[r] = 0.f; }
        const int tB = 32 * wt + l31;
        const bf16_t* vt0 = p.VT + ((size_t)(bh * 68 + 4 + j) * 256 + 64 * wv + l31) * 64 + 8 * hi;
#pragma unroll
        for (int dir = 0; dir < 2; ++dir) {
#pragma unroll
            for (int ks = 0; ks < 4; ++ks) {
                const bf16x8 bb = *(const bf16x8*)(att + ((size_t)dir * 64 + tB) * 72 + 16 * ks + 8 * hi);
                const bf16x8 a0 = *(const bf16x8*)(vt0 + 16 * ks), a1 = *(const bf16x8*)(vt0 + 32 * 64 + 16 * ks);
                o0 = __builtin_amdgcn_mfma_f32_32x32x16_bf16(a0, bb, o0, 0, 0, 0);
                o1 = __builtin_amdgcn_mfma_f32_32x32x16_bf16(a1, bb, o1, 0, 0, 0);
            }
            const bf16_t* ss0 = p.SS + ((((size_t)dir * 8 + bh) * 65 + j) * 256 + 64 * wv + l31) * 128 + 8 * hi;
            const bf16_t* qm = (dir ? p.QB : p.QF) + tb + (size_t)tB * 128 + 8 * hi;
#pragma unroll
            for (int ks = 0; ks < 8; ++ks) {
                const bf16x8 bb = *(const bf16x8*)(qm + 16 * ks);
                const bf16x8 a0 = *(const bf16x8*)(ss0 + 16 * ks), a1 = *(const bf16x8*)(ss0 + 32 * 128 + 16 * ks);
                o0 = __builtin_amdgcn_mfma_f32_32x32x16_bf16(a0, bb, o0, 0, 0, 0);
                o1 = __builtin_amdgcn_mfma_f32_32x32x16_bf16(a1, bb, o1, 0, 0, 0);
            }
        }
        float ss = 0.f;
#pragma unroll
        for (int r = 0; r < 16; ++r) ss += o0[r] * o0[r] + o1[r] * o1[r];
        ss += __shfl_xor(ss, 32);
        if (hi == 0) ssq[(wt * 4 + wv) * 32 + l31] = ss;
        __syncthreads();
        const float tot = ssq[(wt * 4 + 0) * 32 + l31] + ssq[(wt * 4 + 1) * 32 + l31] + ssq[(wt * 4 + 2) * 32 + l31] + ssq[(wt * 4 + 3) * 32 + l31];
        const float rstd = rsqrtf(tot * (1.f / 256.f) + 1e-6f);
        const int row = b * SEQ + 64 * j + tB;
        f32x4 gateA[2][4], gnA[2][4];
#pragma unroll
        for (int vt = 0; vt < 2; ++vt)
#pragma unroll
            for (int g = 0; g < 4; ++g) { const int v = 64 * wv + 32 * vt + 8 * g + 4 * hi;
                const u32x2 g4 = *(const u32x2*)(p.P + (size_t)row * PLD + 5120 + h * 256 + v);
                gateA[vt][g] = (f32x4){bf2f(g4.x & 0xffffu), bf2f(g4.x >> 16), bf2f(g4.y & 0xffffu), bf2f(g4.y >> 16)}; gnA[vt][g] = *(const f32x4*)(p.gla_norm_g + v); }
#pragma unroll
        for (int vt = 0; vt < 2; ++vt)
#pragma unroll
            for (int g = 0; g < 4; ++g) {
                const int v = 64 * wv + 32 * vt + 8 * g + 4 * hi;
                const f32x4 gate = gateA[vt][g], gn = gnA[vt][g];
                float ov[4];
#pragma unroll
                for (int e = 0; e < 4; ++e) { const float x = vt ? o1[4 * g + e] : o0[4 * g + e];
                    ov[e] = x * rstd * gn[e] * gate[e] * __builtin_amdgcn_rcpf(1.f + __builtin_amdgcn_exp2f(-1.4426950408889634f * gate[e])); }
                u32x2 pk; pk.x = cvt_pk_bf16(ov[0], ov[1]); pk.y = cvt_pk_bf16(ov[2], ov[3]);
                *(u32x2*)(p.MIX + (size_t)row * D + 1024 + h * 256 + v) = pk;
            }
        __syncthreads();
    }
}

__device__ void ph_norm2_router(const Params& p, float* sm, const int wid0) {
    const int t = opaque_tid(wid0), w = t >> 6, lane = t & 63;
    float* hs = sm;
    float* part = sm + 8 * D;
    int* hist = (int*)(sm + 8 * D + 8 * 8 * 64);
    const int G = gridDim.x, gpb = (NLAT / 8 + G - 1) / G;
    if (t < 64) hist[t] = 0;
    const int rb0 = blockIdx.x * gpb, rb1 = min(NLAT / 8, rb0 + gpb);
    float4 v[8];
    if (rb0 < rb1) {
#pragma unroll
        for (int j = 0; j < 8; ++j) v[j] = *(const float4*)(p.X1 + (size_t)(rb0 * 8 + w) * D + 256 * j + 4 * lane);
    }
    for (int rb = rb0; rb < rb1; ++rb) {
        const int row = rb * 8 + w, b = row / SEQ;
        const float* m = p.mod + (size_t)b * 6 * D;
        float ss = 0.f;
#pragma unroll
        for (int j = 0; j < 8; ++j) ss += v[j].x * v[j].x + v[j].y * v[j].y + v[j].z * v[j].z + v[j].w * v[j].w;
        ss = wave_sum(ss);
        const float rs = rsqrtf(ss * (1.f / D) + 1e-6f);
        __syncthreads();
#pragma unroll
        for (int j = 0; j < 8; ++j) {
            const int col = 256 * j + 4 * lane;
            const float4 g = *(const float4*)(p.norm2_g + col), sh = *(const float4*)(m + 3 * D + col), sc = *(const float4*)(m + 4 * D + col);
            float4 o;
            o.x = v[j].x * rs * g.x * (1.f + sc.x) + sh.x; o.y = v[j].y * rs * g.y * (1.f + sc.y) + sh.y;
            o.z = v[j].z * rs * g.z * (1.f + sc.z) + sh.z; o.w = v[j].w * rs * g.w * (1.f + sc.w) + sh.w;
            *(float4*)(hs + w * D + col) = o;
            u32x2 pk; pk.x = cvt_pk_bf16(o.x, o.y); pk.y = cvt_pk_bf16(o.z, o.w);
            *(u32x2*)(p.H + (size_t)row * D + col) = pk;
        }
        if (rb + 1 < rb1) {
#pragma unroll
            for (int j = 0; j < 8; ++j) v[j] = *(const float4*)(p.X1 + (size_t)(row + 8) * D + 256 * j + 4 * lane);
        }
        __syncthreads();
        {
            const int e4 = t & 15, kp = t >> 4;
            float a[8][4];
#pragma unroll
            for (int r = 0; r < 8; ++r)
#pragma unroll
                for (int j = 0; j < 4; ++j) a[r][j] = 0.f;
#pragma unroll 4
            for (int kk = 0; kk < 64; ++kk) {
                const int k = kk * 32 + kp;
                const float4 wv = *(const float4*)(p.router_w + (size_t)k * NE + 4 * e4);
#pragma unroll
                for (int r = 0; r < 8; ++r) { const float hv = hs[r * D + k]; a[r][0] += hv * wv.x; a[r][1] += hv * wv.y; a[r][2] += hv * wv.z; a[r][3] += hv * wv.w; }
            }
#pragma unroll
            for (int r = 0; r < 8; ++r)
#pragma unroll
                for (int j = 0; j < 4; ++j) { float x = a[r][j]; x += __shfl_xor(x, 16); x += __shfl_xor(x, 32); a[r][j] = x; }
            if (lane < 16) {
#pragma unroll
                for (int r = 0; r < 8; ++r) *(float4*)(part + (w * 8 + r) * 64 + 4 * lane) = make_float4(a[r][0], a[r][1], a[r][2], a[r][3]);
            }
        }
        __syncthreads();
        {
            float lgt = 0.f;
#pragma unroll
            for (int i = 0; i < 8; ++i) lgt += part[(i * 8 + w) * 64 + lane];
            const float sc = 1.f / (1.f + expf(-lgt));
            const float bs = sc + p.router_bias[lane];
            float m1 = bs; m1 = fmaxf(m1, __shfl_xor(m1, 1)); m1 = fmaxf(m1, __shfl_xor(m1, 2)); m1 = fmaxf(m1, __shfl_xor(m1, 4));
            int ai = (bs == m1) ? lane : 64; ai = min(ai, __shfl_xor(ai, 1)); ai = min(ai, __shfl_xor(ai, 2)); ai = min(ai, __shfl_xor(ai, 4));
            float m2 = (lane == ai) ? -INFINITY : bs; m2 = fmaxf(m2, __shfl_xor(m2, 1)); m2 = fmaxf(m2, __shfl_xor(m2, 2)); m2 = fmaxf(m2, __shfl_xor(m2, 4));
            const float gs = m1 + m2;
            float g0 = __shfl(gs, 0), g1 = __shfl(gs, 8), g2 = __shfl(gs, 16), g3 = __shfl(gs, 24), g4 = __shfl(gs, 32), g5 = __shfl(gs, 40), g6 = __shfl(gs, 48), g7 = __shfl(gs, 56);
            unsigned selmask = 0u;
#pragma unroll
            for (int it = 0; it < 4; ++it) {
                float best = -INFINITY; int bi = 0;
                if (!(selmask & 1u) && g0 > best) { best = g0; bi = 0; }
                if (!(selmask & 2u) && g1 > best) { best = g1; bi = 1; }
                if (!(selmask & 4u) && g2 > best) { best = g2; bi = 2; }
                if (!(selmask & 8u) && g3 > best) { best = g3; bi = 3; }
                if (!(selmask & 16u) && g4 > best) { best = g4; bi = 4; }
                if (!(selmask & 32u) && g5 > best) { best = g5; bi = 5; }
                if (!(selmask & 64u) && g6 > best) { best = g6; bi = 6; }
                if (!(selmask & 128u) && g7 > best) { best = g7; bi = 7; }
                selmask |= 1u << bi;
            }
            float cand = ((selmask >> (lane >> 3)) & 1u) ? bs : -INFINITY;
            int myslot = -1; float ssum = 0.f;
#pragma unroll
            for (int k = 0; k < TOPK; ++k) {
                const float mv = wave_max(cand);
                const int idx = wave_min_i((cand == mv) ? lane : 64);
                const float sv = __shfl(sc, idx);
                ssum += sv;
                if (lane == idx) { myslot = k; cand = -INFINITY; }
            }
            if (myslot >= 0) {
                p.EIDX[row * TOPK + myslot] = lane;
                p.EW[row * TOPK + myslot] = sc / ssum * 2.5f;
                p.LRANK[row * TOPK + myslot] = atomicAdd(&hist[lane], 1);
            }
        }
    }
    __syncthreads();
    if (t < 64) p.CNTB[blockIdx.x * 64 + t] = hist[t];
}

__device__ void ph_lists(const Params& p, int* smi, const int wid0) {
    const int t = opaque_tid(wid0);
    const int G = gridDim.x, gpb = (NLAT / 8 + G - 1) / G;
    int* tp = smi + 128; int* tot = smi + 64;
    __syncthreads();
    if (t < 64) {
        int before = 0, all = 0;
        for (int bb = 0; bb < G; ++bb) { const int cnt = p.CNTB[bb * 64 + t]; all += cnt; if (bb < (int)blockIdx.x) before += cnt; }
        smi[t] = before; tot[t] = all;
        if (blockIdx.x == 0) p.CNT[t] = all;
    }
    __syncthreads();
    if (t == 0) { int tt = 0; for (int e = 0; e < NE; ++e) { tp[e] = tt; tt += (tot[e] + 255) / 256; } tp[NE] = tt; }
    __syncthreads();
    const int r0 = blockIdx.x * gpb * 8, r1 = min(NLAT, r0 + gpb * 8);
    for (int i = r0 * TOPK + t; i < r1 * TOPK; i += NT) {
        const int e = p.EIDX[i];
        const int pos = tp[e] * 256 + smi[e] + p.LRANK[i];
        p.PAIRPOS[i] = pos; p.LIST[pos] = i / TOPK;
    }
    for (int e = blockIdx.x; e < NE; e += G) {
        const int cn = tot[e], end = (tp[e + 1] - tp[e]) * 256;
        for (int i = cn + t; i < end; i += NT) p.LIST[tp[e] * 256 + i] = 0;
    }
}

__device__ void ph_combine(const Params& p, const int wid0) {
    const int t = opaque_tid(wid0), w = t >> 6, lane = t & 63;
    for (int row = blockIdx.x * 8 + w; row < NLAT; row += gridDim.x * 8) {
        const int b = row / SEQ;
        float wk[TOPK]; const bf16_t* yr[TOPK];
#pragma unroll
        for (int k = 0; k < TOPK; ++k) { wk[k] = p.EW[row * TOPK + k]; yr[k] = p.Y + (size_t)p.PAIRPOS[row * TOPK + k] * D + 8 * lane; }
        const bf16_t* ys = p.YS + (size_t)row * D + 8 * lane;
        const float* x1 = p.X1 + (size_t)row * D + 8 * lane;
        const float* g2 = p.mod + (size_t)b * 6 * D + 5 * D + 8 * lane;
        float* o = p.out + (size_t)row * D + 8 * lane;
#pragma unroll
        for (int j = 0; j < 4; ++j) {
            float s[8];
            { const u32x4 v = *(const u32x4*)(ys + 512 * j);
              s[0] = bf2f(v.x & 0xffffu); s[1] = bf2f(v.x >> 16); s[2] = bf2f(v.y & 0xffffu); s[3] = bf2f(v.y >> 16); s[4] = bf2f(v.z & 0xffffu); s[5] = bf2f(v.z >> 16); s[6] = bf2f(v.w & 0xffffu); s[7] = bf2f(v.w >> 16); }
#pragma unroll
            for (int k = 0; k < TOPK; ++k) {
                const u32x4 v = *(const u32x4*)(yr[k] + 512 * j); const float wv = wk[k];
                s[0] += wv * bf2f(v.x & 0xffffu); s[1] += wv * bf2f(v.x >> 16); s[2] += wv * bf2f(v.y & 0xffffu); s[3] += wv * bf2f(v.y >> 16);
                s[4] += wv * bf2f(v.z & 0xffffu); s[5] += wv * bf2f(v.z >> 16); s[6] += wv * bf2f(v.w & 0xffffu); s[7] += wv * bf2f(v.w >> 16);
            }
            const f32x4 xa = *(const f32x4*)(x1 + 512 * j), xb = *(const f32x4*)(x1 + 512 * j + 4), ga = *(const f32x4*)(g2 + 512 * j), gb = *(const f32x4*)(g2 + 512 * j + 4);
            *(f32x4*)(o + 512 * j) = (f32x4){xa[0] + ga[0] * s[0], xa[1] + ga[1] * s[1], xa[2] + ga[2] * s[2], xa[3] + ga[3] * s[3]};
            *(f32x4*)(o + 512 * j + 4) = (f32x4){xb[0] + gb[0] * s[4], xb[1] + gb[1] * s[5], xb[2] + gb[2] * s[6], xb[3] + gb[3] * s[7]};
        }
    }
}

__global__ void __launch_bounds__(NT, 2) mega(Params p) {
    extern __shared__ __attribute__((aligned(16))) unsigned char dynlds[];
    int wid0;
    wid0 = __builtin_amdgcn_readfirstlane((int)threadIdx.x >> 6); asm volatile("" : "+s"(wid0));
    if (wid0 == 0 && xb_lane_id() < 4) ((unsigned*)(dynlds + LDS_BARW))[xb_lane_id()] = 0u;
    __syncthreads();
    XcdBarrier bar = xcd_barrier_post(p.bar, (volatile LAS unsigned*)(dynlds + LDS_BARW), wid0);
    float* sm = (float*)dynlds;
    int* tp = (int*)(dynlds + LDS_TAB);
    LAS unsigned char* lds = (LAS unsigned char*)dynlds;
    const int G = gridDim.x, c = blockIdx.x;

#ifndef REP
#define REP 0
#endif
#define PH(bit, ...) do { __VA_ARGS__; if (REP & (1 << (bit))) { xcd_barrier(bar); __VA_ARGS__; } } while (0)
    PH(0, ph_prologue(p, sm, wid0));                            xcd_barrier(bar);
    PH(1, ph_norm1(p, wid0));                               xcd_barrier(bar);
    { SchedDense S{(const char*)p.H, (const char*)p.WinT, D, NLAT / 256, PLD / 256, G, c}; EpiInproj E{p.P};
      g8::gemm_phase(lds, D, S, E, wid0); }
    { SchedInprojSplit S{(const char*)p.H, (const char*)p.WinT, G, c}; EpiInprojSplit E{p.PS, p.DDS};
      g8::gemm_phase(lds, D, S, E, wid0, 512); }                xcd_barrier(bar);
    PH(3, ph_naprep(p, wid0)); PH(4, ph_glaprep(p, sm, wid0));        xcd_barrier(bar);
    PH(6, ph_attn(p, dynlds, wid0));                            xcd_barrier(bar);
    PH(7, ph_glaout(p, dynlds, wid0));                          xcd_barrier(bar);
    PH(8, { SchedDense S{(const char*)p.MIX, (const char*)p.WoutT, D, NLAT / 256, D / 256, G, c}; EpiOutproj E{p.x, p.mod, p.X1};
      g8::gemm_phase(lds, D, S, E, wid0); });                   xcd_barrier(bar);
    PH(12, ph_norm2_router(p, sm, wid0));                       xcd_barrier(bar);
    PH(13, ph_lists(p, tp, wid0));                              xcd_barrier(bar);
    moe_tables(p, tp, wid0);
    PH(9, { SchedUp S{tp, (const char*)p.H, p.LIST, (const char*)p.E13T, (const char*)p.S13T, G, c}; EpiUp E{p.HB, p.SHH};
      g8::gemm_phase(lds, D, S, E, wid0); });                   xcd_barrier(bar);
    PH(10, { SchedDown S{tp, (const char*)p.HB, (const char*)p.E2T, (const char*)p.SHH, (const char*)p.S2T, G, c}; EpiDown E{p.Y, p.YS};
      g8::gemm_phase(lds, DE, S, E, wid0); });                  xcd_barrier(bar);
    PH(11, ph_combine(p, wid0));
}

extern "C" void kernel_launch(void* const* d_in, const int* in_sizes, int n_in, void* d_out, int out_size, void* d_ws, size_t ws_size, hipStream_t stream) {
    Params p{};
    const float* const* in = (const float* const*)d_in;
    p.x = in[0]; p.c = in[1]; p.ctx = in[2]; p.c_ctx = in[3]; p.w_mod = in[4]; p.b_mod = in[5]; p.norm1_g = in[6]; p.norm2_g = in[7]; p.w_in = in[8];
    p.q_norm_g = in[9]; p.k_norm_g = in[10]; p.na_rpb = in[11]; p.up_f = in[12]; p.bias_f = in[13]; p.up_b = in[14]; p.bias_b = in[15]; p.gla_norm_g = in[16];
    p.w_out = in[17]; p.router_w = in[18]; p.router_bias = in[19]; p.ew1 = in[20]; p.ew3 = in[21]; p.ew2 = in[22]; p.sw1 = in[23]; p.sw3 = in[24]; p.sw2 = in[25];
    p.out = (float*)d_out;
    char* w = (char*)d_ws; size_t o = 0;
    auto take = [&](size_t bytes) { void* r = w + o; o += (bytes + 255) & ~(size_t)255; return r; };
    p.bar = (unsigned*)take((size_t)XCD_BAR_WORDS * 4);
    p.CNT = (int*)take(64 * 4); p.QCTR = (int*)take(64 * 4); p.LRANK = (int*)take((size_t)NPAIR * 4); p.CNTB = (int*)take((size_t)1024 * 64 * 4);
    p.mod = (float*)take((size_t)3 * 6 * D * 4); p.RT = (float*)take((size_t)64 * 32 * 2 * 4);
    p.EIDX = (int*)take((size_t)NPAIR * 4); p.EW = (float*)take((size_t)NPAIR * 4); p.PAIRPOS = (int*)take((size_t)NPAIR * 4); p.LIST = (int*)take((size_t)PADROWS * 4);
    p.WinT = (bf16_t*)take((size_t)(PLD + 256) * D * 2); p.WoutT = (bf16_t*)take((size_t)D * D * 2); p.S13T = (bf16_t*)take((size_t)1024 * D * 2); p.S2T = (bf16_t*)take((size_t)D * DE * 2);
    p.E13T = (bf16_t*)take((size_t)NE * 1024 * D * 2); p.E2T = (bf16_t*)take((size_t)NE * D * DE * 2);
    p.H = (bf16_t*)take((size_t)NROW * D * 2);
    p.X1 = (float*)take((size_t)NLAT * D * 4);
    const size_t big = o;
    p.P = (bf16_t*)take((size_t)NLAT * PLD * 2); p.PS = (float*)take(4 * PS_SLAB * 4); p.DDS = (float*)take(4 * DD_SLAB * 4); p.NQb = (bf16_t*)take((size_t)NLAT * 1024 * 2); p.NKf = (bf16_t*)take((size_t)16 * NTILE * 4096 * 2); p.VTf = (bf16_t*)take((size_t)16 * NTILE * 4096 * 2);
    p.MIX = (bf16_t*)take((size_t)NLAT * D * 2);
    p.QF = (bf16_t*)take((size_t)8 * 64 * 64 * 128 * 2); p.KF = (bf16_t*)take((size_t)8 * 64 * 64 * 128 * 2); p.QB = (bf16_t*)take((size_t)8 * 64 * 64 * 128 * 2); p.KB = (bf16_t*)take((size_t)8 * 64 * 64 * 128 * 2);
    p.KHF = (bf16_t*)take((size_t)8 * 68 * 128 * 64 * 2); p.KHB = (bf16_t*)take((size_t)8 * 68 * 128 * 64 * 2); p.VT = (bf16_t*)take((size_t)8 * 68 * 256 * 64 * 2); p.VTS = (bf16_t*)take((size_t)8 * 68 * 256 * 64 * 2);
    p.DF = (float*)take((size_t)8 * 68 * 128 * 4); p.DB = (float*)take((size_t)8 * 68 * 128 * 4); p.SS = (bf16_t*)take((size_t)16 * 65 * 256 * 128 * 2);
    o = big;
    p.HB = (bf16_t*)take((size_t)PADROWS * DE * 2); p.SHH = (bf16_t*)take((size_t)NLAT * DE * 2); p.Y = (bf16_t*)take((size_t)PADROWS * D * 2); p.YS = (bf16_t*)take((size_t)NLAT * D * 2);
    static int grid = 0;
    if (!grid) {
        int dev = 0, cus = 0, per_cu = 0;
        hipGetDevice(&dev);
        hipDeviceGetAttribute(&cus, hipDeviceAttributeMultiprocessorCount, dev);
        (void)hipFuncSetAttribute((const void*)mega, hipFuncAttributeMaxDynamicSharedMemorySize, LDS_BYTES);
        (void)hipOccupancyMaxActiveBlocksPerMultiprocessor(&per_cu, (const void*)mega, NT, LDS_BYTES);
        (void)hipGetLastError();
        grid = cus;
    }
    (void)hipMemsetAsync(p.bar, 0, (size_t)XCD_BAR_WORDS * 4, stream);
    hipLaunchKernelGGL(mega, dim3(grid), dim3(NT), LDS_BYTES, stream, p);
}
```

```cpp
#include <hip/hip_runtime.h>
#include <stdint.h>

#define XB_TMO      128
#define XB_XCNT(j)  (256  + 64 * (j))
#define XB_XSUB(j)  (1280 + 64 * (j))
#define XB_XGEN(j)  (2304 + 64 * (j))
#define XB_TOP      3328
#define XB_TOPGEN   3392
#define XCD_BAR_WORDS 3456
#define XB_SPIN_CAP (1u << 18)
#define LAS __attribute__((address_space(3)))

__device__ __forceinline__ unsigned xb_ld(unsigned* p)              { return __hip_atomic_load(p, __ATOMIC_RELAXED, __HIP_MEMORY_SCOPE_AGENT); }
__device__ __forceinline__ unsigned xb_add(unsigned* p, unsigned v) { return __hip_atomic_fetch_add(p, v, __ATOMIC_RELAXED, __HIP_MEMORY_SCOPE_AGENT); }
__device__ __forceinline__ unsigned xb_xcc_id() { return (unsigned)__builtin_amdgcn_s_getreg((3 << 11) | 20) & 0xFu; }
#define XB_SPIN(cond, bar) do { unsigned _sp = 0; while (cond) { __builtin_amdgcn_s_sleep(1); \
    if ((++_sp & 255u) == 0u) { if (xb_ld(&(bar)[XB_TMO])) break; if (_sp > XB_SPIN_CAP) { atomicAdd(&(bar)[XB_TMO], 1u); break; } } } } while (0)

__device__ __forceinline__ int xb_lane_id() { return (int)__builtin_amdgcn_mbcnt_hi(~0u, __builtin_amdgcn_mbcnt_lo(~0u, 0u)); }
struct XcdBarrier {
    int wid;
    unsigned* bar; unsigned x;
    volatile LAS unsigned* st;
};

__device__ __forceinline__ XcdBarrier xcd_barrier_post(unsigned* bar, volatile LAS unsigned* st, int wid) {
    XcdBarrier b; b.wid = wid; b.bar = bar; b.x = xb_xcc_id(); b.st = st;
    if (wid == 0 && xb_lane_id() == 0) (void)xb_add(&bar[XB_XCNT(b.x)], 1u);
    return b;
}
__device__ __forceinline__ void xcd_barrier_complete(unsigned* bar, unsigned x, unsigned& nloc, unsigned& nx) {
    const unsigned G = gridDim.x * gridDim.y * gridDim.z;
    unsigned sum, cnt, mine, sp = 0u;
    for (;;) {
        sum = 0u; cnt = 0u; mine = 0u;
#pragma unroll
        for (unsigned j = 0; j < 16; ++j) { const unsigned c = xb_ld(&bar[XB_XCNT(j)]); sum += c; cnt += (c > 0u) ? 1u : 0u; mine = (j == x) ? c : mine; }
        if (sum == G) break;
        __builtin_amdgcn_s_sleep(1);
        if ((++sp & 255u) == 0u) { if (xb_ld(&bar[XB_TMO])) break; if (sp > XB_SPIN_CAP) { atomicAdd(&bar[XB_TMO], 1u); break; } }
    }
    nloc = mine > 0u ? mine : 1u; nx = cnt > 0u ? cnt : 1u;
}

__device__ __forceinline__ void xcd_barrier(const XcdBarrier& b) {
    asm volatile("s_waitcnt vmcnt(0)" ::: "memory");
    __syncthreads();
    if (b.wid == 0 && xb_lane_id() == 0) {
        unsigned* bar = b.bar;
        __builtin_amdgcn_s_waitcnt(0);
        unsigned nloc = b.st[0], nx = b.st[1];
        if (nloc == 0u) { xcd_barrier_complete(bar, b.x, nloc, nx); b.st[0] = nloc; b.st[1] = nx; }
        const unsigned old = xb_add(&bar[XB_XSUB(b.x)], 1u);
        const unsigned gen = old / nloc;
        if (old + 1u == (gen + 1u) * nloc) {
            __builtin_amdgcn_fence(__ATOMIC_RELEASE, "agent");
            asm volatile("s_waitcnt vmcnt(0)" ::: "memory");
            const unsigned og = xb_add(&bar[XB_TOP], 1u);
            const unsigned tg = og / nx;
            if (og + 1u == (tg + 1u) * nx) xb_add(&bar[XB_TOPGEN], 1u);
            else XB_SPIN(xb_ld(&bar[XB_TOPGEN]) == tg, bar);
            __builtin_amdgcn_fence(__ATOMIC_ACQUIRE, "agent");
            xb_add(&bar[XB_XGEN(b.x)], 1u);
            asm volatile("s_waitcnt vmcnt(0)" ::: "memory");
        } else {
            XB_SPIN(xb_ld(&bar[XB_XGEN(b.x)]) == gen, bar);
            __builtin_amdgcn_fence(__ATOMIC_ACQUIRE, "agent");
            asm volatile("s_waitcnt vmcnt(0)" ::: "memory");
        }
    }
    __syncthreads();
}


#define NT 512
typedef unsigned short bf16_t;
typedef short bf16x8 __attribute__((ext_vector_type(8)));
typedef float f32x4 __attribute__((ext_vector_type(4)));
typedef float f32x16 __attribute__((ext_vector_type(16)));
typedef unsigned u32x4 __attribute__((ext_vector_type(4)));
typedef unsigned u32x2 __attribute__((ext_vector_type(2)));

constexpr int D = 2048, SEQ = 4096, CTXL = 256, NB = 2;
constexpr int NLAT = NB * SEQ;
constexpr int NCTX = NB * CTXL;
constexpr int NROW = NLAT + NCTX;
constexpr int INC = 6176;
constexpr int PLD = 6144;
constexpr int PSLD = 3584;
constexpr size_t PS_SLAB = (size_t)512 * 3584, DD_SLAB = (size_t)8704 * 32;
constexpr int NE = 64, TOPK = 6, DE = 512;
constexpr int NPAIR = NLAT * TOPK;
constexpr int PADROWS = NPAIR + NE * 256;
constexpr int YLD8 = D + 64;
constexpr int YLD = D + 64;
constexpr int LDS_STAGE = 131072;
constexpr int LDS_TAB = LDS_STAGE;
constexpr int LDS_BARW = LDS_STAGE + 4096;
constexpr int LDS_BYTES = LDS_BARW + 16 + 8192;

struct Params {
    const float *x, *c, *ctx, *c_ctx, *w_mod, *b_mod, *norm1_g, *norm2_g, *w_in, *q_norm_g, *k_norm_g, *na_rpb,
        *up_f, *bias_f, *up_b, *bias_b, *gla_norm_g, *w_out, *router_w, *router_bias, *ew1, *ew3, *ew2, *sw1, *sw3, *sw2;
    float* out;
    float *mod, *X1, *PS, *DDS, *EW, *RT, *DF, *DB;
    unsigned char *Y8, *YS8;
    bf16_t *P, *H, *MIX, *HB, *SHH, *Y, *WinT, *WoutT, *S13T, *S2T, *E13T, *E2T, *QF, *KF, *QB, *KB, *KHF, *KHB, *VT, *SS, *NQb, *NKf, *VTf, *YS, *VTS;
    int *EIDX, *PAIRPOS, *LIST, *CNT, *QCTR, *LRANK, *CNTB;
    unsigned* bar;
};

__device__ __forceinline__ int fresh_lane_id() { int l; asm volatile("v_mbcnt_lo_u32_b32 %0, -1, 0\n\tv_mbcnt_hi_u32_b32 %0, -1, %0" : "=v"(l)); return l; }
__device__ __forceinline__ int opaque_tid(int wid0) { return wid0 * 64 + fresh_lane_id(); }
__device__ __forceinline__ float wave_sum(float v) { for (int o = 32; o > 0; o >>= 1) v += __shfl_xor(v, o); return v; }
__device__ __forceinline__ float wave_max(float v) { for (int o = 32; o > 0; o >>= 1) v = fmaxf(v, __shfl_xor(v, o)); return v; }
__device__ __forceinline__ int wave_min_i(int v) { for (int o = 32; o > 0; o >>= 1) v = min(v, __shfl_xor(v, o)); return v; }
__device__ __forceinline__ float siluf(float v) { return v / (1.f + expf(-v)); }
typedef float f32x2 __attribute__((ext_vector_type(2)));
typedef __bf16 bf16x2_t __attribute__((ext_vector_type(2)));
__device__ __forceinline__ unsigned cvt_pk_bf16(float lo, float hi) { const f32x2 v = {lo, hi}; return __builtin_bit_cast(unsigned, __builtin_convertvector(v, bf16x2_t)); }
__device__ __forceinline__ bf16_t f2bf(float f) { return (bf16_t)(cvt_pk_bf16(f, 0.f) & 0xffffu); }
__device__ __forceinline__ float bf2f(unsigned b) { return __uint_as_float(b << 16); }

__device__ __forceinline__ void adaln_item(const Params& p, float* sm, int item, const int wid0) {
    const int t = opaque_tid(wid0), cq = t & 15, kg = t >> 4, n0 = item * 64;
    float* red = sm + 3 * D;
    float a[3][4];
#pragma unroll
    for (int r = 0; r < 3; ++r)
#pragma unroll
        for (int j = 0; j < 4; ++j) a[r][j] = 0.f;
#pragma unroll 4
    for (int k = kg; k < D; k += 32) {
        const f32x4 w4 = __builtin_nontemporal_load((const f32x4*)(p.w_mod + (size_t)k * (6 * D) + n0 + 4 * cq)); const float4 w = make_float4(w4[0], w4[1], w4[2], w4[3]);
        const float s0 = sm[k], s1 = sm[D + k], s2 = sm[2 * D + k];
        a[0][0] += s0 * w.x; a[0][1] += s0 * w.y; a[0][2] += s0 * w.z; a[0][3] += s0 * w.w;
        a[1][0] += s1 * w.x; a[1][1] += s1 * w.y; a[1][2] += s1 * w.z; a[1][3] += s1 * w.w;
        a[2][0] += s2 * w.x; a[2][1] += s2 * w.y; a[2][2] += s2 * w.z; a[2][3] += s2 * w.w;
    }
    __syncthreads();
#pragma unroll
    for (int r = 0; r < 3; ++r)
#pragma unroll
        for (int j = 0; j < 4; ++j) red[(kg * 3 + r) * 64 + 4 * cq + j] = a[r][j];
    __syncthreads();
    if (t < 192) {
        const int r = t >> 6, cc = t & 63;
        float s = p.b_mod[n0 + cc];
#pragma unroll 8
        for (int g = 0; g < 32; ++g) s += red[(g * 3 + r) * 64 + cc];
        p.mod[(size_t)r * 6 * D + n0 + cc] = s;
    }
    __syncthreads();
}
__device__ __forceinline__ void transpose_item(const float* W, int K, int N, int k0, int n0, bf16_t* WT, int drow0, float* scr, int lane, int maxc = 63) {
    if (maxc >= 63) {
        const int kr = lane >> 4, nq = lane & 15;
        f32x4 v[16];
#pragma unroll
        for (int q = 0; q < 16; ++q) v[q] = __builtin_nontemporal_load((const f32x4*)(W + (size_t)(k0 + 4 * q + kr) * N + n0 + 4 * nq));
#pragma unroll
        for (int q = 0; q < 16; ++q) { float* d = scr + (4 * q + kr) * 65 + 4 * nq; d[0] = v[q][0]; d[1] = v[q][1]; d[2] = v[q][2]; d[3] = v[q][3]; }
    } else {
        const int cl = lane < maxc ? lane : maxc;
#pragma unroll 8
        for (int kk = 0; kk < 64; ++kk) scr[kk * 65 + lane] = W[(size_t)(k0 + kk) * N + n0 + cl];
    }
    asm volatile("s_waitcnt lgkmcnt(0)" ::: "memory");
    const int c = lane & 7;
#pragma unroll
    for (int j = 0; j < 8; ++j) {
        const int n = (lane >> 3) + 8 * j; const float* s = scr + (8 * c) * 65 + n;
        u32x4 o; o.x = cvt_pk_bf16(s[0], s[65]); o.y = cvt_pk_bf16(s[2 * 65], s[3 * 65]); o.z = cvt_pk_bf16(s[4 * 65], s[5 * 65]); o.w = cvt_pk_bf16(s[6 * 65], s[7 * 65]);
        *(u32x4*)(WT + (size_t)(drow0 + n) * K + k0 + 8 * c) = o;
    }
    asm volatile("s_waitcnt lgkmcnt(0)" ::: "memory");
}
constexpr int CI_WIN = 32 * 97, CI_WOUT = 32 * 32, CI_S13 = 2 * 32 * 8, CI_S2 = 8 * 32, CI_E13 = 64 * 2 * 32 * 8, CI_E2 = 64 * 8 * 32;
constexpr int CI_TOTAL = CI_WIN + CI_WOUT + CI_S13 + CI_S2 + CI_E13 + CI_E2;
__device__ __forceinline__ void convert_item(const Params& p, int it, float* scr, int lane) {
    if (it < CI_WIN) { const int kb = it / 97, nb = it % 97; transpose_item(p.w_in, D, INC, 64 * kb, 64 * nb, p.WinT, 64 * nb, scr, lane, INC - 1 - 64 * nb); return; }
    it -= CI_WIN;
    if (it < CI_WOUT) { const int kb = it / 32, nb = it % 32; transpose_item(p.w_out, D, D, 64 * kb, 64 * nb, p.WoutT, 64 * nb, scr, lane); return; }
    it -= CI_WOUT;
    if (it < CI_S13) {
        const int which = it / 256, r = it % 256, kb = r / 8, nb = r % 8;
        transpose_item(which ? p.sw3 : p.sw1, D, DE, 64 * kb, 64 * nb, p.S13T, (nb >> 1) * 256 + which * 128 + (nb & 1) * 64, scr, lane); return; }
    it -= CI_S13;
    if (it < CI_S2) { const int kb = it / 32, nb = it % 32; transpose_item(p.sw2, DE, D, 64 * kb, 64 * nb, p.S2T, 64 * nb, scr, lane); return; }
    it -= CI_S2;
    if (it < CI_E13) {
        const int e = it / 512, r0 = it % 512, which = r0 / 256, r = r0 % 256, kb = r / 8, nb = r % 8;
        transpose_item((which ? p.ew3 : p.ew1) + (size_t)e * D * DE, D, DE, 64 * kb, 64 * nb, p.E13T + (size_t)e * 1024 * D, (nb >> 1) * 256 + which * 128 + (nb & 1) * 64, scr, lane); return; }
    it -= CI_E13;
    { const int e = it / 256, r = it % 256, kb = r / 32, nb = r % 32;
      transpose_item(p.ew2 + (size_t)e * DE * D, DE, D, 64 * kb, 64 * nb, p.E2T + (size_t)e * D * DE, 64 * nb, scr, lane); }
}
__device__ void ph_prologue(const Params& p, float* sm, const int wid0) {
    const int t = opaque_tid(wid0), w = t >> 6, lane = t & 63;
    if (blockIdx.x == 0 && t == 0) { p.QCTR[0] = 0; p.QCTR[32] = 0; }
    if (blockIdx.x == gridDim.x - 1) {
        for (int i = t; i < 64 * 32; i += NT) { const float ang = (float)(i >> 5) * powf(10000.f, -(float)(i & 31) / 32.f); p.RT[2 * i] = cosf(ang); p.RT[2 * i + 1] = sinf(ang); }
    }
    if (blockIdx.x < 192) {
        for (int i = t; i < 3 * D; i += NT) { const int r = i / D, k = i % D; sm[i] = siluf(r < 2 ? p.c[r * D + k] : p.c_ctx[k]); }
        __syncthreads();
        for (int item = blockIdx.x; item < 192; item += gridDim.x) adaln_item(p, sm, item, wid0);
    }
    __syncthreads();
    float* scr = sm + w * (64 * 65);
    for (int it = blockIdx.x * 8 + w; it < CI_TOTAL; it += gridDim.x * 8) convert_item(p, it, scr, lane);
}

__device__ void ph_norm1(const Params& p, const int wid0) {
    const int t = opaque_tid(wid0), w = t >> 6, lane = t & 63;
    for (int row = blockIdx.x * 8 + w; row < NROW; row += gridDim.x * 8) {
        const float* src; int mr;
        if (row < NLAT) { src = p.x + (size_t)row * D; mr = row / SEQ; } else { src = p.ctx + (size_t)(row - NLAT) * D; mr = 2; }
        const float* m = p.mod + (size_t)mr * 6 * D;
        float4 v[8]; float ss = 0.f;
#pragma unroll
        for (int j = 0; j < 8; ++j) { v[j] = *(const float4*)(src + 256 * j + 4 * lane); ss += v[j].x * v[j].x + v[j].y * v[j].y + v[j].z * v[j].z + v[j].w * v[j].w; }
        ss = wave_sum(ss);
        const float rs = rsqrtf(ss * (1.f / D) + 1e-6f);
#pragma unroll
        for (int j = 0; j < 8; ++j) {
            const int col = 256 * j + 4 * lane;
            const float4 g = *(const float4*)(p.norm1_g + col), sh = *(const float4*)(m + col), sc = *(const float4*)(m + D + col);
            u32x2 pk;
            pk.x = cvt_pk_bf16(v[j].x * rs * g.x * (1.f + sc.x) + sh.x, v[j].y * rs * g.y * (1.f + sc.y) + sh.y);
            pk.y = cvt_pk_bf16(v[j].z * rs * g.z * (1.f + sc.z) + sh.z, v[j].w * rs * g.w * (1.f + sc.w) + sh.w);
            *(u32x2*)(p.H + (size_t)row * D + col) = pk;
        }
    }
}

namespace g8 {
constexpr int BM = 256, BK = 64, HALF = 128, HTB = HALF * BK * 2;
__device__ __forceinline__ int lds_byte(int r, int c) { const int st = (r >> 4) * 2 + (c >> 5), rr = r & 15, cc = c & 31, ob = rr * 64 + cc * 2; return st * 1024 + (ob ^ (((ob >> 9) & 1) << 5)); }
__device__ __forceinline__ void stage_rc(int b, int& R, int& C) { const int st = b / 1024, sb = b % 1024, swz = sb ^ (((sb >> 9) & 1) << 5); R = (st >> 1) * 16 + swz / 64; C = (st & 1) * 32 + (swz % 64) / 2; }
__device__ __forceinline__ int perm32(int rho) { const int n = rho >> 4, i = rho & 15; return 8 * (i >> 2) + 4 * n + (i & 3); }

struct Unit { const char* A; const int* rows; int row0; const char* Bt; int orow, pn, aux; int nv = 256; };

__device__ __forceinline__ bool work_id(int i, int G, int c, int nwg, int& wgid) {
    const long L = (long)i * G + c; if (L >= nwg) return false;
    const int l = (int)L, q = nwg / 8, r = nwg % 8, xcd = l % 8, off = l / 8;
    wgid = (xcd < r ? xcd * (q + 1) : r * (q + 1) + (xcd - r) * q) + off; return true;
}

template <class Epi, class Sched>
__device__ __forceinline__ void gemm_phase(LAS unsigned char* lds, const int K, const Sched& S, const Epi& E, const int wid0, const int kloop = 0) {
    const int tid_ = wid0 * 64 + fresh_lane_id();
    const int tid = tid_, wid = __builtin_amdgcn_readfirstlane(tid >> 6), lane = tid & 63, wr = wid >> 2, wc = wid & 3, fr = lane & 15, fq = lane >> 4;
    const int nt = (kloop ? kloop : K) / BK;
    int sR[2]; unsigned sC2[2], voffB[2], voffB1[2];
#pragma unroll
    for (int i = 0; i < 2; ++i) { int R, C; stage_rc(tid * 16 + i * 8192, R, C);
        const int Rb = Epi::PERM == 3 ? (64 * (R >> 5) + 16 * ((R & 15) >> 2) + 4 * ((R >> 4) & 1) + (R & 3)) : (Epi::PERM == 1 ? ((R & ~31) + perm32(R & 31)) : R);
        sR[i] = R; sC2[i] = (unsigned)C * 2u; voffB[i] = (unsigned)(Rb * K + C) * 2u; voffB1[i] = Epi::PERM == 3 ? (unsigned)((Rb + 8) * K + C) * 2u : voffB[i]; }
    const size_t kstep = (size_t)(BK * 2);
    const size_t hstep = (size_t)HALF * K * 2;
    const size_t hB1 = Epi::PERM == 3 ? 0 : hstep;
    const unsigned ldsw = (unsigned)wid * 1024u;
    const int aoff = lds_byte(wr * 64 + fr, fq * 8), boff = lds_byte(wc * 32 + fr, fq * 8);
#define G8_SA(b, h) (((b) * 2 + (h)) * g8::HTB)
#define G8_SB(b, h) ((4 + (b) * 2 + (h)) * g8::HTB)
#define G8_STAGE(bufoff, gbase, v0, v1) do { \
        __builtin_amdgcn_global_load_lds((const unsigned*)((const char*)(gbase) + (v0)), (LAS unsigned*)(lds + (bufoff) + ldsw), 16, 0, 0); \
        __builtin_amdgcn_global_load_lds((const unsigned*)((const char*)(gbase) + (v1)), (LAS unsigned*)(lds + (bufoff) + ldsw + 8192), 16, 0, 0); } while (0)
#define G8_LDA(dst, b, h) do { _Pragma("unroll") for (int m = 0; m < 4; ++m) _Pragma("unroll") for (int k = 0; k < 2; ++k) dst[m][k] = *(const LAS bf16x8*)(lds + G8_SA(b, h) + aoff + m * 2048 + k * 1024); } while (0)
#define G8_LDB(dst, b, h) do { _Pragma("unroll") for (int n = 0; n < 2; ++n) _Pragma("unroll") for (int k = 0; k < 2; ++k) dst[n][k] = *(const LAS bf16x8*)(lds + G8_SB(b, h) + boff + n * 2048 + k * 1024); } while (0)
#define G8_MMA(ai, bj, At, Bt) do { __builtin_amdgcn_s_setprio(1); _Pragma("unroll") for (int m = 0; m < 4; ++m) _Pragma("unroll") for (int n = 0; n < 2; ++n) _Pragma("unroll") for (int k = 0; k < 2; ++k) \
        acc[ai][bj][m][n] = __builtin_amdgcn_mfma_f32_16x16x32_bf16(Bt[n][k], At[m][k], acc[ai][bj][m][n], 0, 0, 0); __builtin_amdgcn_s_setprio(0); } while (0)
#define G8_WAIT_V(n) asm volatile("s_waitcnt vmcnt(" #n ")" ::: "memory")
#define G8_WAIT_L(n) asm volatile("s_waitcnt lgkmcnt(" #n ")" ::: "memory")
#define G8_BAR __builtin_amdgcn_s_barrier()
#define G8_SCHED __builtin_amdgcn_sched_barrier(0)
    Unit cur, nxt; int ui = 0;
    if (!S.next(0, cur)) return;
    f32x4 acc[2][2][4][2];
#pragma unroll
    for (int a = 0; a < 2; ++a)
#pragma unroll
        for (int b = 0; b < 2; ++b)
#pragma unroll
            for (int m = 0; m < 4; ++m)
#pragma unroll
                for (int n = 0; n < 2; ++n) acc[a][b][m][n] = (f32x4){0.f, 0.f, 0.f, 0.f};
    bf16x8 At[4][2], B0[2][2], B1[2][2];
    unsigned vA00, vA01, vA10, vA11, nA00, nA01, nA10, nA11;
#define G8_MKOFF(u, o00, o01, o10, o11) do { \
        int r00, r01, r10, r11; \
        if ((u).rows) { r00 = (u).rows[sR[0]]; r01 = (u).rows[sR[1]]; r10 = (u).rows[128 + sR[0]]; r11 = (u).rows[128 + sR[1]]; } \
        else { r00 = (u).row0 + sR[0]; r01 = (u).row0 + sR[1]; r10 = (u).row0 + 128 + sR[0]; r11 = (u).row0 + 128 + sR[1]; } \
        o00 = (unsigned)r00 * (unsigned)(K * 2) + sC2[0]; o01 = (unsigned)r01 * (unsigned)(K * 2) + sC2[1]; \
        o10 = (unsigned)r10 * (unsigned)(K * 2) + sC2[0]; o11 = (unsigned)r11 * (unsigned)(K * 2) + sC2[1]; } while (0)
    G8_MKOFF(cur, vA00, vA01, vA10, vA11);
    const char* cA = cur.A; const char* cB = cur.Bt;
    G8_STAGE(G8_SB(0, 0), cB, voffB[0], voffB[1]); G8_STAGE(G8_SA(0, 0), cA, vA00, vA01); G8_STAGE(G8_SB(0, 1), cB + hB1, voffB1[0], voffB1[1]); G8_STAGE(G8_SA(0, 1), cA, vA10, vA11);
    if (wr == 1) G8_BAR;
    G8_WAIT_V(4); G8_BAR;
    G8_STAGE(G8_SB(1, 0), cB + kstep, voffB[0], voffB[1]); G8_STAGE(G8_SA(1, 0), cA + kstep, vA00, vA01); G8_STAGE(G8_SB(1, 1), cB + hB1 + kstep, voffB1[0], voffB1[1]);
    G8_WAIT_V(6); G8_BAR;
    for (;;) {
        const bool h1 = cur.nv > 128;
        const bool has_next = S.next(ui + 1, nxt);
        const char* nA = has_next ? nxt.A : cA; const char* nB = has_next ? nxt.Bt : cB;
        if (has_next) G8_MKOFF(nxt, nA00, nA01, nA10, nA11); else { nA00 = vA00; nA01 = vA01; nA10 = vA10; nA11 = vA11; }
        for (int t = 0; t < nt; t += 2) {
            const bool last = (t == nt - 2);
            const char* a1 = cA + (size_t)(t + 1) * kstep;
            G8_LDB(B0, 0, 0); G8_SCHED; G8_LDA(At, 0, 0); G8_STAGE(G8_SA(1, 1), a1, vA10, vA11);
            G8_WAIT_L(8); G8_BAR; G8_WAIT_L(0); G8_MMA(0, 0, At, B0); G8_BAR; G8_SCHED;
            if (last) { vA00 = nA00; vA01 = nA01; vA10 = nA10; vA11 = nA11; }
            const char* a2 = last ? nA : cA + (size_t)(t + 2) * kstep; const char* b2 = last ? nB : cB + (size_t)(t + 2) * kstep;
            const char* a3 = a2 + kstep; const char* b3 = b2 + kstep;
            G8_LDB(B1, 0, 1); G8_STAGE(G8_SB(0, 0), b2, voffB[0], voffB[1]);
            G8_BAR; G8_WAIT_L(0); G8_MMA(0, 1, At, B1); G8_BAR;
            G8_LDA(At, 0, 1); G8_STAGE(G8_SA(0, 0), a2, vA00, vA01);
            G8_BAR; G8_WAIT_L(0); if (h1) G8_MMA(1, 0, At, B0); G8_BAR; G8_SCHED;
            G8_STAGE(G8_SB(0, 1), b2 + hB1, voffB1[0], voffB1[1]);
            G8_WAIT_V(6); G8_BAR; if (h1) G8_MMA(1, 1, At, B1); G8_BAR;
            G8_LDB(B0, 1, 0); G8_SCHED; G8_LDA(At, 1, 0); G8_STAGE(G8_SA(0, 1), a2, vA10, vA11);
            G8_WAIT_L(8); G8_BAR; G8_WAIT_L(0); G8_MMA(0, 0, At, B0); G8_BAR; G8_SCHED;
            G8_LDB(B1, 1, 1); G8_STAGE(G8_SB(1, 0), b3, voffB[0], voffB[1]);
            G8_BAR; G8_WAIT_L(0); G8_MMA(0, 1, At, B1); G8_BAR;
            G8_LDA(At, 1, 1); G8_STAGE(G8_SA(1, 0), a3, vA00, vA01);
            G8_BAR; G8_WAIT_L(0); if (h1) G8_MMA(1, 0, At, B0); G8_BAR; G8_SCHED;
            G8_STAGE(G8_SB(1, 1), b3 + hB1, voffB1[0], voffB1[1]);
            G8_WAIT_V(6); G8_BAR; if (h1) G8_MMA(1, 1, At, B1); G8_BAR;
        }
        E(acc, cur, wr, wc, fr, fq);
        if (!has_next) break;
#pragma unroll
        for (int a = 0; a < 2; ++a)
#pragma unroll
            for (int b = 0; b < 2; ++b)
#pragma unroll
                for (int m = 0; m < 4; ++m)
#pragma unroll
                    for (int n = 0; n < 2; ++n) acc[a][b][m][n] = (f32x4){0.f, 0.f, 0.f, 0.f};
        cur = nxt; cA = nA; cB = nB; ++ui;
    }
    G8_WAIT_V(0);
    if (wr == 0) G8_BAR;
    G8_BAR;
}
}

struct EpiInproj {
    static constexpr int PERM = 1;
    bf16_t* P;
    __device__ __forceinline__ void operator()(const f32x4 (&acc)[2][2][4][2], const g8::Unit& u, int wr, int wc, int fr, int fq) const {
#pragma unroll
        for (int ai = 0; ai < 2; ++ai)
#pragma unroll
            for (int m = 0; m < 4; ++m) { bf16_t* rowp = P + (size_t)(u.orow + ai * 128 + wr * 64 + m * 16 + fr) * PLD + u.pn * 256 + wc * 32 + 8 * fq;
#pragma unroll
                for (int bj = 0; bj < 2; ++bj) { const f32x4 v0 = acc[ai][bj][m][0], v1 = acc[ai][bj][m][1];
                    u32x4 w; w.x = cvt_pk_bf16(v0[0], v0[1]); w.y = cvt_pk_bf16(v0[2], v0[3]); w.z = cvt_pk_bf16(v1[0], v1[1]); w.w = cvt_pk_bf16(v1[2], v1[3]);
                    *(u32x4*)(rowp + bj * 128) = w; } }
    }
};
struct EpiInprojSplit {
    static constexpr int PERM = 0;
    float* PS; float* DDS;
    __device__ __forceinline__ void operator()(const f32x4 (&acc)[2][2][4][2], const g8::Unit& u, int wr, int wc, int fr, int fq) const {
        if (u.pn == PLD / 256) {
            if (wc == 0) {
#pragma unroll
                for (int ai = 0; ai < 2; ++ai)
#pragma unroll
                    for (int m = 0; m < 4; ++m) { float* rowp = DDS + (size_t)u.aux * DD_SLAB + (size_t)(u.orow + ai * 128 + wr * 64 + m * 16 + fr) * 32 + 4 * fq;
                        *(f32x4*)(rowp) = acc[ai][0][m][0]; *(f32x4*)(rowp + 16) = acc[ai][0][m][1]; }
            }
            return;
        }
        const int ccol = (u.pn < 12 ? u.pn - 4 : u.pn - 6) * 256;
#pragma unroll
        for (int ai = 0; ai < 2; ++ai)
#pragma unroll
            for (int m = 0; m < 4; ++m) { float* rowp = PS + (size_t)u.aux * PS_SLAB + (size_t)(u.orow - NLAT + ai * 128 + wr * 64 + m * 16 + fr) * PSLD + ccol + wc * 32 + 4 * fq;
#pragma unroll
                for (int bj = 0; bj < 2; ++bj)
#pragma unroll
                    for (int n = 0; n < 2; ++n) *(f32x4*)(rowp + bj * 128 + n * 16) = acc[ai][bj][m][n]; }
    }
};
struct SchedInprojSplit {
    const char* A; const char* Bt; int G, c;
    static constexpr int NITEM = 4 * (28 + 34);
    __device__ __forceinline__ bool next(int i, g8::Unit& u) const {
        int it; if (!g8::work_id(i, G, c, NITEM, it)) return false;
        int pm, pn; const int ks = it & 3, q = it >> 2;
        if (q < 28) { const int j = q % 14; pm = 32 + q / 14; pn = j < 8 ? 4 + j : (j < 10 ? 6 + j : 6 + j); }
        else { pm = q - 28; pn = PLD / 256; }
        u.A = A + ks * 1024; u.rows = nullptr; u.row0 = pm * 256; u.Bt = Bt + (size_t)pn * 256 * D * 2 + ks * 1024; u.orow = pm * 256; u.pn = pn; u.aux = ks; return true;
    }
};
struct EpiOutproj {
    static constexpr int PERM = 0;
    const float* x; const float* mod; float* X1;
    __device__ __forceinline__ void operator()(const f32x4 (&acc)[2][2][4][2], const g8::Unit& u, int wr, int wc, int fr, int fq) const {
        const int b = u.orow / SEQ; const int col0 = u.pn * 256 + wc * 32 + 4 * fq;
        f32x4 gv[2][2];
#pragma unroll
        for (int bj = 0; bj < 2; ++bj)
#pragma unroll
            for (int n = 0; n < 2; ++n) gv[bj][n] = *(const f32x4*)(mod + (size_t)b * 6 * D + 2 * D + col0 + bj * 128 + n * 16);
#pragma unroll
        for (int ai = 0; ai < 2; ++ai)
#pragma unroll
            for (int m = 0; m < 4; ++m) { const size_t ro = (size_t)(u.orow + ai * 128 + wr * 64 + m * 16 + fr) * D + col0;
#pragma unroll
                for (int bj = 0; bj < 2; ++bj)
#pragma unroll
                    for (int n = 0; n < 2; ++n) { const f32x4 xv = *(const f32x4*)(x + ro + bj * 128 + n * 16);
                        *(f32x4*)(X1 + ro + bj * 128 + n * 16) = xv + gv[bj][n] * acc[ai][bj][m][n]; } }
    }
};
struct EpiUp {
    static constexpr int PERM = 1;
    bf16_t* HB; bf16_t* SHH;
    __device__ __forceinline__ void operator()(const f32x4 (&acc)[2][2][4][2], const g8::Unit& u, int wr, int wc, int fr, int fq) const {
        bf16_t* O = u.aux ? SHH : HB;
#pragma unroll
        for (int ai = 0; ai < 2; ++ai)
#pragma unroll
            for (int m = 0; m < 4; ++m) {
                if (ai * 128 + wr * 64 + m * 16 + fr >= u.nv) continue;
                f32x4 h0, h1;
#pragma unroll
                for (int j = 0; j < 4; ++j) { const float a0 = acc[ai][0][m][0][j], a1 = acc[ai][0][m][1][j];
                    h0[j] = a0 * __builtin_amdgcn_rcpf(1.f + __builtin_amdgcn_exp2f(-1.4426950408889634f * a0)) * acc[ai][1][m][0][j];
                    h1[j] = a1 * __builtin_amdgcn_rcpf(1.f + __builtin_amdgcn_exp2f(-1.4426950408889634f * a1)) * acc[ai][1][m][1][j]; }
                u32x4 w; w.x = cvt_pk_bf16(h0[0], h0[1]); w.y = cvt_pk_bf16(h0[2], h0[3]); w.z = cvt_pk_bf16(h1[0], h1[1]); w.w = cvt_pk_bf16(h1[2], h1[3]);
                *(u32x4*)(O + (size_t)(u.orow + ai * 128 + wr * 64 + m * 16 + fr) * DE + u.pn * 128 + wc * 32 + 8 * fq) = w;
            }
    }
};
struct EpiDown {
    static constexpr int PERM = 3;
    unsigned char* Y; unsigned char* YS;
    __device__ __forceinline__ void operator()(const f32x4 (&acc)[2][2][4][2], const g8::Unit& u, int wr, int wc, int fr, int fq) const {
        unsigned char* O = u.aux ? YS : Y;
#pragma unroll
        for (int ai = 0; ai < 2; ++ai)
#pragma unroll
            for (int m = 0; m < 4; ++m) { if (ai * 128 + wr * 64 + m * 16 + fr >= u.nv) continue;
                u32x4 w;
#pragma unroll
                for (int q = 0; q < 4; ++q) { const f32x4 v = acc[ai][q >> 1][m][q & 1]; int pk = 0;
                    pk = __builtin_amdgcn_cvt_pk_fp8_f32(v[0], v[1], pk, false); pk = __builtin_amdgcn_cvt_pk_fp8_f32(v[2], v[3], pk, true); w[q] = (unsigned)pk; }
                *(u32x4*)(O + (size_t)(u.orow + ai * 128 + wr * 64 + m * 16 + fr) * YLD8 + u.pn * 256 + wc * 64 + 16 * fq) = w; }
    }
};
struct SchedDense {
    const char* A; const char* Bt; int K, nM, nN, G, c;
    __device__ __forceinline__ bool next(int i, g8::Unit& u) const {
        int wgid; if (!g8::work_id(i, G, c, nM * nN, wgid)) return false;
        const int nig = 8 * nN, gid = wgid / nig, fm = gid * 8, gsz = (nM - fm) < 8 ? (nM - fm) : 8;
        const int pm = fm + ((wgid % nig) % gsz), pn = (wgid % nig) / gsz;
        u.A = A; u.rows = nullptr; u.row0 = pm * 256; u.Bt = Bt + (size_t)pn * 256 * K * 2; u.orow = pm * 256; u.pn = pn; u.aux = 0; return true;
    }
};
struct SchedUp {
    const int* tp; const char* H2; const int* LIST; const char* E13T; const char* S13T; int G, c;
    __device__ __forceinline__ bool next(int i, g8::Unit& u) const {
        const int T = tp[NE]; int wgid; if (!g8::work_id(i, G, c, 4 * T + 128, wgid)) return false;
        u.A = H2;
        if (wgid < 4 * T) {
            int e = 0;
#pragma unroll
            for (int s = 32; s > 0; s >>= 1) if (4 * tp[e + s] <= wgid) e += s;
            const int tc = tp[e + 1] - tp[e], li = wgid - 4 * tp[e], nt = li / tc, mt = li % tc, r0 = (tp[e] + mt) * 256;
            u.rows = LIST + r0; u.row0 = 0; u.Bt = E13T + ((size_t)e * 1024 + nt * 256) * D * 2; u.orow = r0; u.pn = nt; u.aux = 0; u.nv = min(256, tp[80 + e] - mt * 256);
        } else {
            const int s = wgid - 4 * T, pn = s / 32, pm = s % 32;
            u.rows = nullptr; u.row0 = pm * 256; u.Bt = S13T + (size_t)pn * 256 * D * 2; u.orow = pm * 256; u.pn = pn; u.aux = 1; u.nv = 256;
        }
        return true;
    }
};
struct SchedDown {
    const int* tp; const char* HB; const char* E2T; const char* SHH; const char* S2T; int G, c;
    __device__ __forceinline__ bool next(int i, g8::Unit& u) const {
        const int T = tp[NE]; int wgid; if (!g8::work_id(i, G, c, 8 * T + 256, wgid)) return false;
        u.rows = nullptr;
        if (wgid < 8 * T) {
            int e = 0;
#pragma unroll
            for (int s = 32; s > 0; s >>= 1) if (8 * tp[e + s] <= wgid) e += s;
            const int tc = tp[e + 1] - tp[e], li = wgid - 8 * tp[e], nt = li / tc, mt = li % tc, r0 = (tp[e] + mt) * 256;
            u.A = HB; u.row0 = r0; u.Bt = E2T + ((size_t)e * D + nt * 256) * DE * 2; u.orow = r0; u.pn = nt; u.aux = 0; u.nv = min(256, tp[80 + e] - mt * 256);
        } else {
            const int s = wgid - 8 * T, pn = s / 32, pm = s % 32;
            u.A = SHH; u.row0 = pm * 256; u.Bt = S2T + (size_t)pn * 256 * DE * 2; u.orow = pm * 256; u.pn = pn; u.aux = 1; u.nv = 256;
        }
        return true;
    }
};
__device__ __forceinline__ void moe_tables(const Params& p, int* tp, const int wid0) {
    __syncthreads();
    if (wid0 == 0 && xb_lane_id() == 0) { int tt = 0; for (int e = 0; e < NE; ++e) { const int cn = p.CNT[e]; tp[e] = tt; tp[80 + e] = cn; tt += (cn + 255) / 256; } tp[NE] = tt; }
    __syncthreads();
}

constexpr int NTILE = 136;
__device__ void ph_naprep(const Params& p, const int wid0, const int ubeg, const int uend, const int ustep) {
    const int t = opaque_tid(wid0), w = t >> 6, lane = t & 63, kk = lane >> 4, pc = lane & 15;
    for (int u = ubeg; u < uend; u += ustep) {
        const int b = u / NTILE, T = u % NTILE; const bool lat = T < 128;
        const int row0 = lat ? (b * SEQ + 32 * T) : (NLAT + b * CTXL + 32 * (T - 128));
#pragma unroll 2
        for (int it = w; it < 128; it += 8) {
            const int which = it & 1, hh = (it >> 1) & 7, tt = 4 * (it >> 4) + kk;
            if (which == 0 && !lat) continue;
            float4 v0, v1;
            if (lat) { const u32x4 r8 = *(const u32x4*)(p.P + (size_t)(row0 + tt) * PLD + which * 1024 + hh * 128 + 8 * pc);
                v0 = make_float4(bf2f(r8.x & 0xffffu), bf2f(r8.x >> 16), bf2f(r8.y & 0xffffu), bf2f(r8.y >> 16)); v1 = make_float4(bf2f(r8.z & 0xffffu), bf2f(r8.z >> 16), bf2f(r8.w & 0xffffu), bf2f(r8.w >> 16)); }
            else {
                const float* src = p.PS + (size_t)(row0 - NLAT + tt) * PSLD + hh * 128 + 8 * pc;
                v0 = *(const float4*)src; v1 = *(const float4*)(src + 4);
#pragma unroll
                for (int s = 1; s < 4; ++s) { const float4 a0 = *(const float4*)(src + s * PS_SLAB), a1 = *(const float4*)(src + s * PS_SLAB + 4);
                    v0.x += a0.x; v0.y += a0.y; v0.z += a0.z; v0.w += a0.w; v1.x += a1.x; v1.y += a1.y; v1.z += a1.z; v1.w += a1.w; }
            }
            float ss = v0.x * v0.x + v0.y * v0.y + v0.z * v0.z + v0.w * v0.w + v1.x * v1.x + v1.y * v1.y + v1.z * v1.z + v1.w * v1.w;
            ss += __shfl_xor(ss, 1); ss += __shfl_xor(ss, 2); ss += __shfl_xor(ss, 4); ss += __shfl_xor(ss, 8);
            const float* gp = (which ? p.k_norm_g : p.q_norm_g) + 8 * pc;
            const float4 g0 = *(const float4*)gp, g1 = *(const float4*)(gp + 4);
            const float r = rsqrtf(ss * (1.f / 128.f) + 1e-6f) * (which ? 1.f : 0.08838834764831845f * 1.4426950408889634f);
            u32x4 o;
            o.x = cvt_pk_bf16(v0.x * r * g0.x, v0.y * r * g0.y); o.y = cvt_pk_bf16(v0.z * r * g0.z, v0.w * r * g0.w);
            o.z = cvt_pk_bf16(v1.x * r * g1.x, v1.y * r * g1.y); o.w = cvt_pk_bf16(v1.z * r * g1.z, v1.w * r * g1.w);
            if (which) *(u32x4*)(p.NKf + (((size_t)((b * 8 + hh) * NTILE + T) * 8 + (pc >> 1)) * 64 + tt + 32 * (pc & 1)) * 8) = o;
            else *(u32x4*)(p.NQb + (size_t)(row0 + tt) * 1024 + hh * 128 + 8 * pc) = o;
        }
        if (lat) {
            const int col = 2 * t, hh = col >> 7, dv = col & 127;
            unsigned wv[32];
#pragma unroll
            for (int s = 0; s < 32; ++s) wv[s] = *(const unsigned*)(p.P + (size_t)(row0 + s) * PLD + 2048 + col);
            unsigned pk0[16], pk1[16];
#pragma unroll
            for (int s2 = 0; s2 < 16; ++s2) { pk0[s2] = (wv[2 * s2] & 0xffffu) | (wv[2 * s2 + 1] << 16); pk1[s2] = (wv[2 * s2] >> 16) | (wv[2 * s2 + 1] & 0xffff0000u); }
            bf16_t* o = p.VTf + ((((size_t)((b * 8 + hh) * NTILE + T) * 4 + (dv >> 5)) * 2) * 64 + (dv & 31)) * 8;
#pragma unroll
            for (int g2 = 0; g2 < 2; ++g2) {
                *(u32x4*)(o + (g2 * 64) * 8) = (u32x4){pk0[8 * g2], pk0[8 * g2 + 1], pk0[8 * g2 + 4], pk0[8 * g2 + 5]};
                *(u32x4*)(o + (g2 * 64 + 32) * 8) = (u32x4){pk0[8 * g2 + 2], pk0[8 * g2 + 3], pk0[8 * g2 + 6], pk0[8 * g2 + 7]};
                *(u32x4*)(o + (g2 * 64 + 1) * 8) = (u32x4){pk1[8 * g2], pk1[8 * g2 + 1], pk1[8 * g2 + 4], pk1[8 * g2 + 5]};
                *(u32x4*)(o + (g2 * 64 + 33) * 8) = (u32x4){pk1[8 * g2 + 2], pk1[8 * g2 + 3], pk1[8 * g2 + 6], pk1[8 * g2 + 7]};
            }
        } else {
#pragma unroll 1
        for (int i = 0; i < 2; ++i) {
            const int col = t + 512 * i, hh = col >> 7, dv = col & 127;
            unsigned pk[16];
#pragma unroll
            for (int s2 = 0; s2 < 16; ++s2) {
                const float* s0 = p.PS + (size_t)(row0 - NLAT + 2 * s2) * PSLD + 1024 + col;
                const float x0 = s0[0] + s0[PS_SLAB] + s0[2 * PS_SLAB] + s0[3 * PS_SLAB], x1 = s0[PSLD] + s0[PS_SLAB + PSLD] + s0[2 * PS_SLAB + PSLD] + s0[3 * PS_SLAB + PSLD];
                pk[s2] = cvt_pk_bf16(x0, x1);
            }
            bf16_t* o = p.VTf + ((((size_t)((b * 8 + hh) * NTILE + T) * 4 + (dv >> 5)) * 2) * 64 + (dv & 31)) * 8;
#pragma unroll
            for (int g2 = 0; g2 < 2; ++g2) {
                *(u32x4*)(o + (g2 * 64) * 8) = (u32x4){pk[8 * g2], pk[8 * g2 + 1], pk[8 * g2 + 4], pk[8 * g2 + 5]};
                *(u32x4*)(o + (g2 * 64 + 32) * 8) = (u32x4){pk[8 * g2 + 2], pk[8 * g2 + 3], pk[8 * g2 + 6], pk[8 * g2 + 7]};
            }
        }
        }
    }
}

__device__ __forceinline__ void attn_tile(const LAS unsigned char* sb, const float* bt0, const bf16x8 (&qf)[8], f32x16& o0, f32x16& o1, f32x16& o2, f32x16& o3, float& m, float& l,
                                          bool loc, int half, int dr, int c, int cs, int hi) {
    bf16x8 kc[8], va[8];
#pragma unroll
    for (int ks = 0; ks < 8; ++ks) kc[ks] = *(const LAS bf16x8*)(sb + ks * 1024);
#pragma unroll
    for (int q = 0; q < 8; ++q) va[q] = *(const LAS bf16x8*)(sb + 8192 + q * 1024);
    f32x16 s;
#pragma unroll
    for (int e = 0; e < 16; ++e) s[e] = 0.f;
#pragma unroll
    for (int ks = 0; ks < 8; ++ks) s = __builtin_amdgcn_mfma_f32_32x32x16_bf16(kc[ks], qf[ks], s, 0, 0, 0);
    if (loc) {
        int rel0 = 32 * half + 4 * hi - cs; asm volatile("" : "+v"(rel0));
        const float* bt = bt0 + dr * 31 + cs - c + 15;
        float bz[16];
#pragma unroll
        for (int e = 0; e < 16; ++e) bz[e] = bt[rel0 + (e & 3) + 8 * (e >> 2)];
#pragma unroll
        for (int e = 0; e < 16; ++e) asm volatile("" : "+v"(bz[e]));
#pragma unroll
        for (int e = 0; e < 16; ++e) {
            const int rel = rel0 + (e & 3) + 8 * (e >> 2);
            s[e] = ((unsigned)rel < 16u) ? (s[e] + bz[e]) : -INFINITY;
        }
    }
    float mt = s[0];
#pragma unroll
    for (int e = 1; e < 16; ++e) mt = fmaxf(mt, s[e]);
    mt = fmaxf(mt, __shfl_xor(mt, 32));
    if (__any(mt > m)) {
        const float mn = fmaxf(m, mt);
        const float alpha = __builtin_amdgcn_exp2f(m - mn);
        m = mn; l *= alpha;
#pragma unroll
        for (int e = 0; e < 16; ++e) { o0[e] *= alpha; o1[e] *= alpha; o2[e] *= alpha; o3[e] *= alpha; }
    }
    float ps = 0.f;
#pragma unroll
    for (int e = 0; e < 16; ++e) { s[e] = __builtin_amdgcn_exp2f(s[e] - m); ps += s[e]; }
    l += ps;
    bf16x8 pb[2];
#pragma unroll
    for (int s2 = 0; s2 < 2; ++s2) {
        const u32x4 cat = (u32x4){cvt_pk_bf16(s[8 * s2], s[8 * s2 + 1]), cvt_pk_bf16(s[8 * s2 + 2], s[8 * s2 + 3]), cvt_pk_bf16(s[8 * s2 + 4], s[8 * s2 + 5]), cvt_pk_bf16(s[8 * s2 + 6], s[8 * s2 + 7])};
        pb[s2] = __builtin_bit_cast(bf16x8, cat);
    }
#pragma unroll
    for (int s2 = 0; s2 < 2; ++s2) {
        o0 = __builtin_amdgcn_mfma_f32_32x32x16_bf16(va[0 + s2], pb[s2], o0, 0, 0, 0);
        o1 = __builtin_amdgcn_mfma_f32_32x32x16_bf16(va[2 + s2], pb[s2], o1, 0, 0, 0);
        o2 = __builtin_amdgcn_mfma_f32_32x32x16_bf16(va[4 + s2], pb[s2], o2, 0, 0, 0);
        o3 = __builtin_amdgcn_mfma_f32_32x32x16_bf16(va[6 + s2], pb[s2], o3, 0, 0, 0);
    }
}
__device__ __forceinline__ void glascan_wave(const Params& p, int unit, int dh, int lane, LAS unsigned char* ldsw);
__device__ void ph_attn(const Params& p, unsigned char* smb, const int wid0) {
    const int t = opaque_tid(wid0), lane = t & 63, l31 = lane & 31, hi = lane >> 5;
    const int w = __builtin_amdgcn_readfirstlane(t >> 6);
    LAS unsigned char* lds = (LAS unsigned char*)smb;
    for (int u0 = blockIdx.x; u0 < 256; u0 += gridDim.x) { const int unit = (((u0 & 7) + 8 * (u0 >> 7)) << 4) | ((u0 >> 3) & 15); glascan_wave(p, unit, w, lane, lds + w * 8192); }
    float* tab = (float*)(smb + 4 * 16384);
    for (int u0 = blockIdx.x; u0 < 256; u0 += gridDim.x) {
        const int u = (((u0 & 7) + 8 * (u0 >> 7)) << 4) | ((u0 >> 3) & 15);
        const int rg = u & 15, h = (u >> 4) & 7, b = u >> 7, bh8 = b * 8 + h;
        asm volatile("s_waitcnt vmcnt(0)" ::: "memory");
        __syncthreads();
        for (int i = t; i < 465; i += NT) tab[i] = p.na_rpb[h * 465 + i] * 1.4426950408889634f;
        const int r = 4 * rg + (w >> 1), qt = w & 1, c = 32 * qt + l31;
        const int rs = min(max(r - 4, 0), 56), cs = min(max(c - 8, 0), 48);
        const int Rlo = min(max(4 * rg - 4, 0), 56), Rhi = min(max(4 * rg - 1, 0), 56) + 7, nt = 8 + 2 * (Rhi - Rlo + 1);
        const int qrow = b * SEQ + r * 64 + c;
        bf16x8 qf[8];
#pragma unroll
        for (int ks = 0; ks < 8; ++ks) qf[ks] = *(const bf16x8*)(p.NQb + (size_t)qrow * 1024 + h * 128 + 16 * ks + 8 * hi);
#pragma unroll
        for (int ks = 0; ks < 8; ++ks) asm volatile("" : "+v"(qf[ks]));
        f32x16 o0, o1, o2, o3;
#pragma unroll
        for (int e = 0; e < 16; ++e) { o0[e] = 0.f; o1[e] = 0.f; o2[e] = 0.f; o3[e] = 0.f; }
        float m = -INFINITY, l = 0.f;
        const bf16_t* kg = p.NKf + ((size_t)bh8 * NTILE * 8 + w) * 512 + lane * 8;
        const bf16_t* vg = p.VTf + ((size_t)bh8 * NTILE * 8 + w) * 512 + lane * 8;
#define AT_T(i_) ((i_) < 8 ? (128 + (i_)) : (2 * Rlo + ((i_) - 8)))
#define AT_DMA(i_, st_) do { const int ii_ = (i_) < nt ? (i_) : nt - 1; const size_t to_ = (size_t)AT_T(ii_) * 4096; \
        __builtin_amdgcn_global_load_lds((const unsigned*)(kg + to_), (LAS unsigned*)(lds + (st_) * 16384 + w * 1024), 16, 0, 0); \
        __builtin_amdgcn_global_load_lds((const unsigned*)(vg + to_), (LAS unsigned*)(lds + (st_) * 16384 + 8192 + w * 1024), 16, 0, 0); } while (0)
        asm volatile("s_waitcnt vmcnt(0)" ::: "memory");
        __syncthreads();
        AT_DMA(0, 0); AT_DMA(1, 1); AT_DMA(2, 2);
        int st = 0;
#pragma unroll 1
        for (int i = 0; i < nt; ++i) {
            asm volatile("s_waitcnt vmcnt(4)" ::: "memory");
            __builtin_amdgcn_s_barrier();
            asm volatile("" ::: "memory");
            const int st2 = (st + 3) & 3;
            AT_DMA(i + 3, st2);
            const bool loc = i >= 8; const int R = Rlo + ((i - 8) >> 1), half = (i - 8) & 1;
            if (!loc || (unsigned)(R - rs) < 8u)
                attn_tile(lds + st * 16384 + lane * 16, tab, qf, o0, o1, o2, o3, m, l, loc, half, R - r + 7, c, cs, hi);
            st = (st + 1) & 3;
        }
#undef AT_T
#undef AT_DMA
        l += __shfl_xor(l, 32);
        const float inv = 1.f / l;
        bf16_t* orow = p.MIX + (size_t)qrow * D + h * 128 + 4 * hi;
#pragma unroll
        for (int g = 0; g < 4; ++g) {
            u32x2 pk;
            pk.x = cvt_pk_bf16(o0[4 * g] * inv, o0[4 * g + 1] * inv); pk.y = cvt_pk_bf16(o0[4 * g + 2] * inv, o0[4 * g + 3] * inv); *(u32x2*)(orow + 0 + 8 * g) = pk;
            pk.x = cvt_pk_bf16(o1[4 * g] * inv, o1[4 * g + 1] * inv); pk.y = cvt_pk_bf16(o1[4 * g + 2] * inv, o1[4 * g + 3] * inv); *(u32x2*)(orow + 32 + 8 * g) = pk;
            pk.x = cvt_pk_bf16(o2[4 * g] * inv, o2[4 * g + 1] * inv); pk.y = cvt_pk_bf16(o2[4 * g + 2] * inv, o2[4 * g + 3] * inv); *(u32x2*)(orow + 64 + 8 * g) = pk;
            pk.x = cvt_pk_bf16(o3[4 * g] * inv, o3[4 * g + 1] * inv); pk.y = cvt_pk_bf16(o3[4 * g + 2] * inv, o3[4 * g + 3] * inv); *(u32x2*)(orow + 96 + 8 * g) = pk;
        }
    }
    asm volatile("s_waitcnt vmcnt(0)" ::: "memory");
}

__device__ __forceinline__ float logsigf(float z) { return fminf(z, 0.f) - log1pf(expf(-fabsf(z))); }

__device__ __forceinline__ float fexp2(float x) { return __builtin_amdgcn_exp2f(x); }
__device__ __forceinline__ float logsig2_16(float z) { return (fminf(z, 0.f) * 1.4426950408889634f - __builtin_amdgcn_logf(1.f + fexp2(-fabsf(z) * 1.4426950408889634f))) * (1.f / 16.f); }

__device__ void ph_glaprep(const Params& p, float* sm, const int wid0, const int ubeg, const int uend, const int ustep) {
    const int t = opaque_tid(wid0), d2 = t & 63, tq = t >> 6, d = 2 * d2;
    float* qs = sm;
    float* ksm = sm + 8192;
    float* dds = sm + 16384;
    float* tot = sm + 16384 + 2048;
    for (int u = ubeg; u < uend; u += ustep) {
        const int bh = u / 68, c = u % 68, b = bh >> 2, h = bh & 3;
        const bool lat = c >= 4; const int j = c - 4;
        const int row0 = lat ? (b * SEQ + 64 * j) : (NLAT + b * CTXL + 64 * c);
        __syncthreads();
        {
            const int cq = t & 31, tr = t >> 5;
#pragma unroll
            for (int i = 0; i < 4; ++i) { const int tt = tr + 16 * i;
                if (lat) {
                    const u32x2 q4 = *(const u32x2*)(p.P + (size_t)(row0 + tt) * PLD + 3072 + h * 128 + 4 * cq), k4 = *(const u32x2*)(p.P + (size_t)(row0 + tt) * PLD + 3584 + h * 128 + 4 * cq);
                    *(float4*)(qs + tt * 128 + 4 * cq) = make_float4(bf2f(q4.x & 0xffffu), bf2f(q4.x >> 16), bf2f(q4.y & 0xffffu), bf2f(q4.y >> 16));
                    *(float4*)(ksm + tt * 128 + 4 * cq) = make_float4(bf2f(k4.x & 0xffffu), bf2f(k4.x >> 16), bf2f(k4.y & 0xffffu), bf2f(k4.y >> 16));
                } else {
                    const float* src = p.PS + (size_t)(row0 - NLAT + tt) * PSLD + 2048 + h * 128 + 4 * cq;
                    float4 kv = *(const float4*)src;
#pragma unroll
                    for (int s = 1; s < 4; ++s) { const float4 a0 = *(const float4*)(src + s * PS_SLAB); kv.x += a0.x; kv.y += a0.y; kv.z += a0.z; kv.w += a0.w; }
                    *(float4*)(qs + tt * 128 + 4 * cq) = make_float4(0.f, 0.f, 0.f, 0.f); *(float4*)(ksm + tt * 128 + 4 * cq) = kv;
                } }
            { const float* src = p.DDS + (size_t)row0 * 32 + 4 * t; float4 dv = *(const float4*)src;
#pragma unroll
              for (int s = 1; s < 4; ++s) { const float4 a0 = *(const float4*)(src + s * DD_SLAB); dv.x += a0.x; dv.y += a0.y; dv.z += a0.z; dv.w += a0.w; }
              *(float4*)(dds + 4 * t) = dv; }
        }
        __syncthreads();
        float gf0[8], gf1[8], gb0[8], gb1[8];
        {
            float uf0[16], uf1[16], ub0[16], ub1[16];
#pragma unroll
            for (int r = 0; r < 16; ++r) { const float2 a = *(const float2*)(p.up_f + r * 512 + h * 128 + d), bq = *(const float2*)(p.up_b + r * 512 + h * 128 + d); uf0[r] = a.x; uf1[r] = a.y; ub0[r] = bq.x; ub1[r] = bq.y; }
            const float2 bf = *(const float2*)(p.bias_f + h * 128 + d), bb = *(const float2*)(p.bias_b + h * 128 + d);
            float sf0 = 0.f, sf1 = 0.f, sb0 = 0.f, sb1 = 0.f;
#pragma unroll
            for (int i = 0; i < 8; ++i) {
                const float* dr = dds + (8 * tq + i) * 32; float zf0 = bf.x, zf1 = bf.y, zb0 = bb.x, zb1 = bb.y;
#pragma unroll
                for (int r = 0; r < 16; ++r) { const float x = dr[r], y = dr[16 + r]; zf0 += x * uf0[r]; zf1 += x * uf1[r]; zb0 += y * ub0[r]; zb1 += y * ub1[r]; }
                gf0[i] = logsig2_16(zf0); gf1[i] = logsig2_16(zf1); gb0[i] = logsig2_16(zb0); gb1[i] = logsig2_16(zb1);
                sf0 += gf0[i]; sf1 += gf1[i]; sb0 += gb0[i]; sb1 += gb1[i];
            }
            *(float2*)(tot + tq * 128 + d) = make_float2(sf0, sf1); *(float2*)(tot + (8 + tq) * 128 + d) = make_float2(sb0, sb1);
        }
        __syncthreads();
        float2 basef = make_float2(0.f, 0.f), baseb = basef, allf = basef, allb = basef;
#pragma unroll
        for (int q8 = 0; q8 < 8; ++q8) { const float2 a = *(const float2*)(tot + q8 * 128 + d), bq = *(const float2*)(tot + (8 + q8) * 128 + d);
            allf.x += a.x; allf.y += a.y; allb.x += bq.x; allb.y += bq.y;
            if (q8 < tq) { basef.x += a.x; basef.y += a.y; } if (q8 > tq) { baseb.x += bq.x; baseb.y += bq.y; } }
        { float r0 = basef.x, r1 = basef.y;
#pragma unroll
          for (int i = 0; i < 8; ++i) { r0 += gf0[i]; gf0[i] = r0; r1 += gf1[i]; gf1[i] = r1; }
          r0 = baseb.x; r1 = baseb.y;
#pragma unroll
          for (int i = 7; i >= 0; --i) { r0 += gb0[i]; gb0[i] = r0; r1 += gb1[i]; gb1[i] = r1; } }
        const int dd2 = d & 63, ii = dd2 & 31, partner = (dd2 < 32) ? (d + 32) : (d - 32);
        const float sgn = (dd2 < 32) ? -1.f : 1.f;
        unsigned khf0[4], khf1[4], khb0[4], khb1[4]; float pf0 = 0.f, pf1 = 0.f, pb0 = 0.f, pb1 = 0.f;
        const size_t tb = ((size_t)(bh * 64 + j) * 64) * 128;
#pragma unroll
        for (int i = 0; i < 8; ++i) {
            const int tt = 8 * tq + i;
            float2 qv = *(const float2*)(qs + tt * 128 + d), kv = *(const float2*)(ksm + tt * 128 + d);
            if (lat) {
                const int pos = (d < 64) ? j : tt;
                const float4 cssn = *(const float4*)(p.RT + (pos * 32 + ii) * 2);
                const float2 qp = *(const float2*)(qs + tt * 128 + partner), kp = *(const float2*)(ksm + tt * 128 + partner);
                qv.x = qv.x * cssn.x + sgn * qp.x * cssn.y; qv.y = qv.y * cssn.z + sgn * qp.y * cssn.w;
                kv.x = kv.x * cssn.x + sgn * kp.x * cssn.y; kv.y = kv.y * cssn.z + sgn * kp.y * cssn.w;
            }
            qv.x *= 0.08838834764831845f; qv.y *= 0.08838834764831845f;
            if (lat) {
                const float ef0 = fexp2(gf0[i]), ef1 = fexp2(gf1[i]), eb0 = fexp2(gb0[i]), eb1 = fexp2(gb1[i]);
                const float nf0 = fexp2(-gf0[i]), nf1 = fexp2(-gf1[i]), nb0 = fexp2(-gb0[i]), nb1 = fexp2(-gb1[i]);
                const size_t o = tb + (size_t)tt * 128 + d;
                *(unsigned*)(p.QF + o) = cvt_pk_bf16(qv.x * ef0, qv.y * ef1); *(unsigned*)(p.KF + o) = cvt_pk_bf16(kv.x * nf0, kv.y * nf1);
                *(unsigned*)(p.QB + o) = cvt_pk_bf16(qv.x * eb0, qv.y * eb1); *(unsigned*)(p.KB + o) = cvt_pk_bf16(kv.x * nb0, kv.y * nb1);
            }
            const float hf0 = kv.x * fexp2(allf.x - gf0[i]), hf1 = kv.y * fexp2(allf.y - gf1[i]), hb0 = kv.x * fexp2(allb.x - gb0[i]), hb1 = kv.y * fexp2(allb.y - gb1[i]);
            if (i & 1) { khf0[i >> 1] = cvt_pk_bf16(pf0, hf0); khf1[i >> 1] = cvt_pk_bf16(pf1, hf1); khb0[i >> 1] = cvt_pk_bf16(pb0, hb0); khb1[i >> 1] = cvt_pk_bf16(pb1, hb1); }
            else { pf0 = hf0; pf1 = hf1; pb0 = hb0; pb1 = hb1; }
        }
        {
            const size_t o = ((((size_t)(bh * 68 + c) * 8 + (d >> 4)) * 2 + (tq >> 2)) * 64 + (d & 15) + 16 * (tq & 3)) * 8;
            *(u32x4*)(p.KHF + o) = (u32x4){khf0[0], khf0[1], khf0[2], khf0[3]}; *(u32x4*)(p.KHF + o + 8) = (u32x4){khf1[0], khf1[1], khf1[2], khf1[3]};
            *(u32x4*)(p.KHB + o) = (u32x4){khb0[0], khb0[1], khb0[2], khb0[3]}; *(u32x4*)(p.KHB + o + 8) = (u32x4){khb1[0], khb1[1], khb1[2], khb1[3]};
            if (tq == 0) { *(float2*)(p.DF + (size_t)(bh * 68 + c) * 128 + d) = make_float2(fexp2(allf.x), fexp2(allf.y)); *(float2*)(p.DB + (size_t)(bh * 68 + c) * 128 + d) = make_float2(fexp2(allb.x), fexp2(allb.y)); }
        }
        if (lat) {
            const int v = 2 * (t & 127), qr = t >> 7;
            unsigned wv[16];
#pragma unroll
            for (int s = 0; s < 16; ++s) wv[s] = *(const unsigned*)(p.P + (size_t)(row0 + 16 * qr + s) * PLD + 4096 + h * 256 + v);
            unsigned pk0[8], pk1[8];
#pragma unroll
            for (int s2 = 0; s2 < 8; ++s2) { pk0[s2] = (wv[2 * s2] & 0xffffu) | (wv[2 * s2 + 1] << 16); pk1[s2] = (wv[2 * s2] >> 16) | (wv[2 * s2 + 1] & 0xffff0000u); }
            bf16_t* o = p.VT + ((size_t)(bh * 68 + c) * 256 + v) * 64 + 16 * qr;
#pragma unroll
            for (int q8 = 0; q8 < 2; ++q8) {
                const u32x4 a0 = (u32x4){pk0[4 * q8], pk0[4 * q8 + 1], pk0[4 * q8 + 2], pk0[4 * q8 + 3]}, a1 = (u32x4){pk1[4 * q8], pk1[4 * q8 + 1], pk1[4 * q8 + 2], pk1[4 * q8 + 3]};
                *(u32x4*)(o + 8 * q8) = a0; *(u32x4*)(o + 64 + 8 * q8) = a1;
                bf16_t* o2 = p.VTS + ((((size_t)(bh * 68 + c) * 16 + (v >> 4)) * 2 + (qr >> 1)) * 64 + (v & 15) + 16 * ((2 * qr + q8) & 3)) * 8;
                *(u32x4*)o2 = a0; *(u32x4*)(o2 + 8) = a1;
            }
        } else {
            const int v = t & 255, half = t >> 8;
            unsigned pk[16];
#pragma unroll
            for (int s2 = 0; s2 < 16; ++s2) {
                const float* s0 = p.PS + (size_t)(row0 - NLAT + 32 * half + 2 * s2) * PSLD + 2560 + h * 256 + v;
                const float a = s0[0] + s0[PS_SLAB] + s0[2 * PS_SLAB] + s0[3 * PS_SLAB], bq = s0[PSLD] + s0[PS_SLAB + PSLD] + s0[2 * PS_SLAB + PSLD] + s0[3 * PS_SLAB + PSLD];
                pk[s2] = cvt_pk_bf16(a, bq);
            }
            bf16_t* o = p.VT + ((size_t)(bh * 68 + c) * 256 + v) * 64 + 32 * half;
            bf16_t* o2 = p.VTS + ((((size_t)(bh * 68 + c) * 16 + (v >> 4)) * 2 + half) * 64 + (v & 15)) * 8;
#pragma unroll
            for (int q4 = 0; q4 < 4; ++q4) { const u32x4 pv = (u32x4){pk[4 * q4], pk[4 * q4 + 1], pk[4 * q4 + 2], pk[4 * q4 + 3]}; *(u32x4*)(o + 8 * q4) = pv; *(u32x4*)(o2 + (16 * q4) * 8) = pv; }
        }
    }
}

__device__ __forceinline__ void glascan_wave(const Params& p, int unit, int dh, int lane, LAS unsigned char* ldsw) {
    const int v16 = unit & 15, scan = unit >> 4, dir = scan >> 3, bh = scan & 7;
    const int fr = lane & 15, fq = lane >> 4, d0 = 16 * dh, v0 = 16 * v16;
    const bf16_t* KH = (dir ? p.KHB : p.KHF) + (((size_t)bh * 68 * 8 + dh) * 2) * 512 + lane * 8;
    const bf16_t* VTp = p.VTS + (((size_t)bh * 68 * 16 + v16) * 2) * 512 + lane * 8;
    const float* DV = (dir ? p.DB : p.DF) + (size_t)bh * 68 * 128 + d0 + 4 * fq;
    bf16_t* SSp = p.SS + ((((size_t)dir * 8 + bh) * 65) * 256 + v0 + fr) * 128 + d0 + 4 * fq;
    LAS u32x2* sl = (LAS u32x2*)ldsw + lane;
    f32x4 acc = (f32x4){0.f, 0.f, 0.f, 0.f};
#define SC_CHUNK(n) (dir ? ((n) < 4 ? 3 - (n) : 71 - (n)) : (n))
#define SC_LOAD(S_, n) do { const int nn_ = (n) < 68 ? (n) : 67; const int c_ = SC_CHUNK(nn_); \
        S_##a0 = *(const bf16x8*)(KH + (size_t)c_ * 8192); S_##a1 = *(const bf16x8*)(KH + (size_t)c_ * 8192 + 512); \
        S_##b0 = *(const bf16x8*)(VTp + (size_t)c_ * 16384); S_##b1 = *(const bf16x8*)(VTp + (size_t)c_ * 16384 + 512); \
        S_##d = *(const f32x4*)(DV + (size_t)c_ * 128); } while (0)
#define SC_STEP(S_, k) do { u32x2 pk; pk.x = cvt_pk_bf16(acc[0], acc[1]); pk.y = cvt_pk_bf16(acc[2], acc[3]); sl[(k) * 64] = pk; \
        acc = acc * S_##d; \
        acc = __builtin_amdgcn_mfma_f32_16x16x32_bf16(S_##a0, S_##b0, acc, 0, 0, 0); acc = __builtin_amdgcn_mfma_f32_16x16x32_bf16(S_##a1, S_##b1, acc, 0, 0, 0); } while (0)
    bf16x8 Aa0, Aa1, Ab0, Ab1, Ba0, Ba1, Bb0, Bb1, Ca0, Ca1, Cb0, Cb1, Da0, Da1, Db0, Db1; f32x4 Ad, Bd, Cd, Dd;
    SC_LOAD(A, 0); SC_LOAD(B, 1); SC_LOAD(C, 2);
#pragma unroll 1
    for (int nb = 0; nb < 68; nb += 16) {
        const int iters = (nb + 16 <= 68) ? 4 : 1;
#pragma unroll 1
        for (int it = 0; it < iters; ++it) {
            const int n = nb + 4 * it;
            SC_LOAD(D, n + 3); SC_STEP(A, 4 * it);
            SC_LOAD(A, n + 4); SC_STEP(B, 4 * it + 1);
            SC_LOAD(B, n + 5); SC_STEP(C, 4 * it + 2);
            SC_LOAD(C, n + 6); SC_STEP(D, 4 * it + 3);
        }
#pragma unroll 1
        for (int k = 0; k < 4 * iters; ++k) { const int c_ = SC_CHUNK(nb + k); *(u32x2*)(SSp + (size_t)(c_ >= 4 ? c_ - 4 : 64) * 256 * 128) = sl[k * 64]; }
    }
#undef SC_CHUNK
#undef SC_LOAD
#undef SC_STEP
}

__device__ void ph_glaout(const Params& p, unsigned char* smb, const int wid0) {
    const int t = opaque_tid(wid0), w = t >> 6, lane = t & 63, l31 = lane & 31, hi = lane >> 5;
    const int wv = w & 3, wt = w >> 2;
    bf16_t* att = (bf16_t*)smb;
    float* ssq = (float*)(smb + 2 * 64 * 144);
    for (int u = blockIdx.x; u < 512; u += gridDim.x) {
        const int bh = u >> 6, j = u & 63, b = bh >> 2, h = bh & 3;
        const size_t tb = ((size_t)(bh * 64 + j) * 64) * 128;
        {
            const int dir = w >> 2, ts = (w >> 1) & 1, tt = w & 1;
            const bf16_t* Qm = (dir ? p.QB : p.QF) + tb; const bf16_t* Km = (dir ? p.KB : p.KF) + tb;
            const bool zero = dir ? (ts < tt) : (ts > tt);
            f32x16 s;
#pragma unroll
            for (int r = 0; r < 16; ++r) s[r] = 0.f;
            if (!zero) {
#pragma unroll
                for (int ks = 0; ks < 8; ++ks) {
                    const bf16x8 ka = *(const bf16x8*)(Km + (size_t)(32 * ts + l31) * 128 + 16 * ks + 8 * hi);
                    const bf16x8 qb = *(const bf16x8*)(Qm + (size_t)(32 * tt + l31) * 128 + 16 * ks + 8 * hi);
                    s = __builtin_amdgcn_mfma_f32_32x32x16_bf16(ka, qb, s, 0, 0, 0);
                }
            }
            const int tcol = 32 * tt + l31;
#pragma unroll
            for (int g = 0; g < 4; ++g) {
                float vv[4];
#pragma unroll
                for (int e = 0; e < 4; ++e) { const int srow = 32 * ts + 8 * g + 4 * hi + e; const bool keep = dir ? (srow >= tcol) : (srow <= tcol); vv[e] = keep ? s[4 * g + e] : 0.f; }
                u32x2 pk; pk.x = cvt_pk_bf16(vv[0], vv[1]); pk.y = cvt_pk_bf16(vv[2], vv[3]);
                *(u32x2*)(att + ((size_t)dir * 64 + tcol) * 72 + 32 * ts + 8 * g + 4 * hi) = pk;
            }
        }
        __syncthreads();
        f32x16 o0, o1;
#pragma unroll
        for (int r = 0; r < 16; ++r) { o0[r] = 0.f; o1[r] = 0.f; }
        const int tB = 32 * wt + l31;
        const bf16_t* vt0 = p.VT + ((size_t)(bh * 68 + 4 + j) * 256 + 64 * wv + l31) * 64 + 8 * hi;
#pragma unroll
        for (int dir = 0; dir < 2; ++dir) {
#pragma unroll
            for (int ks = 0; ks < 4; ++ks) {
                const bf16x8 bb = *(const bf16x8*)(att + ((size_t)dir * 64 + tB) * 72 + 16 * ks + 8 * hi);
                const bf16x8 a0 = *(const bf16x8*)(vt0 + 16 * ks), a1 = *(const bf16x8*)(vt0 + 32 * 64 + 16 * ks);
                o0 = __builtin_amdgcn_mfma_f32_32x32x16_bf16(a0, bb, o0, 0, 0, 0);
                o1 = __builtin_amdgcn_mfma_f32_32x32x16_bf16(a1, bb, o1, 0, 0, 0);
            }
            const bf16_t* ss0 = p.SS + ((((size_t)dir * 8 + bh) * 65 + j) * 256 + 64 * wv + l31) * 128 + 8 * hi;
            const bf16_t* qm = (dir ? p.QB : p.QF) + tb + (size_t)tB * 128 + 8 * hi;
#pragma unroll
            for (int ks = 0; ks < 8; ++ks) {
                const bf16x8 bb = *(const bf16x8*)(qm + 16 * ks);
                const bf16x8 a0 = *(const bf16x8*)(ss0 + 16 * ks), a1 = *(const bf16x8*)(ss0 + 32 * 128 + 16 * ks);
                o0 = __builtin_amdgcn_mfma_f32_32x32x16_bf16(a0, bb, o0, 0, 0, 0);
                o1 = __builtin_amdgcn_mfma_f32_32x32x16_bf16(a1, bb, o1, 0, 0, 0);
            }
        }
        float ss = 0.f;
#pragma unroll
        for (int r = 0; r < 16; ++r) ss += o0[r] * o0[r] + o1[r] * o1[r];
        ss += __shfl_xor(ss, 32);
        if (hi == 0) ssq[(wt * 4 + wv) * 32 + l31] = ss;
        __syncthreads();
        const float tot = ssq[(wt * 4 + 0) * 32 + l31] + ssq[(wt * 4 + 1) * 32 + l31] + ssq[(wt * 4 + 2) * 32 + l31] + ssq[(wt * 4 + 3) * 32 + l31];
        const float rstd = rsqrtf(tot * (1.f / 256.f) + 1e-6f);
        const int row = b * SEQ + 64 * j + tB;
        f32x4 gateA[2][4], gnA[2][4];
#pragma unroll
        for (int vt = 0; vt < 2; ++vt)
#pragma unroll
            for (int g = 0; g < 4; ++g) { const int v = 64 * wv + 32 * vt + 8 * g + 4 * hi;
                const u32x2 g4 = *(const u32x2*)(p.P + (size_t)row * PLD + 5120 + h * 256 + v);
                gateA[vt][g] = (f32x4){bf2f(g4.x & 0xffffu), bf2f(g4.x >> 16), bf2f(g4.y & 0xffffu), bf2f(g4.y >> 16)}; gnA[vt][g] = *(const f32x4*)(p.gla_norm_g + v); }
#pragma unroll
        for (int vt = 0; vt < 2; ++vt)
#pragma unroll
            for (int g = 0; g < 4; ++g) {
                const int v = 64 * wv + 32 * vt + 8 * g + 4 * hi;
                const f32x4 gate = gateA[vt][g], gn = gnA[vt][g];
                float ov[4];
#pragma unroll
                for (int e = 0; e < 4; ++e) { const float x = vt ? o1[4 * g + e] : o0[4 * g + e];
                    ov[e] = x * rstd * gn[e] * gate[e] * __builtin_amdgcn_rcpf(1.f + __builtin_amdgcn_exp2f(-1.4426950408889634f * gate[e])); }
                u32x2 pk; pk.x = cvt_pk_bf16(ov[0], ov[1]); pk.y = cvt_pk_bf16(ov[2], ov[3]);
                *(u32x2*)(p.MIX + (size_t)row * D + 1024 + h * 256 + v) = pk;
            }
        __syncthreads();
    }
}

__device__ void ph_norm2_router(const Params& p, float* sm, const int wid0) {
    const int t = opaque_tid(wid0), w = t >> 6, lane = t & 63;
    float* hs = sm;
    float* part = sm + 8 * D;
    int* hist = (int*)(sm + 8 * D + 8 * 8 * 64);
    const int G = gridDim.x, gpb = (NLAT / 8 + G - 1) / G;
    if (t < 64) hist[t] = 0;
    const int rb0 = blockIdx.x * gpb, rb1 = min(NLAT / 8, rb0 + gpb);
    float4 v[8];
    if (rb0 < rb1) {
#pragma unroll
        for (int j = 0; j < 8; ++j) v[j] = *(const float4*)(p.X1 + (size_t)(rb0 * 8 + w) * D + 256 * j + 4 * lane);
    }
    for (int rb = rb0; rb < rb1; ++rb) {
        const int row = rb * 8 + w, b = row / SEQ;
        const float* m = p.mod + (size_t)b * 6 * D;
        float ss = 0.f;
#pragma unroll
        for (int j = 0; j < 8; ++j) ss += v[j].x * v[j].x + v[j].y * v[j].y + v[j].z * v[j].z + v[j].w * v[j].w;
        ss = wave_sum(ss);
        const float rs = rsqrtf(ss * (1.f / D) + 1e-6f);
        __syncthreads();
        float4 vn[8];
        if (rb + 1 < rb1) {
#pragma unroll
            for (int j = 0; j < 8; ++j) vn[j] = *(const float4*)(p.X1 + (size_t)(row + 8) * D + 256 * j + 4 * lane);
        }
#pragma unroll
        for (int j = 0; j < 8; ++j) {
            const int col = 256 * j + 4 * lane;
            const float4 g = *(const float4*)(p.norm2_g + col), sh = *(const float4*)(m + 3 * D + col), sc = *(const float4*)(m + 4 * D + col);
            float4 o;
            o.x = v[j].x * rs * g.x * (1.f + sc.x) + sh.x; o.y = v[j].y * rs * g.y * (1.f + sc.y) + sh.y;
            o.z = v[j].z * rs * g.z * (1.f + sc.z) + sh.z; o.w = v[j].w * rs * g.w * (1.f + sc.w) + sh.w;
            *(float4*)(hs + w * D + col) = o;
            u32x2 pk; pk.x = cvt_pk_bf16(o.x, o.y); pk.y = cvt_pk_bf16(o.z, o.w);
            *(u32x2*)(p.H + (size_t)row * D + col) = pk;
        }
        if (rb + 1 < rb1) {
#pragma unroll
            for (int j = 0; j < 8; ++j) v[j] = vn[j];
        }
        __syncthreads();
        {
            const int e4 = t & 15, kp = t >> 4;
            float a[8][4];
#pragma unroll
            for (int r = 0; r < 8; ++r)
#pragma unroll
                for (int j = 0; j < 4; ++j) a[r][j] = 0.f;
#pragma unroll 4
            for (int kk = 0; kk < 64; ++kk) {
                const int k = kk * 32 + kp;
                const float4 wv = *(const float4*)(p.router_w + (size_t)k * NE + 4 * e4);
#pragma unroll
                for (int r = 0; r < 8; ++r) { const float hv = hs[r * D + k]; a[r][0] += hv * wv.x; a[r][1] += hv * wv.y; a[r][2] += hv * wv.z; a[r][3] += hv * wv.w; }
            }
#pragma unroll
            for (int r = 0; r < 8; ++r)
#pragma unroll
                for (int j = 0; j < 4; ++j) { float x = a[r][j]; x += __shfl_xor(x, 16); x += __shfl_xor(x, 32); a[r][j] = x; }
            if (lane < 16) {
#pragma unroll
                for (int r = 0; r < 8; ++r) *(float4*)(part + (w * 8 + r) * 64 + 4 * lane) = make_float4(a[r][0], a[r][1], a[r][2], a[r][3]);
            }
        }
        __syncthreads();
        {
            float lgt = 0.f;
#pragma unroll
            for (int i = 0; i < 8; ++i) lgt += part[(i * 8 + w) * 64 + lane];
            const float sc = 1.f / (1.f + expf(-lgt));
            const float bs = sc + p.router_bias[lane];
            float m1 = bs; m1 = fmaxf(m1, __shfl_xor(m1, 1)); m1 = fmaxf(m1, __shfl_xor(m1, 2)); m1 = fmaxf(m1, __shfl_xor(m1, 4));
            int ai = (bs == m1) ? lane : 64; ai = min(ai, __shfl_xor(ai, 1)); ai = min(ai, __shfl_xor(ai, 2)); ai = min(ai, __shfl_xor(ai, 4));
            float m2 = (lane == ai) ? -INFINITY : bs; m2 = fmaxf(m2, __shfl_xor(m2, 1)); m2 = fmaxf(m2, __shfl_xor(m2, 2)); m2 = fmaxf(m2, __shfl_xor(m2, 4));
            const float gs = m1 + m2;
            float g0 = __shfl(gs, 0), g1 = __shfl(gs, 8), g2 = __shfl(gs, 16), g3 = __shfl(gs, 24), g4 = __shfl(gs, 32), g5 = __shfl(gs, 40), g6 = __shfl(gs, 48), g7 = __shfl(gs, 56);
            unsigned selmask = 0u;
#pragma unroll
            for (int it = 0; it < 4; ++it) {
                float best = -INFINITY; int bi = 0;
                if (!(selmask & 1u) && g0 > best) { best = g0; bi = 0; }
                if (!(selmask & 2u) && g1 > best) { best = g1; bi = 1; }
                if (!(selmask & 4u) && g2 > best) { best = g2; bi = 2; }
                if (!(selmask & 8u) && g3 > best) { best = g3; bi = 3; }
                if (!(selmask & 16u) && g4 > best) { best = g4; bi = 4; }
                if (!(selmask & 32u) && g5 > best) { best = g5; bi = 5; }
                if (!(selmask & 64u) && g6 > best) { best = g6; bi = 6; }
                if (!(selmask & 128u) && g7 > best) { best = g7; bi = 7; }
                selmask |= 1u << bi;
            }
            float cand = ((selmask >> (lane >> 3)) & 1u) ? bs : -INFINITY;
            int myslot = -1; float ssum = 0.f;
#pragma unroll
            for (int k = 0; k < TOPK; ++k) {
                const float mv = wave_max(cand);
                const int idx = wave_min_i((cand == mv) ? lane : 64);
                const float sv = __shfl(sc, idx);
                ssum += sv;
                if (lane == idx) { myslot = k; cand = -INFINITY; }
            }
            if (myslot >= 0) {
                p.EIDX[row * TOPK + myslot] = lane;
                p.EW[row * TOPK + myslot] = sc / ssum * 2.5f;
                p.LRANK[row * TOPK + myslot] = atomicAdd(&hist[lane], 1);
            }
        }
    }
    __syncthreads();
    if (t < 64) p.CNTB[blockIdx.x * 64 + t] = hist[t];
}

__device__ void ph_lists(const Params& p, int* smi, const int wid0) {
    const int t = opaque_tid(wid0);
    const int G = gridDim.x, gpb = (NLAT / 8 + G - 1) / G;
    int* tp = smi + 128; int* tot = smi + 64;
    __syncthreads();
    if (t < 64) {
        int before = 0, all = 0;
        for (int bb = 0; bb < G; ++bb) { const int cnt = p.CNTB[bb * 64 + t]; all += cnt; if (bb < (int)blockIdx.x) before += cnt; }
        smi[t] = before; tot[t] = all;
        if (blockIdx.x == 0) p.CNT[t] = all;
    }
    __syncthreads();
    if (t == 0) { int tt = 0; for (int e = 0; e < NE; ++e) { tp[e] = tt; tt += (tot[e] + 255) / 256; } tp[NE] = tt; }
    __syncthreads();
    const int r0 = blockIdx.x * gpb * 8, r1 = min(NLAT, r0 + gpb * 8);
    for (int i = r0 * TOPK + t; i < r1 * TOPK; i += NT) {
        const int e = p.EIDX[i];
        const int pos = tp[e] * 256 + smi[e] + p.LRANK[i];
        p.PAIRPOS[i] = pos; p.LIST[pos] = i / TOPK;
    }
    for (int e = blockIdx.x; e < NE; e += G) {
        const int cn = tot[e], end = (tp[e + 1] - tp[e]) * 256;
        for (int i = cn + t; i < end; i += NT) p.LIST[tp[e] * 256 + i] = 0;
    }
}


__device__ void ph_prep(const Params& p, float* sm, const int wid0) {
    int* qslot = (int*)(sm + 21000);
    for (;;) {
        __syncthreads();
        if (wid0 == 0 && xb_lane_id() == 0) *qslot = atomicAdd(p.QCTR, 1);
        __syncthreads();
        const int it = *qslot;
        if (it >= 272 + 544) break;
        if (it < 272) { const int u = it < 16 ? ((it >> 3) * NTILE + 128 + (it & 7)) : (((it - 16) >> 7) * NTILE + ((it - 16) & 127)); ph_naprep(p, wid0, u, u + 1, 1); }
        else ph_glaprep(p, sm, wid0, it - 272, it - 271, 1);
    }
}

__device__ void ph_combine(const Params& p, const int wid0) {
    const int t = opaque_tid(wid0), w = t >> 6, lane = t & 63;
    for (int row = blockIdx.x * 8 + w; row < NLAT; row += gridDim.x * 8) {
        const int b = row / SEQ;
        float wk[TOPK]; const unsigned char* yr[TOPK];
#pragma unroll
        for (int k = 0; k < TOPK; ++k) { wk[k] = p.EW[row * TOPK + k]; yr[k] = p.Y8 + (size_t)p.PAIRPOS[row * TOPK + k] * YLD8 + 16 * lane; }
        const unsigned char* ys = p.YS8 + (size_t)row * YLD8 + 16 * lane;
        const float* x1 = p.X1 + (size_t)row * D + 16 * lane;
        const float* g2 = p.mod + (size_t)b * 6 * D + 5 * D + 16 * lane;
        float* o = p.out + (size_t)row * D + 16 * lane;
#pragma unroll
        for (int j = 0; j < 2; ++j) {
            float s[16];
            { const u32x4 v = *(const u32x4*)(ys + 1024 * j);
#pragma unroll
              for (int q = 0; q < 4; ++q) { const f32x2 lo = __builtin_amdgcn_cvt_pk_f32_fp8((int)v[q], false), hi = __builtin_amdgcn_cvt_pk_f32_fp8((int)v[q], true);
                  s[4 * q] = lo[0]; s[4 * q + 1] = lo[1]; s[4 * q + 2] = hi[0]; s[4 * q + 3] = hi[1]; } }
#pragma unroll
            for (int k = 0; k < TOPK; ++k) {
                const u32x4 v = *(const u32x4*)(yr[k] + 1024 * j); const float wv = wk[k];
#pragma unroll
                for (int q = 0; q < 4; ++q) { const f32x2 lo = __builtin_amdgcn_cvt_pk_f32_fp8((int)v[q], false), hi = __builtin_amdgcn_cvt_pk_f32_fp8((int)v[q], true);
                    s[4 * q] += wv * lo[0]; s[4 * q + 1] += wv * lo[1]; s[4 * q + 2] += wv * hi[0]; s[4 * q + 3] += wv * hi[1]; }
            }
#pragma unroll
            for (int q = 0; q < 4; ++q) { const f32x4 xa = *(const f32x4*)(x1 + 1024 * j + 4 * q), ga = *(const f32x4*)(g2 + 1024 * j + 4 * q);
                *(f32x4*)(o + 1024 * j + 4 * q) = (f32x4){xa[0] + ga[0] * s[4 * q], xa[1] + ga[1] * s[4 * q + 1], xa[2] + ga[2] * s[4 * q + 2], xa[3] + ga[3] * s[4 * q + 3]}; }
        }
    }
}

__global__ void __launch_bounds__(NT, 2) mega(Params p) {
    extern __shared__ __attribute__((aligned(16))) unsigned char dynlds[];
    int wid0;
    wid0 = __builtin_amdgcn_readfirstlane((int)threadIdx.x >> 6); asm volatile("" : "+s"(wid0));
    if (wid0 == 0 && xb_lane_id() < 4) ((unsigned*)(dynlds + LDS_BARW))[xb_lane_id()] = 0u;
    __syncthreads();
    XcdBarrier bar = xcd_barrier_post(p.bar, (volatile LAS unsigned*)(dynlds + LDS_BARW), wid0);
    float* sm = (float*)dynlds;
    int* tp = (int*)(dynlds + LDS_TAB);
    LAS unsigned char* lds = (LAS unsigned char*)dynlds;
    const int G = gridDim.x, c = blockIdx.x;

#ifndef REP
#define REP 0
#endif
#define PH(bit, ...) do { __VA_ARGS__; if (REP & (1 << (bit))) { xcd_barrier(bar); __VA_ARGS__; } } while (0)
    PH(0, ph_prologue(p, sm, wid0));                            xcd_barrier(bar);
    PH(1, ph_norm1(p, wid0));                               xcd_barrier(bar);
    { SchedDense S{(const char*)p.H, (const char*)p.WinT, D, NLAT / 256, PLD / 256, G, c}; EpiInproj E{p.P};
      g8::gemm_phase(lds, D, S, E, wid0); }
    { SchedInprojSplit S{(const char*)p.H, (const char*)p.WinT, G, c}; EpiInprojSplit E{p.PS, p.DDS};
      g8::gemm_phase(lds, D, S, E, wid0, 512); }                xcd_barrier(bar);
    ph_prep(p, sm, wid0);                                       xcd_barrier(bar);
    PH(6, ph_attn(p, dynlds, wid0));                            xcd_barrier(bar);
    PH(7, ph_glaout(p, dynlds, wid0));                          xcd_barrier(bar);
    PH(8, { SchedDense S{(const char*)p.MIX, (const char*)p.WoutT, D, NLAT / 256, D / 256, G, c}; EpiOutproj E{p.x, p.mod, p.X1};
      g8::gemm_phase(lds, D, S, E, wid0); });                   xcd_barrier(bar);
    PH(12, ph_norm2_router(p, sm, wid0));                       xcd_barrier(bar);
    PH(13, ph_lists(p, tp, wid0));                              xcd_barrier(bar);
    moe_tables(p, tp, wid0);
    PH(9, { SchedUp S{tp, (const char*)p.H, p.LIST, (const char*)p.E13T, (const char*)p.S13T, G, c}; EpiUp E{p.HB, p.SHH};
      g8::gemm_phase(lds, D, S, E, wid0); });                   xcd_barrier(bar);
    PH(10, { SchedDown S{tp, (const char*)p.HB, (const char*)p.E2T, (const char*)p.SHH, (const char*)p.S2T, G, c}; EpiDown E{p.Y8, p.YS8};
      g8::gemm_phase(lds, DE, S, E, wid0); });                  xcd_barrier(bar);
    PH(11, ph_combine(p, wid0));
}

extern "C" void kernel_launch(void* const* d_in, const int* in_sizes, int n_in, void* d_out, int out_size, void* d_ws, size_t ws_size, hipStream_t stream) {
    Params p{};
    const float* const* in = (const float* const*)d_in;
    p.x = in[0]; p.c = in[1]; p.ctx = in[2]; p.c_ctx = in[3]; p.w_mod = in[4]; p.b_mod = in[5]; p.norm1_g = in[6]; p.norm2_g = in[7]; p.w_in = in[8];
    p.q_norm_g = in[9]; p.k_norm_g = in[10]; p.na_rpb = in[11]; p.up_f = in[12]; p.bias_f = in[13]; p.up_b = in[14]; p.bias_b = in[15]; p.gla_norm_g = in[16];
    p.w_out = in[17]; p.router_w = in[18]; p.router_bias = in[19]; p.ew1 = in[20]; p.ew3 = in[21]; p.ew2 = in[22]; p.sw1 = in[23]; p.sw3 = in[24]; p.sw2 = in[25];
    p.out = (float*)d_out;
    char* w = (char*)d_ws; size_t o = 0;
    auto take = [&](size_t bytes) { void* r = w + o; o += (bytes + 255) & ~(size_t)255; return r; };
    p.bar = (unsigned*)take((size_t)XCD_BAR_WORDS * 4);
    p.CNT = (int*)take(64 * 4); p.QCTR = (int*)take(64 * 4); p.LRANK = (int*)take((size_t)NPAIR * 4); p.CNTB = (int*)take((size_t)1024 * 64 * 4);
    p.mod = (float*)take((size_t)3 * 6 * D * 4); p.RT = (float*)take((size_t)64 * 32 * 2 * 4);
    p.EIDX = (int*)take((size_t)NPAIR * 4); p.EW = (float*)take((size_t)NPAIR * 4); p.PAIRPOS = (int*)take((size_t)NPAIR * 4); p.LIST = (int*)take((size_t)PADROWS * 4);
    p.WinT = (bf16_t*)take((size_t)(PLD + 256) * D * 2); p.WoutT = (bf16_t*)take((size_t)D * D * 2); p.S13T = (bf16_t*)take((size_t)1024 * D * 2); p.S2T = (bf16_t*)take((size_t)D * DE * 2);
    p.E13T = (bf16_t*)take((size_t)NE * 1024 * D * 2); p.E2T = (bf16_t*)take((size_t)NE * D * DE * 2);
    p.H = (bf16_t*)take((size_t)NROW * D * 2);
    p.X1 = (float*)take((size_t)NLAT * D * 4);
    const size_t big = o;
    p.P = (bf16_t*)take((size_t)NLAT * PLD * 2); p.PS = (float*)take(4 * PS_SLAB * 4); p.DDS = (float*)take(4 * DD_SLAB * 4); p.NQb = (bf16_t*)take((size_t)NLAT * 1024 * 2); p.NKf = (bf16_t*)take((size_t)16 * NTILE * 4096 * 2); p.VTf = (bf16_t*)take((size_t)16 * NTILE * 4096 * 2);
    p.MIX = (bf16_t*)take((size_t)NLAT * D * 2);
    p.QF = (bf16_t*)take((size_t)8 * 64 * 64 * 128 * 2); p.KF = (bf16_t*)take((size_t)8 * 64 * 64 * 128 * 2); p.QB = (bf16_t*)take((size_t)8 * 64 * 64 * 128 * 2); p.KB = (bf16_t*)take((size_t)8 * 64 * 64 * 128 * 2);
    p.KHF = (bf16_t*)take((size_t)8 * 68 * 128 * 64 * 2); p.KHB = (bf16_t*)take((size_t)8 * 68 * 128 * 64 * 2); p.VT = (bf16_t*)take((size_t)8 * 68 * 256 * 64 * 2); p.VTS = (bf16_t*)take((size_t)8 * 68 * 256 * 64 * 2);
    p.DF = (float*)take((size_t)8 * 68 * 128 * 4); p.DB = (float*)take((size_t)8 * 68 * 128 * 4); p.SS = (bf16_t*)take((size_t)16 * 65 * 256 * 128 * 2);
    o = big;
    p.HB = (bf16_t*)take((size_t)PADROWS * DE * 2); p.SHH = (bf16_t*)take((size_t)NLAT * DE * 2); p.Y8 = (unsigned char*)take((size_t)PADROWS * YLD8); p.YS8 = (unsigned char*)take((size_t)NLAT * YLD8);
    static int grid = 0;
    if (!grid) {
        int dev = 0, cus = 0, per_cu = 0;
        hipGetDevice(&dev);
        hipDeviceGetAttribute(&cus, hipDeviceAttributeMultiprocessorCount, dev);
        (void)hipFuncSetAttribute((const void*)mega, hipFuncAttributeMaxDynamicSharedMemorySize, LDS_BYTES);
        (void)hipOccupancyMaxActiveBlocksPerMultiprocessor(&per_cu, (const void*)mega, NT, LDS_BYTES);
        (void)hipGetLastError();
        grid = cus;
    }
    (void)hipMemsetAsync(p.bar, 0, (size_t)XCD_BAR_WORDS * 4, stream);
    hipLaunchKernelGGL(mega, dim3(grid), dim3(NT), LDS_BYTES, stream, p);
}
```

```cpp
#include <hip/hip_runtime.h>
#include <stdint.h>

#define XB_TMO      128
#define XB_XCNT(j)  (256  + 64 * (j))
#define XB_XSUB(j)  (1280 + 64 * (j))
#define XB_XGEN(j)  (2304 + 64 * (j))
#define XB_TOP      3328
#define XB_TOPGEN   3392
#define XCD_BAR_WORDS 3456
#define XB_SPIN_CAP (1u << 18)
#define LAS __attribute__((address_space(3)))

__device__ __forceinline__ unsigned xb_ld(unsigned* p)              { return __hip_atomic_load(p, __ATOMIC_RELAXED, __HIP_MEMORY_SCOPE_AGENT); }
__device__ __forceinline__ unsigned xb_add(unsigned* p, unsigned v) { return __hip_atomic_fetch_add(p, v, __ATOMIC_RELAXED, __HIP_MEMORY_SCOPE_AGENT); }
__device__ __forceinline__ unsigned xb_xcc_id() { return (unsigned)__builtin_amdgcn_s_getreg((3 << 11) | 20) & 0xFu; }
#define XB_SPIN(cond, bar) do { unsigned _sp = 0; while (cond) { __builtin_amdgcn_s_sleep(1); \
    if ((++_sp & 255u) == 0u) { if (xb_ld(&(bar)[XB_TMO])) break; if (_sp > XB_SPIN_CAP) { atomicAdd(&(bar)[XB_TMO], 1u); break; } } } } while (0)

__device__ __forceinline__ int xb_lane_id() { return (int)__builtin_amdgcn_mbcnt_hi(~0u, __builtin_amdgcn_mbcnt_lo(~0u, 0u)); }
struct XcdBarrier {
    int wid;
    unsigned* bar; unsigned x;
    volatile LAS unsigned* st;
};

__device__ __forceinline__ XcdBarrier xcd_barrier_post(unsigned* bar, volatile LAS unsigned* st, int wid) {
    XcdBarrier b; b.wid = wid; b.bar = bar; b.x = xb_xcc_id(); b.st = st;
    if (wid == 0 && xb_lane_id() == 0) (void)xb_add(&bar[XB_XCNT(b.x)], 1u);
    return b;
}
__device__ __forceinline__ void xcd_barrier_complete(unsigned* bar, unsigned x, unsigned& nloc, unsigned& nx) {
    const unsigned G = gridDim.x * gridDim.y * gridDim.z;
    unsigned sum, cnt, mine, sp = 0u;
    for (;;) {
        sum = 0u; cnt = 0u; mine = 0u;
#pragma unroll
        for (unsigned j = 0; j < 16; ++j) { const unsigned c = xb_ld(&bar[XB_XCNT(j)]); sum += c; cnt += (c > 0u) ? 1u : 0u; mine = (j == x) ? c : mine; }
        if (sum == G) break;
        __builtin_amdgcn_s_sleep(1);
        if ((++sp & 255u) == 0u) { if (xb_ld(&bar[XB_TMO])) break; if (sp > XB_SPIN_CAP) { atomicAdd(&bar[XB_TMO], 1u); break; } }
    }
    nloc = mine > 0u ? mine : 1u; nx = cnt > 0u ? cnt : 1u;
}

__device__ __forceinline__ void xcd_barrier(const XcdBarrier& b) {
    asm volatile("s_waitcnt vmcnt(0)" ::: "memory");
    __syncthreads();
    if (b.wid == 0 && xb_lane_id() == 0) {
        unsigned* bar = b.bar;
        __builtin_amdgcn_s_waitcnt(0);
        unsigned nloc = b.st[0], nx = b.st[1];
        if (nloc == 0u) { xcd_barrier_complete(bar, b.x, nloc, nx); b.st[0] = nloc; b.st[1] = nx; }
        const unsigned old = xb_add(&bar[XB_XSUB(b.x)], 1u);
        const unsigned gen = old / nloc;
        if (old + 1u == (gen + 1u) * nloc) {
            __builtin_amdgcn_fence(__ATOMIC_RELEASE, "agent");
            asm volatile("s_waitcnt vmcnt(0)" ::: "memory");
            const unsigned og = xb_add(&bar[XB_TOP], 1u);
            const unsigned tg = og / nx;
            if (og + 1u == (tg + 1u) * nx) xb_add(&bar[XB_TOPGEN], 1u);
            else XB_SPIN(xb_ld(&bar[XB_TOPGEN]) == tg, bar);
            __builtin_amdgcn_fence(__ATOMIC_ACQUIRE, "agent");
            xb_add(&bar[XB_XGEN(b.x)], 1u);
            asm volatile("s_waitcnt vmcnt(0)" ::: "memory");
        } else {
            XB_SPIN(xb_ld(&bar[XB_XGEN(b.x)]) == gen, bar);
            __builtin_amdgcn_fence(__ATOMIC_ACQUIRE, "agent");
            asm volatile("s_waitcnt vmcnt(0)" ::: "memory");
        }
    }
    __syncthreads();
}


#define NT 512
typedef unsigned short bf16_t;
typedef short bf16x8 __attribute__((ext_vector_type(8)));
typedef float f32x4 __attribute__((ext_vector_type(4)));
typedef float f32x16 __attribute__((ext_vector_type(16)));
typedef unsigned u32x4 __attribute__((ext_vector_type(4)));
typedef unsigned u32x2 __attribute__((ext_vector_type(2)));
typedef int i32x4 __attribute__((ext_vector_type(4)));
typedef int i32x8 __attribute__((ext_vector_type(8)));

constexpr int D = 2048, SEQ = 4096, CTXL = 256, NB = 2;
constexpr int NLAT = NB * SEQ;
constexpr int NCTX = NB * CTXL;
constexpr int NROW = NLAT + NCTX;
constexpr int INC = 6176;
constexpr int PLD = 6144;
constexpr int PSLD = 3584;
constexpr size_t PS_SLAB = (size_t)512 * 3584, DD_SLAB = (size_t)8704 * 32;
constexpr int NE = 64, TOPK = 6, DE = 512;
constexpr int NPAIR = NLAT * TOPK;
constexpr int PADROWS = NPAIR + NE * 256;
constexpr float W13SC = 64.f, W2SC = 32.f, HSC = 4.f;
constexpr int YLD8 = D + 64;
constexpr int YLD = D + 64;
constexpr int LDS_STAGE = 131072;
constexpr int LDS_TAB = LDS_STAGE;
constexpr int LDS_BARW = LDS_STAGE + 4096;
constexpr int LDS_BYTES = LDS_BARW + 16 + 8192;

struct Params {
    const float *x, *c, *ctx, *c_ctx, *w_mod, *b_mod, *norm1_g, *norm2_g, *w_in, *q_norm_g, *k_norm_g, *na_rpb,
        *up_f, *bias_f, *up_b, *bias_b, *gla_norm_g, *w_out, *router_w, *router_bias, *ew1, *ew3, *ew2, *sw1, *sw3, *sw2;
    float* out;
    float *mod, *X1, *PS, *DDS, *EW, *RT, *DF, *DB;
    unsigned char *Y8, *YS8;
    bf16_t *P, *H, *MIX, *HB, *SHH, *Y, *WinT, *WoutT, *S13T, *S2T, *E13T, *E2T, *QF, *KF, *QB, *KB, *KHF, *KHB, *VT, *SS, *NQb, *NKf, *VTf, *YS, *VTS;
    int *EIDX, *PAIRPOS, *LIST, *CNT, *QCTR, *LRANK, *CNTB;
    unsigned* bar;
};

__device__ __forceinline__ int fresh_lane_id() { int l; asm volatile("v_mbcnt_lo_u32_b32 %0, -1, 0\n\tv_mbcnt_hi_u32_b32 %0, -1, %0" : "=v"(l)); return l; }
__device__ __forceinline__ int opaque_tid(int wid0) { return wid0 * 64 + fresh_lane_id(); }
__device__ __forceinline__ float wave_sum(float v) { for (int o = 32; o > 0; o >>= 1) v += __shfl_xor(v, o); return v; }
__device__ __forceinline__ float wave_max(float v) { for (int o = 32; o > 0; o >>= 1) v = fmaxf(v, __shfl_xor(v, o)); return v; }
__device__ __forceinline__ int wave_min_i(int v) { for (int o = 32; o > 0; o >>= 1) v = min(v, __shfl_xor(v, o)); return v; }
__device__ __forceinline__ float siluf(float v) { return v / (1.f + expf(-v)); }
typedef float f32x2 __attribute__((ext_vector_type(2)));
typedef __bf16 bf16x2_t __attribute__((ext_vector_type(2)));
__device__ __forceinline__ unsigned cvt_pk_bf16(float lo, float hi) { const f32x2 v = {lo, hi}; return __builtin_bit_cast(unsigned, __builtin_convertvector(v, bf16x2_t)); }
__device__ __forceinline__ bf16_t f2bf(float f) { return (bf16_t)(cvt_pk_bf16(f, 0.f) & 0xffffu); }
__device__ __forceinline__ float bf2f(unsigned b) { return __uint_as_float(b << 16); }

__device__ __forceinline__ void adaln_item(const Params& p, float* sm, int item, const int wid0) {
    const int t = opaque_tid(wid0), cq = t & 15, kg = t >> 4, n0 = item * 64;
    float* red = sm + 3 * D;
    float a[3][4];
#pragma unroll
    for (int r = 0; r < 3; ++r)
#pragma unroll
        for (int j = 0; j < 4; ++j) a[r][j] = 0.f;
#pragma unroll 4
    for (int k = kg; k < D; k += 32) {
        const f32x4 w4 = __builtin_nontemporal_load((const f32x4*)(p.w_mod + (size_t)k * (6 * D) + n0 + 4 * cq)); const float4 w = make_float4(w4[0], w4[1], w4[2], w4[3]);
        const float s0 = sm[k], s1 = sm[D + k], s2 = sm[2 * D + k];
        a[0][0] += s0 * w.x; a[0][1] += s0 * w.y; a[0][2] += s0 * w.z; a[0][3] += s0 * w.w;
        a[1][0] += s1 * w.x; a[1][1] += s1 * w.y; a[1][2] += s1 * w.z; a[1][3] += s1 * w.w;
        a[2][0] += s2 * w.x; a[2][1] += s2 * w.y; a[2][2] += s2 * w.z; a[2][3] += s2 * w.w;
    }
    __syncthreads();
#pragma unroll
    for (int r = 0; r < 3; ++r)
#pragma unroll
        for (int j = 0; j < 4; ++j) red[(kg * 3 + r) * 64 + 4 * cq + j] = a[r][j];
    __syncthreads();
    if (t < 192) {
        const int r = t >> 6, cc = t & 63;
        float s = p.b_mod[n0 + cc];
#pragma unroll 8
        for (int g = 0; g < 32; ++g) s += red[(g * 3 + r) * 64 + cc];
        p.mod[(size_t)r * 6 * D + n0 + cc] = s;
    }
    __syncthreads();
}
__device__ __forceinline__ void transpose_item(const float* W, int K, int N, int k0, int n0, bf16_t* WT, int drow0, float* scr, int lane, int maxc = 63) {
    if (maxc >= 63) {
        const int kr = lane >> 4, nq = lane & 15;
        f32x4 v[16];
#pragma unroll
        for (int q = 0; q < 16; ++q) v[q] = __builtin_nontemporal_load((const f32x4*)(W + (size_t)(k0 + 4 * q + kr) * N + n0 + 4 * nq));
#pragma unroll
        for (int q = 0; q < 16; ++q) { float* d = scr + (4 * q + kr) * 65 + 4 * nq; d[0] = v[q][0]; d[1] = v[q][1]; d[2] = v[q][2]; d[3] = v[q][3]; }
    } else {
        const int cl = lane < maxc ? lane : maxc;
#pragma unroll 8
        for (int kk = 0; kk < 64; ++kk) scr[kk * 65 + lane] = W[(size_t)(k0 + kk) * N + n0 + cl];
    }
    asm volatile("s_waitcnt lgkmcnt(0)" ::: "memory");
    const int c = lane & 7;
#pragma unroll
    for (int j = 0; j < 8; ++j) {
        const int n = (lane >> 3) + 8 * j; const float* s = scr + (8 * c) * 65 + n;
        u32x4 o; o.x = cvt_pk_bf16(s[0], s[65]); o.y = cvt_pk_bf16(s[2 * 65], s[3 * 65]); o.z = cvt_pk_bf16(s[4 * 65], s[5 * 65]); o.w = cvt_pk_bf16(s[6 * 65], s[7 * 65]);
        *(u32x4*)(WT + (size_t)(drow0 + n) * K + k0 + 8 * c) = o;
    }
    asm volatile("s_waitcnt lgkmcnt(0)" ::: "memory");
}
__device__ __forceinline__ void transpose_item8(const float* W, int K, int N, int k0, int n0, unsigned char* WT, int drow0, float* scr, int lane, float sc) {
    {
        const int kr = lane >> 4, nq = lane & 15;
        f32x4 v[16];
#pragma unroll
        for (int q = 0; q < 16; ++q) v[q] = __builtin_nontemporal_load((const f32x4*)(W + (size_t)(k0 + 4 * q + kr) * N + n0 + 4 * nq));
#pragma unroll
        for (int q = 0; q < 16; ++q) { float* d = scr + (4 * q + kr) * 65 + 4 * nq; d[0] = v[q][0]; d[1] = v[q][1]; d[2] = v[q][2]; d[3] = v[q][3]; }
    }
    asm volatile("s_waitcnt lgkmcnt(0)" ::: "memory");
    const int c = lane & 3;
#pragma unroll
    for (int j = 0; j < 4; ++j) {
        const int n = (lane >> 2) + 16 * j; const float* s = scr + (16 * c) * 65 + n;
        u32x4 o;
#pragma unroll
        for (int q = 0; q < 4; ++q) { int pk = 0;
            pk = __builtin_amdgcn_cvt_pk_fp8_f32(s[(4 * q) * 65] * sc, s[(4 * q + 1) * 65] * sc, pk, false);
            pk = __builtin_amdgcn_cvt_pk_fp8_f32(s[(4 * q + 2) * 65] * sc, s[(4 * q + 3) * 65] * sc, pk, true); o[q] = (unsigned)pk; }
        *(u32x4*)(WT + (size_t)(drow0 + n) * K + k0 + 16 * c) = o;
    }
    asm volatile("s_waitcnt lgkmcnt(0)" ::: "memory");
}
constexpr int CI_WIN = 32 * 97, CI_WOUT = 32 * 32, CI_S13 = 2 * 32 * 8, CI_S2 = 8 * 32, CI_E13 = 64 * 2 * 32 * 8, CI_E2 = 64 * 8 * 32;
constexpr int CI_TOTAL = CI_WIN + CI_WOUT + CI_S13 + CI_S2 + CI_E13 + CI_E2;
__device__ __forceinline__ void convert_item(const Params& p, int it, float* scr, int lane) {
    if (it < CI_WIN) { const int kb = it / 97, nb = it % 97; transpose_item(p.w_in, D, INC, 64 * kb, 64 * nb, p.WinT, 64 * nb, scr, lane, INC - 1 - 64 * nb); return; }
    it -= CI_WIN;
    if (it < CI_WOUT) { const int kb = it / 32, nb = it % 32; transpose_item(p.w_out, D, D, 64 * kb, 64 * nb, p.WoutT, 64 * nb, scr, lane); return; }
    it -= CI_WOUT;
    if (it < CI_S13) {
        const int which = it / 256, r = it % 256, kb = r / 8, nb = r % 8;
        transpose_item(which ? p.sw3 : p.sw1, D, DE, 64 * kb, 64 * nb, p.S13T, (nb >> 1) * 256 + which * 128 + (nb & 1) * 64, scr, lane); return; }
    it -= CI_S13;
    if (it < CI_S2) { const int kb = it / 32, nb = it % 32; transpose_item8(p.sw2, DE, D, 64 * kb, 64 * nb, (unsigned char*)p.S2T, 64 * nb, scr, lane, W2SC); return; }
    it -= CI_S2;
    if (it < CI_E13) {
        const int e = it / 512, r0 = it % 512, which = r0 / 256, r = r0 % 256, kb = r / 8, nb = r % 8;
        transpose_item((which ? p.ew3 : p.ew1) + (size_t)e * D * DE, D, DE, 64 * kb, 64 * nb, p.E13T + (size_t)e * 1024 * D, (nb >> 1) * 256 + which * 128 + (nb & 1) * 64, scr, lane); return; }
    it -= CI_E13;
    { const int e = it / 256, r = it % 256, kb = r / 32, nb = r % 32;
      transpose_item8(p.ew2 + (size_t)e * DE * D, DE, D, 64 * kb, 64 * nb, (unsigned char*)p.E2T + (size_t)e * D * DE, 64 * nb, scr, lane, W2SC); }
}
__device__ void ph_prologue(const Params& p, float* sm, const int wid0) {
    const int t = opaque_tid(wid0), w = t >> 6, lane = t & 63;
    if (blockIdx.x == 0 && t == 0) { p.QCTR[0] = 0; p.QCTR[32] = 0; }
    if (blockIdx.x == gridDim.x - 1) {
        for (int i = t; i < 64 * 32; i += NT) { const float ang = (float)(i >> 5) * powf(10000.f, -(float)(i & 31) / 32.f); p.RT[2 * i] = cosf(ang); p.RT[2 * i + 1] = sinf(ang); }
    }
    if (blockIdx.x < 192) {
        for (int i = t; i < 3 * D; i += NT) { const int r = i / D, k = i % D; sm[i] = siluf(r < 2 ? p.c[r * D + k] : p.c_ctx[k]); }
        __syncthreads();
        for (int item = blockIdx.x; item < 192; item += gridDim.x) adaln_item(p, sm, item, wid0);
    }
    __syncthreads();
    float* scr = sm + w * (64 * 65);
    for (int it = blockIdx.x * 8 + w; it < CI_TOTAL; it += gridDim.x * 8) convert_item(p, it, scr, lane);
}

__device__ void ph_norm1(const Params& p, const int wid0) {
    const int t = opaque_tid(wid0), w = t >> 6, lane = t & 63;
    for (int row = blockIdx.x * 8 + w; row < NROW; row += gridDim.x * 8) {
        const float* src; int mr;
        if (row < NLAT) { src = p.x + (size_t)row * D; mr = row / SEQ; } else { src = p.ctx + (size_t)(row - NLAT) * D; mr = 2; }
        const float* m = p.mod + (size_t)mr * 6 * D;
        float4 v[8]; float ss = 0.f;
#pragma unroll
        for (int j = 0; j < 8; ++j) { v[j] = *(const float4*)(src + 256 * j + 4 * lane); ss += v[j].x * v[j].x + v[j].y * v[j].y + v[j].z * v[j].z + v[j].w * v[j].w; }
        ss = wave_sum(ss);
        const float rs = rsqrtf(ss * (1.f / D) + 1e-6f);
#pragma unroll
        for (int j = 0; j < 8; ++j) {
            const int col = 256 * j + 4 * lane;
            const float4 g = *(const float4*)(p.norm1_g + col), sh = *(const float4*)(m + col), sc = *(const float4*)(m + D + col);
            u32x2 pk;
            pk.x = cvt_pk_bf16(v[j].x * rs * g.x * (1.f + sc.x) + sh.x, v[j].y * rs * g.y * (1.f + sc.y) + sh.y);
            pk.y = cvt_pk_bf16(v[j].z * rs * g.z * (1.f + sc.z) + sh.z, v[j].w * rs * g.w * (1.f + sc.w) + sh.w);
            *(u32x2*)(p.H + (size_t)row * D + col) = pk;
        }
    }
}

namespace g8 {
constexpr int BM = 256, BK = 64, HALF = 128, HTB = HALF * BK * 2;
__device__ __forceinline__ int lds_byte(int r, int c) { const int st = (r >> 4) * 2 + (c >> 5), rr = r & 15, cc = c & 31, ob = rr * 64 + cc * 2; return st * 1024 + (ob ^ (((ob >> 9) & 1) << 5)); }
__device__ __forceinline__ void stage_rc(int b, int& R, int& C) { const int st = b / 1024, sb = b % 1024, swz = sb ^ (((sb >> 9) & 1) << 5); R = (st >> 1) * 16 + swz / 64; C = (st & 1) * 32 + (swz % 64) / 2; }
__device__ __forceinline__ int perm32(int rho) { const int n = rho >> 4, i = rho & 15; return 8 * (i >> 2) + 4 * n + (i & 3); }

struct Unit { const char* A; const int* rows; int row0; const char* Bt; int orow, pn, aux; int nv = 256; };

__device__ __forceinline__ bool work_id(int i, int G, int c, int nwg, int& wgid) {
    const long L = (long)i * G + c; if (L >= nwg) return false;
    const int l = (int)L, q = nwg / 8, r = nwg % 8, xcd = l % 8, off = l / 8;
    wgid = (xcd < r ? xcd * (q + 1) : r * (q + 1) + (xcd - r) * q) + off; return true;
}

__device__ __forceinline__ i32x8 cat8(bf16x8 a, bf16x8 b) { const i32x4 x = __builtin_bit_cast(i32x4, a), y = __builtin_bit_cast(i32x4, b); return __builtin_shufflevector(x, y, 0, 1, 2, 3, 4, 5, 6, 7); }
template <class Epi, class Sched, bool F8 = false>
__device__ __forceinline__ void gemm_phase(LAS unsigned char* lds, const int K, const Sched& S, const Epi& E, const int wid0, const int kloop = 0) {
    const int tid_ = wid0 * 64 + fresh_lane_id();
    const int tid = tid_, wid = __builtin_amdgcn_readfirstlane(tid >> 6), lane = tid & 63, wr = wid >> 2, wc = wid & 3, fr = lane & 15, fq = lane >> 4;
    const int nt = (kloop ? kloop : K) / BK;
    int sR[2]; unsigned sC2[2], voffB[2], voffB1[2];
#pragma unroll
    for (int i = 0; i < 2; ++i) { int R, C; stage_rc(tid * 16 + i * 8192, R, C);
        const int Rb = Epi::PERM == 3 ? (64 * (R >> 5) + 16 * ((R & 15) >> 2) + 4 * ((R >> 4) & 1) + (R & 3)) : (Epi::PERM == 1 ? ((R & ~31) + perm32(R & 31)) : R);
        sR[i] = R; sC2[i] = (unsigned)C * 2u; voffB[i] = (unsigned)(Rb * K + C) * 2u; voffB1[i] = Epi::PERM == 3 ? (unsigned)((Rb + 8) * K + C) * 2u : voffB[i]; }
    const size_t kstep = (size_t)(BK * 2);
    const size_t hstep = (size_t)HALF * K * 2;
    const size_t hB1 = Epi::PERM == 3 ? 0 : hstep;
    const unsigned ldsw = (unsigned)wid * 1024u;
    const int aoff = lds_byte(wr * 64 + fr, fq * 8), boff = lds_byte(wc * 32 + fr, fq * 8);
#define G8_SA(b, h) (((b) * 2 + (h)) * g8::HTB)
#define G8_SB(b, h) ((4 + (b) * 2 + (h)) * g8::HTB)
#define G8_STAGE(bufoff, gbase, v0, v1) do { \
        __builtin_amdgcn_global_load_lds((const unsigned*)((const char*)(gbase) + (v0)), (LAS unsigned*)(lds + (bufoff) + ldsw), 16, 0, 0); \
        __builtin_amdgcn_global_load_lds((const unsigned*)((const char*)(gbase) + (v1)), (LAS unsigned*)(lds + (bufoff) + ldsw + 8192), 16, 0, 0); } while (0)
#define G8_LDA(dst, b, h) do { _Pragma("unroll") for (int m = 0; m < 4; ++m) _Pragma("unroll") for (int k = 0; k < 2; ++k) dst[m][k] = *(const LAS bf16x8*)(lds + G8_SA(b, h) + aoff + m * 2048 + k * 1024); } while (0)
#define G8_LDB(dst, b, h) do { _Pragma("unroll") for (int n = 0; n < 2; ++n) _Pragma("unroll") for (int k = 0; k < 2; ++k) dst[n][k] = *(const LAS bf16x8*)(lds + G8_SB(b, h) + boff + n * 2048 + k * 1024); } while (0)
#define G8_MMA(ai, bj, At, Bt) do { __builtin_amdgcn_s_setprio(1); \
        if constexpr (F8) { _Pragma("unroll") for (int m = 0; m < 4; ++m) _Pragma("unroll") for (int n = 0; n < 2; ++n) \
            acc[ai][bj][m][n] = __builtin_amdgcn_mfma_scale_f32_16x16x128_f8f6f4(cat8(Bt[n][0], Bt[n][1]), cat8(At[m][0], At[m][1]), acc[ai][bj][m][n], 0, 0, 0, 0, 0, 0); } \
        else { _Pragma("unroll") for (int m = 0; m < 4; ++m) _Pragma("unroll") for (int n = 0; n < 2; ++n) _Pragma("unroll") for (int k = 0; k < 2; ++k) \
            acc[ai][bj][m][n] = __builtin_amdgcn_mfma_f32_16x16x32_bf16(Bt[n][k], At[m][k], acc[ai][bj][m][n], 0, 0, 0); } \
        __builtin_amdgcn_s_setprio(0); } while (0)
#define G8_WAIT_V(n) asm volatile("s_waitcnt vmcnt(" #n ")" ::: "memory")
#define G8_WAIT_L(n) asm volatile("s_waitcnt lgkmcnt(" #n ")" ::: "memory")
#define G8_BAR __builtin_amdgcn_s_barrier()
#define G8_SCHED __builtin_amdgcn_sched_barrier(0)
    Unit cur, nxt; int ui = 0;
    if (!S.next(0, cur)) return;
    f32x4 acc[2][2][4][2];
#pragma unroll
    for (int a = 0; a < 2; ++a)
#pragma unroll
        for (int b = 0; b < 2; ++b)
#pragma unroll
            for (int m = 0; m < 4; ++m)
#pragma unroll
                for (int n = 0; n < 2; ++n) acc[a][b][m][n] = (f32x4){0.f, 0.f, 0.f, 0.f};
    bf16x8 At[4][2], B0[2][2], B1[2][2];
    unsigned vA00, vA01, vA10, vA11, nA00, nA01, nA10, nA11;
#define G8_MKOFF(u, o00, o01, o10, o11) do { \
        int r00, r01, r10, r11; \
        if ((u).rows) { r00 = (u).rows[sR[0]]; r01 = (u).rows[sR[1]]; r10 = (u).rows[128 + sR[0]]; r11 = (u).rows[128 + sR[1]]; } \
        else { r00 = (u).row0 + sR[0]; r01 = (u).row0 + sR[1]; r10 = (u).row0 + 128 + sR[0]; r11 = (u).row0 + 128 + sR[1]; } \
        o00 = (unsigned)r00 * (unsigned)(K * 2) + sC2[0]; o01 = (unsigned)r01 * (unsigned)(K * 2) + sC2[1]; \
        o10 = (unsigned)r10 * (unsigned)(K * 2) + sC2[0]; o11 = (unsigned)r11 * (unsigned)(K * 2) + sC2[1]; } while (0)
    G8_MKOFF(cur, vA00, vA01, vA10, vA11);
    const char* cA = cur.A; const char* cB = cur.Bt;
    G8_STAGE(G8_SB(0, 0), cB, voffB[0], voffB[1]); G8_STAGE(G8_SA(0, 0), cA, vA00, vA01); G8_STAGE(G8_SB(0, 1), cB + hB1, voffB1[0], voffB1[1]); G8_STAGE(G8_SA(0, 1), cA, vA10, vA11);
    if (wr == 1) G8_BAR;
    G8_WAIT_V(4); G8_BAR;
    G8_STAGE(G8_SB(1, 0), cB + kstep, voffB[0], voffB[1]); G8_STAGE(G8_SA(1, 0), cA + kstep, vA00, vA01); G8_STAGE(G8_SB(1, 1), cB + hB1 + kstep, voffB1[0], voffB1[1]);
    G8_WAIT_V(6); G8_BAR;
    for (;;) {
        const bool h1 = cur.nv > 128;
        const bool has_next = S.next(ui + 1, nxt);
        const char* nA = has_next ? nxt.A : cA; const char* nB = has_next ? nxt.Bt : cB;
        if (has_next) G8_MKOFF(nxt, nA00, nA01, nA10, nA11); else { nA00 = vA00; nA01 = vA01; nA10 = vA10; nA11 = vA11; }
#pragma nounroll
        for (int t = 0; t < nt; t += 2) {
            const bool last = (t == nt - 2);
            const char* a1 = cA + (size_t)(t + 1) * kstep;
            G8_LDB(B0, 0, 0); G8_SCHED; G8_LDA(At, 0, 0); G8_STAGE(G8_SA(1, 1), a1, vA10, vA11);
            G8_WAIT_L(8); G8_BAR; G8_WAIT_L(0); G8_MMA(0, 0, At, B0); G8_BAR; G8_SCHED;
            if (last) { vA00 = nA00; vA01 = nA01; vA10 = nA10; vA11 = nA11; }
            const char* a2 = last ? nA : cA + (size_t)(t + 2) * kstep; const char* b2 = last ? nB : cB + (size_t)(t + 2) * kstep;
            const char* a3 = a2 + kstep; const char* b3 = b2 + kstep;
            G8_LDB(B1, 0, 1); G8_STAGE(G8_SB(0, 0), b2, voffB[0], voffB[1]);
            G8_BAR; G8_WAIT_L(0); G8_MMA(0, 1, At, B1); G8_BAR;
            G8_LDA(At, 0, 1); G8_STAGE(G8_SA(0, 0), a2, vA00, vA01);
            G8_BAR; G8_WAIT_L(0); if (h1) G8_MMA(1, 0, At, B0); G8_BAR; G8_SCHED;
            G8_STAGE(G8_SB(0, 1), b2 + hB1, voffB1[0], voffB1[1]);
            G8_WAIT_V(6); G8_BAR; if (h1) G8_MMA(1, 1, At, B1); G8_BAR;
            G8_LDB(B0, 1, 0); G8_SCHED; G8_LDA(At, 1, 0); G8_STAGE(G8_SA(0, 1), a2, vA10, vA11);
            G8_WAIT_L(8); G8_BAR; G8_WAIT_L(0); G8_MMA(0, 0, At, B0); G8_BAR; G8_SCHED;
            G8_LDB(B1, 1, 1); G8_STAGE(G8_SB(1, 0), b3, voffB[0], voffB[1]);
            G8_BAR; G8_WAIT_L(0); G8_MMA(0, 1, At, B1); G8_BAR;
            G8_LDA(At, 1, 1); G8_STAGE(G8_SA(1, 0), a3, vA00, vA01);
            G8_BAR; G8_WAIT_L(0); if (h1) G8_MMA(1, 0, At, B0); G8_BAR; G8_SCHED;
            G8_STAGE(G8_SB(1, 1), b3 + hB1, voffB1[0], voffB1[1]);
            G8_WAIT_V(6); G8_BAR; if (h1) G8_MMA(1, 1, At, B1); G8_BAR;
        }
        E(acc, cur, wr, wc, fr, fq);
        if (!has_next) break;
#pragma unroll
        for (int a = 0; a < 2; ++a)
#pragma unroll
            for (int b = 0; b < 2; ++b)
#pragma unroll
                for (int m = 0; m < 4; ++m)
#pragma unroll
                    for (int n = 0; n < 2; ++n) acc[a][b][m][n] = (f32x4){0.f, 0.f, 0.f, 0.f};
        cur = nxt; cA = nA; cB = nB; ++ui;
    }
    G8_WAIT_V(0);
    if (wr == 0) G8_BAR;
    G8_BAR;
}
}

struct EpiInproj {
    static constexpr int PERM = 1;
    bf16_t* P;
    __device__ __forceinline__ void operator()(const f32x4 (&acc)[2][2][4][2], const g8::Unit& u, int wr, int wc, int fr, int fq) const {
#pragma unroll
        for (int ai = 0; ai < 2; ++ai)
#pragma unroll
            for (int m = 0; m < 4; ++m) { bf16_t* rowp = P + (size_t)(u.orow + ai * 128 + wr * 64 + m * 16 + fr) * PLD + u.pn * 256 + wc * 32 + 8 * fq;
#pragma unroll
                for (int bj = 0; bj < 2; ++bj) { const f32x4 v0 = acc[ai][bj][m][0], v1 = acc[ai][bj][m][1];
                    u32x4 w; w.x = cvt_pk_bf16(v0[0], v0[1]); w.y = cvt_pk_bf16(v0[2], v0[3]); w.z = cvt_pk_bf16(v1[0], v1[1]); w.w = cvt_pk_bf16(v1[2], v1[3]);
                    *(u32x4*)(rowp + bj * 128) = w; } }
    }
};
struct EpiInprojSplit {
    static constexpr int PERM = 0;
    float* PS; float* DDS;
    __device__ __forceinline__ void operator()(const f32x4 (&acc)[2][2][4][2], const g8::Unit& u, int wr, int wc, int fr, int fq) const {
        if (u.pn == PLD / 256) {
            if (wc == 0) {
#pragma unroll
                for (int ai = 0; ai < 2; ++ai)
#pragma unroll
                    for (int m = 0; m < 4; ++m) { float* rowp = DDS + (size_t)u.aux * DD_SLAB + (size_t)(u.orow + ai * 128 + wr * 64 + m * 16 + fr) * 32 + 4 * fq;
                        *(f32x4*)(rowp) = acc[ai][0][m][0]; *(f32x4*)(rowp + 16) = acc[ai][0][m][1]; }
            }
            return;
        }
        const int ccol = (u.pn < 12 ? u.pn - 4 : u.pn - 6) * 256;
#pragma unroll
        for (int ai = 0; ai < 2; ++ai)
#pragma unroll
            for (int m = 0; m < 4; ++m) { float* rowp = PS + (size_t)u.aux * PS_SLAB + (size_t)(u.orow - NLAT + ai * 128 + wr * 64 + m * 16 + fr) * PSLD + ccol + wc * 32 + 4 * fq;
#pragma unroll
                for (int bj = 0; bj < 2; ++bj)
#pragma unroll
                    for (int n = 0; n < 2; ++n) *(f32x4*)(rowp + bj * 128 + n * 16) = acc[ai][bj][m][n]; }
    }
};
struct SchedInprojSplit {
    const char* A; const char* Bt; int G, c;
    static constexpr int NITEM = 4 * (28 + 34);
    __device__ __forceinline__ bool next(int i, g8::Unit& u) const {
        int it; if (!g8::work_id(i, G, c, NITEM, it)) return false;
        int pm, pn; const int ks = it & 3, q = it >> 2;
        if (q < 28) { const int j = q % 14; pm = 32 + q / 14; pn = j < 8 ? 4 + j : (j < 10 ? 6 + j : 6 + j); }
        else { pm = q - 28; pn = PLD / 256; }
        u.A = A + ks * 1024; u.rows = nullptr; u.row0 = pm * 256; u.Bt = Bt + (size_t)pn * 256 * D * 2 + ks * 1024; u.orow = pm * 256; u.pn = pn; u.aux = ks; return true;
    }
};
struct EpiOutproj {
    static constexpr int PERM = 0;
    const float* x; const float* mod; float* X1;
    __device__ __forceinline__ void operator()(const f32x4 (&acc)[2][2][4][2], const g8::Unit& u, int wr, int wc, int fr, int fq) const {
        const int b = u.orow / SEQ; const int col0 = u.pn * 256 + wc * 32 + 4 * fq;
        f32x4 gv[2][2];
#pragma unroll
        for (int bj = 0; bj < 2; ++bj)
#pragma unroll
            for (int n = 0; n < 2; ++n) gv[bj][n] = *(const f32x4*)(mod + (size_t)b * 6 * D + 2 * D + col0 + bj * 128 + n * 16);
#pragma unroll
        for (int ai = 0; ai < 2; ++ai)
#pragma unroll
            for (int m = 0; m < 4; ++m) { const size_t ro = (size_t)(u.orow + ai * 128 + wr * 64 + m * 16 + fr) * D + col0;
#pragma unroll
                for (int bj = 0; bj < 2; ++bj)
#pragma unroll
                    for (int n = 0; n < 2; ++n) { const f32x4 xv = *(const f32x4*)(x + ro + bj * 128 + n * 16);
                        *(f32x4*)(X1 + ro + bj * 128 + n * 16) = xv + gv[bj][n] * acc[ai][bj][m][n]; } }
    }
};
struct EpiUp {
    static constexpr int PERM = 1;
    unsigned char* HB; unsigned char* SHH;
    __device__ __forceinline__ void operator()(const f32x4 (&acc)[2][2][4][2], const g8::Unit& u, int wr, int wc, int fr, int fq) const {
        unsigned char* O = u.aux ? SHH : HB;
#pragma unroll
        for (int ai = 0; ai < 2; ++ai)
#pragma unroll
            for (int m = 0; m < 4; ++m) {
                if (ai * 128 + wr * 64 + m * 16 + fr >= u.nv) continue;
                f32x4 h0, h1;
#pragma unroll
                for (int j = 0; j < 4; ++j) { const float a0 = acc[ai][0][m][0][j], a1 = acc[ai][0][m][1][j];
                    h0[j] = a0 * __builtin_amdgcn_rcpf(1.f + __builtin_amdgcn_exp2f(-1.4426950408889634f * a0)) * acc[ai][1][m][0][j];
                    h1[j] = a1 * __builtin_amdgcn_rcpf(1.f + __builtin_amdgcn_exp2f(-1.4426950408889634f * a1)) * acc[ai][1][m][1][j]; }
                u32x2 w; int pk = 0;
                pk = __builtin_amdgcn_cvt_pk_fp8_f32(h0[0] * HSC, h0[1] * HSC, pk, false); pk = __builtin_amdgcn_cvt_pk_fp8_f32(h0[2] * HSC, h0[3] * HSC, pk, true); w.x = (unsigned)pk;
                pk = __builtin_amdgcn_cvt_pk_fp8_f32(h1[0] * HSC, h1[1] * HSC, pk, false); pk = __builtin_amdgcn_cvt_pk_fp8_f32(h1[2] * HSC, h1[3] * HSC, pk, true); w.y = (unsigned)pk;
                *(u32x2*)(O + (size_t)(u.orow + ai * 128 + wr * 64 + m * 16 + fr) * DE + u.pn * 128 + wc * 32 + 8 * fq) = w;
            }
    }
};
struct EpiDown {
    static constexpr int PERM = 3;
    unsigned char* Y; unsigned char* YS;
    __device__ __forceinline__ void operator()(const f32x4 (&acc)[2][2][4][2], const g8::Unit& u, int wr, int wc, int fr, int fq) const {
        unsigned char* O = u.aux ? YS : Y;
#pragma unroll
        for (int ai = 0; ai < 2; ++ai)
#pragma unroll
            for (int m = 0; m < 4; ++m) { if (ai * 128 + wr * 64 + m * 16 + fr >= u.nv) continue;
                u32x4 w;
#pragma unroll
                for (int q = 0; q < 4; ++q) { const f32x4 v = acc[ai][q >> 1][m][q & 1] * (1.f / (W2SC * HSC)); int pk = 0;
                    pk = __builtin_amdgcn_cvt_pk_fp8_f32(v[0], v[1], pk, false); pk = __builtin_amdgcn_cvt_pk_fp8_f32(v[2], v[3], pk, true); w[q] = (unsigned)pk; }
                *(u32x4*)(O + (size_t)(u.orow + ai * 128 + wr * 64 + m * 16 + fr) * YLD8 + u.pn * 256 + wc * 64 + 16 * fq) = w; }
    }
};
struct SchedDense {
    const char* A; const char* Bt; int K, nM, nN, G, c;
    __device__ __forceinline__ bool next(int i, g8::Unit& u) const {
        int wgid; if (!g8::work_id(i, G, c, nM * nN, wgid)) return false;
        const int nig = 8 * nN, gid = wgid / nig, fm = gid * 8, gsz = (nM - fm) < 8 ? (nM - fm) : 8;
        const int pm = fm + ((wgid % nig) % gsz), pn = (wgid % nig) / gsz;
        u.A = A; u.rows = nullptr; u.row0 = pm * 256; u.Bt = Bt + (size_t)pn * 256 * K * 2; u.orow = pm * 256; u.pn = pn; u.aux = 0; return true;
    }
};
struct SchedUp {
    const int* tp; const char* H2; const int* LIST; const char* E13T; const char* S13T; int G, c;
    __device__ __forceinline__ bool next(int i, g8::Unit& u) const {
        const int T = tp[NE]; int wgid; if (!g8::work_id(i, G, c, 4 * T + 128, wgid)) return false;
        u.A = H2;
        if (wgid < 4 * T) {
            int e = 0;
#pragma unroll
            for (int s = 32; s > 0; s >>= 1) if (4 * tp[e + s] <= wgid) e += s;
            const int tc = tp[e + 1] - tp[e], li = wgid - 4 * tp[e], nt = li / tc, mt = li % tc, r0 = (tp[e] + mt) * 256;
            u.rows = LIST + r0; u.row0 = 0; u.Bt = E13T + ((size_t)e * 1024 + nt * 256) * D * 2; u.orow = r0; u.pn = nt; u.aux = 0; u.nv = min(256, tp[80 + e] - mt * 256);
        } else {
            const int s = wgid - 4 * T, pn = s / 32, pm = s % 32;
            u.rows = nullptr; u.row0 = pm * 256; u.Bt = S13T + (size_t)pn * 256 * D * 2; u.orow = pm * 256; u.pn = pn; u.aux = 1; u.nv = 256;
        }
        return true;
    }
};
struct SchedDown {
    const int* tp; const char* HB; const char* E2T; const char* SHH; const char* S2T; int G, c;
    __device__ __forceinline__ bool next(int i, g8::Unit& u) const {
        const int T = tp[NE]; int wgid; if (!g8::work_id(i, G, c, 8 * T + 256, wgid)) return false;
        u.rows = nullptr;
        if (wgid < 8 * T) {
            int e = 0;
#pragma unroll
            for (int s = 32; s > 0; s >>= 1) if (8 * tp[e + s] <= wgid) e += s;
            const int tc = tp[e + 1] - tp[e], li = wgid - 8 * tp[e], nt = li / tc, mt = li % tc, r0 = (tp[e] + mt) * 256;
            u.A = HB; u.row0 = r0; u.Bt = E2T + ((size_t)e * D + nt * 256) * DE; u.orow = r0; u.pn = nt; u.aux = 0; u.nv = min(256, tp[80 + e] - mt * 256);
        } else {
            const int s = wgid - 8 * T, pn = s / 32, pm = s % 32;
            u.A = SHH; u.row0 = pm * 256; u.Bt = S2T + (size_t)pn * 256 * DE; u.orow = pm * 256; u.pn = pn; u.aux = 1; u.nv = 256;
        }
        return true;
    }
};
__device__ __forceinline__ void moe_tables(const Params& p, int* tp, const int wid0) {
    __syncthreads();
    if (wid0 == 0 && xb_lane_id() == 0) { int tt = 0; for (int e = 0; e < NE; ++e) { const int cn = p.CNT[e]; tp[e] = tt; tp[80 + e] = cn; tt += (cn + 255) / 256; } tp[NE] = tt; }
    __syncthreads();
}

constexpr int NTILE = 136;
__device__ void ph_naprep(const Params& p, const int wid0, const int ubeg, const int uend, const int ustep) {
    const int t = opaque_tid(wid0), w = t >> 6, lane = t & 63, kk = lane >> 4, pc = lane & 15;
    for (int u = ubeg; u < uend; u += ustep) {
        const int b = u / NTILE, T = u % NTILE; const bool lat = T < 128;
        const int row0 = lat ? (b * SEQ + 32 * T) : (NLAT + b * CTXL + 32 * (T - 128));
#pragma unroll 2
        for (int it = w; it < 128; it += 8) {
            const int which = it & 1, hh = (it >> 1) & 7, tt = 4 * (it >> 4) + kk;
            if (which == 0 && !lat) continue;
            float4 v0, v1;
            if (lat) { const u32x4 r8 = *(const u32x4*)(p.P + (size_t)(row0 + tt) * PLD + which * 1024 + hh * 128 + 8 * pc);
                v0 = make_float4(bf2f(r8.x & 0xffffu), bf2f(r8.x >> 16), bf2f(r8.y & 0xffffu), bf2f(r8.y >> 16)); v1 = make_float4(bf2f(r8.z & 0xffffu), bf2f(r8.z >> 16), bf2f(r8.w & 0xffffu), bf2f(r8.w >> 16)); }
            else {
                const float* src = p.PS + (size_t)(row0 - NLAT + tt) * PSLD + hh * 128 + 8 * pc;
                v0 = *(const float4*)src; v1 = *(const float4*)(src + 4);
#pragma unroll
                for (int s = 1; s < 4; ++s) { const float4 a0 = *(const float4*)(src + s * PS_SLAB), a1 = *(const float4*)(src + s * PS_SLAB + 4);
                    v0.x += a0.x; v0.y += a0.y; v0.z += a0.z; v0.w += a0.w; v1.x += a1.x; v1.y += a1.y; v1.z += a1.z; v1.w += a1.w; }
            }
            float ss = v0.x * v0.x + v0.y * v0.y + v0.z * v0.z + v0.w * v0.w + v1.x * v1.x + v1.y * v1.y + v1.z * v1.z + v1.w * v1.w;
            ss += __shfl_xor(ss, 1); ss += __shfl_xor(ss, 2); ss += __shfl_xor(ss, 4); ss += __shfl_xor(ss, 8);
            const float* gp = (which ? p.k_norm_g : p.q_norm_g) + 8 * pc;
            const float4 g0 = *(const float4*)gp, g1 = *(const float4*)(gp + 4);
            const float r = rsqrtf(ss * (1.f / 128.f) + 1e-6f) * (which ? 1.f : 0.08838834764831845f * 1.4426950408889634f);
            u32x4 o;
            o.x = cvt_pk_bf16(v0.x * r * g0.x, v0.y * r * g0.y); o.y = cvt_pk_bf16(v0.z * r * g0.z, v0.w * r * g0.w);
            o.z = cvt_pk_bf16(v1.x * r * g1.x, v1.y * r * g1.y); o.w = cvt_pk_bf16(v1.z * r * g1.z, v1.w * r * g1.w);
            if (which) *(u32x4*)(p.NKf + (((size_t)((b * 8 + hh) * NTILE + T) * 8 + (pc >> 1)) * 64 + tt + 32 * (pc & 1)) * 8) = o;
            else *(u32x4*)(p.NQb + (size_t)(row0 + tt) * 1024 + hh * 128 + 8 * pc) = o;
        }
        if (lat) {
            const int col = 2 * t, hh = col >> 7, dv = col & 127;
            unsigned wv[32];
#pragma unroll
            for (int s = 0; s < 32; ++s) wv[s] = *(const unsigned*)(p.P + (size_t)(row0 + s) * PLD + 2048 + col);
            unsigned pk0[16], pk1[16];
#pragma unroll
            for (int s2 = 0; s2 < 16; ++s2) { pk0[s2] = (wv[2 * s2] & 0xffffu) | (wv[2 * s2 + 1] << 16); pk1[s2] = (wv[2 * s2] >> 16) | (wv[2 * s2 + 1] & 0xffff0000u); }
            bf16_t* o = p.VTf + ((((size_t)((b * 8 + hh) * NTILE + T) * 4 + (dv >> 5)) * 2) * 64 + (dv & 31)) * 8;
#pragma unroll
            for (int g2 = 0; g2 < 2; ++g2) {
                *(u32x4*)(o + (g2 * 64) * 8) = (u32x4){pk0[8 * g2], pk0[8 * g2 + 1], pk0[8 * g2 + 4], pk0[8 * g2 + 5]};
                *(u32x4*)(o + (g2 * 64 + 32) * 8) = (u32x4){pk0[8 * g2 + 2], pk0[8 * g2 + 3], pk0[8 * g2 + 6], pk0[8 * g2 + 7]};
                *(u32x4*)(o + (g2 * 64 + 1) * 8) = (u32x4){pk1[8 * g2], pk1[8 * g2 + 1], pk1[8 * g2 + 4], pk1[8 * g2 + 5]};
                *(u32x4*)(o + (g2 * 64 + 33) * 8) = (u32x4){pk1[8 * g2 + 2], pk1[8 * g2 + 3], pk1[8 * g2 + 6], pk1[8 * g2 + 7]};
            }
        } else {
#pragma unroll 1
        for (int i = 0; i < 2; ++i) {
            const int col = t + 512 * i, hh = col >> 7, dv = col & 127;
            unsigned pk[16];
#pragma unroll
            for (int s2 = 0; s2 < 16; ++s2) {
                const float* s0 = p.PS + (size_t)(row0 - NLAT + 2 * s2) * PSLD + 1024 + col;
                const float x0 = s0[0] + s0[PS_SLAB] + s0[2 * PS_SLAB] + s0[3 * PS_SLAB], x1 = s0[PSLD] + s0[PS_SLAB + PSLD] + s0[2 * PS_SLAB + PSLD] + s0[3 * PS_SLAB + PSLD];
                pk[s2] = cvt_pk_bf16(x0, x1);
            }
            bf16_t* o = p.VTf + ((((size_t)((b * 8 + hh) * NTILE + T) * 4 + (dv >> 5)) * 2) * 64 + (dv & 31)) * 8;
#pragma unroll
            for (int g2 = 0; g2 < 2; ++g2) {
                *(u32x4*)(o + (g2 * 64) * 8) = (u32x4){pk[8 * g2], pk[8 * g2 + 1], pk[8 * g2 + 4], pk[8 * g2 + 5]};
                *(u32x4*)(o + (g2 * 64 + 32) * 8) = (u32x4){pk[8 * g2 + 2], pk[8 * g2 + 3], pk[8 * g2 + 6], pk[8 * g2 + 7]};
            }
        }
        }
    }
}

__device__ __forceinline__ void attn_tile(const LAS unsigned char* sb, const float* bt0, const bf16x8 (&qf)[8], f32x16& o0, f32x16& o1, f32x16& o2, f32x16& o3, float& m, float& l,
                                          bool loc, int half, int dr, int c, int cs, int hi) {
    bf16x8 kc[8], va[8];
#pragma unroll
    for (int ks = 0; ks < 8; ++ks) kc[ks] = *(const LAS bf16x8*)(sb + ks * 1024);
#pragma unroll
    for (int q = 0; q < 8; ++q) va[q] = *(const LAS bf16x8*)(sb + 8192 + q * 1024);
    f32x16 s;
#pragma unroll
    for (int e = 0; e < 16; ++e) s[e] = 0.f;
#pragma unroll
    for (int ks = 0; ks < 8; ++ks) s = __builtin_amdgcn_mfma_f32_32x32x16_bf16(kc[ks], qf[ks], s, 0, 0, 0);
    if (loc) {
        int rel0 = 32 * half + 4 * hi - cs; asm volatile("" : "+v"(rel0));
        const float* bt = bt0 + dr * 31 + cs - c + 15;
        float bz[16];
#pragma unroll
        for (int e = 0; e < 16; ++e) bz[e] = bt[rel0 + (e & 3) + 8 * (e >> 2)];
#pragma unroll
        for (int e = 0; e < 16; ++e) asm volatile("" : "+v"(bz[e]));
#pragma unroll
        for (int e = 0; e < 16; ++e) {
            const int rel = rel0 + (e & 3) + 8 * (e >> 2);
            s[e] = ((unsigned)rel < 16u) ? (s[e] + bz[e]) : -INFINITY;
        }
    }
    float mt = s[0];
#pragma unroll
    for (int e = 1; e < 16; ++e) mt = fmaxf(mt, s[e]);
    mt = fmaxf(mt, __shfl_xor(mt, 32));
    if (__any(mt > m)) {
        const float mn = fmaxf(m, mt);
        const float alpha = __builtin_amdgcn_exp2f(m - mn);
        m = mn; l *= alpha;
#pragma unroll
        for (int e = 0; e < 16; ++e) { o0[e] *= alpha; o1[e] *= alpha; o2[e] *= alpha; o3[e] *= alpha; }
    }
    float ps = 0.f;
#pragma unroll
    for (int e = 0; e < 16; ++e) { s[e] = __builtin_amdgcn_exp2f(s[e] - m); ps += s[e]; }
    l += ps;
    bf16x8 pb[2];
#pragma unroll
    for (int s2 = 0; s2 < 2; ++s2) {
        const u32x4 cat = (u32x4){cvt_pk_bf16(s[8 * s2], s[8 * s2 + 1]), cvt_pk_bf16(s[8 * s2 + 2], s[8 * s2 + 3]), cvt_pk_bf16(s[8 * s2 + 4], s[8 * s2 + 5]), cvt_pk_bf16(s[8 * s2 + 6], s[8 * s2 + 7])};
        pb[s2] = __builtin_bit_cast(bf16x8, cat);
    }
#pragma unroll
    for (int s2 = 0; s2 < 2; ++s2) {
        o0 = __builtin_amdgcn_mfma_f32_32x32x16_bf16(va[0 + s2], pb[s2], o0, 0, 0, 0);
        o1 = __builtin_amdgcn_mfma_f32_32x32x16_bf16(va[2 + s2], pb[s2], o1, 0, 0, 0);
        o2 = __builtin_amdgcn_mfma_f32_32x32x16_bf16(va[4 + s2], pb[s2], o2, 0, 0, 0);
        o3 = __builtin_amdgcn_mfma_f32_32x32x16_bf16(va[6 + s2], pb[s2], o3, 0, 0, 0);
    }
}
__device__ __forceinline__ void glascan_wave(const Params& p, int unit, int dh, int lane, LAS unsigned char* ldsw);
__device__ void ph_attn(const Params& p, unsigned char* smb, const int wid0) {
    const int t = opaque_tid(wid0), lane = t & 63, l31 = lane & 31, hi = lane >> 5;
    const int w = __builtin_amdgcn_readfirstlane(t >> 6);
    LAS unsigned char* lds = (LAS unsigned char*)smb;
    for (int u0 = blockIdx.x; u0 < 256; u0 += gridDim.x) { const int unit = (((u0 & 7) + 8 * (u0 >> 7)) << 4) | ((u0 >> 3) & 15); glascan_wave(p, unit, w, lane, lds + w * 8192); }
    float* tab = (float*)(smb + 4 * 16384);
    for (int u0 = blockIdx.x; u0 < 256; u0 += gridDim.x) {
        const int u = (((u0 & 7) + 8 * (u0 >> 7)) << 4) | ((u0 >> 3) & 15);
        const int rg = u & 15, h = (u >> 4) & 7, b = u >> 7, bh8 = b * 8 + h;
        asm volatile("s_waitcnt vmcnt(0)" ::: "memory");
        __syncthreads();
        for (int i = t; i < 465; i += NT) tab[i] = p.na_rpb[h * 465 + i] * 1.4426950408889634f;
        const int r = 4 * rg + (w >> 1), qt = w & 1, c = 32 * qt + l31;
        const int rs = min(max(r - 4, 0), 56), cs = min(max(c - 8, 0), 48);
        const int Rlo = min(max(4 * rg - 4, 0), 56), Rhi = min(max(4 * rg - 1, 0), 56) + 7, nt = 8 + 2 * (Rhi - Rlo + 1);
        const int qrow = b * SEQ + r * 64 + c;
        bf16x8 qf[8];
#pragma unroll
        for (int ks = 0; ks < 8; ++ks) qf[ks] = *(const bf16x8*)(p.NQb + (size_t)qrow * 1024 + h * 128 + 16 * ks + 8 * hi);
#pragma unroll
        for (int ks = 0; ks < 8; ++ks) asm volatile("" : "+v"(qf[ks]));
        f32x16 o0, o1, o2, o3;
#pragma unroll
        for (int e = 0; e < 16; ++e) { o0[e] = 0.f; o1[e] = 0.f; o2[e] = 0.f; o3[e] = 0.f; }
        float m = -INFINITY, l = 0.f;
        const bf16_t* kg = p.NKf + ((size_t)bh8 * NTILE * 8 + w) * 512 + lane * 8;
        const bf16_t* vg = p.VTf + ((size_t)bh8 * NTILE * 8 + w) * 512 + lane * 8;
#define AT_T(i_) ((i_) < 8 ? (128 + (i_)) : (2 * Rlo + ((i_) - 8)))
#define AT_DMA(i_, st_) do { const int ii_ = (i_) < nt ? (i_) : nt - 1; const size_t to_ = (size_t)AT_T(ii_) * 4096; \
        __builtin_amdgcn_global_load_lds((const unsigned*)(kg + to_), (LAS unsigned*)(lds + (st_) * 16384 + w * 1024), 16, 0, 0); \
        __builtin_amdgcn_global_load_lds((const unsigned*)(vg + to_), (LAS unsigned*)(lds + (st_) * 16384 + 8192 + w * 1024), 16, 0, 0); } while (0)
        asm volatile("s_waitcnt vmcnt(0)" ::: "memory");
        __syncthreads();
        AT_DMA(0, 0); AT_DMA(1, 1); AT_DMA(2, 2);
        int st = 0;
#pragma unroll 1
        for (int i = 0; i < nt; ++i) {
            asm volatile("s_waitcnt vmcnt(4)" ::: "memory");
            __builtin_amdgcn_s_barrier();
            asm volatile("" ::: "memory");
            const int st2 = (st + 3) & 3;
            AT_DMA(i + 3, st2);
            const bool loc = i >= 8; const int R = Rlo + ((i - 8) >> 1), half = (i - 8) & 1;
            if (!loc || (unsigned)(R - rs) < 8u)
                attn_tile(lds + st * 16384 + lane * 16, tab, qf, o0, o1, o2, o3, m, l, loc, half, R - r + 7, c, cs, hi);
            st = (st + 1) & 3;
        }
#undef AT_T
#undef AT_DMA
        l += __shfl_xor(l, 32);
        const float inv = 1.f / l;
        bf16_t* orow = p.MIX + (size_t)qrow * D + h * 128 + 4 * hi;
#pragma unroll
        for (int g = 0; g < 4; ++g) {
            u32x2 pk;
            pk.x = cvt_pk_bf16(o0[4 * g] * inv, o0[4 * g + 1] * inv); pk.y = cvt_pk_bf16(o0[4 * g + 2] * inv, o0[4 * g + 3] * inv); *(u32x2*)(orow + 0 + 8 * g) = pk;
            pk.x = cvt_pk_bf16(o1[4 * g] * inv, o1[4 * g + 1] * inv); pk.y = cvt_pk_bf16(o1[4 * g + 2] * inv, o1[4 * g + 3] * inv); *(u32x2*)(orow + 32 + 8 * g) = pk;
            pk.x = cvt_pk_bf16(o2[4 * g] * inv, o2[4 * g + 1] * inv); pk.y = cvt_pk_bf16(o2[4 * g + 2] * inv, o2[4 * g + 3] * inv); *(u32x2*)(orow + 64 + 8 * g) = pk;
            pk.x = cvt_pk_bf16(o3[4 * g] * inv, o3[4 * g + 1] * inv); pk.y = cvt_pk_bf16(o3[4 * g + 2] * inv, o3[4 * g + 3] * inv); *(u32x2*)(orow + 96 + 8 * g) = pk;
        }
    }
    asm volatile("s_waitcnt vmcnt(0)" ::: "memory");
}

__device__ __forceinline__ float logsigf(float z) { return fminf(z, 0.f) - log1pf(expf(-fabsf(z))); }

__device__ __forceinline__ float fexp2(float x) { return __builtin_amdgcn_exp2f(x); }
__device__ __forceinline__ float logsig2_16(float z) { return (fminf(z, 0.f) * 1.4426950408889634f - __builtin_amdgcn_logf(1.f + fexp2(-fabsf(z) * 1.4426950408889634f))) * (1.f / 16.f); }

__device__ void ph_glaprep(const Params& p, float* sm, const int wid0, const int ubeg, const int uend, const int ustep) {
    const int t = opaque_tid(wid0), d2 = t & 63, tq = t >> 6, d = 2 * d2;
    float* qs = sm;
    float* ksm = sm + 8192;
    float* dds = sm + 16384;
    float* tot = sm + 16384 + 2048;
    for (int u = ubeg; u < uend; u += ustep) {
        const int bh = u / 68, c = u % 68, b = bh >> 2, h = bh & 3;
        const bool lat = c >= 4; const int j = c - 4;
        const int row0 = lat ? (b * SEQ + 64 * j) : (NLAT + b * CTXL + 64 * c);
        __syncthreads();
        {
            const int cq = t & 31, tr = t >> 5;
#pragma unroll
            for (int i = 0; i < 4; ++i) { const int tt = tr + 16 * i;
                if (lat) {
                    const u32x2 q4 = *(const u32x2*)(p.P + (size_t)(row0 + tt) * PLD + 3072 + h * 128 + 4 * cq), k4 = *(const u32x2*)(p.P + (size_t)(row0 + tt) * PLD + 3584 + h * 128 + 4 * cq);
                    *(float4*)(qs + tt * 128 + 4 * cq) = make_float4(bf2f(q4.x & 0xffffu), bf2f(q4.x >> 16), bf2f(q4.y & 0xffffu), bf2f(q4.y >> 16));
                    *(float4*)(ksm + tt * 128 + 4 * cq) = make_float4(bf2f(k4.x & 0xffffu), bf2f(k4.x >> 16), bf2f(k4.y & 0xffffu), bf2f(k4.y >> 16));
                } else {
                    const float* src = p.PS + (size_t)(row0 - NLAT + tt) * PSLD + 2048 + h * 128 + 4 * cq;
                    float4 kv = *(const float4*)src;
#pragma unroll
                    for (int s = 1; s < 4; ++s) { const float4 a0 = *(const float4*)(src + s * PS_SLAB); kv.x += a0.x; kv.y += a0.y; kv.z += a0.z; kv.w += a0.w; }
                    *(float4*)(qs + tt * 128 + 4 * cq) = make_float4(0.f, 0.f, 0.f, 0.f); *(float4*)(ksm + tt * 128 + 4 * cq) = kv;
                } }
            { const float* src = p.DDS + (size_t)row0 * 32 + 4 * t; float4 dv = *(const float4*)src;
#pragma unroll
              for (int s = 1; s < 4; ++s) { const float4 a0 = *(const float4*)(src + s * DD_SLAB); dv.x += a0.x; dv.y += a0.y; dv.z += a0.z; dv.w += a0.w; }
              *(float4*)(dds + 4 * t) = dv; }
        }
        __syncthreads();
        float gf0[8], gf1[8], gb0[8], gb1[8];
        {
            float uf0[16], uf1[16], ub0[16], ub1[16];
#pragma unroll
            for (int r = 0; r < 16; ++r) { const float2 a = *(const float2*)(p.up_f + r * 512 + h * 128 + d), bq = *(const float2*)(p.up_b + r * 512 + h * 128 + d); uf0[r] = a.x; uf1[r] = a.y; ub0[r] = bq.x; ub1[r] = bq.y; }
            const float2 bf = *(const float2*)(p.bias_f + h * 128 + d), bb = *(const float2*)(p.bias_b + h * 128 + d);
            float sf0 = 0.f, sf1 = 0.f, sb0 = 0.f, sb1 = 0.f;
#pragma unroll
            for (int i = 0; i < 8; ++i) {
                const float* dr = dds + (8 * tq + i) * 32; float zf0 = bf.x, zf1 = bf.y, zb0 = bb.x, zb1 = bb.y;
#pragma unroll
                for (int r = 0; r < 16; ++r) { const float x = dr[r], y = dr[16 + r]; zf0 += x * uf0[r]; zf1 += x * uf1[r]; zb0 += y * ub0[r]; zb1 += y * ub1[r]; }
                gf0[i] = logsig2_16(zf0); gf1[i] = logsig2_16(zf1); gb0[i] = logsig2_16(zb0); gb1[i] = logsig2_16(zb1);
                sf0 += gf0[i]; sf1 += gf1[i]; sb0 += gb0[i]; sb1 += gb1[i];
            }
            *(float2*)(tot + tq * 128 + d) = make_float2(sf0, sf1); *(float2*)(tot + (8 + tq) * 128 + d) = make_float2(sb0, sb1);
        }
        __syncthreads();
        float2 basef = make_float2(0.f, 0.f), baseb = basef, allf = basef, allb = basef;
#pragma unroll
        for (int q8 = 0; q8 < 8; ++q8) { const float2 a = *(const float2*)(tot + q8 * 128 + d), bq = *(const float2*)(tot + (8 + q8) * 128 + d);
            allf.x += a.x; allf.y += a.y; allb.x += bq.x; allb.y += bq.y;
            if (q8 < tq) { basef.x += a.x; basef.y += a.y; } if (q8 > tq) { baseb.x += bq.x; baseb.y += bq.y; } }
        { float r0 = basef.x, r1 = basef.y;
#pragma unroll
          for (int i = 0; i < 8; ++i) { r0 += gf0[i]; gf0[i] = r0; r1 += gf1[i]; gf1[i] = r1; }
          r0 = baseb.x; r1 = baseb.y;
#pragma unroll
          for (int i = 7; i >= 0; --i) { r0 += gb0[i]; gb0[i] = r0; r1 += gb1[i]; gb1[i] = r1; } }
        const int dd2 = d & 63, ii = dd2 & 31, partner = (dd2 < 32) ? (d + 32) : (d - 32);
        const float sgn = (dd2 < 32) ? -1.f : 1.f;
        unsigned khf0[4], khf1[4], khb0[4], khb1[4]; float pf0 = 0.f, pf1 = 0.f, pb0 = 0.f, pb1 = 0.f;
        const size_t tb = ((size_t)(bh * 64 + j) * 64) * 128;
#pragma unroll
        for (int i = 0; i < 8; ++i) {
            const int tt = 8 * tq + i;
            float2 qv = *(const float2*)(qs + tt * 128 + d), kv = *(const float2*)(ksm + tt * 128 + d);
            if (lat) {
                const int pos = (d < 64) ? j : tt;
                const float4 cssn = *(const float4*)(p.RT + (pos * 32 + ii) * 2);
                const float2 qp = *(const float2*)(qs + tt * 128 + partner), kp = *(const float2*)(ksm + tt * 128 + partner);
                qv.x = qv.x * cssn.x + sgn * qp.x * cssn.y; qv.y = qv.y * cssn.z + sgn * qp.y * cssn.w;
                kv.x = kv.x * cssn.x + sgn * kp.x * cssn.y; kv.y = kv.y * cssn.z + sgn * kp.y * cssn.w;
            }
            qv.x *= 0.08838834764831845f; qv.y *= 0.08838834764831845f;
            if (lat) {
                const float ef0 = fexp2(gf0[i]), ef1 = fexp2(gf1[i]), eb0 = fexp2(gb0[i]), eb1 = fexp2(gb1[i]);
                const float nf0 = fexp2(-gf0[i]), nf1 = fexp2(-gf1[i]), nb0 = fexp2(-gb0[i]), nb1 = fexp2(-gb1[i]);
                const size_t o = tb + (size_t)tt * 128 + d;
                *(unsigned*)(p.QF + o) = cvt_pk_bf16(qv.x * ef0, qv.y * ef1); *(unsigned*)(p.KF + o) = cvt_pk_bf16(kv.x * nf0, kv.y * nf1);
                *(unsigned*)(p.QB + o) = cvt_pk_bf16(qv.x * eb0, qv.y * eb1); *(unsigned*)(p.KB + o) = cvt_pk_bf16(kv.x * nb0, kv.y * nb1);
            }
            const float hf0 = kv.x * fexp2(allf.x - gf0[i]), hf1 = kv.y * fexp2(allf.y - gf1[i]), hb0 = kv.x * fexp2(allb.x - gb0[i]), hb1 = kv.y * fexp2(allb.y - gb1[i]);
            if (i & 1) { khf0[i >> 1] = cvt_pk_bf16(pf0, hf0); khf1[i >> 1] = cvt_pk_bf16(pf1, hf1); khb0[i >> 1] = cvt_pk_bf16(pb0, hb0); khb1[i >> 1] = cvt_pk_bf16(pb1, hb1); }
            else { pf0 = hf0; pf1 = hf1; pb0 = hb0; pb1 = hb1; }
        }
        {
            const size_t o = ((((size_t)(bh * 68 + c) * 8 + (d >> 4)) * 2 + (tq >> 2)) * 64 + (d & 15) + 16 * (tq & 3)) * 8;
            *(u32x4*)(p.KHF + o) = (u32x4){khf0[0], khf0[1], khf0[2], khf0[3]}; *(u32x4*)(p.KHF + o + 8) = (u32x4){khf1[0], khf1[1], khf1[2], khf1[3]};
            *(u32x4*)(p.KHB + o) = (u32x4){khb0[0], khb0[1], khb0[2], khb0[3]}; *(u32x4*)(p.KHB + o + 8) = (u32x4){khb1[0], khb1[1], khb1[2], khb1[3]};
            if (tq == 0) { *(float2*)(p.DF + (size_t)(bh * 68 + c) * 128 + d) = make_float2(fexp2(allf.x), fexp2(allf.y)); *(float2*)(p.DB + (size_t)(bh * 68 + c) * 128 + d) = make_float2(fexp2(allb.x), fexp2(allb.y)); }
        }
        if (lat) {
            const int v = 2 * (t & 127), qr = t >> 7;
            unsigned wv[16];
#pragma unroll
            for (int s = 0; s < 16; ++s) wv[s] = *(const unsigned*)(p.P + (size_t)(row0 + 16 * qr + s) * PLD + 4096 + h * 256 + v);
            unsigned pk0[8], pk1[8];
#pragma unroll
            for (int s2 = 0; s2 < 8; ++s2) { pk0[s2] = (wv[2 * s2] & 0xffffu) | (wv[2 * s2 + 1] << 16); pk1[s2] = (wv[2 * s2] >> 16) | (wv[2 * s2 + 1] & 0xffff0000u); }
            bf16_t* o = p.VT + ((size_t)(bh * 68 + c) * 256 + v) * 64 + 16 * qr;
#pragma unroll
            for (int q8 = 0; q8 < 2; ++q8) {
                const u32x4 a0 = (u32x4){pk0[4 * q8], pk0[4 * q8 + 1], pk0[4 * q8 + 2], pk0[4 * q8 + 3]}, a1 = (u32x4){pk1[4 * q8], pk1[4 * q8 + 1], pk1[4 * q8 + 2], pk1[4 * q8 + 3]};
                *(u32x4*)(o + 8 * q8) = a0; *(u32x4*)(o + 64 + 8 * q8) = a1;
                bf16_t* o2 = p.VTS + ((((size_t)(bh * 68 + c) * 16 + (v >> 4)) * 2 + (qr >> 1)) * 64 + (v & 15) + 16 * ((2 * qr + q8) & 3)) * 8;
                *(u32x4*)o2 = a0; *(u32x4*)(o2 + 8) = a1;
            }
        } else {
            const int v = t & 255, half = t >> 8;
            unsigned pk[16];
#pragma unroll
            for (int s2 = 0; s2 < 16; ++s2) {
                const float* s0 = p.PS + (size_t)(row0 - NLAT + 32 * half + 2 * s2) * PSLD + 2560 + h * 256 + v;
                const float a = s0[0] + s0[PS_SLAB] + s0[2 * PS_SLAB] + s0[3 * PS_SLAB], bq = s0[PSLD] + s0[PS_SLAB + PSLD] + s0[2 * PS_SLAB + PSLD] + s0[3 * PS_SLAB + PSLD];
                pk[s2] = cvt_pk_bf16(a, bq);
            }
            bf16_t* o = p.VT + ((size_t)(bh * 68 + c) * 256 + v) * 64 + 32 * half;
            bf16_t* o2 = p.VTS + ((((size_t)(bh * 68 + c) * 16 + (v >> 4)) * 2 + half) * 64 + (v & 15)) * 8;
#pragma unroll
            for (int q4 = 0; q4 < 4; ++q4) { const u32x4 pv = (u32x4){pk[4 * q4], pk[4 * q4 + 1], pk[4 * q4 + 2], pk[4 * q4 + 3]}; *(u32x4*)(o + 8 * q4) = pv; *(u32x4*)(o2 + (16 * q4) * 8) = pv; }
        }
    }
}

__device__ __forceinline__ void glascan_wave(const Params& p, int unit, int dh, int lane, LAS unsigned char* ldsw) {
    const int v16 = unit & 15, scan = unit >> 4, dir = scan >> 3, bh = scan & 7;
    const int fr = lane & 15, fq = lane >> 4, d0 = 16 * dh, v0 = 16 * v16;
    const bf16_t* KH = (dir ? p.KHB : p.KHF) + (((size_t)bh * 68 * 8 + dh) * 2) * 512 + lane * 8;
    const bf16_t* VTp = p.VTS + (((size_t)bh * 68 * 16 + v16) * 2) * 512 + lane * 8;
    const float* DV = (dir ? p.DB : p.DF) + (size_t)bh * 68 * 128 + d0 + 4 * fq;
    bf16_t* SSp = p.SS + ((((size_t)dir * 8 + bh) * 65) * 256 + v0 + fr) * 128 + d0 + 4 * fq;
    LAS u32x2* sl = (LAS u32x2*)ldsw + lane;
    f32x4 acc = (f32x4){0.f, 0.f, 0.f, 0.f};
#define SC_CHUNK(n) (dir ? ((n) < 4 ? 3 - (n) : 71 - (n)) : (n))
#define SC_LOAD(S_, n) do { const int nn_ = (n) < 68 ? (n) : 67; const int c_ = SC_CHUNK(nn_); \
        S_##a0 = *(const bf16x8*)(KH + (size_t)c_ * 8192); S_##a1 = *(const bf16x8*)(KH + (size_t)c_ * 8192 + 512); \
        S_##b0 = *(const bf16x8*)(VTp + (size_t)c_ * 16384); S_##b1 = *(const bf16x8*)(VTp + (size_t)c_ * 16384 + 512); \
        S_##d = *(const f32x4*)(DV + (size_t)c_ * 128); } while (0)
#define SC_STEP(S_, k) do { u32x2 pk; pk.x = cvt_pk_bf16(acc[0], acc[1]); pk.y = cvt_pk_bf16(acc[2], acc[3]); sl[(k) * 64] = pk; \
        acc = acc * S_##d; \
        acc = __builtin_amdgcn_mfma_f32_16x16x32_bf16(S_##a0, S_##b0, acc, 0, 0, 0); acc = __builtin_amdgcn_mfma_f32_16x16x32_bf16(S_##a1, S_##b1, acc, 0, 0, 0); } while (0)
    bf16x8 Aa0, Aa1, Ab0, Ab1, Ba0, Ba1, Bb0, Bb1, Ca0, Ca1, Cb0, Cb1, Da0, Da1, Db0, Db1; f32x4 Ad, Bd, Cd, Dd;
    SC_LOAD(A, 0); SC_LOAD(B, 1); SC_LOAD(C, 2);
#pragma unroll 1
    for (int nb = 0; nb < 68; nb += 16) {
        const int iters = (nb + 16 <= 68) ? 4 : 1;
#pragma unroll 1
        for (int it = 0; it < iters; ++it) {
            const int n = nb + 4 * it;
            SC_LOAD(D, n + 3); SC_STEP(A, 4 * it);
            SC_LOAD(A, n + 4); SC_STEP(B, 4 * it + 1);
            SC_LOAD(B, n + 5); SC_STEP(C, 4 * it + 2);
            SC_LOAD(C, n + 6); SC_STEP(D, 4 * it + 3);
        }
#pragma unroll 1
        for (int k = 0; k < 4 * iters; ++k) { const int c_ = SC_CHUNK(nb + k); *(u32x2*)(SSp + (size_t)(c_ >= 4 ? c_ - 4 : 64) * 256 * 128) = sl[k * 64]; }
    }
#undef SC_CHUNK
#undef SC_LOAD
#undef SC_STEP
}

__device__ void ph_glaout(const Params& p, unsigned char* smb, const int wid0) {
    const int t = opaque_tid(wid0), w = t >> 6, lane = t & 63, l31 = lane & 31, hi = lane >> 5;
    const int wv = w & 3, wt = w >> 2;
    bf16_t* att = (bf16_t*)smb;
    float* ssq = (float*)(smb + 2 * 64 * 144);
    for (int u = blockIdx.x; u < 512; u += gridDim.x) {
        const int bh = u >> 6, j = u & 63, b = bh >> 2, h = bh & 3;
        const size_t tb = ((size_t)(bh * 64 + j) * 64) * 128;
        {
            const int dir = w >> 2, ts = (w >> 1) & 1, tt = w & 1;
            const bf16_t* Qm = (dir ? p.QB : p.QF) + tb; const bf16_t* Km = (dir ? p.KB : p.KF) + tb;
            const bool zero = dir ? (ts < tt) : (ts > tt);
            f32x16 s;
#pragma unroll
            for (int r = 0; r < 16; ++r) s[r] = 0.f;
            if (!zero) {
#pragma unroll
                for (int ks = 0; ks < 8; ++ks) {
                    const bf16x8 ka = *(const bf16x8*)(Km + (size_t)(32 * ts + l31) * 128 + 16 * ks + 8 * hi);
                    const bf16x8 qb = *(const bf16x8*)(Qm + (size_t)(32 * tt + l31) * 128 + 16 * ks + 8 * hi);
                    s = __builtin_amdgcn_mfma_f32_32x32x16_bf16(ka, qb, s, 0, 0, 0);
                }
            }
            const int tcol = 32 * tt + l31;
#pragma unroll
            for (int g = 0; g < 4; ++g) {
                float vv[4];
#pragma unroll
                for (int e = 0; e < 4; ++e) { const int srow = 32 * ts + 8 * g + 4 * hi + e; const bool keep = dir ? (srow >= tcol) : (srow <= tcol); vv[e] = keep ? s[4 * g + e] : 0.f; }
                u32x2 pk; pk.x = cvt_pk_bf16(vv[0], vv[1]); pk.y = cvt_pk_bf16(vv[2], vv[3]);
                *(u32x2*)(att + ((size_t)dir * 64 + tcol) * 72 + 32 * ts + 8 * g + 4 * hi) = pk;
            }
        }
        __syncthreads();
        f32x16 o0, o1;
#pragma unroll
        for (int r = 0; r < 16; ++r) { o0[r] = 0.f; o1[r] = 0.f; }
        const int tB = 32 * wt + l31;
        const bf16_t* vt0 = p.VT + ((size_t)(bh * 68 + 4 + j) * 256 + 64 * wv + l31) * 64 + 8 * hi;
#pragma unroll
        for (int dir = 0; dir < 2; ++dir) {
#pragma unroll
            for (int ks = 0; ks < 4; ++ks) {
                const bf16x8 bb = *(const bf16x8*)(att + ((size_t)dir * 64 + tB) * 72 + 16 * ks + 8 * hi);
                const bf16x8 a0 = *(const bf16x8*)(vt0 + 16 * ks), a1 = *(const bf16x8*)(vt0 + 32 * 64 + 16 * ks);
                o0 = __builtin_amdgcn_mfma_f32_32x32x16_bf16(a0, bb, o0, 0, 0, 0);
                o1 = __builtin_amdgcn_mfma_f32_32x32x16_bf16(a1, bb, o1, 0, 0, 0);
            }
            const bf16_t* ss0 = p.SS + ((((size_t)dir * 8 + bh) * 65 + j) * 256 + 64 * wv + l31) * 128 + 8 * hi;
            const bf16_t* qm = (dir ? p.QB : p.QF) + tb + (size_t)tB * 128 + 8 * hi;
#pragma unroll
            for (int ks = 0; ks < 8; ++ks) {
                const bf16x8 bb = *(const bf16x8*)(qm + 16 * ks);
                const bf16x8 a0 = *(const bf16x8*)(ss0 + 16 * ks), a1 = *(const bf16x8*)(ss0 + 32 * 128 + 16 * ks);
                o0 = __builtin_amdgcn_mfma_f32_32x32x16_bf16(a0, bb, o0, 0, 0, 0);
                o1 = __builtin_amdgcn_mfma_f32_32x32x16_bf16(a1, bb, o1, 0, 0, 0);
            }
        }
        float ss = 0.f;
#pragma unroll
        for (int r = 0; r < 16; ++r) ss += o0[r] * o0[r] + o1[r] * o1[r];
        ss += __shfl_xor(ss, 32);
        if (hi == 0) ssq[(wt * 4 + wv) * 32 + l31] = ss;
        __syncthreads();
        const float tot = ssq[(wt * 4 + 0) * 32 + l31] + ssq[(wt * 4 + 1) * 32 + l31] + ssq[(wt * 4 + 2) * 32 + l31] + ssq[(wt * 4 + 3) * 32 + l31];
        const float rstd = rsqrtf(tot * (1.f / 256.f) + 1e-6f);
        const int row = b * SEQ + 64 * j + tB;
        f32x4 gateA[2][4], gnA[2][4];
#pragma unroll
        for (int vt = 0; vt < 2; ++vt)
#pragma unroll
            for (int g = 0; g < 4; ++g) { const int v = 64 * wv + 32 * vt + 8 * g + 4 * hi;
                const u32x2 g4 = *(const u32x2*)(p.P + (size_t)row * PLD + 5120 + h * 256 + v);
                gateA[vt][g] = (f32x4){bf2f(g4.x & 0xffffu), bf2f(g4.x >> 16), bf2f(g4.y & 0xffffu), bf2f(g4.y >> 16)}; gnA[vt][g] = *(const f32x4*)(p.gla_norm_g + v); }
#pragma unroll
        for (int vt = 0; vt < 2; ++vt)
#pragma unroll
            for (int g = 0; g < 4; ++g) {
                const int v = 64 * wv + 32 * vt + 8 * g + 4 * hi;
                const f32x4 gate = gateA[vt][g], gn = gnA[vt][g];
                float ov[4];
#pragma unroll
                for (int e = 0; e < 4; ++e) { const float x = vt ? o1[4 * g + e] : o0[4 * g + e];
                    ov[e] = x * rstd * gn[e] * gate[e] * __builtin_amdgcn_rcpf(1.f + __builtin_amdgcn_exp2f(-1.4426950408889634f * gate[e])); }
                u32x2 pk; pk.x = cvt_pk_bf16(ov[0], ov[1]); pk.y = cvt_pk_bf16(ov[2], ov[3]);
                *(u32x2*)(p.MIX + (size_t)row * D + 1024 + h * 256 + v) = pk;
            }
        __syncthreads();
    }
}

__device__ void ph_norm2_router(const Params& p, float* sm, const int wid0) {
    const int t = opaque_tid(wid0), w = t >> 6, lane = t & 63;
    float* hs = sm;
    float* part = sm + 8 * D;
    int* hist = (int*)(sm + 8 * D + 8 * 8 * 64);
    const int G = gridDim.x, gpb = (NLAT / 8 + G - 1) / G;
    if (t < 64) hist[t] = 0;
    const int rb0 = blockIdx.x * gpb, rb1 = min(NLAT / 8, rb0 + gpb);
    float4 v[8];
    if (rb0 < rb1) {
#pragma unroll
        for (int j = 0; j < 8; ++j) v[j] = *(const float4*)(p.X1 + (size_t)(rb0 * 8 + w) * D + 256 * j + 4 * lane);
    }
    for (int rb = rb0; rb < rb1; ++rb) {
        const int row = rb * 8 + w, b = row / SEQ;
        const float* m = p.mod + (size_t)b * 6 * D;
        float ss = 0.f;
#pragma unroll
        for (int j = 0; j < 8; ++j) ss += v[j].x * v[j].x + v[j].y * v[j].y + v[j].z * v[j].z + v[j].w * v[j].w;
        ss = wave_sum(ss);
        const float rs = rsqrtf(ss * (1.f / D) + 1e-6f);
        __syncthreads();
        float4 vn[8];
        if (rb + 1 < rb1) {
#pragma unroll
            for (int j = 0; j < 8; ++j) vn[j] = *(const float4*)(p.X1 + (size_t)(row + 8) * D + 256 * j + 4 * lane);
        }
#pragma unroll
        for (int j = 0; j < 8; ++j) {
            const int col = 256 * j + 4 * lane;
            const float4 g = *(const float4*)(p.norm2_g + col), sh = *(const float4*)(m + 3 * D + col), sc = *(const float4*)(m + 4 * D + col);
            float4 o;
            o.x = v[j].x * rs * g.x * (1.f + sc.x) + sh.x; o.y = v[j].y * rs * g.y * (1.f + sc.y) + sh.y;
            o.z = v[j].z * rs * g.z * (1.f + sc.z) + sh.z; o.w = v[j].w * rs * g.w * (1.f + sc.w) + sh.w;
            *(float4*)(hs + w * D + col) = o;
            u32x2 pk; pk.x = cvt_pk_bf16(o.x, o.y); pk.y = cvt_pk_bf16(o.z, o.w);
            *(u32x2*)(p.H + (size_t)row * D + col) = pk;
        }
        if (rb + 1 < rb1) {
#pragma unroll
            for (int j = 0; j < 8; ++j) v[j] = vn[j];
        }
        __syncthreads();
        {
            const int e4 = t & 15, kp = t >> 4;
            float a[8][4];
#pragma unroll
            for (int r = 0; r < 8; ++r)
#pragma unroll
                for (int j = 0; j < 4; ++j) a[r][j] = 0.f;
#pragma unroll 4
            for (int kk = 0; kk < 64; ++kk) {
                const int k = kk * 32 + kp;
                const float4 wv = *(const float4*)(p.router_w + (size_t)k * NE + 4 * e4);
#pragma unroll
                for (int r = 0; r < 8; ++r) { const float hv = hs[r * D + k]; a[r][0] += hv * wv.x; a[r][1] += hv * wv.y; a[r][2] += hv * wv.z; a[r][3] += hv * wv.w; }
            }
#pragma unroll
            for (int r = 0; r < 8; ++r)
#pragma unroll
                for (int j = 0; j < 4; ++j) { float x = a[r][j]; x += __shfl_xor(x, 16); x += __shfl_xor(x, 32); a[r][j] = x; }
            if (lane < 16) {
#pragma unroll
                for (int r = 0; r < 8; ++r) *(float4*)(part + (w * 8 + r) * 64 + 4 * lane) = make_float4(a[r][0], a[r][1], a[r][2], a[r][3]);
            }
        }
        __syncthreads();
        {
            float lgt = 0.f;
#pragma unroll
            for (int i = 0; i < 8; ++i) lgt += part[(i * 8 + w) * 64 + lane];
            const float sc = 1.f / (1.f + expf(-lgt));
            const float bs = sc + p.router_bias[lane];
            float m1 = bs; m1 = fmaxf(m1, __shfl_xor(m1, 1)); m1 = fmaxf(m1, __shfl_xor(m1, 2)); m1 = fmaxf(m1, __shfl_xor(m1, 4));
            int ai = (bs == m1) ? lane : 64; ai = min(ai, __shfl_xor(ai, 1)); ai = min(ai, __shfl_xor(ai, 2)); ai = min(ai, __shfl_xor(ai, 4));
            float m2 = (lane == ai) ? -INFINITY : bs; m2 = fmaxf(m2, __shfl_xor(m2, 1)); m2 = fmaxf(m2, __shfl_xor(m2, 2)); m2 = fmaxf(m2, __shfl_xor(m2, 4));
            const float gs = m1 + m2;
            float g0 = __shfl(gs, 0), g1 = __shfl(gs, 8), g2 = __shfl(gs, 16), g3 = __shfl(gs, 24), g4 = __shfl(gs, 32), g5 = __shfl(gs, 40), g6 = __shfl(gs, 48), g7 = __shfl(gs, 56);
            unsigned selmask = 0u;
#pragma unroll
            for (int it = 0; it < 4; ++it) {
                float best = -INFINITY; int bi = 0;
                if (!(selmask & 1u) && g0 > best) { best = g0; bi = 0; }
                if (!(selmask & 2u) && g1 > best) { best = g1; bi = 1; }
                if (!(selmask & 4u) && g2 > best) { best = g2; bi = 2; }
                if (!(selmask & 8u) && g3 > best) { best = g3; bi = 3; }
                if (!(selmask & 16u) && g4 > best) { best = g4; bi = 4; }
                if (!(selmask & 32u) && g5 > best) { best = g5; bi = 5; }
                if (!(selmask & 64u) && g6 > best) { best = g6; bi = 6; }
                if (!(selmask & 128u) && g7 > best) { best = g7; bi = 7; }
                selmask |= 1u << bi;
            }
            float cand = ((selmask >> (lane >> 3)) & 1u) ? bs : -INFINITY;
            int myslot = -1; float ssum = 0.f;
#pragma unroll
            for (int k = 0; k < TOPK; ++k) {
                const float mv = wave_max(cand);
                const int idx = wave_min_i((cand == mv) ? lane : 64);
                const float sv = __shfl(sc, idx);
                ssum += sv;
                if (lane == idx) { myslot = k; cand = -INFINITY; }
            }
            if (myslot >= 0) {
                p.EIDX[row * TOPK + myslot] = lane;
                p.EW[row * TOPK + myslot] = sc / ssum * 2.5f;
                p.LRANK[row * TOPK + myslot] = atomicAdd(&hist[lane], 1);
            }
        }
    }
    __syncthreads();
    if (t < 64) p.CNTB[blockIdx.x * 64 + t] = hist[t];
}

__device__ void ph_lists(const Params& p, int* smi, const int wid0) {
    const int t = opaque_tid(wid0);
    const int G = gridDim.x, gpb = (NLAT / 8 + G - 1) / G;
    int* tp = smi + 128; int* tot = smi + 64;
    __syncthreads();
    if (t < 64) {
        int before = 0, all = 0;
        for (int bb = 0; bb < G; ++bb) { const int cnt = p.CNTB[bb * 64 + t]; all += cnt; if (bb < (int)blockIdx.x) before += cnt; }
        smi[t] = before; tot[t] = all;
        if (blockIdx.x == 0) p.CNT[t] = all;
    }
    __syncthreads();
    if (t == 0) { int tt = 0; for (int e = 0; e < NE; ++e) { tp[e] = tt; tt += (tot[e] + 255) / 256; } tp[NE] = tt; }
    __syncthreads();
    const int r0 = blockIdx.x * gpb * 8, r1 = min(NLAT, r0 + gpb * 8);
    for (int i = r0 * TOPK + t; i < r1 * TOPK; i += NT) {
        const int e = p.EIDX[i];
        const int pos = tp[e] * 256 + smi[e] + p.LRANK[i];
        p.PAIRPOS[i] = pos; p.LIST[pos] = i / TOPK;
    }
    for (int e = blockIdx.x; e < NE; e += G) {
        const int cn = tot[e], end = (tp[e + 1] - tp[e]) * 256;
        for (int i = cn + t; i < end; i += NT) p.LIST[tp[e] * 256 + i] = 0;
    }
}


__device__ void ph_prep(const Params& p, float* sm, const int wid0) {
    int* qslot = (int*)(sm + 21000);
    for (;;) {
        __syncthreads();
        if (wid0 == 0 && xb_lane_id() == 0) *qslot = atomicAdd(p.QCTR, 1);
        __syncthreads();
        const int it = *qslot;
        if (it >= 272 + 544) break;
        if (it < 272) { const int u = it < 16 ? ((it >> 3) * NTILE + 128 + (it & 7)) : (((it - 16) >> 7) * NTILE + ((it - 16) & 127)); ph_naprep(p, wid0, u, u + 1, 1); }
        else ph_glaprep(p, sm, wid0, it - 272, it - 271, 1);
    }
}

__device__ void ph_combine(const Params& p, const int wid0) {
    const int t = opaque_tid(wid0), w = t >> 6, lane = t & 63;
    for (int row = blockIdx.x * 8 + w; row < NLAT; row += gridDim.x * 8) {
        const int b = row / SEQ;
        float wk[TOPK]; const unsigned char* yr[TOPK];
#pragma unroll
        for (int k = 0; k < TOPK; ++k) { wk[k] = p.EW[row * TOPK + k]; yr[k] = p.Y8 + (size_t)p.PAIRPOS[row * TOPK + k] * YLD8 + 16 * lane; }
        const unsigned char* ys = p.YS8 + (size_t)row * YLD8 + 16 * lane;
        const float* x1 = p.X1 + (size_t)row * D + 16 * lane;
        const float* g2 = p.mod + (size_t)b * 6 * D + 5 * D + 16 * lane;
        float* o = p.out + (size_t)row * D + 16 * lane;
#pragma unroll
        for (int j = 0; j < 2; ++j) {
            float s[16];
            { const u32x4 v = *(const u32x4*)(ys + 1024 * j);
#pragma unroll
              for (int q = 0; q < 4; ++q) { const f32x2 lo = __builtin_amdgcn_cvt_pk_f32_fp8((int)v[q], false), hi = __builtin_amdgcn_cvt_pk_f32_fp8((int)v[q], true);
                  s[4 * q] = lo[0]; s[4 * q + 1] = lo[1]; s[4 * q + 2] = hi[0]; s[4 * q + 3] = hi[1]; } }
#pragma unroll
            for (int k = 0; k < TOPK; ++k) {
                const u32x4 v = *(const u32x4*)(yr[k] + 1024 * j); const float wv = wk[k];
#pragma unroll
                for (int q = 0; q < 4; ++q) { const f32x2 lo = __builtin_amdgcn_cvt_pk_f32_fp8((int)v[q], false), hi = __builtin_amdgcn_cvt_pk_f32_fp8((int)v[q], true);
                    s[4 * q] += wv * lo[0]; s[4 * q + 1] += wv * lo[1]; s[4 * q + 2] += wv * hi[0]; s[4 * q + 3] += wv * hi[1]; }
            }
#pragma unroll
            for (int q = 0; q < 4; ++q) { const f32x4 xa = *(const f32x4*)(x1 + 1024 * j + 4 * q), ga = *(const f32x4*)(g2 + 1024 * j + 4 * q);
                *(f32x4*)(o + 1024 * j + 4 * q) = (f32x4){xa[0] + ga[0] * s[4 * q], xa[1] + ga[1] * s[4 * q + 1], xa[2] + ga[2] * s[4 * q + 2], xa[3] + ga[3] * s[4 * q + 3]}; }
        }
    }
}

__global__ void __launch_bounds__(NT, 2) mega(Params p) {
    extern __shared__ __attribute__((aligned(16))) unsigned char dynlds[];
    int wid0;
    wid0 = __builtin_amdgcn_readfirstlane((int)threadIdx.x >> 6); asm volatile("" : "+s"(wid0));
    if (wid0 == 0 && xb_lane_id() < 4) ((unsigned*)(dynlds + LDS_BARW))[xb_lane_id()] = 0u;
    __syncthreads();
    XcdBarrier bar = xcd_barrier_post(p.bar, (volatile LAS unsigned*)(dynlds + LDS_BARW), wid0);
    float* sm = (float*)dynlds;
    int* tp = (int*)(dynlds + LDS_TAB);
    LAS unsigned char* lds = (LAS unsigned char*)dynlds;
    const int G = gridDim.x, c = blockIdx.x;

#ifndef REP
#define REP 0
#endif
#define PH(bit, ...) do { __VA_ARGS__; if (REP & (1 << (bit))) { xcd_barrier(bar); __VA_ARGS__; } } while (0)
    PH(0, ph_prologue(p, sm, wid0));                            xcd_barrier(bar);
    PH(1, ph_norm1(p, wid0));                               xcd_barrier(bar);
    { SchedDense S{(const char*)p.H, (const char*)p.WinT, D, NLAT / 256, PLD / 256, G, c}; EpiInproj E{p.P};
      g8::gemm_phase(lds, D, S, E, wid0); }
    { SchedInprojSplit S{(const char*)p.H, (const char*)p.WinT, G, c}; EpiInprojSplit E{p.PS, p.DDS};
      g8::gemm_phase(lds, D, S, E, wid0, 512); }                xcd_barrier(bar);
    ph_prep(p, sm, wid0);                                       xcd_barrier(bar);
    PH(6, ph_attn(p, dynlds, wid0));                            xcd_barrier(bar);
    PH(7, ph_glaout(p, dynlds, wid0));                          xcd_barrier(bar);
    PH(8, { SchedDense S{(const char*)p.MIX, (const char*)p.WoutT, D, NLAT / 256, D / 256, G, c}; EpiOutproj E{p.x, p.mod, p.X1};
      g8::gemm_phase(lds, D, S, E, wid0); });                   xcd_barrier(bar);
    PH(12, ph_norm2_router(p, sm, wid0));                       xcd_barrier(bar);
    PH(13, ph_lists(p, tp, wid0));                              xcd_barrier(bar);
    moe_tables(p, tp, wid0);
    PH(9, { SchedUp S{tp, (const char*)p.H, p.LIST, (const char*)p.E13T, (const char*)p.S13T, G, c}; EpiUp E{(unsigned char*)p.HB, (unsigned char*)p.SHH};
      g8::gemm_phase(lds, D, S, E, wid0); });                   xcd_barrier(bar);
    PH(10, { SchedDown S{tp, (const char*)p.HB, (const char*)p.E2T, (const char*)p.SHH, (const char*)p.S2T, G, c}; EpiDown E{p.Y8, p.YS8};
      g8::gemm_phase<EpiDown, SchedDown, true>(lds, DE / 2, S, E, wid0); });                  xcd_barrier(bar);
    PH(11, ph_combine(p, wid0));
}

extern "C" void kernel_launch(void* const* d_in, const int* in_sizes, int n_in, void* d_out, int out_size, void* d_ws, size_t ws_size, hipStream_t stream) {
    Params p{};
    const float* const* in = (const float* const*)d_in;
    p.x = in[0]; p.c = in[1]; p.ctx = in[2]; p.c_ctx = in[3]; p.w_mod = in[4]; p.b_mod = in[5]; p.norm1_g = in[6]; p.norm2_g = in[7]; p.w_in = in[8];
    p.q_norm_g = in[9]; p.k_norm_g = in[10]; p.na_rpb = in[11]; p.up_f = in[12]; p.bias_f = in[13]; p.up_b = in[14]; p.bias_b = in[15]; p.gla_norm_g = in[16];
    p.w_out = in[17]; p.router_w = in[18]; p.router_bias = in[19]; p.ew1 = in[20]; p.ew3 = in[21]; p.ew2 = in[22]; p.sw1 = in[23]; p.sw3 = in[24]; p.sw2 = in[25];
    p.out = (float*)d_out;
    char* w = (char*)d_ws; size_t o = 0;
    auto take = [&](size_t bytes) { void* r = w + o; o += (bytes + 255) & ~(size_t)255; return r; };
    p.bar = (unsigned*)take((size_t)XCD_BAR_WORDS * 4);
    p.CNT = (int*)take(64 * 4); p.QCTR = (int*)take(64 * 4); p.LRANK = (int*)take((size_t)NPAIR * 4); p.CNTB = (int*)take((size_t)1024 * 64 * 4);
    p.mod = (float*)take((size_t)3 * 6 * D * 4); p.RT = (float*)take((size_t)64 * 32 * 2 * 4);
    p.EIDX = (int*)take((size_t)NPAIR * 4); p.EW = (float*)take((size_t)NPAIR * 4); p.PAIRPOS = (int*)take((size_t)NPAIR * 4); p.LIST = (int*)take((size_t)PADROWS * 4);
    p.WinT = (bf16_t*)take((size_t)(PLD + 256) * D * 2); p.WoutT = (bf16_t*)take((size_t)D * D * 2); p.S13T = (bf16_t*)take((size_t)1024 * D * 2); p.S2T = (bf16_t*)take((size_t)D * DE * 2);
    p.E13T = (bf16_t*)take((size_t)NE * 1024 * D * 2); p.E2T = (bf16_t*)take((size_t)NE * D * DE * 2);
    p.H = (bf16_t*)take((size_t)NROW * D * 2);
    p.X1 = (float*)take((size_t)NLAT * D * 4);
    const size_t big = o;
    p.P = (bf16_t*)take((size_t)NLAT * PLD * 2); p.PS = (float*)take(4 * PS_SLAB * 4); p.DDS = (float*)take(4 * DD_SLAB * 4); p.NQb = (bf16_t*)take((size_t)NLAT * 1024 * 2); p.NKf = (bf16_t*)take((size_t)16 * NTILE * 4096 * 2); p.VTf = (bf16_t*)take((size_t)16 * NTILE * 4096 * 2);
    p.MIX = (bf16_t*)take((size_t)NLAT * D * 2);
    p.QF = (bf16_t*)take((size_t)8 * 64 * 64 * 128 * 2); p.KF = (bf16_t*)take((size_t)8 * 64 * 64 * 128 * 2); p.QB = (bf16_t*)take((size_t)8 * 64 * 64 * 128 * 2); p.KB = (bf16_t*)take((size_t)8 * 64 * 64 * 128 * 2);
    p.KHF = (bf16_t*)take((size_t)8 * 68 * 128 * 64 * 2); p.KHB = (bf16_t*)take((size_t)8 * 68 * 128 * 64 * 2); p.VT = (bf16_t*)take((size_t)8 * 68 * 256 * 64 * 2); p.VTS = (bf16_t*)take((size_t)8 * 68 * 256 * 64 * 2);
    p.DF = (float*)take((size_t)8 * 68 * 128 * 4); p.DB = (float*)take((size_t)8 * 68 * 128 * 4); p.SS = (bf16_t*)take((size_t)16 * 65 * 256 * 128 * 2);
    o = big;
    p.HB = (bf16_t*)take((size_t)PADROWS * DE * 2); p.SHH = (bf16_t*)take((size_t)NLAT * DE * 2); p.Y8 = (unsigned char*)take((size_t)PADROWS * YLD8); p.YS8 = (unsigned char*)take((size_t)NLAT * YLD8);
    static int grid = 0;
    if (!grid) {
        int dev = 0, cus = 0, per_cu = 0;
        hipGetDevice(&dev);
        hipDeviceGetAttribute(&cus, hipDeviceAttributeMultiprocessorCount, dev);
        (void)hipFuncSetAttribute((const void*)mega, hipFuncAttributeMaxDynamicSharedMemorySize, LDS_BYTES);
        (void)hipOccupancyMaxActiveBlocksPerMultiprocessor(&per_cu, (const void*)mega, NT, LDS_BYTES);
        (void)hipGetLastError();
        grid = cus;
    }
    (void)hipMemsetAsync(p.bar, 0, (size_t)XCD_BAR_WORDS * 4, stream);
    hipLaunchKernelGGL(mega, dim3(grid), dim3(NT), LDS_BYTES, stream, p);
}
```

```cpp
#include <hip/hip_runtime.h>
#include <stdint.h>

#define XB_TMO      128
#define XB_XCNT(j)  (256  + 64 * (j))
#define XB_XSUB(j)  (1280 + 64 * (j))
#define XB_XGEN(j)  (2304 + 64 * (j))
#define XB_TOP      3328
#define XB_TOPGEN   3392
#define XCD_BAR_WORDS 3456
#define XB_SPIN_CAP (1u << 18)
#define LAS __attribute__((address_space(3)))

__device__ __forceinline__ unsigned xb_ld(unsigned* p)              { return __hip_atomic_load(p, __ATOMIC_RELAXED, __HIP_MEMORY_SCOPE_AGENT); }
__device__ __forceinline__ unsigned xb_add(unsigned* p, unsigned v) { return __hip_atomic_fetch_add(p, v, __ATOMIC_RELAXED, __HIP_MEMORY_SCOPE_AGENT); }
__device__ __forceinline__ unsigned xb_xcc_id() { return (unsigned)__builtin_amdgcn_s_getreg((3 << 11) | 20) & 0xFu; }
#define XB_SPIN(cond, bar) do { unsigned _sp = 0; while (cond) { __builtin_amdgcn_s_sleep(1); \
    if ((++_sp & 255u) == 0u) { if (xb_ld(&(bar)[XB_TMO])) break; if (_sp > XB_SPIN_CAP) { atomicAdd(&(bar)[XB_TMO], 1u); break; } } } } while (0)

__device__ __forceinline__ int xb_lane_id() { return (int)__builtin_amdgcn_mbcnt_hi(~0u, __builtin_amdgcn_mbcnt_lo(~0u, 0u)); }
struct XcdBarrier {
    int wid;
    unsigned* bar; unsigned x;
    volatile LAS unsigned* st;
};

__device__ __forceinline__ XcdBarrier xcd_barrier_post(unsigned* bar, volatile LAS unsigned* st, int wid) {
    XcdBarrier b; b.wid = wid; b.bar = bar; b.x = xb_xcc_id(); b.st = st;
    if (wid == 0 && xb_lane_id() == 0) (void)xb_add(&bar[XB_XCNT(b.x)], 1u);
    return b;
}
__device__ __forceinline__ void xcd_barrier_complete(unsigned* bar, unsigned x, unsigned& nloc, unsigned& nx) {
    const unsigned G = gridDim.x * gridDim.y * gridDim.z;
    unsigned sum, cnt, mine, sp = 0u;
    for (;;) {
        sum = 0u; cnt = 0u; mine = 0u;
#pragma unroll
        for (unsigned j = 0; j < 16; ++j) { const unsigned c = xb_ld(&bar[XB_XCNT(j)]); sum += c; cnt += (c > 0u) ? 1u : 0u; mine = (j == x) ? c : mine; }
        if (sum == G) break;
        __builtin_amdgcn_s_sleep(1);
        if ((++sp & 255u) == 0u) { if (xb_ld(&bar[XB_TMO])) break; if (sp > XB_SPIN_CAP) { atomicAdd(&bar[XB_TMO], 1u); break; } }
    }
    nloc = mine > 0u ? mine : 1u; nx = cnt > 0u ? cnt : 1u;
}

__device__ __forceinline__ void xcd_barrier(const XcdBarrier& b) {
    asm volatile("s_waitcnt vmcnt(0)" ::: "memory");
    __syncthreads();
    if (b.wid == 0 && xb_lane_id() == 0) {
        unsigned* bar = b.bar;
        __builtin_amdgcn_s_waitcnt(0);
        unsigned nloc = b.st[0], nx = b.st[1];
        if (nloc == 0u) { xcd_barrier_complete(bar, b.x, nloc, nx); b.st[0] = nloc; b.st[1] = nx; }
        const unsigned old = xb_add(&bar[XB_XSUB(b.x)], 1u);
        const unsigned gen = old / nloc;
        if (old + 1u == (gen + 1u) * nloc) {
            __builtin_amdgcn_fence(__ATOMIC_RELEASE, "agent");
            asm volatile("s_waitcnt vmcnt(0)" ::: "memory");
            const unsigned og = xb_add(&bar[XB_TOP], 1u);
            const unsigned tg = og / nx;
            if (og + 1u == (tg + 1u) * nx) xb_add(&bar[XB_TOPGEN], 1u);
            else XB_SPIN(xb_ld(&bar[XB_TOPGEN]) == tg, bar);
            __builtin_amdgcn_fence(__ATOMIC_ACQUIRE, "agent");
            xb_add(&bar[XB_XGEN(b.x)], 1u);
            asm volatile("s_waitcnt vmcnt(0)" ::: "memory");
        } else {
            XB_SPIN(xb_ld(&bar[XB_XGEN(b.x)]) == gen, bar);
            __builtin_amdgcn_fence(__ATOMIC_ACQUIRE, "agent");
            asm volatile("s_waitcnt vmcnt(0)" ::: "memory");
        }
    }
    __syncthreads();
}


#define NT 512
typedef unsigned short bf16_t;
typedef short bf16x8 __attribute__((ext_vector_type(8)));
typedef float f32x4 __attribute__((ext_vector_type(4)));
typedef float f32x16 __attribute__((ext_vector_type(16)));
typedef unsigned u32x4 __attribute__((ext_vector_type(4)));
typedef unsigned u32x2 __attribute__((ext_vector_type(2)));
typedef int i32x4 __attribute__((ext_vector_type(4)));
typedef int i32x8 __attribute__((ext_vector_type(8)));

constexpr int D = 2048, SEQ = 4096, CTXL = 256, NB = 2;
constexpr int NLAT = NB * SEQ;
constexpr int NCTX = NB * CTXL;
constexpr int NROW = NLAT + NCTX;
constexpr int INC = 6176;
constexpr int PLD = 6144;
constexpr int PSLD = 3584;
constexpr size_t PS_SLAB = (size_t)512 * 3584, DD_SLAB = (size_t)8704 * 32;
constexpr int NE = 64, TOPK = 6, DE = 512;
constexpr int NPAIR = NLAT * TOPK;
constexpr int PADROWS = NPAIR + NE * 256;
constexpr float W13SC = 64.f, W2SC = 32.f, HSC = 4.f;
constexpr int YLD8 = D + 64;
constexpr int YLD = D + 64;
constexpr int LDS_STAGE = 131072;
constexpr int LDS_TAB = LDS_STAGE;
constexpr int LDS_BARW = LDS_STAGE + 4096;
constexpr int LDS_BYTES = LDS_BARW + 16 + 8192;

struct Params {
    const float *x, *c, *ctx, *c_ctx, *w_mod, *b_mod, *norm1_g, *norm2_g, *w_in, *q_norm_g, *k_norm_g, *na_rpb,
        *up_f, *bias_f, *up_b, *bias_b, *gla_norm_g, *w_out, *router_w, *router_bias, *ew1, *ew3, *ew2, *sw1, *sw3, *sw2;
    float* out;
    float *mod, *X1, *PS, *DDS, *EW, *RT, *DF, *DB;
    unsigned char *Y8, *YS8;
    bf16_t *P, *H, *MIX, *HB, *SHH, *Y, *WinT, *WoutT, *S13T, *S2T, *E13T, *E2T, *QF, *KF, *QB, *KB, *KHF, *KHB, *VT, *SS, *NQb, *NKf, *VTf, *YS, *VTS;
    int *EIDX, *PAIRPOS, *LIST, *CNT, *QCTR, *LRANK, *CNTB;
    unsigned* bar;
};

__device__ __forceinline__ int fresh_lane_id() { int l; asm volatile("v_mbcnt_lo_u32_b32 %0, -1, 0\n\tv_mbcnt_hi_u32_b32 %0, -1, %0" : "=v"(l)); return l; }
__device__ __forceinline__ int opaque_tid(int wid0) { return wid0 * 64 + fresh_lane_id(); }
__device__ __forceinline__ float wave_sum(float v) { for (int o = 32; o > 0; o >>= 1) v += __shfl_xor(v, o); return v; }
__device__ __forceinline__ float wave_max(float v) { for (int o = 32; o > 0; o >>= 1) v = fmaxf(v, __shfl_xor(v, o)); return v; }
__device__ __forceinline__ int wave_min_i(int v) { for (int o = 32; o > 0; o >>= 1) v = min(v, __shfl_xor(v, o)); return v; }
__device__ __forceinline__ float siluf(float v) { return v / (1.f + expf(-v)); }
typedef float f32x2 __attribute__((ext_vector_type(2)));
typedef __bf16 bf16x2_t __attribute__((ext_vector_type(2)));
__device__ __forceinline__ unsigned cvt_pk_bf16(float lo, float hi) { const f32x2 v = {lo, hi}; return __builtin_bit_cast(unsigned, __builtin_convertvector(v, bf16x2_t)); }
__device__ __forceinline__ bf16_t f2bf(float f) { return (bf16_t)(cvt_pk_bf16(f, 0.f) & 0xffffu); }
__device__ __forceinline__ float bf2f(unsigned b) { return __uint_as_float(b << 16); }

__device__ __forceinline__ void adaln_item(const Params& p, float* sm, int item, const int wid0) {
    const int t = opaque_tid(wid0), cq = t & 15, kg = t >> 4, n0 = item * 64;
    float* red = sm + 3 * D;
    float a[3][4];
#pragma unroll
    for (int r = 0; r < 3; ++r)
#pragma unroll
        for (int j = 0; j < 4; ++j) a[r][j] = 0.f;
#pragma unroll 4
    for (int k = kg; k < D; k += 32) {
        const f32x4 w4 = __builtin_nontemporal_load((const f32x4*)(p.w_mod + (size_t)k * (6 * D) + n0 + 4 * cq)); const float4 w = make_float4(w4[0], w4[1], w4[2], w4[3]);
        const float s0 = sm[k], s1 = sm[D + k], s2 = sm[2 * D + k];
        a[0][0] += s0 * w.x; a[0][1] += s0 * w.y; a[0][2] += s0 * w.z; a[0][3] += s0 * w.w;
        a[1][0] += s1 * w.x; a[1][1] += s1 * w.y; a[1][2] += s1 * w.z; a[1][3] += s1 * w.w;
        a[2][0] += s2 * w.x; a[2][1] += s2 * w.y; a[2][2] += s2 * w.z; a[2][3] += s2 * w.w;
    }
    __syncthreads();
#pragma unroll
    for (int r = 0; r < 3; ++r)
#pragma unroll
        for (int j = 0; j < 4; ++j) red[(kg * 3 + r) * 64 + 4 * cq + j] = a[r][j];
    __syncthreads();
    if (t < 192) {
        const int r = t >> 6, cc = t & 63;
        float s = p.b_mod[n0 + cc];
#pragma unroll 8
        for (int g = 0; g < 32; ++g) s += red[(g * 3 + r) * 64 + cc];
        p.mod[(size_t)r * 6 * D + n0 + cc] = s;
    }
    __syncthreads();
}
__device__ __forceinline__ void transpose_item(const float* W, int K, int N, int k0, int n0, bf16_t* WT, int drow0, float* scr, int lane, int maxc = 63) {
    if (maxc >= 63) {
        const int kr = lane >> 4, nq = lane & 15;
        f32x4 v[16];
#pragma unroll
        for (int q = 0; q < 16; ++q) v[q] = __builtin_nontemporal_load((const f32x4*)(W + (size_t)(k0 + 4 * q + kr) * N + n0 + 4 * nq));
#pragma unroll
        for (int q = 0; q < 16; ++q) { float* d = scr + (4 * q + kr) * 65 + 4 * nq; d[0] = v[q][0]; d[1] = v[q][1]; d[2] = v[q][2]; d[3] = v[q][3]; }
    } else {
        const int cl = lane < maxc ? lane : maxc;
#pragma unroll 8
        for (int kk = 0; kk < 64; ++kk) scr[kk * 65 + lane] = W[(size_t)(k0 + kk) * N + n0 + cl];
    }
    asm volatile("s_waitcnt lgkmcnt(0)" ::: "memory");
    const int c = lane & 7;
#pragma unroll
    for (int j = 0; j < 8; ++j) {
        const int n = (lane >> 3) + 8 * j; const float* s = scr + (8 * c) * 65 + n;
        u32x4 o; o.x = cvt_pk_bf16(s[0], s[65]); o.y = cvt_pk_bf16(s[2 * 65], s[3 * 65]); o.z = cvt_pk_bf16(s[4 * 65], s[5 * 65]); o.w = cvt_pk_bf16(s[6 * 65], s[7 * 65]);
        *(u32x4*)(WT + (size_t)(drow0 + n) * K + k0 + 8 * c) = o;
    }
    asm volatile("s_waitcnt lgkmcnt(0)" ::: "memory");
}
__device__ __forceinline__ void transpose_item8(const float* W, int K, int N, int k0, int n0, unsigned char* WT, int drow0, float* scr, int lane, float sc) {
    {
        const int kr = lane >> 4, nq = lane & 15;
        f32x4 v[16];
#pragma unroll
        for (int q = 0; q < 16; ++q) v[q] = __builtin_nontemporal_load((const f32x4*)(W + (size_t)(k0 + 4 * q + kr) * N + n0 + 4 * nq));
#pragma unroll
        for (int q = 0; q < 16; ++q) { float* d = scr + (4 * q + kr) * 65 + 4 * nq; d[0] = v[q][0]; d[1] = v[q][1]; d[2] = v[q][2]; d[3] = v[q][3]; }
    }
    asm volatile("s_waitcnt lgkmcnt(0)" ::: "memory");
    const int c = lane & 3;
#pragma unroll
    for (int j = 0; j < 4; ++j) {
        const int n = (lane >> 2) + 16 * j; const float* s = scr + (16 * c) * 65 + n;
        u32x4 o;
#pragma unroll
        for (int q = 0; q < 4; ++q) { int pk = 0;
            pk = __builtin_amdgcn_cvt_pk_fp8_f32(s[(4 * q) * 65] * sc, s[(4 * q + 1) * 65] * sc, pk, false);
            pk = __builtin_amdgcn_cvt_pk_fp8_f32(s[(4 * q + 2) * 65] * sc, s[(4 * q + 3) * 65] * sc, pk, true); o[q] = (unsigned)pk; }
        *(u32x4*)(WT + (size_t)(drow0 + n) * K + k0 + 16 * c) = o;
    }
    asm volatile("s_waitcnt lgkmcnt(0)" ::: "memory");
}
constexpr int CI_WIN = 32 * 97, CI_WOUT = 32 * 32, CI_S13 = 2 * 32 * 8, CI_S2 = 8 * 32, CI_E13 = 64 * 2 * 32 * 8, CI_E2 = 64 * 8 * 32;
constexpr int CI_TOTAL = CI_WIN + CI_WOUT + CI_S13 + CI_S2 + CI_E13 + CI_E2;
__device__ __forceinline__ void convert_item(const Params& p, int it, float* scr, int lane) {
    if (it < CI_WIN) { const int kb = it / 97, nb = it % 97; transpose_item(p.w_in, D, INC, 64 * kb, 64 * nb, p.WinT, 64 * nb, scr, lane, INC - 1 - 64 * nb); return; }
    it -= CI_WIN;
    if (it < CI_WOUT) { const int kb = it / 32, nb = it % 32; transpose_item(p.w_out, D, D, 64 * kb, 64 * nb, p.WoutT, 64 * nb, scr, lane); return; }
    it -= CI_WOUT;
    if (it < CI_S13) {
        const int which = it / 256, r = it % 256, kb = r / 8, nb = r % 8;
        transpose_item8(which ? p.sw3 : p.sw1, D, DE, 64 * kb, 64 * nb, (unsigned char*)p.S13T, (nb >> 1) * 256 + which * 128 + (nb & 1) * 64, scr, lane, W13SC); return; }
    it -= CI_S13;
    if (it < CI_S2) { const int kb = it / 32, nb = it % 32; transpose_item8(p.sw2, DE, D, 64 * kb, 64 * nb, (unsigned char*)p.S2T, 64 * nb, scr, lane, W2SC); return; }
    it -= CI_S2;
    if (it < CI_E13) {
        const int e = it / 512, r0 = it % 512, which = r0 / 256, r = r0 % 256, kb = r / 8, nb = r % 8;
        transpose_item8((which ? p.ew3 : p.ew1) + (size_t)e * D * DE, D, DE, 64 * kb, 64 * nb, (unsigned char*)p.E13T + (size_t)e * 1024 * D, (nb >> 1) * 256 + which * 128 + (nb & 1) * 64, scr, lane, W13SC); return; }
    it -= CI_E13;
    { const int e = it / 256, r = it % 256, kb = r / 32, nb = r % 32;
      transpose_item8(p.ew2 + (size_t)e * DE * D, DE, D, 64 * kb, 64 * nb, (unsigned char*)p.E2T + (size_t)e * D * DE, 64 * nb, scr, lane, W2SC); }
}
__device__ void ph_prologue(const Params& p, float* sm, const int wid0) {
    const int t = opaque_tid(wid0), w = t >> 6, lane = t & 63;
    if (blockIdx.x == 0 && t == 0) { p.QCTR[0] = 0; p.QCTR[32] = 0; }
    if (blockIdx.x == gridDim.x - 1) {
        for (int i = t; i < 64 * 32; i += NT) { const float ang = (float)(i >> 5) * powf(10000.f, -(float)(i & 31) / 32.f); p.RT[2 * i] = cosf(ang); p.RT[2 * i + 1] = sinf(ang); }
    }
    if (blockIdx.x < 192) {
        for (int i = t; i < 3 * D; i += NT) { const int r = i / D, k = i % D; sm[i] = siluf(r < 2 ? p.c[r * D + k] : p.c_ctx[k]); }
        __syncthreads();
        for (int item = blockIdx.x; item < 192; item += gridDim.x) adaln_item(p, sm, item, wid0);
    }
    __syncthreads();
    float* scr = sm + w * (64 * 65);
    for (int it = blockIdx.x * 8 + w; it < CI_TOTAL; it += gridDim.x * 8) convert_item(p, it, scr, lane);
}

__device__ void ph_norm1(const Params& p, const int wid0) {
    const int t = opaque_tid(wid0), w = t >> 6, lane = t & 63;
    for (int row = blockIdx.x * 8 + w; row < NROW; row += gridDim.x * 8) {
        const float* src; int mr;
        if (row < NLAT) { src = p.x + (size_t)row * D; mr = row / SEQ; } else { src = p.ctx + (size_t)(row - NLAT) * D; mr = 2; }
        const float* m = p.mod + (size_t)mr * 6 * D;
        float4 v[8]; float ss = 0.f;
#pragma unroll
        for (int j = 0; j < 8; ++j) { v[j] = *(const float4*)(src + 256 * j + 4 * lane); ss += v[j].x * v[j].x + v[j].y * v[j].y + v[j].z * v[j].z + v[j].w * v[j].w; }
        ss = wave_sum(ss);
        const float rs = rsqrtf(ss * (1.f / D) + 1e-6f);
#pragma unroll
        for (int j = 0; j < 8; ++j) {
            const int col = 256 * j + 4 * lane;
            const float4 g = *(const float4*)(p.norm1_g + col), sh = *(const float4*)(m + col), sc = *(const float4*)(m + D + col);
            u32x2 pk;
            pk.x = cvt_pk_bf16(v[j].x * rs * g.x * (1.f + sc.x) + sh.x, v[j].y * rs * g.y * (1.f + sc.y) + sh.y);
            pk.y = cvt_pk_bf16(v[j].z * rs * g.z * (1.f + sc.z) + sh.z, v[j].w * rs * g.w * (1.f + sc.w) + sh.w);
            *(u32x2*)(p.H + (size_t)row * D + col) = pk;
        }
    }
}

namespace g8 {
constexpr int BM = 256, BK = 64, HALF = 128, HTB = HALF * BK * 2;
__device__ __forceinline__ int lds_byte(int r, int c) { const int st = (r >> 4) * 2 + (c >> 5), rr = r & 15, cc = c & 31, ob = rr * 64 + cc * 2; return st * 1024 + (ob ^ (((ob >> 9) & 1) << 5)); }
__device__ __forceinline__ void stage_rc(int b, int& R, int& C) { const int st = b / 1024, sb = b % 1024, swz = sb ^ (((sb >> 9) & 1) << 5); R = (st >> 1) * 16 + swz / 64; C = (st & 1) * 32 + (swz % 64) / 2; }
__device__ __forceinline__ int perm32(int rho) { const int n = rho >> 4, i = rho & 15; return 8 * (i >> 2) + 4 * n + (i & 3); }

struct Unit { const char* A; const int* rows; int row0; const char* Bt; int orow, pn, aux; int nv = 256; };

__device__ __forceinline__ bool work_id(int i, int G, int c, int nwg, int& wgid) {
    const long L = (long)i * G + c; if (L >= nwg) return false;
    const int l = (int)L, q = nwg / 8, r = nwg % 8, xcd = l % 8, off = l / 8;
    wgid = (xcd < r ? xcd * (q + 1) : r * (q + 1) + (xcd - r) * q) + off; return true;
}

__device__ __forceinline__ i32x8 cat8(bf16x8 a, bf16x8 b) { const i32x4 x = __builtin_bit_cast(i32x4, a), y = __builtin_bit_cast(i32x4, b); return __builtin_shufflevector(x, y, 0, 1, 2, 3, 4, 5, 6, 7); }
template <class Epi, class Sched, bool F8 = false>
__device__ __forceinline__ void gemm_phase(LAS unsigned char* lds, const int K, const Sched& S, const Epi& E, const int wid0, const int kloop = 0) {
    const int tid_ = wid0 * 64 + fresh_lane_id();
    const int tid = tid_, wid = __builtin_amdgcn_readfirstlane(tid >> 6), lane = tid & 63, wr = wid >> 2, wc = wid & 3, fr = lane & 15, fq = lane >> 4;
    const int nt = (kloop ? kloop : K) / BK;
    int sR[2]; unsigned sC2[2], voffB[2], voffB1[2];
#pragma unroll
    for (int i = 0; i < 2; ++i) { int R, C; stage_rc(tid * 16 + i * 8192, R, C);
        const int Rb = Epi::PERM == 3 ? (64 * (R >> 5) + 16 * ((R & 15) >> 2) + 4 * ((R >> 4) & 1) + (R & 3)) : (Epi::PERM == 1 ? ((R & ~31) + perm32(R & 31)) : R);
        sR[i] = R; sC2[i] = (unsigned)C * 2u; voffB[i] = (unsigned)(Rb * K + C) * 2u; voffB1[i] = Epi::PERM == 3 ? (unsigned)((Rb + 8) * K + C) * 2u : voffB[i]; }
    const size_t kstep = (size_t)(BK * 2);
    const size_t hstep = (size_t)HALF * K * 2;
    const size_t hB1 = Epi::PERM == 3 ? 0 : hstep;
    const unsigned ldsw = (unsigned)wid * 1024u;
    const int aoff = lds_byte(wr * 64 + fr, fq * 8), boff = lds_byte(wc * 32 + fr, fq * 8);
#define G8_SA(b, h) (((b) * 2 + (h)) * g8::HTB)
#define G8_SB(b, h) ((4 + (b) * 2 + (h)) * g8::HTB)
#define G8_STAGE(bufoff, gbase, v0, v1) do { \
        __builtin_amdgcn_global_load_lds((const unsigned*)((const char*)(gbase) + (v0)), (LAS unsigned*)(lds + (bufoff) + ldsw), 16, 0, 0); \
        __builtin_amdgcn_global_load_lds((const unsigned*)((const char*)(gbase) + (v1)), (LAS unsigned*)(lds + (bufoff) + ldsw + 8192), 16, 0, 0); } while (0)
#define G8_LDA(dst, b, h) do { _Pragma("unroll") for (int m = 0; m < 4; ++m) _Pragma("unroll") for (int k = 0; k < 2; ++k) dst[m][k] = *(const LAS bf16x8*)(lds + G8_SA(b, h) + aoff + m * 2048 + k * 1024); } while (0)
#define G8_LDB(dst, b, h) do { _Pragma("unroll") for (int n = 0; n < 2; ++n) _Pragma("unroll") for (int k = 0; k < 2; ++k) dst[n][k] = *(const LAS bf16x8*)(lds + G8_SB(b, h) + boff + n * 2048 + k * 1024); } while (0)
#define G8_MMA(ai, bj, At, Bt) do { __builtin_amdgcn_s_setprio(1); \
        if constexpr (F8) { _Pragma("unroll") for (int m = 0; m < 4; ++m) _Pragma("unroll") for (int n = 0; n < 2; ++n) \
            acc[ai][bj][m][n] = __builtin_amdgcn_mfma_scale_f32_16x16x128_f8f6f4(cat8(Bt[n][0], Bt[n][1]), cat8(At[m][0], At[m][1]), acc[ai][bj][m][n], 0, 0, 0, 0, 0, 0); } \
        else { _Pragma("unroll") for (int m = 0; m < 4; ++m) _Pragma("unroll") for (int n = 0; n < 2; ++n) _Pragma("unroll") for (int k = 0; k < 2; ++k) \
            acc[ai][bj][m][n] = __builtin_amdgcn_mfma_f32_16x16x32_bf16(Bt[n][k], At[m][k], acc[ai][bj][m][n], 0, 0, 0); } \
        __builtin_amdgcn_s_setprio(0); } while (0)
#define G8_WAIT_V(n) asm volatile("s_waitcnt vmcnt(" #n ")" ::: "memory")
#define G8_WAIT_L(n) asm volatile("s_waitcnt lgkmcnt(" #n ")" ::: "memory")
#define G8_BAR __builtin_amdgcn_s_barrier()
#define G8_SCHED __builtin_amdgcn_sched_barrier(0)
    Unit cur, nxt; int ui = 0;
    if (!S.next(0, cur)) return;
    f32x4 acc[2][2][4][2];
#pragma unroll
    for (int a = 0; a < 2; ++a)
#pragma unroll
        for (int b = 0; b < 2; ++b)
#pragma unroll
            for (int m = 0; m < 4; ++m)
#pragma unroll
                for (int n = 0; n < 2; ++n) acc[a][b][m][n] = (f32x4){0.f, 0.f, 0.f, 0.f};
    bf16x8 At[4][2], B0[2][2], B1[2][2];
    unsigned vA00, vA01, vA10, vA11, nA00, nA01, nA10, nA11;
#define G8_MKOFF(u, o00, o01, o10, o11) do { \
        int r00, r01, r10, r11; \
        if ((u).rows) { r00 = (u).rows[sR[0]]; r01 = (u).rows[sR[1]]; r10 = (u).rows[128 + sR[0]]; r11 = (u).rows[128 + sR[1]]; } \
        else { r00 = (u).row0 + sR[0]; r01 = (u).row0 + sR[1]; r10 = (u).row0 + 128 + sR[0]; r11 = (u).row0 + 128 + sR[1]; } \
        o00 = (unsigned)r00 * (unsigned)(K * 2) + sC2[0]; o01 = (unsigned)r01 * (unsigned)(K * 2) + sC2[1]; \
        o10 = (unsigned)r10 * (unsigned)(K * 2) + sC2[0]; o11 = (unsigned)r11 * (unsigned)(K * 2) + sC2[1]; } while (0)
    G8_MKOFF(cur, vA00, vA01, vA10, vA11);
    const char* cA = cur.A; const char* cB = cur.Bt;
    G8_STAGE(G8_SB(0, 0), cB, voffB[0], voffB[1]); G8_STAGE(G8_SA(0, 0), cA, vA00, vA01); G8_STAGE(G8_SB(0, 1), cB + hB1, voffB1[0], voffB1[1]); G8_STAGE(G8_SA(0, 1), cA, vA10, vA11);
    if (wr == 1) G8_BAR;
    G8_WAIT_V(4); G8_BAR;
    G8_STAGE(G8_SB(1, 0), cB + kstep, voffB[0], voffB[1]); G8_STAGE(G8_SA(1, 0), cA + kstep, vA00, vA01); G8_STAGE(G8_SB(1, 1), cB + hB1 + kstep, voffB1[0], voffB1[1]);
    G8_WAIT_V(6); G8_BAR;
    for (;;) {
        const bool h1 = cur.nv > 128;
        const bool has_next = S.next(ui + 1, nxt);
        const char* nA = has_next ? nxt.A : cA; const char* nB = has_next ? nxt.Bt : cB;
        if (has_next) G8_MKOFF(nxt, nA00, nA01, nA10, nA11); else { nA00 = vA00; nA01 = vA01; nA10 = vA10; nA11 = vA11; }
#pragma nounroll
        for (int t = 0; t < nt; t += 2) {
            const bool last = (t == nt - 2);
            const char* a1 = cA + (size_t)(t + 1) * kstep;
            G8_LDB(B0, 0, 0); G8_SCHED; G8_LDA(At, 0, 0); G8_STAGE(G8_SA(1, 1), a1, vA10, vA11);
            G8_WAIT_L(8); G8_BAR; G8_WAIT_L(0); G8_MMA(0, 0, At, B0); G8_BAR; G8_SCHED;
            if (last) { vA00 = nA00; vA01 = nA01; vA10 = nA10; vA11 = nA11; }
            const char* a2 = last ? nA : cA + (size_t)(t + 2) * kstep; const char* b2 = last ? nB : cB + (size_t)(t + 2) * kstep;
            const char* a3 = a2 + kstep; const char* b3 = b2 + kstep;
            G8_LDB(B1, 0, 1); G8_STAGE(G8_SB(0, 0), b2, voffB[0], voffB[1]);
            G8_BAR; G8_WAIT_L(0); G8_MMA(0, 1, At, B1); G8_BAR;
            G8_LDA(At, 0, 1); G8_STAGE(G8_SA(0, 0), a2, vA00, vA01);
            G8_BAR; G8_WAIT_L(0); if (h1) G8_MMA(1, 0, At, B0); G8_BAR; G8_SCHED;
            G8_STAGE(G8_SB(0, 1), b2 + hB1, voffB1[0], voffB1[1]);
            G8_WAIT_V(6); G8_BAR; if (h1) G8_MMA(1, 1, At, B1); G8_BAR;
            G8_LDB(B0, 1, 0); G8_SCHED; G8_LDA(At, 1, 0); G8_STAGE(G8_SA(0, 1), a2, vA10, vA11);
            G8_WAIT_L(8); G8_BAR; G8_WAIT_L(0); G8_MMA(0, 0, At, B0); G8_BAR; G8_SCHED;
            G8_LDB(B1, 1, 1); G8_STAGE(G8_SB(1, 0), b3, voffB[0], voffB[1]);
            G8_BAR; G8_WAIT_L(0); G8_MMA(0, 1, At, B1); G8_BAR;
            G8_LDA(At, 1, 1); G8_STAGE(G8_SA(1, 0), a3, vA00, vA01);
            G8_BAR; G8_WAIT_L(0); if (h1) G8_MMA(1, 0, At, B0); G8_BAR; G8_SCHED;
            G8_STAGE(G8_SB(1, 1), b3 + hB1, voffB1[0], voffB1[1]);
            G8_WAIT_V(6); G8_BAR; if (h1) G8_MMA(1, 1, At, B1); G8_BAR;
        }
        E(acc, cur, wr, wc, fr, fq);
        if (!has_next) break;
#pragma unroll
        for (int a = 0; a < 2; ++a)
#pragma unroll
            for (int b = 0; b < 2; ++b)
#pragma unroll
                for (int m = 0; m < 4; ++m)
#pragma unroll
                    for (int n = 0; n < 2; ++n) acc[a][b][m][n] = (f32x4){0.f, 0.f, 0.f, 0.f};
        cur = nxt; cA = nA; cB = nB; ++ui;
    }
    G8_WAIT_V(0);
    if (wr == 0) G8_BAR;
    G8_BAR;
}
}

struct EpiInproj {
    static constexpr int PERM = 1;
    bf16_t* P;
    __device__ __forceinline__ void operator()(const f32x4 (&acc)[2][2][4][2], const g8::Unit& u, int wr, int wc, int fr, int fq) const {
#pragma unroll
        for (int ai = 0; ai < 2; ++ai)
#pragma unroll
            for (int m = 0; m < 4; ++m) { bf16_t* rowp = P + (size_t)(u.orow + ai * 128 + wr * 64 + m * 16 + fr) * PLD + u.pn * 256 + wc * 32 + 8 * fq;
#pragma unroll
                for (int bj = 0; bj < 2; ++bj) { const f32x4 v0 = acc[ai][bj][m][0], v1 = acc[ai][bj][m][1];
                    u32x4 w; w.x = cvt_pk_bf16(v0[0], v0[1]); w.y = cvt_pk_bf16(v0[2], v0[3]); w.z = cvt_pk_bf16(v1[0], v1[1]); w.w = cvt_pk_bf16(v1[2], v1[3]);
                    *(u32x4*)(rowp + bj * 128) = w; } }
    }
};
struct EpiInprojSplit {
    static constexpr int PERM = 0;
    float* PS; float* DDS;
    __device__ __forceinline__ void operator()(const f32x4 (&acc)[2][2][4][2], const g8::Unit& u, int wr, int wc, int fr, int fq) const {
        if (u.pn == PLD / 256) {
            if (wc == 0) {
#pragma unroll
                for (int ai = 0; ai < 2; ++ai)
#pragma unroll
                    for (int m = 0; m < 4; ++m) { float* rowp = DDS + (size_t)u.aux * DD_SLAB + (size_t)(u.orow + ai * 128 + wr * 64 + m * 16 + fr) * 32 + 4 * fq;
                        *(f32x4*)(rowp) = acc[ai][0][m][0]; *(f32x4*)(rowp + 16) = acc[ai][0][m][1]; }
            }
            return;
        }
        const int ccol = (u.pn < 12 ? u.pn - 4 : u.pn - 6) * 256;
#pragma unroll
        for (int ai = 0; ai < 2; ++ai)
#pragma unroll
            for (int m = 0; m < 4; ++m) { float* rowp = PS + (size_t)u.aux * PS_SLAB + (size_t)(u.orow - NLAT + ai * 128 + wr * 64 + m * 16 + fr) * PSLD + ccol + wc * 32 + 4 * fq;
#pragma unroll
                for (int bj = 0; bj < 2; ++bj)
#pragma unroll
                    for (int n = 0; n < 2; ++n) *(f32x4*)(rowp + bj * 128 + n * 16) = acc[ai][bj][m][n]; }
    }
};
struct SchedInprojSplit {
    const char* A; const char* Bt; int G, c;
    static constexpr int NITEM = 4 * (28 + 34);
    __device__ __forceinline__ bool next(int i, g8::Unit& u) const {
        int it; if (!g8::work_id(i, G, c, NITEM, it)) return false;
        int pm, pn; const int ks = it & 3, q = it >> 2;
        if (q < 28) { const int j = q % 14; pm = 32 + q / 14; pn = j < 8 ? 4 + j : (j < 10 ? 6 + j : 6 + j); }
        else { pm = q - 28; pn = PLD / 256; }
        u.A = A + ks * 1024; u.rows = nullptr; u.row0 = pm * 256; u.Bt = Bt + (size_t)pn * 256 * D * 2 + ks * 1024; u.orow = pm * 256; u.pn = pn; u.aux = ks; return true;
    }
};
struct EpiOutproj {
    static constexpr int PERM = 0;
    const float* x; const float* mod; float* X1;
    __device__ __forceinline__ void operator()(const f32x4 (&acc)[2][2][4][2], const g8::Unit& u, int wr, int wc, int fr, int fq) const {
        const int b = u.orow / SEQ; const int col0 = u.pn * 256 + wc * 32 + 4 * fq;
        f32x4 gv[2][2];
#pragma unroll
        for (int bj = 0; bj < 2; ++bj)
#pragma unroll
            for (int n = 0; n < 2; ++n) gv[bj][n] = *(const f32x4*)(mod + (size_t)b * 6 * D + 2 * D + col0 + bj * 128 + n * 16);
#pragma unroll
        for (int ai = 0; ai < 2; ++ai)
#pragma unroll
            for (int m = 0; m < 4; ++m) { const size_t ro = (size_t)(u.orow + ai * 128 + wr * 64 + m * 16 + fr) * D + col0;
#pragma unroll
                for (int bj = 0; bj < 2; ++bj)
#pragma unroll
                    for (int n = 0; n < 2; ++n) { const f32x4 xv = *(const f32x4*)(x + ro + bj * 128 + n * 16);
                        *(f32x4*)(X1 + ro + bj * 128 + n * 16) = xv + gv[bj][n] * acc[ai][bj][m][n]; } }
    }
};
struct EpiUp {
    static constexpr int PERM = 1;
    unsigned char* HB; unsigned char* SHH;
    __device__ __forceinline__ void operator()(const f32x4 (&acc)[2][2][4][2], const g8::Unit& u, int wr, int wc, int fr, int fq) const {
        unsigned char* O = u.aux ? SHH : HB;
#pragma unroll
        for (int ai = 0; ai < 2; ++ai)
#pragma unroll
            for (int m = 0; m < 4; ++m) {
                if (ai * 128 + wr * 64 + m * 16 + fr >= u.nv) continue;
                f32x4 h0, h1;
#pragma unroll
                for (int j = 0; j < 4; ++j) { const float a0 = acc[ai][0][m][0][j] * (1.f / W13SC), a1 = acc[ai][0][m][1][j] * (1.f / W13SC);
                    h0[j] = a0 * __builtin_amdgcn_rcpf(1.f + __builtin_amdgcn_exp2f(-1.4426950408889634f * a0)) * (acc[ai][1][m][0][j] * (HSC / W13SC));
                    h1[j] = a1 * __builtin_amdgcn_rcpf(1.f + __builtin_amdgcn_exp2f(-1.4426950408889634f * a1)) * (acc[ai][1][m][1][j] * (HSC / W13SC)); }
                u32x2 w; int pk = 0;
                pk = __builtin_amdgcn_cvt_pk_fp8_f32(h0[0], h0[1], pk, false); pk = __builtin_amdgcn_cvt_pk_fp8_f32(h0[2], h0[3], pk, true); w.x = (unsigned)pk;
                pk = __builtin_amdgcn_cvt_pk_fp8_f32(h1[0], h1[1], pk, false); pk = __builtin_amdgcn_cvt_pk_fp8_f32(h1[2], h1[3], pk, true); w.y = (unsigned)pk;
                *(u32x2*)(O + (size_t)(u.orow + ai * 128 + wr * 64 + m * 16 + fr) * DE + u.pn * 128 + wc * 32 + 8 * fq) = w;
            }
    }
};
struct EpiDown {
    static constexpr int PERM = 3;
    unsigned char* Y; unsigned char* YS;
    __device__ __forceinline__ void operator()(const f32x4 (&acc)[2][2][4][2], const g8::Unit& u, int wr, int wc, int fr, int fq) const {
        unsigned char* O = u.aux ? YS : Y;
#pragma unroll
        for (int ai = 0; ai < 2; ++ai)
#pragma unroll
            for (int m = 0; m < 4; ++m) { if (ai * 128 + wr * 64 + m * 16 + fr >= u.nv) continue;
                u32x4 w;
#pragma unroll
                for (int q = 0; q < 4; ++q) { const f32x4 v = acc[ai][q >> 1][m][q & 1] * (1.f / (W2SC * HSC)); int pk = 0;
                    pk = __builtin_amdgcn_cvt_pk_fp8_f32(v[0], v[1], pk, false); pk = __builtin_amdgcn_cvt_pk_fp8_f32(v[2], v[3], pk, true); w[q] = (unsigned)pk; }
                *(u32x4*)(O + (size_t)(u.orow + ai * 128 + wr * 64 + m * 16 + fr) * YLD8 + u.pn * 256 + wc * 64 + 16 * fq) = w; }
    }
};
struct SchedDense {
    const char* A; const char* Bt; int K, nM, nN, G, c;
    __device__ __forceinline__ bool next(int i, g8::Unit& u) const {
        int wgid; if (!g8::work_id(i, G, c, nM * nN, wgid)) return false;
        const int nig = 8 * nN, gid = wgid / nig, fm = gid * 8, gsz = (nM - fm) < 8 ? (nM - fm) : 8;
        const int pm = fm + ((wgid % nig) % gsz), pn = (wgid % nig) / gsz;
        u.A = A; u.rows = nullptr; u.row0 = pm * 256; u.Bt = Bt + (size_t)pn * 256 * K * 2; u.orow = pm * 256; u.pn = pn; u.aux = 0; return true;
    }
};
struct SchedUp {
    const int* tp; const char* H2; const int* LIST; const char* E13T; const char* S13T; int G, c;
    __device__ __forceinline__ bool next(int i, g8::Unit& u) const {
        const int T = tp[NE]; int wgid; if (!g8::work_id(i, G, c, 4 * T + 128, wgid)) return false;
        u.A = H2;
        if (wgid < 4 * T) {
            int e = 0;
#pragma unroll
            for (int s = 32; s > 0; s >>= 1) if (4 * tp[e + s] <= wgid) e += s;
            const int tc = tp[e + 1] - tp[e], li = wgid - 4 * tp[e], nt = li / tc, mt = li % tc, r0 = (tp[e] + mt) * 256;
            u.rows = LIST + r0; u.row0 = 0; u.Bt = E13T + ((size_t)e * 1024 + nt * 256) * D; u.orow = r0; u.pn = nt; u.aux = 0; u.nv = min(256, tp[80 + e] - mt * 256);
        } else {
            const int s = wgid - 4 * T, pn = s / 32, pm = s % 32;
            u.rows = nullptr; u.row0 = pm * 256; u.Bt = S13T + (size_t)pn * 256 * D; u.orow = pm * 256; u.pn = pn; u.aux = 1; u.nv = 256;
        }
        return true;
    }
};
struct SchedDown {
    const int* tp; const char* HB; const char* E2T; const char* SHH; const char* S2T; int G, c;
    __device__ __forceinline__ bool next(int i, g8::Unit& u) const {
        const int T = tp[NE]; int wgid; if (!g8::work_id(i, G, c, 8 * T + 256, wgid)) return false;
        u.rows = nullptr;
        if (wgid < 8 * T) {
            int e = 0;
#pragma unroll
            for (int s = 32; s > 0; s >>= 1) if (8 * tp[e + s] <= wgid) e += s;
            const int tc = tp[e + 1] - tp[e], li = wgid - 8 * tp[e], nt = li / tc, mt = li % tc, r0 = (tp[e] + mt) * 256;
            u.A = HB; u.row0 = r0; u.Bt = E2T + ((size_t)e * D + nt * 256) * DE; u.orow = r0; u.pn = nt; u.aux = 0; u.nv = min(256, tp[80 + e] - mt * 256);
        } else {
            const int s = wgid - 8 * T, pn = s / 32, pm = s % 32;
            u.A = SHH; u.row0 = pm * 256; u.Bt = S2T + (size_t)pn * 256 * DE; u.orow = pm * 256; u.pn = pn; u.aux = 1; u.nv = 256;
        }
        return true;
    }
};
__device__ __forceinline__ void moe_tables(const Params& p, int* tp, const int wid0) {
    __syncthreads();
    if (wid0 == 0 && xb_lane_id() == 0) { int tt = 0; for (int e = 0; e < NE; ++e) { const int cn = p.CNT[e]; tp[e] = tt; tp[80 + e] = cn; tt += (cn + 255) / 256; } tp[NE] = tt; }
    __syncthreads();
}

constexpr int NTILE = 136;
__device__ void ph_naprep(const Params& p, const int wid0, const int ubeg, const int uend, const int ustep) {
    const int t = opaque_tid(wid0), w = t >> 6, lane = t & 63, kk = lane >> 4, pc = lane & 15;
    for (int u = ubeg; u < uend; u += ustep) {
        const int b = u / NTILE, T = u % NTILE; const bool lat = T < 128;
        const int row0 = lat ? (b * SEQ + 32 * T) : (NLAT + b * CTXL + 32 * (T - 128));
#pragma unroll 2
        for (int it = w; it < 128; it += 8) {
            const int which = it & 1, hh = (it >> 1) & 7, tt = 4 * (it >> 4) + kk;
            if (which == 0 && !lat) continue;
            float4 v0, v1;
            if (lat) { const u32x4 r8 = *(const u32x4*)(p.P + (size_t)(row0 + tt) * PLD + which * 1024 + hh * 128 + 8 * pc);
                v0 = make_float4(bf2f(r8.x & 0xffffu), bf2f(r8.x >> 16), bf2f(r8.y & 0xffffu), bf2f(r8.y >> 16)); v1 = make_float4(bf2f(r8.z & 0xffffu), bf2f(r8.z >> 16), bf2f(r8.w & 0xffffu), bf2f(r8.w >> 16)); }
            else {
                const float* src = p.PS + (size_t)(row0 - NLAT + tt) * PSLD + hh * 128 + 8 * pc;
                v0 = *(const float4*)src; v1 = *(const float4*)(src + 4);
#pragma unroll
                for (int s = 1; s < 4; ++s) { const float4 a0 = *(const float4*)(src + s * PS_SLAB), a1 = *(const float4*)(src + s * PS_SLAB + 4);
                    v0.x += a0.x; v0.y += a0.y; v0.z += a0.z; v0.w += a0.w; v1.x += a1.x; v1.y += a1.y; v1.z += a1.z; v1.w += a1.w; }
            }
            float ss = v0.x * v0.x + v0.y * v0.y + v0.z * v0.z + v0.w * v0.w + v1.x * v1.x + v1.y * v1.y + v1.z * v1.z + v1.w * v1.w;
            ss += __shfl_xor(ss, 1); ss += __shfl_xor(ss, 2); ss += __shfl_xor(ss, 4); ss += __shfl_xor(ss, 8);
            const float* gp = (which ? p.k_norm_g : p.q_norm_g) + 8 * pc;
            const float4 g0 = *(const float4*)gp, g1 = *(const float4*)(gp + 4);
            const float r = rsqrtf(ss * (1.f / 128.f) + 1e-6f) * (which ? 1.f : 0.08838834764831845f * 1.4426950408889634f);
            u32x4 o;
            o.x = cvt_pk_bf16(v0.x * r * g0.x, v0.y * r * g0.y); o.y = cvt_pk_bf16(v0.z * r * g0.z, v0.w * r * g0.w);
            o.z = cvt_pk_bf16(v1.x * r * g1.x, v1.y * r * g1.y); o.w = cvt_pk_bf16(v1.z * r * g1.z, v1.w * r * g1.w);
            if (which) *(u32x4*)(p.NKf + (((size_t)((b * 8 + hh) * NTILE + T) * 8 + (pc >> 1)) * 64 + tt + 32 * (pc & 1)) * 8) = o;
            else *(u32x4*)(p.NQb + (size_t)(row0 + tt) * 1024 + hh * 128 + 8 * pc) = o;
        }
        if (lat) {
            const int col = 2 * t, hh = col >> 7, dv = col & 127;
            unsigned wv[32];
#pragma unroll
            for (int s = 0; s < 32; ++s) wv[s] = *(const unsigned*)(p.P + (size_t)(row0 + s) * PLD + 2048 + col);
            unsigned pk0[16], pk1[16];
#pragma unroll
            for (int s2 = 0; s2 < 16; ++s2) { pk0[s2] = (wv[2 * s2] & 0xffffu) | (wv[2 * s2 + 1] << 16); pk1[s2] = (wv[2 * s2] >> 16) | (wv[2 * s2 + 1] & 0xffff0000u); }
            bf16_t* o = p.VTf + ((((size_t)((b * 8 + hh) * NTILE + T) * 4 + (dv >> 5)) * 2) * 64 + (dv & 31)) * 8;
#pragma unroll
            for (int g2 = 0; g2 < 2; ++g2) {
                *(u32x4*)(o + (g2 * 64) * 8) = (u32x4){pk0[8 * g2], pk0[8 * g2 + 1], pk0[8 * g2 + 4], pk0[8 * g2 + 5]};
                *(u32x4*)(o + (g2 * 64 + 32) * 8) = (u32x4){pk0[8 * g2 + 2], pk0[8 * g2 + 3], pk0[8 * g2 + 6], pk0[8 * g2 + 7]};
                *(u32x4*)(o + (g2 * 64 + 1) * 8) = (u32x4){pk1[8 * g2], pk1[8 * g2 + 1], pk1[8 * g2 + 4], pk1[8 * g2 + 5]};
                *(u32x4*)(o + (g2 * 64 + 33) * 8) = (u32x4){pk1[8 * g2 + 2], pk1[8 * g2 + 3], pk1[8 * g2 + 6], pk1[8 * g2 + 7]};
            }
        } else {
#pragma unroll 1
        for (int i = 0; i < 2; ++i) {
            const int col = t + 512 * i, hh = col >> 7, dv = col & 127;
            unsigned pk[16];
#pragma unroll
            for (int s2 = 0; s2 < 16; ++s2) {
                const float* s0 = p.PS + (size_t)(row0 - NLAT + 2 * s2) * PSLD + 1024 + col;
                const float x0 = s0[0] + s0[PS_SLAB] + s0[2 * PS_SLAB] + s0[3 * PS_SLAB], x1 = s0[PSLD] + s0[PS_SLAB + PSLD] + s0[2 * PS_SLAB + PSLD] + s0[3 * PS_SLAB + PSLD];
                pk[s2] = cvt_pk_bf16(x0, x1);
            }
            bf16_t* o = p.VTf + ((((size_t)((b * 8 + hh) * NTILE + T) * 4 + (dv >> 5)) * 2) * 64 + (dv & 31)) * 8;
#pragma unroll
            for (int g2 = 0; g2 < 2; ++g2) {
                *(u32x4*)(o + (g2 * 64) * 8) = (u32x4){pk[8 * g2], pk[8 * g2 + 1], pk[8 * g2 + 4], pk[8 * g2 + 5]};
                *(u32x4*)(o + (g2 * 64 + 32) * 8) = (u32x4){pk[8 * g2 + 2], pk[8 * g2 + 3], pk[8 * g2 + 6], pk[8 * g2 + 7]};
            }
        }
        }
    }
}

__device__ __forceinline__ void attn_tile(const LAS unsigned char* sb, const float* bt0, const bf16x8 (&qf)[8], f32x16& o0, f32x16& o1, f32x16& o2, f32x16& o3, float& m, float& l,
                                          bool loc, int half, int dr, int c, int cs, int hi) {
    bf16x8 kc[8], va[8];
#pragma unroll
    for (int ks = 0; ks < 8; ++ks) kc[ks] = *(const LAS bf16x8*)(sb + ks * 1024);
#pragma unroll
    for (int q = 0; q < 8; ++q) va[q] = *(const LAS bf16x8*)(sb + 8192 + q * 1024);
    f32x16 s;
#pragma unroll
    for (int e = 0; e < 16; ++e) s[e] = 0.f;
#pragma unroll
    for (int ks = 0; ks < 8; ++ks) s = __builtin_amdgcn_mfma_f32_32x32x16_bf16(kc[ks], qf[ks], s, 0, 0, 0);
    if (loc) {
        int rel0 = 32 * half + 4 * hi - cs; asm volatile("" : "+v"(rel0));
        const float* bt = bt0 + dr * 31 + cs - c + 15;
        float bz[16];
#pragma unroll
        for (int e = 0; e < 16; ++e) bz[e] = bt[rel0 + (e & 3) + 8 * (e >> 2)];
#pragma unroll
        for (int e = 0; e < 16; ++e) asm volatile("" : "+v"(bz[e]));
#pragma unroll
        for (int e = 0; e < 16; ++e) {
            const int rel = rel0 + (e & 3) + 8 * (e >> 2);
            s[e] = ((unsigned)rel < 16u) ? (s[e] + bz[e]) : -INFINITY;
        }
    }
    float mt = s[0];
#pragma unroll
    for (int e = 1; e < 16; ++e) mt = fmaxf(mt, s[e]);
    mt = fmaxf(mt, __shfl_xor(mt, 32));
    if (__any(mt > m)) {
        const float mn = fmaxf(m, mt);
        const float alpha = __builtin_amdgcn_exp2f(m - mn);
        m = mn; l *= alpha;
#pragma unroll
        for (int e = 0; e < 16; ++e) { o0[e] *= alpha; o1[e] *= alpha; o2[e] *= alpha; o3[e] *= alpha; }
    }
    float ps = 0.f;
#pragma unroll
    for (int e = 0; e < 16; ++e) { s[e] = __builtin_amdgcn_exp2f(s[e] - m); ps += s[e]; }
    l += ps;
    bf16x8 pb[2];
#pragma unroll
    for (int s2 = 0; s2 < 2; ++s2) {
        const u32x4 cat = (u32x4){cvt_pk_bf16(s[8 * s2], s[8 * s2 + 1]), cvt_pk_bf16(s[8 * s2 + 2], s[8 * s2 + 3]), cvt_pk_bf16(s[8 * s2 + 4], s[8 * s2 + 5]), cvt_pk_bf16(s[8 * s2 + 6], s[8 * s2 + 7])};
        pb[s2] = __builtin_bit_cast(bf16x8, cat);
    }
#pragma unroll
    for (int s2 = 0; s2 < 2; ++s2) {
        o0 = __builtin_amdgcn_mfma_f32_32x32x16_bf16(va[0 + s2], pb[s2], o0, 0, 0, 0);
        o1 = __builtin_amdgcn_mfma_f32_32x32x16_bf16(va[2 + s2], pb[s2], o1, 0, 0, 0);
        o2 = __builtin_amdgcn_mfma_f32_32x32x16_bf16(va[4 + s2], pb[s2], o2, 0, 0, 0);
        o3 = __builtin_amdgcn_mfma_f32_32x32x16_bf16(va[6 + s2], pb[s2], o3, 0, 0, 0);
    }
}
__device__ __forceinline__ void glascan_wave(const Params& p, int unit, int dh, int lane, LAS unsigned char* ldsw);
__device__ void ph_attn(const Params& p, unsigned char* smb, const int wid0) {
    const int t = opaque_tid(wid0), lane = t & 63, l31 = lane & 31, hi = lane >> 5;
    const int w = __builtin_amdgcn_readfirstlane(t >> 6);
    LAS unsigned char* lds = (LAS unsigned char*)smb;
    for (int u0 = blockIdx.x; u0 < 256; u0 += gridDim.x) { const int unit = (((u0 & 7) + 8 * (u0 >> 7)) << 4) | ((u0 >> 3) & 15); glascan_wave(p, unit, w, lane, lds + w * 8192); }
    float* tab = (float*)(smb + 4 * 16384);
    for (int u0 = blockIdx.x; u0 < 256; u0 += gridDim.x) {
        const int u = (((u0 & 7) + 8 * (u0 >> 7)) << 4) | ((u0 >> 3) & 15);
        const int rg = u & 15, h = (u >> 4) & 7, b = u >> 7, bh8 = b * 8 + h;
        asm volatile("s_waitcnt vmcnt(0)" ::: "memory");
        __syncthreads();
        for (int i = t; i < 465; i += NT) tab[i] = p.na_rpb[h * 465 + i] * 1.4426950408889634f;
        const int r = 4 * rg + (w >> 1), qt = w & 1, c = 32 * qt + l31;
        const int rs = min(max(r - 4, 0), 56), cs = min(max(c - 8, 0), 48);
        const int Rlo = min(max(4 * rg - 4, 0), 56), Rhi = min(max(4 * rg - 1, 0), 56) + 7, nt = 8 + 2 * (Rhi - Rlo + 1);
        const int qrow = b * SEQ + r * 64 + c;
        bf16x8 qf[8];
#pragma unroll
        for (int ks = 0; ks < 8; ++ks) qf[ks] = *(const bf16x8*)(p.NQb + (size_t)qrow * 1024 + h * 128 + 16 * ks + 8 * hi);
#pragma unroll
        for (int ks = 0; ks < 8; ++ks) asm volatile("" : "+v"(qf[ks]));
        f32x16 o0, o1, o2, o3;
#pragma unroll
        for (int e = 0; e < 16; ++e) { o0[e] = 0.f; o1[e] = 0.f; o2[e] = 0.f; o3[e] = 0.f; }
        float m = -INFINITY, l = 0.f;
        const bf16_t* kg = p.NKf + ((size_t)bh8 * NTILE * 8 + w) * 512 + lane * 8;
        const bf16_t* vg = p.VTf + ((size_t)bh8 * NTILE * 8 + w) * 512 + lane * 8;
#define AT_T(i_) ((i_) < 8 ? (128 + (i_)) : (2 * Rlo + ((i_) - 8)))
#define AT_DMA(i_, st_) do { const int ii_ = (i_) < nt ? (i_) : nt - 1; const size_t to_ = (size_t)AT_T(ii_) * 4096; \
        __builtin_amdgcn_global_load_lds((const unsigned*)(kg + to_), (LAS unsigned*)(lds + (st_) * 16384 + w * 1024), 16, 0, 0); \
        __builtin_amdgcn_global_load_lds((const unsigned*)(vg + to_), (LAS unsigned*)(lds + (st_) * 16384 + 8192 + w * 1024), 16, 0, 0); } while (0)
        asm volatile("s_waitcnt vmcnt(0)" ::: "memory");
        __syncthreads();
        AT_DMA(0, 0); AT_DMA(1, 1); AT_DMA(2, 2);
        int st = 0;
#pragma unroll 1
        for (int i = 0; i < nt; ++i) {
            asm volatile("s_waitcnt vmcnt(4)" ::: "memory");
            __builtin_amdgcn_s_barrier();
            asm volatile("" ::: "memory");
            const int st2 = (st + 3) & 3;
            AT_DMA(i + 3, st2);
            const bool loc = i >= 8; const int R = Rlo + ((i - 8) >> 1), half = (i - 8) & 1;
            if (!loc || (unsigned)(R - rs) < 8u)
                attn_tile(lds + st * 16384 + lane * 16, tab, qf, o0, o1, o2, o3, m, l, loc, half, R - r + 7, c, cs, hi);
            st = (st + 1) & 3;
        }
#undef AT_T
#undef AT_DMA
        l += __shfl_xor(l, 32);
        const float inv = 1.f / l;
        bf16_t* orow = p.MIX + (size_t)qrow * D + h * 128 + 4 * hi;
#pragma unroll
        for (int g = 0; g < 4; ++g) {
            u32x2 pk;
            pk.x = cvt_pk_bf16(o0[4 * g] * inv, o0[4 * g + 1] * inv); pk.y = cvt_pk_bf16(o0[4 * g + 2] * inv, o0[4 * g + 3] * inv); *(u32x2*)(orow + 0 + 8 * g) = pk;
            pk.x = cvt_pk_bf16(o1[4 * g] * inv, o1[4 * g + 1] * inv); pk.y = cvt_pk_bf16(o1[4 * g + 2] * inv, o1[4 * g + 3] * inv); *(u32x2*)(orow + 32 + 8 * g) = pk;
            pk.x = cvt_pk_bf16(o2[4 * g] * inv, o2[4 * g + 1] * inv); pk.y = cvt_pk_bf16(o2[4 * g + 2] * inv, o2[4 * g + 3] * inv); *(u32x2*)(orow + 64 + 8 * g) = pk;
            pk.x = cvt_pk_bf16(o3[4 * g] * inv, o3[4 * g + 1] * inv); pk.y = cvt_pk_bf16(o3[4 * g + 2] * inv, o3[4 * g + 3] * inv); *(u32x2*)(orow + 96 + 8 * g) = pk;
        }
    }
    asm volatile("s_waitcnt vmcnt(0)" ::: "memory");
}

__device__ __forceinline__ float logsigf(float z) { return fminf(z, 0.f) - log1pf(expf(-fabsf(z))); }

__device__ __forceinline__ float fexp2(float x) { return __builtin_amdgcn_exp2f(x); }
__device__ __forceinline__ float logsig2_16(float z) { return (fminf(z, 0.f) * 1.4426950408889634f - __builtin_amdgcn_logf(1.f + fexp2(-fabsf(z) * 1.4426950408889634f))) * (1.f / 16.f); }

__device__ void ph_glaprep(const Params& p, float* sm, const int wid0, const int ubeg, const int uend, const int ustep) {
    const int t = opaque_tid(wid0), d2 = t & 63, tq = t >> 6, d = 2 * d2;
    float* qs = sm;
    float* ksm = sm + 8192;
    float* dds = sm + 16384;
    float* tot = sm + 16384 + 2048;
    for (int u = ubeg; u < uend; u += ustep) {
        const int bh = u / 68, c = u % 68, b = bh >> 2, h = bh & 3;
        const bool lat = c >= 4; const int j = c - 4;
        const int row0 = lat ? (b * SEQ + 64 * j) : (NLAT + b * CTXL + 64 * c);
        __syncthreads();
        {
            const int cq = t & 31, tr = t >> 5;
#pragma unroll
            for (int i = 0; i < 4; ++i) { const int tt = tr + 16 * i;
                if (lat) {
                    const u32x2 q4 = *(const u32x2*)(p.P + (size_t)(row0 + tt) * PLD + 3072 + h * 128 + 4 * cq), k4 = *(const u32x2*)(p.P + (size_t)(row0 + tt) * PLD + 3584 + h * 128 + 4 * cq);
                    *(float4*)(qs + tt * 128 + 4 * cq) = make_float4(bf2f(q4.x & 0xffffu), bf2f(q4.x >> 16), bf2f(q4.y & 0xffffu), bf2f(q4.y >> 16));
                    *(float4*)(ksm + tt * 128 + 4 * cq) = make_float4(bf2f(k4.x & 0xffffu), bf2f(k4.x >> 16), bf2f(k4.y & 0xffffu), bf2f(k4.y >> 16));
                } else {
                    const float* src = p.PS + (size_t)(row0 - NLAT + tt) * PSLD + 2048 + h * 128 + 4 * cq;
                    float4 kv = *(const float4*)src;
#pragma unroll
                    for (int s = 1; s < 4; ++s) { const float4 a0 = *(const float4*)(src + s * PS_SLAB); kv.x += a0.x; kv.y += a0.y; kv.z += a0.z; kv.w += a0.w; }
                    *(float4*)(qs + tt * 128 + 4 * cq) = make_float4(0.f, 0.f, 0.f, 0.f); *(float4*)(ksm + tt * 128 + 4 * cq) = kv;
                } }
            { const float* src = p.DDS + (size_t)row0 * 32 + 4 * t; float4 dv = *(const float4*)src;
#pragma unroll
              for (int s = 1; s < 4; ++s) { const float4 a0 = *(const float4*)(src + s * DD_SLAB); dv.x += a0.x; dv.y += a0.y; dv.z += a0.z; dv.w += a0.w; }
              *(float4*)(dds + 4 * t) = dv; }
        }
        __syncthreads();
        float gf0[8], gf1[8], gb0[8], gb1[8];
        {
            float uf0[16], uf1[16], ub0[16], ub1[16];
#pragma unroll
            for (int r = 0; r < 16; ++r) { const float2 a = *(const float2*)(p.up_f + r * 512 + h * 128 + d), bq = *(const float2*)(p.up_b + r * 512 + h * 128 + d); uf0[r] = a.x; uf1[r] = a.y; ub0[r] = bq.x; ub1[r] = bq.y; }
            const float2 bf = *(const float2*)(p.bias_f + h * 128 + d), bb = *(const float2*)(p.bias_b + h * 128 + d);
            float sf0 = 0.f, sf1 = 0.f, sb0 = 0.f, sb1 = 0.f;
#pragma unroll
            for (int i = 0; i < 8; ++i) {
                const float* dr = dds + (8 * tq + i) * 32; float zf0 = bf.x, zf1 = bf.y, zb0 = bb.x, zb1 = bb.y;
#pragma unroll
                for (int r = 0; r < 16; ++r) { const float x = dr[r], y = dr[16 + r]; zf0 += x * uf0[r]; zf1 += x * uf1[r]; zb0 += y * ub0[r]; zb1 += y * ub1[r]; }
                gf0[i] = logsig2_16(zf0); gf1[i] = logsig2_16(zf1); gb0[i] = logsig2_16(zb0); gb1[i] = logsig2_16(zb1);
                sf0 += gf0[i]; sf1 += gf1[i]; sb0 += gb0[i]; sb1 += gb1[i];
            }
            *(float2*)(tot + tq * 128 + d) = make_float2(sf0, sf1); *(float2*)(tot + (8 + tq) * 128 + d) = make_float2(sb0, sb1);
        }
        __syncthreads();
        float2 basef = make_float2(0.f, 0.f), baseb = basef, allf = basef, allb = basef;
#pragma unroll
        for (int q8 = 0; q8 < 8; ++q8) { const float2 a = *(const float2*)(tot + q8 * 128 + d), bq = *(const float2*)(tot + (8 + q8) * 128 + d);
            allf.x += a.x; allf.y += a.y; allb.x += bq.x; allb.y += bq.y;
            if (q8 < tq) { basef.x += a.x; basef.y += a.y; } if (q8 > tq) { baseb.x += bq.x; baseb.y += bq.y; } }
        { float r0 = basef.x, r1 = basef.y;
#pragma unroll
          for (int i = 0; i < 8; ++i) { r0 += gf0[i]; gf0[i] = r0; r1 += gf1[i]; gf1[i] = r1; }
          r0 = baseb.x; r1 = baseb.y;
#pragma unroll
          for (int i = 7; i >= 0; --i) { r0 += gb0[i]; gb0[i] = r0; r1 += gb1[i]; gb1[i] = r1; } }
        const int dd2 = d & 63, ii = dd2 & 31, partner = (dd2 < 32) ? (d + 32) : (d - 32);
        const float sgn = (dd2 < 32) ? -1.f : 1.f;
        unsigned khf0[4], khf1[4], khb0[4], khb1[4]; float pf0 = 0.f, pf1 = 0.f, pb0 = 0.f, pb1 = 0.f;
        const size_t tb = ((size_t)(bh * 64 + j) * 64) * 128;
#pragma unroll
        for (int i = 0; i < 8; ++i) {
            const int tt = 8 * tq + i;
            float2 qv = *(const float2*)(qs + tt * 128 + d), kv = *(const float2*)(ksm + tt * 128 + d);
            if (lat) {
                const int pos = (d < 64) ? j : tt;
                const float4 cssn = *(const float4*)(p.RT + (pos * 32 + ii) * 2);
                const float2 qp = *(const float2*)(qs + tt * 128 + partner), kp = *(const float2*)(ksm + tt * 128 + partner);
                qv.x = qv.x * cssn.x + sgn * qp.x * cssn.y; qv.y = qv.y * cssn.z + sgn * qp.y * cssn.w;
                kv.x = kv.x * cssn.x + sgn * kp.x * cssn.y; kv.y = kv.y * cssn.z + sgn * kp.y * cssn.w;
            }
            qv.x *= 0.08838834764831845f; qv.y *= 0.08838834764831845f;
            if (lat) {
                const float ef0 = fexp2(gf0[i]), ef1 = fexp2(gf1[i]), eb0 = fexp2(gb0[i]), eb1 = fexp2(gb1[i]);
                const float nf0 = fexp2(-gf0[i]), nf1 = fexp2(-gf1[i]), nb0 = fexp2(-gb0[i]), nb1 = fexp2(-gb1[i]);
                const size_t o = tb + (size_t)tt * 128 + d;
                *(unsigned*)(p.QF + o) = cvt_pk_bf16(qv.x * ef0, qv.y * ef1); *(unsigned*)(p.KF + o) = cvt_pk_bf16(kv.x * nf0, kv.y * nf1);
                *(unsigned*)(p.QB + o) = cvt_pk_bf16(qv.x * eb0, qv.y * eb1); *(unsigned*)(p.KB + o) = cvt_pk_bf16(kv.x * nb0, kv.y * nb1);
            }
            const float hf0 = kv.x * fexp2(allf.x - gf0[i]), hf1 = kv.y * fexp2(allf.y - gf1[i]), hb0 = kv.x * fexp2(allb.x - gb0[i]), hb1 = kv.y * fexp2(allb.y - gb1[i]);
            if (i & 1) { khf0[i >> 1] = cvt_pk_bf16(pf0, hf0); khf1[i >> 1] = cvt_pk_bf16(pf1, hf1); khb0[i >> 1] = cvt_pk_bf16(pb0, hb0); khb1[i >> 1] = cvt_pk_bf16(pb1, hb1); }
            else { pf0 = hf0; pf1 = hf1; pb0 = hb0; pb1 = hb1; }
        }
        {
            const size_t o = ((((size_t)(bh * 68 + c) * 8 + (d >> 4)) * 2 + (tq >> 2)) * 64 + (d & 15) + 16 * (tq & 3)) * 8;
            *(u32x4*)(p.KHF + o) = (u32x4){khf0[0], khf0[1], khf0[2], khf0[3]}; *(u32x4*)(p.KHF + o + 8) = (u32x4){khf1[0], khf1[1], khf1[2], khf1[3]};
            *(u32x4*)(p.KHB + o) = (u32x4){khb0[0], khb0[1], khb0[2], khb0[3]}; *(u32x4*)(p.KHB + o + 8) = (u32x4){khb1[0], khb1[1], khb1[2], khb1[3]};
            if (tq == 0) { *(float2*)(p.DF + (size_t)(bh * 68 + c) * 128 + d) = make_float2(fexp2(allf.x), fexp2(allf.y)); *(float2*)(p.DB + (size_t)(bh * 68 + c) * 128 + d) = make_float2(fexp2(allb.x), fexp2(allb.y)); }
        }
        if (lat) {
            const int v = 2 * (t & 127), qr = t >> 7;
            unsigned wv[16];
#pragma unroll
            for (int s = 0; s < 16; ++s) wv[s] = *(const unsigned*)(p.P + (size_t)(row0 + 16 * qr + s) * PLD + 4096 + h * 256 + v);
            unsigned pk0[8], pk1[8];
#pragma unroll
            for (int s2 = 0; s2 < 8; ++s2) { pk0[s2] = (wv[2 * s2] & 0xffffu) | (wv[2 * s2 + 1] << 16); pk1[s2] = (wv[2 * s2] >> 16) | (wv[2 * s2 + 1] & 0xffff0000u); }
            bf16_t* o = p.VT + ((size_t)(bh * 68 + c) * 256 + v) * 64 + 16 * qr;
#pragma unroll
            for (int q8 = 0; q8 < 2; ++q8) {
                const u32x4 a0 = (u32x4){pk0[4 * q8], pk0[4 * q8 + 1], pk0[4 * q8 + 2], pk0[4 * q8 + 3]}, a1 = (u32x4){pk1[4 * q8], pk1[4 * q8 + 1], pk1[4 * q8 + 2], pk1[4 * q8 + 3]};
                *(u32x4*)(o + 8 * q8) = a0; *(u32x4*)(o + 64 + 8 * q8) = a1;
                bf16_t* o2 = p.VTS + ((((size_t)(bh * 68 + c) * 16 + (v >> 4)) * 2 + (qr >> 1)) * 64 + (v & 15) + 16 * ((2 * qr + q8) & 3)) * 8;
                *(u32x4*)o2 = a0; *(u32x4*)(o2 + 8) = a1;
            }
        } else {
            const int v = t & 255, half = t >> 8;
            unsigned pk[16];
#pragma unroll
            for (int s2 = 0; s2 < 16; ++s2) {
                const float* s0 = p.PS + (size_t)(row0 - NLAT + 32 * half + 2 * s2) * PSLD + 2560 + h * 256 + v;
                const float a = s0[0] + s0[PS_SLAB] + s0[2 * PS_SLAB] + s0[3 * PS_SLAB], bq = s0[PSLD] + s0[PS_SLAB + PSLD] + s0[2 * PS_SLAB + PSLD] + s0[3 * PS_SLAB + PSLD];
                pk[s2] = cvt_pk_bf16(a, bq);
            }
            bf16_t* o = p.VT + ((size_t)(bh * 68 + c) * 256 + v) * 64 + 32 * half;
            bf16_t* o2 = p.VTS + ((((size_t)(bh * 68 + c) * 16 + (v >> 4)) * 2 + half) * 64 + (v & 15)) * 8;
#pragma unroll
            for (int q4 = 0; q4 < 4; ++q4) { const u32x4 pv = (u32x4){pk[4 * q4], pk[4 * q4 + 1], pk[4 * q4 + 2], pk[4 * q4 + 3]}; *(u32x4*)(o + 8 * q4) = pv; *(u32x4*)(o2 + (16 * q4) * 8) = pv; }
        }
    }
}

__device__ __forceinline__ void glascan_wave(const Params& p, int unit, int dh, int lane, LAS unsigned char* ldsw) {
    const int v16 = unit & 15, scan = unit >> 4, dir = scan >> 3, bh = scan & 7;
    const int fr = lane & 15, fq = lane >> 4, d0 = 16 * dh, v0 = 16 * v16;
    const bf16_t* KH = (dir ? p.KHB : p.KHF) + (((size_t)bh * 68 * 8 + dh) * 2) * 512 + lane * 8;
    const bf16_t* VTp = p.VTS + (((size_t)bh * 68 * 16 + v16) * 2) * 512 + lane * 8;
    const float* DV = (dir ? p.DB : p.DF) + (size_t)bh * 68 * 128 + d0 + 4 * fq;
    bf16_t* SSp = p.SS + ((((size_t)dir * 8 + bh) * 65) * 256 + v0 + fr) * 128 + d0 + 4 * fq;
    LAS u32x2* sl = (LAS u32x2*)ldsw + lane;
    f32x4 acc = (f32x4){0.f, 0.f, 0.f, 0.f};
#define SC_CHUNK(n) (dir ? ((n) < 4 ? 3 - (n) : 71 - (n)) : (n))
#define SC_LOAD(S_, n) do { const int nn_ = (n) < 68 ? (n) : 67; const int c_ = SC_CHUNK(nn_); \
        S_##a0 = *(const bf16x8*)(KH + (size_t)c_ * 8192); S_##a1 = *(const bf16x8*)(KH + (size_t)c_ * 8192 + 512); \
        S_##b0 = *(const bf16x8*)(VTp + (size_t)c_ * 16384); S_##b1 = *(const bf16x8*)(VTp + (size_t)c_ * 16384 + 512); \
        S_##d = *(const f32x4*)(DV + (size_t)c_ * 128); } while (0)
#define SC_STEP(S_, k) do { u32x2 pk; pk.x = cvt_pk_bf16(acc[0], acc[1]); pk.y = cvt_pk_bf16(acc[2], acc[3]); sl[(k) * 64] = pk; \
        acc = acc * S_##d; \
        acc = __builtin_amdgcn_mfma_f32_16x16x32_bf16(S_##a0, S_##b0, acc, 0, 0, 0); acc = __builtin_amdgcn_mfma_f32_16x16x32_bf16(S_##a1, S_##b1, acc, 0, 0, 0); } while (0)
    bf16x8 Aa0, Aa1, Ab0, Ab1, Ba0, Ba1, Bb0, Bb1, Ca0, Ca1, Cb0, Cb1, Da0, Da1, Db0, Db1; f32x4 Ad, Bd, Cd, Dd;
    SC_LOAD(A, 0); SC_LOAD(B, 1); SC_LOAD(C, 2);
#pragma unroll 1
    for (int nb = 0; nb < 68; nb += 16) {
        const int iters = (nb + 16 <= 68) ? 4 : 1;
#pragma unroll 1
        for (int it = 0; it < iters; ++it) {
            const int n = nb + 4 * it;
            SC_LOAD(D, n + 3); SC_STEP(A, 4 * it);
            SC_LOAD(A, n + 4); SC_STEP(B, 4 * it + 1);
            SC_LOAD(B, n + 5); SC_STEP(C, 4 * it + 2);
            SC_LOAD(C, n + 6); SC_STEP(D, 4 * it + 3);
        }
#pragma unroll 1
        for (int k = 0; k < 4 * iters; ++k) { const int c_ = SC_CHUNK(nb + k); *(u32x2*)(SSp + (size_t)(c_ >= 4 ? c_ - 4 : 64) * 256 * 128) = sl[k * 64]; }
    }
#undef SC_CHUNK
#undef SC_LOAD
#undef SC_STEP
}

__device__ void ph_glaout(const Params& p, unsigned char* smb, const int wid0) {
    const int t = opaque_tid(wid0), w = t >> 6, lane = t & 63, l31 = lane & 31, hi = lane >> 5;
    const int wv = w & 3, wt = w >> 2;
    bf16_t* att = (bf16_t*)smb;
    float* ssq = (float*)(smb + 2 * 64 * 144);
    for (int u = blockIdx.x; u < 512; u += gridDim.x) {
        const int bh = u >> 6, j = u & 63, b = bh >> 2, h = bh & 3;
        const size_t tb = ((size_t)(bh * 64 + j) * 64) * 128;
        {
            const int dir = w >> 2, ts = (w >> 1) & 1, tt = w & 1;
            const bf16_t* Qm = (dir ? p.QB : p.QF) + tb; const bf16_t* Km = (dir ? p.KB : p.KF) + tb;
            const bool zero = dir ? (ts < tt) : (ts > tt);
            f32x16 s;
#pragma unroll
            for (int r = 0; r < 16; ++r) s[r] = 0.f;
            if (!zero) {
#pragma unroll
                for (int ks = 0; ks < 8; ++ks) {
                    const bf16x8 ka = *(const bf16x8*)(Km + (size_t)(32 * ts + l31) * 128 + 16 * ks + 8 * hi);
                    const bf16x8 qb = *(const bf16x8*)(Qm + (size_t)(32 * tt + l31) * 128 + 16 * ks + 8 * hi);
                    s = __builtin_amdgcn_mfma_f32_32x32x16_bf16(ka, qb, s, 0, 0, 0);
                }
            }
            const int tcol = 32 * tt + l31;
#pragma unroll
            for (int g = 0; g < 4; ++g) {
                float vv[4];
#pragma unroll
                for (int e = 0; e < 4; ++e) { const int srow = 32 * ts + 8 * g + 4 * hi + e; const bool keep = dir ? (srow >= tcol) : (srow <= tcol); vv[e] = keep ? s[4 * g + e] : 0.f; }
                u32x2 pk; pk.x = cvt_pk_bf16(vv[0], vv[1]); pk.y = cvt_pk_bf16(vv[2], vv[3]);
                *(u32x2*)(att + ((size_t)dir * 64 + tcol) * 72 + 32 * ts + 8 * g + 4 * hi) = pk;
            }
        }
        __syncthreads();
        f32x16 o0, o1;
#pragma unroll
        for (int r = 0; r < 16; ++r) { o0[r] = 0.f; o1[r] = 0.f; }
        const int tB = 32 * wt + l31;
        const bf16_t* vt0 = p.VT + ((size_t)(bh * 68 + 4 + j) * 256 + 64 * wv + l31) * 64 + 8 * hi;
#pragma unroll
        for (int dir = 0; dir < 2; ++dir) {
#pragma unroll
            for (int ks = 0; ks < 4; ++ks) {
                const bf16x8 bb = *(const bf16x8*)(att + ((size_t)dir * 64 + tB) * 72 + 16 * ks + 8 * hi);
                const bf16x8 a0 = *(const bf16x8*)(vt0 + 16 * ks), a1 = *(const bf16x8*)(vt0 + 32 * 64 + 16 * ks);
                o0 = __builtin_amdgcn_mfma_f32_32x32x16_bf16(a0, bb, o0, 0, 0, 0);
                o1 = __builtin_amdgcn_mfma_f32_32x32x16_bf16(a1, bb, o1, 0, 0, 0);
            }
            const bf16_t* ss0 = p.SS + ((((size_t)dir * 8 + bh) * 65 + j) * 256 + 64 * wv + l31) * 128 + 8 * hi;
            const bf16_t* qm = (dir ? p.QB : p.QF) + tb + (size_t)tB * 128 + 8 * hi;
#pragma unroll
            for (int ks = 0; ks < 8; ++ks) {
                const bf16x8 bb = *(const bf16x8*)(qm + 16 * ks);
                const bf16x8 a0 = *(const bf16x8*)(ss0 + 16 * ks), a1 = *(const bf16x8*)(ss0 + 32 * 128 + 16 * ks);
                o0 = __builtin_amdgcn_mfma_f32_32x32x16_bf16(a0, bb, o0, 0, 0, 0);
                o1 = __builtin_amdgcn_mfma_f32_32x32x16_bf16(a1, bb, o1, 0, 0, 0);
            }
        }
        float ss = 0.f;
#pragma unroll
        for (int r = 0; r < 16; ++r) ss += o0[r] * o0[r] + o1[r] * o1[r];
        ss += __shfl_xor(ss, 32);
        if (hi == 0) ssq[(wt * 4 + wv) * 32 + l31] = ss;
        __syncthreads();
        const float tot = ssq[(wt * 4 + 0) * 32 + l31] + ssq[(wt * 4 + 1) * 32 + l31] + ssq[(wt * 4 + 2) * 32 + l31] + ssq[(wt * 4 + 3) * 32 + l31];
        const float rstd = rsqrtf(tot * (1.f / 256.f) + 1e-6f);
        const int row = b * SEQ + 64 * j + tB;
        f32x4 gateA[2][4], gnA[2][4];
#pragma unroll
        for (int vt = 0; vt < 2; ++vt)
#pragma unroll
            for (int g = 0; g < 4; ++g) { const int v = 64 * wv + 32 * vt + 8 * g + 4 * hi;
                const u32x2 g4 = *(const u32x2*)(p.P + (size_t)row * PLD + 5120 + h * 256 + v);
                gateA[vt][g] = (f32x4){bf2f(g4.x & 0xffffu), bf2f(g4.x >> 16), bf2f(g4.y & 0xffffu), bf2f(g4.y >> 16)}; gnA[vt][g] = *(const f32x4*)(p.gla_norm_g + v); }
#pragma unroll
        for (int vt = 0; vt < 2; ++vt)
#pragma unroll
            for (int g = 0; g < 4; ++g) {
                const int v = 64 * wv + 32 * vt + 8 * g + 4 * hi;
                const f32x4 gate = gateA[vt][g], gn = gnA[vt][g];
                float ov[4];
#pragma unroll
                for (int e = 0; e < 4; ++e) { const float x = vt ? o1[4 * g + e] : o0[4 * g + e];
                    ov[e] = x * rstd * gn[e] * gate[e] * __builtin_amdgcn_rcpf(1.f + __builtin_amdgcn_exp2f(-1.4426950408889634f * gate[e])); }
                u32x2 pk; pk.x = cvt_pk_bf16(ov[0], ov[1]); pk.y = cvt_pk_bf16(ov[2], ov[3]);
                *(u32x2*)(p.MIX + (size_t)row * D + 1024 + h * 256 + v) = pk;
            }
        __syncthreads();
    }
}

__device__ void ph_norm2_router(const Params& p, float* sm, const int wid0) {
    const int t = opaque_tid(wid0), w = t >> 6, lane = t & 63;
    float* hs = sm;
    float* part = sm + 8 * D;
    int* hist = (int*)(sm + 8 * D + 8 * 8 * 64);
    const int G = gridDim.x, gpb = (NLAT / 8 + G - 1) / G;
    if (t < 64) hist[t] = 0;
    const int rb0 = blockIdx.x * gpb, rb1 = min(NLAT / 8, rb0 + gpb);
    float4 v[8];
    if (rb0 < rb1) {
#pragma unroll
        for (int j = 0; j < 8; ++j) v[j] = *(const float4*)(p.X1 + (size_t)(rb0 * 8 + w) * D + 256 * j + 4 * lane);
    }
    for (int rb = rb0; rb < rb1; ++rb) {
        const int row = rb * 8 + w, b = row / SEQ;
        const float* m = p.mod + (size_t)b * 6 * D;
        float ss = 0.f;
#pragma unroll
        for (int j = 0; j < 8; ++j) ss += v[j].x * v[j].x + v[j].y * v[j].y + v[j].z * v[j].z + v[j].w * v[j].w;
        ss = wave_sum(ss);
        const float rs = rsqrtf(ss * (1.f / D) + 1e-6f);
        __syncthreads();
        float4 vn[8];
        if (rb + 1 < rb1) {
#pragma unroll
            for (int j = 0; j < 8; ++j) vn[j] = *(const float4*)(p.X1 + (size_t)(row + 8) * D + 256 * j + 4 * lane);
        }
#pragma unroll
        for (int j = 0; j < 8; ++j) {
            const int col = 256 * j + 4 * lane;
            const float4 g = *(const float4*)(p.norm2_g + col), sh = *(const float4*)(m + 3 * D + col), sc = *(const float4*)(m + 4 * D + col);
            float4 o;
            o.x = v[j].x * rs * g.x * (1.f + sc.x) + sh.x; o.y = v[j].y * rs * g.y * (1.f + sc.y) + sh.y;
            o.z = v[j].z * rs * g.z * (1.f + sc.z) + sh.z; o.w = v[j].w * rs * g.w * (1.f + sc.w) + sh.w;
            *(float4*)(hs + w * D + col) = o;
            int pk = 0; pk = __builtin_amdgcn_cvt_pk_fp8_f32(o.x, o.y, pk, false); pk = __builtin_amdgcn_cvt_pk_fp8_f32(o.z, o.w, pk, true);
            *(unsigned*)((unsigned char*)p.H + (size_t)row * D + col) = (unsigned)pk;
        }
        if (rb + 1 < rb1) {
#pragma unroll
            for (int j = 0; j < 8; ++j) v[j] = vn[j];
        }
        __syncthreads();
        {
            const int e4 = t & 15, kp = t >> 4;
            float a[8][4];
#pragma unroll
            for (int r = 0; r < 8; ++r)
#pragma unroll
                for (int j = 0; j < 4; ++j) a[r][j] = 0.f;
#pragma unroll 4
            for (int kk = 0; kk < 64; ++kk) {
                const int k = kk * 32 + kp;
                const float4 wv = *(const float4*)(p.router_w + (size_t)k * NE + 4 * e4);
#pragma unroll
                for (int r = 0; r < 8; ++r) { const float hv = hs[r * D + k]; a[r][0] += hv * wv.x; a[r][1] += hv * wv.y; a[r][2] += hv * wv.z; a[r][3] += hv * wv.w; }
            }
#pragma unroll
            for (int r = 0; r < 8; ++r)
#pragma unroll
                for (int j = 0; j < 4; ++j) { float x = a[r][j]; x += __shfl_xor(x, 16); x += __shfl_xor(x, 32); a[r][j] = x; }
            if (lane < 16) {
#pragma unroll
                for (int r = 0; r < 8; ++r) *(float4*)(part + (w * 8 + r) * 64 + 4 * lane) = make_float4(a[r][0], a[r][1], a[r][2], a[r][3]);
            }
        }
        __syncthreads();
        {
            float lgt = 0.f;
#pragma unroll
            for (int i = 0; i < 8; ++i) lgt += part[(i * 8 + w) * 64 + lane];
            const float sc = 1.f / (1.f + expf(-lgt));
            const float bs = sc + p.router_bias[lane];
            float m1 = bs; m1 = fmaxf(m1, __shfl_xor(m1, 1)); m1 = fmaxf(m1, __shfl_xor(m1, 2)); m1 = fmaxf(m1, __shfl_xor(m1, 4));
            int ai = (bs == m1) ? lane : 64; ai = min(ai, __shfl_xor(ai, 1)); ai = min(ai, __shfl_xor(ai, 2)); ai = min(ai, __shfl_xor(ai, 4));
            float m2 = (lane == ai) ? -INFINITY : bs; m2 = fmaxf(m2, __shfl_xor(m2, 1)); m2 = fmaxf(m2, __shfl_xor(m2, 2)); m2 = fmaxf(m2, __shfl_xor(m2, 4));
            const float gs = m1 + m2;
            float g0 = __shfl(gs, 0), g1 = __shfl(gs, 8), g2 = __shfl(gs, 16), g3 = __shfl(gs, 24), g4 = __shfl(gs, 32), g5 = __shfl(gs, 40), g6 = __shfl(gs, 48), g7 = __shfl(gs, 56);
            unsigned selmask = 0u;
#pragma unroll
            for (int it = 0; it < 4; ++it) {
                float best = -INFINITY; int bi = 0;
                if (!(selmask & 1u) && g0 > best) { best = g0; bi = 0; }
                if (!(selmask & 2u) && g1 > best) { best = g1; bi = 1; }
                if (!(selmask & 4u) && g2 > best) { best = g2; bi = 2; }
                if (!(selmask & 8u) && g3 > best) { best = g3; bi = 3; }
                if (!(selmask & 16u) && g4 > best) { best = g4; bi = 4; }
                if (!(selmask & 32u) && g5 > best) { best = g5; bi = 5; }
                if (!(selmask & 64u) && g6 > best) { best = g6; bi = 6; }
                if (!(selmask & 128u) && g7 > best) { best = g7; bi = 7; }
                selmask |= 1u << bi;
            }
            float cand = ((selmask >> (lane >> 3)) & 1u) ? bs : -INFINITY;
            int myslot = -1; float ssum = 0.f;
#pragma unroll
            for (int k = 0; k < TOPK; ++k) {
                const float mv = wave_max(cand);
                const int idx = wave_min_i((cand == mv) ? lane : 64);
                const float sv = __shfl(sc, idx);
                ssum += sv;
                if (lane == idx) { myslot = k; cand = -INFINITY; }
            }
            if (myslot >= 0) {
                p.EIDX[row * TOPK + myslot] = lane;
                p.EW[row * TOPK + myslot] = sc / ssum * 2.5f;
                p.LRANK[row * TOPK + myslot] = atomicAdd(&hist[lane], 1);
            }
        }
    }
    __syncthreads();
    if (t < 64) p.CNTB[blockIdx.x * 64 + t] = hist[t];
}

__device__ void ph_lists(const Params& p, int* smi, const int wid0) {
    const int t = opaque_tid(wid0);
    const int G = gridDim.x, gpb = (NLAT / 8 + G - 1) / G;
    int* tp = smi + 128; int* tot = smi + 64;
    __syncthreads();
    if (t < 64) {
        int before = 0, all = 0;
        for (int bb = 0; bb < G; ++bb) { const int cnt = p.CNTB[bb * 64 + t]; all += cnt; if (bb < (int)blockIdx.x) before += cnt; }
        smi[t] = before; tot[t] = all;
        if (blockIdx.x == 0) p.CNT[t] = all;
    }
    __syncthreads();
    if (t == 0) { int tt = 0; for (int e = 0; e < NE; ++e) { tp[e] = tt; tt += (tot[e] + 255) / 256; } tp[NE] = tt; }
    __syncthreads();
    const int r0 = blockIdx.x * gpb * 8, r1 = min(NLAT, r0 + gpb * 8);
    for (int i = r0 * TOPK + t; i < r1 * TOPK; i += NT) {
        const int e = p.EIDX[i];
        const int pos = tp[e] * 256 + smi[e] + p.LRANK[i];
        p.PAIRPOS[i] = pos; p.LIST[pos] = i / TOPK;
    }
    for (int e = blockIdx.x; e < NE; e += G) {
        const int cn = tot[e], end = (tp[e + 1] - tp[e]) * 256;
        for (int i = cn + t; i < end; i += NT) p.LIST[tp[e] * 256 + i] = 0;
    }
}


__device__ void ph_prep(const Params& p, float* sm, const int wid0) {
    int* qslot = (int*)(sm + 21000);
    for (;;) {
        __syncthreads();
        if (wid0 == 0 && xb_lane_id() == 0) *qslot = atomicAdd(p.QCTR, 1);
        __syncthreads();
        const int it = *qslot;
        if (it >= 272 + 544) break;
        if (it < 272) { const int u = it < 16 ? ((it >> 3) * NTILE + 128 + (it & 7)) : (((it - 16) >> 7) * NTILE + ((it - 16) & 127)); ph_naprep(p, wid0, u, u + 1, 1); }
        else ph_glaprep(p, sm, wid0, it - 272, it - 271, 1);
    }
}

__device__ void ph_combine(const Params& p, const int wid0) {
    const int t = opaque_tid(wid0), w = t >> 6, lane = t & 63;
    for (int row = blockIdx.x * 8 + w; row < NLAT; row += gridDim.x * 8) {
        const int b = row / SEQ;
        float wk[TOPK]; const unsigned char* yr[TOPK];
#pragma unroll
        for (int k = 0; k < TOPK; ++k) { wk[k] = p.EW[row * TOPK + k]; yr[k] = p.Y8 + (size_t)p.PAIRPOS[row * TOPK + k] * YLD8 + 16 * lane; }
        const unsigned char* ys = p.YS8 + (size_t)row * YLD8 + 16 * lane;
        const float* x1 = p.X1 + (size_t)row * D + 16 * lane;
        const float* g2 = p.mod + (size_t)b * 6 * D + 5 * D + 16 * lane;
        float* o = p.out + (size_t)row * D + 16 * lane;
#pragma unroll
        for (int j = 0; j < 2; ++j) {
            float s[16];
            { const u32x4 v = *(const u32x4*)(ys + 1024 * j);
#pragma unroll
              for (int q = 0; q < 4; ++q) { const f32x2 lo = __builtin_amdgcn_cvt_pk_f32_fp8((int)v[q], false), hi = __builtin_amdgcn_cvt_pk_f32_fp8((int)v[q], true);
                  s[4 * q] = lo[0]; s[4 * q + 1] = lo[1]; s[4 * q + 2] = hi[0]; s[4 * q + 3] = hi[1]; } }
#pragma unroll
            for (int k = 0; k < TOPK; ++k) {
                const u32x4 v = *(const u32x4*)(yr[k] + 1024 * j); const float wv = wk[k];
#pragma unroll
                for (int q = 0; q < 4; ++q) { const f32x2 lo = __builtin_amdgcn_cvt_pk_f32_fp8((int)v[q], false), hi = __builtin_amdgcn_cvt_pk_f32_fp8((int)v[q], true);
                    s[4 * q] += wv * lo[0]; s[4 * q + 1] += wv * lo[1]; s[4 * q + 2] += wv * hi[0]; s[4 * q + 3] += wv * hi[1]; }
            }
#pragma unroll
            for (int q = 0; q < 4; ++q) { const f32x4 xa = *(const f32x4*)(x1 + 1024 * j + 4 * q), ga = *(const f32x4*)(g2 + 1024 * j + 4 * q);
                *(f32x4*)(o + 1024 * j + 4 * q) = (f32x4){xa[0] + ga[0] * s[4 * q], xa[1] + ga[1] * s[4 * q + 1], xa[2] + ga[2] * s[4 * q + 2], xa[3] + ga[3] * s[4 * q + 3]}; }
        }
    }
}

__global__ void __launch_bounds__(NT, 2) mega(Params p) {
    extern __shared__ __attribute__((aligned(16))) unsigned char dynlds[];
    int wid0;
    wid0 = __builtin_amdgcn_readfirstlane((int)threadIdx.x >> 6); asm volatile("" : "+s"(wid0));
    if (wid0 == 0 && xb_lane_id() < 4) ((unsigned*)(dynlds + LDS_BARW))[xb_lane_id()] = 0u;
    __syncthreads();
    XcdBarrier bar = xcd_barrier_post(p.bar, (volatile LAS unsigned*)(dynlds + LDS_BARW), wid0);
    float* sm = (float*)dynlds;
    int* tp = (int*)(dynlds + LDS_TAB);
    LAS unsigned char* lds = (LAS unsigned char*)dynlds;
    const int G = gridDim.x, c = blockIdx.x;

#ifndef REP
#define REP 0
#endif
#define PH(bit, ...) do { __VA_ARGS__; if (REP & (1 << (bit))) { xcd_barrier(bar); __VA_ARGS__; } } while (0)
    PH(0, ph_prologue(p, sm, wid0));                            xcd_barrier(bar);
    PH(1, ph_norm1(p, wid0));                               xcd_barrier(bar);
    { SchedDense S{(const char*)p.H, (const char*)p.WinT, D, NLAT / 256, PLD / 256, G, c}; EpiInproj E{p.P};
      g8::gemm_phase(lds, D, S, E, wid0); }
    { SchedInprojSplit S{(const char*)p.H, (const char*)p.WinT, G, c}; EpiInprojSplit E{p.PS, p.DDS};
      g8::gemm_phase(lds, D, S, E, wid0, 512); }                xcd_barrier(bar);
    ph_prep(p, sm, wid0);                                       xcd_barrier(bar);
    PH(6, ph_attn(p, dynlds, wid0));                            xcd_barrier(bar);
    PH(7, ph_glaout(p, dynlds, wid0));                          xcd_barrier(bar);
    PH(8, { SchedDense S{(const char*)p.MIX, (const char*)p.WoutT, D, NLAT / 256, D / 256, G, c}; EpiOutproj E{p.x, p.mod, p.X1};
      g8::gemm_phase(lds, D, S, E, wid0); });                   xcd_barrier(bar);
    PH(12, ph_norm2_router(p, sm, wid0));                       xcd_barrier(bar);
    PH(13, ph_lists(p, tp, wid0));                              xcd_barrier(bar);
    moe_tables(p, tp, wid0);
    PH(9, { SchedUp S{tp, (const char*)p.H, p.LIST, (const char*)p.E13T, (const char*)p.S13T, G, c}; EpiUp E{(unsigned char*)p.HB, (unsigned char*)p.SHH};
      g8::gemm_phase<EpiUp, SchedUp, true>(lds, D / 2, S, E, wid0); });                   xcd_barrier(bar);
    PH(10, { SchedDown S{tp, (const char*)p.HB, (const char*)p.E2T, (const char*)p.SHH, (const char*)p.S2T, G, c}; EpiDown E{p.Y8, p.YS8};
      g8::gemm_phase<EpiDown, SchedDown, true>(lds, DE / 2, S, E, wid0); });                  xcd_barrier(bar);
    PH(11, ph_combine(p, wid0));
}

extern "C" void kernel_launch(void* const* d_in, const int* in_sizes, int n_in, void* d_out, int out_size, void* d_ws, size_t ws_size, hipStream_t stream) {
    Params p{};
    const float* const* in = (const float* const*)d_in;
    p.x = in[0]; p.c = in[1]; p.ctx = in[2]; p.c_ctx = in[3]; p.w_mod = in[4]; p.b_mod = in[5]; p.norm1_g = in[6]; p.norm2_g = in[7]; p.w_in = in[8];
    p.q_norm_g = in[9]; p.k_norm_g = in[10]; p.na_rpb = in[11]; p.up_f = in[12]; p.bias_f = in[13]; p.up_b = in[14]; p.bias_b = in[15]; p.gla_norm_g = in[16];
    p.w_out = in[17]; p.router_w = in[18]; p.router_bias = in[19]; p.ew1 = in[20]; p.ew3 = in[21]; p.ew2 = in[22]; p.sw1 = in[23]; p.sw3 = in[24]; p.sw2 = in[25];
    p.out = (float*)d_out;
    char* w = (char*)d_ws; size_t o = 0;
    auto take = [&](size_t bytes) { void* r = w + o; o += (bytes + 255) & ~(size_t)255; return r; };
    p.bar = (unsigned*)take((size_t)XCD_BAR_WORDS * 4);
    p.CNT = (int*)take(64 * 4); p.QCTR = (int*)take(64 * 4); p.LRANK = (int*)take((size_t)NPAIR * 4); p.CNTB = (int*)take((size_t)1024 * 64 * 4);
    p.mod = (float*)take((size_t)3 * 6 * D * 4); p.RT = (float*)take((size_t)64 * 32 * 2 * 4);
    p.EIDX = (int*)take((size_t)NPAIR * 4); p.EW = (float*)take((size_t)NPAIR * 4); p.PAIRPOS = (int*)take((size_t)NPAIR * 4); p.LIST = (int*)take((size_t)PADROWS * 4);
    p.WinT = (bf16_t*)take((size_t)(PLD + 256) * D * 2); p.WoutT = (bf16_t*)take((size_t)D * D * 2); p.S13T = (bf16_t*)take((size_t)1024 * D * 2); p.S2T = (bf16_t*)take((size_t)D * DE * 2);
    p.E13T = (bf16_t*)take((size_t)NE * 1024 * D * 2); p.E2T = (bf16_t*)take((size_t)NE * D * DE * 2);
    p.H = (bf16_t*)take((size_t)NROW * D * 2);
    p.X1 = (float*)take((size_t)NLAT * D * 4);
    const size_t big = o;
    p.P = (bf16_t*)take((size_t)NLAT * PLD * 2); p.PS = (float*)take(4 * PS_SLAB * 4); p.DDS = (float*)take(4 * DD_SLAB * 4); p.NQb = (bf16_t*)take((size_t)NLAT * 1024 * 2); p.NKf = (bf16_t*)take((size_t)16 * NTILE * 4096 * 2); p.VTf = (bf16_t*)take((size_t)16 * NTILE * 4096 * 2);
    p.MIX = (bf16_t*)take((size_t)NLAT * D * 2);
    p.QF = (bf16_t*)take((size_t)8 * 64 * 64 * 128 * 2); p.KF = (bf16_t*)take((size_t)8 * 64 * 64 * 128 * 2); p.QB = (bf16_t*)take((size_t)8 * 64 * 64 * 128 * 2); p.KB = (bf16_t*)take((size_t)8 * 64 * 64 * 128 * 2);
    p.KHF = (bf16_t*)take((size_t)8 * 68 * 128 * 64 * 2); p.KHB = (bf16_t*)take((size_t)8 * 68 * 128 * 64 * 2); p.VT = (bf16_t*)take((size_t)8 * 68 * 256 * 64 * 2); p.VTS = (bf16_t*)take((size_t)8 * 68 * 256 * 64 * 2);
    p.DF = (float*)take((size_t)8 * 68 * 128 * 4); p.DB = (float*)take((size_t)8 * 68 * 128 * 4); p.SS = (bf16_t*)take((size_t)16 * 65 * 256 * 128 * 2);
    o = big;
    p.HB = (bf16_t*)take((size_t)PADROWS * DE * 2); p.SHH = (bf16_t*)take((size_t)NLAT * DE * 2); p.Y8 = (unsigned char*)take((size_t)PADROWS * YLD8); p.YS8 = (unsigned char*)take((size_t)NLAT * YLD8);
    static int grid = 0;
    if (!grid) {
        int dev = 0, cus = 0, per_cu = 0;
        hipGetDevice(&dev);
        hipDeviceGetAttribute(&cus, hipDeviceAttributeMultiprocessorCount, dev);
        (void)hipFuncSetAttribute((const void*)mega, hipFuncAttributeMaxDynamicSharedMemorySize, LDS_BYTES);
        (void)hipOccupancyMaxActiveBlocksPerMultiprocessor(&per_cu, (const void*)mega, NT, LDS_BYTES);
        (void)hipGetLastError();
        grid = cus;
    }
    (void)hipMemsetAsync(p.bar, 0, (size_t)XCD_BAR_WORDS * 4, stream);
    hipLaunchKernelGGL(mega, dim3(grid), dim3(NT), LDS_BYTES, stream, p);
}
```

```cpp
#include <hip/hip_runtime.h>
#include <stdint.h>

#define XB_TMO      128
#define XB_XCNT(j)  (256  + 64 * (j))
#define XB_XSUB(j)  (1280 + 64 * (j))
#define XB_XGEN(j)  (2304 + 64 * (j))
#define XB_TOP      3328
#define XB_TOPGEN   3392
#define XCD_BAR_WORDS 3456
#define XB_SPIN_CAP (1u << 18)
#define LAS __attribute__((address_space(3)))

__device__ __forceinline__ unsigned xb_ld(unsigned* p)              { return __hip_atomic_load(p, __ATOMIC_RELAXED, __HIP_MEMORY_SCOPE_AGENT); }
__device__ __forceinline__ unsigned xb_add(unsigned* p, unsigned v) { return __hip_atomic_fetch_add(p, v, __ATOMIC_RELAXED, __HIP_MEMORY_SCOPE_AGENT); }
__device__ __forceinline__ unsigned xb_xcc_id() { return (unsigned)__builtin_amdgcn_s_getreg((3 << 11) | 20) & 0xFu; }
#define XB_SPIN(cond, bar) do { unsigned _sp = 0; while (cond) { __builtin_amdgcn_s_sleep(1); \
    if ((++_sp & 255u) == 0u) { if (xb_ld(&(bar)[XB_TMO])) break; if (_sp > XB_SPIN_CAP) { atomicAdd(&(bar)[XB_TMO], 1u); break; } } } } while (0)

__device__ __forceinline__ int xb_lane_id() { return (int)__builtin_amdgcn_mbcnt_hi(~0u, __builtin_amdgcn_mbcnt_lo(~0u, 0u)); }
struct XcdBarrier {
    int wid;
    unsigned* bar; unsigned x;
    volatile LAS unsigned* st;
};

__device__ __forceinline__ XcdBarrier xcd_barrier_post(unsigned* bar, volatile LAS unsigned* st, int wid) {
    XcdBarrier b; b.wid = wid; b.bar = bar; b.x = xb_xcc_id(); b.st = st;
    if (wid == 0 && xb_lane_id() == 0) (void)xb_add(&bar[XB_XCNT(b.x)], 1u);
    return b;
}
__device__ __forceinline__ void xcd_barrier_complete(unsigned* bar, unsigned x, unsigned& nloc, unsigned& nx) {
    const unsigned G = gridDim.x * gridDim.y * gridDim.z;
    unsigned sum, cnt, mine, sp = 0u;
    for (;;) {
        sum = 0u; cnt = 0u; mine = 0u;
#pragma unroll
        for (unsigned j = 0; j < 16; ++j) { const unsigned c = xb_ld(&bar[XB_XCNT(j)]); sum += c; cnt += (c > 0u) ? 1u : 0u; mine = (j == x) ? c : mine; }
        if (sum == G) break;
        __builtin_amdgcn_s_sleep(1);
        if ((++sp & 255u) == 0u) { if (xb_ld(&bar[XB_TMO])) break; if (sp > XB_SPIN_CAP) { atomicAdd(&bar[XB_TMO], 1u); break; } }
    }
    nloc = mine > 0u ? mine : 1u; nx = cnt > 0u ? cnt : 1u;
}

__device__ __forceinline__ void xcd_barrier(const XcdBarrier& b) {
    asm volatile("s_waitcnt vmcnt(0)" ::: "memory");
    __syncthreads();
    if (b.wid == 0 && xb_lane_id() == 0) {
        unsigned* bar = b.bar;
        __builtin_amdgcn_s_waitcnt(0);
        unsigned nloc = b.st[0], nx = b.st[1];
        if (nloc == 0u) { xcd_barrier_complete(bar, b.x, nloc, nx); b.st[0] = nloc; b.st[1] = nx; }
        const unsigned old = xb_add(&bar[XB_XSUB(b.x)], 1u);
        const unsigned gen = old / nloc;
        if (old + 1u == (gen + 1u) * nloc) {
            __builtin_amdgcn_fence(__ATOMIC_RELEASE, "agent");
            asm volatile("s_waitcnt vmcnt(0)" ::: "memory");
            const unsigned og = xb_add(&bar[XB_TOP], 1u);
            const unsigned tg = og / nx;
            if (og + 1u == (tg + 1u) * nx) xb_add(&bar[XB_TOPGEN], 1u);
            else XB_SPIN(xb_ld(&bar[XB_TOPGEN]) == tg, bar);
            __builtin_amdgcn_fence(__ATOMIC_ACQUIRE, "agent");
            xb_add(&bar[XB_XGEN(b.x)], 1u);
            asm volatile("s_waitcnt vmcnt(0)" ::: "memory");
        } else {
            XB_SPIN(xb_ld(&bar[XB_XGEN(b.x)]) == gen, bar);
            __builtin_amdgcn_fence(__ATOMIC_ACQUIRE, "agent");
            asm volatile("s_waitcnt vmcnt(0)" ::: "memory");
        }
    }
    __syncthreads();
}


#define NT 512
typedef unsigned short bf16_t;
typedef short bf16x8 __attribute__((ext_vector_type(8)));
typedef float f32x4 __attribute__((ext_vector_type(4)));
typedef float f32x16 __attribute__((ext_vector_type(16)));
typedef unsigned u32x4 __attribute__((ext_vector_type(4)));
typedef unsigned u32x2 __attribute__((ext_vector_type(2)));
typedef int i32x4 __attribute__((ext_vector_type(4)));
typedef int i32x8 __attribute__((ext_vector_type(8)));

constexpr int D = 2048, SEQ = 4096, CTXL = 256, NB = 2;
constexpr int NLAT = NB * SEQ;
constexpr int NCTX = NB * CTXL;
constexpr int NROW = NLAT + NCTX;
constexpr int INC = 6176;
constexpr int PLD = 6144;
constexpr int PSLD = 3584;
constexpr size_t PS_SLAB = (size_t)512 * 3584, DD_SLAB = (size_t)8704 * 32;
constexpr int NE = 64, TOPK = 6, DE = 512;
constexpr int NPAIR = NLAT * TOPK;
constexpr int PADROWS = NPAIR + NE * 256;
constexpr float W13SC = 64.f, W2SC = 32.f, HSC = 4.f;
constexpr int YLD8 = D + 64;
constexpr int YLD = D + 64;
constexpr int LDS_STAGE = 131072;
constexpr int LDS_TAB = LDS_STAGE;
constexpr int LDS_BARW = LDS_STAGE + 4096;
constexpr int LDS_BYTES = LDS_BARW + 16 + 8192;

struct Params {
    const float *x, *c, *ctx, *c_ctx, *w_mod, *b_mod, *norm1_g, *norm2_g, *w_in, *q_norm_g, *k_norm_g, *na_rpb,
        *up_f, *bias_f, *up_b, *bias_b, *gla_norm_g, *w_out, *router_w, *router_bias, *ew1, *ew3, *ew2, *sw1, *sw3, *sw2;
    float* out;
    float *mod, *X1, *PS, *DDS, *EW, *RT, *DF, *DB;
    unsigned char *Y8, *YS8;
    bf16_t *P, *H, *MIX, *HB, *SHH, *Y, *WinT, *WoutT, *S13T, *S2T, *E13T, *E2T, *QF, *KF, *QB, *KB, *KHF, *KHB, *VT, *SS, *NQb, *NKf, *VTf, *YS, *VTS;
    int *EIDX, *PAIRPOS, *LIST, *CNT, *QCTR, *LRANK, *CNTB;
    unsigned* bar;
};

__device__ __forceinline__ int fresh_lane_id() { int l; asm volatile("v_mbcnt_lo_u32_b32 %0, -1, 0\n\tv_mbcnt_hi_u32_b32 %0, -1, %0" : "=v"(l)); return l; }
__device__ __forceinline__ int opaque_tid(int wid0) { return wid0 * 64 + fresh_lane_id(); }
__device__ __forceinline__ float wave_sum(float v) { for (int o = 32; o > 0; o >>= 1) v += __shfl_xor(v, o); return v; }
__device__ __forceinline__ float wave_max(float v) { for (int o = 32; o > 0; o >>= 1) v = fmaxf(v, __shfl_xor(v, o)); return v; }
__device__ __forceinline__ int wave_min_i(int v) { for (int o = 32; o > 0; o >>= 1) v = min(v, __shfl_xor(v, o)); return v; }
__device__ __forceinline__ float siluf(float v) { return v / (1.f + expf(-v)); }
typedef float f32x2 __attribute__((ext_vector_type(2)));
typedef __bf16 bf16x2_t __attribute__((ext_vector_type(2)));
__device__ __forceinline__ unsigned cvt_pk_bf16(float lo, float hi) { const f32x2 v = {lo, hi}; return __builtin_bit_cast(unsigned, __builtin_convertvector(v, bf16x2_t)); }
__device__ __forceinline__ bf16_t f2bf(float f) { return (bf16_t)(cvt_pk_bf16(f, 0.f) & 0xffffu); }
__device__ __forceinline__ float bf2f(unsigned b) { return __uint_as_float(b << 16); }

__device__ __forceinline__ void adaln_item(const Params& p, float* sm, int item, const int wid0) {
    const int t = opaque_tid(wid0), cq = t & 15, kg = t >> 4, n0 = item * 64;
    float* red = sm + 3 * D;
    float a[3][4];
#pragma unroll
    for (int r = 0; r < 3; ++r)
#pragma unroll
        for (int j = 0; j < 4; ++j) a[r][j] = 0.f;
#pragma unroll 4
    for (int k = kg; k < D; k += 32) {
        const f32x4 w4 = __builtin_nontemporal_load((const f32x4*)(p.w_mod + (size_t)k * (6 * D) + n0 + 4 * cq)); const float4 w = make_float4(w4[0], w4[1], w4[2], w4[3]);
        const float s0 = sm[k], s1 = sm[D + k], s2 = sm[2 * D + k];
        a[0][0] += s0 * w.x; a[0][1] += s0 * w.y; a[0][2] += s0 * w.z; a[0][3] += s0 * w.w;
        a[1][0] += s1 * w.x; a[1][1] += s1 * w.y; a[1][2] += s1 * w.z; a[1][3] += s1 * w.w;
        a[2][0] += s2 * w.x; a[2][1] += s2 * w.y; a[2][2] += s2 * w.z; a[2][3] += s2 * w.w;
    }
    __syncthreads();
#pragma unroll
    for (int r = 0; r < 3; ++r)
#pragma unroll
        for (int j = 0; j < 4; ++j) red[(kg * 3 + r) * 64 + 4 * cq + j] = a[r][j];
    __syncthreads();
    if (t < 192) {
        const int r = t >> 6, cc = t & 63;
        float s = p.b_mod[n0 + cc];
#pragma unroll 8
        for (int g = 0; g < 32; ++g) s += red[(g * 3 + r) * 64 + cc];
        p.mod[(size_t)r * 6 * D + n0 + cc] = s;
    }
    __syncthreads();
}
__device__ __forceinline__ void transpose_item(const float* W, int K, int N, int k0, int n0, bf16_t* WT, int drow0, float* scr, int lane, int maxc = 63) {
    if (maxc >= 63) {
        const int kr = lane >> 4, nq = lane & 15;
        f32x4 v[16];
#pragma unroll
        for (int q = 0; q < 16; ++q) v[q] = __builtin_nontemporal_load((const f32x4*)(W + (size_t)(k0 + 4 * q + kr) * N + n0 + 4 * nq));
#pragma unroll
        for (int q = 0; q < 16; ++q) { float* d = scr + (4 * q + kr) * 65 + 4 * nq; d[0] = v[q][0]; d[1] = v[q][1]; d[2] = v[q][2]; d[3] = v[q][3]; }
    } else {
        const int cl = lane < maxc ? lane : maxc;
#pragma unroll 8
        for (int kk = 0; kk < 64; ++kk) scr[kk * 65 + lane] = W[(size_t)(k0 + kk) * N + n0 + cl];
    }
    asm volatile("s_waitcnt lgkmcnt(0)" ::: "memory");
    const int c = lane & 7;
#pragma unroll
    for (int j = 0; j < 8; ++j) {
        const int n = (lane >> 3) + 8 * j; const float* s = scr + (8 * c) * 65 + n;
        u32x4 o; o.x = cvt_pk_bf16(s[0], s[65]); o.y = cvt_pk_bf16(s[2 * 65], s[3 * 65]); o.z = cvt_pk_bf16(s[4 * 65], s[5 * 65]); o.w = cvt_pk_bf16(s[6 * 65], s[7 * 65]);
        *(u32x4*)(WT + (size_t)(drow0 + n) * K + k0 + 8 * c) = o;
    }
    asm volatile("s_waitcnt lgkmcnt(0)" ::: "memory");
}
__device__ __forceinline__ void transpose_item8(const float* W, int K, int N, int k0, int n0, unsigned char* WT, int drow0, float* scr, int lane, float sc) {
    {
        const int kr = lane >> 4, nq = lane & 15;
        f32x4 v[16];
#pragma unroll
        for (int q = 0; q < 16; ++q) v[q] = __builtin_nontemporal_load((const f32x4*)(W + (size_t)(k0 + 4 * q + kr) * N + n0 + 4 * nq));
#pragma unroll
        for (int q = 0; q < 16; ++q) { float* d = scr + (4 * q + kr) * 65 + 4 * nq; d[0] = v[q][0]; d[1] = v[q][1]; d[2] = v[q][2]; d[3] = v[q][3]; }
    }
    asm volatile("s_waitcnt lgkmcnt(0)" ::: "memory");
    const int c = lane & 3;
#pragma unroll
    for (int j = 0; j < 4; ++j) {
        const int n = (lane >> 2) + 16 * j; const float* s = scr + (16 * c) * 65 + n;
        u32x4 o;
#pragma unroll
        for (int q = 0; q < 4; ++q) { int pk = 0;
            pk = __builtin_amdgcn_cvt_pk_fp8_f32(s[(4 * q) * 65] * sc, s[(4 * q + 1) * 65] * sc, pk, false);
            pk = __builtin_amdgcn_cvt_pk_fp8_f32(s[(4 * q + 2) * 65] * sc, s[(4 * q + 3) * 65] * sc, pk, true); o[q] = (unsigned)pk; }
        *(u32x4*)(WT + (size_t)(drow0 + n) * K + k0 + 16 * c) = o;
    }
    asm volatile("s_waitcnt lgkmcnt(0)" ::: "memory");
}
constexpr int CI_WIN = 32 * 97, CI_WOUT = 32 * 32, CI_S13 = 2 * 32 * 8, CI_S2 = 8 * 32, CI_E13 = 64 * 2 * 32 * 8, CI_E2 = 64 * 8 * 32;
constexpr int CI_TOTAL = CI_WIN + CI_WOUT + CI_S13 + CI_S2 + CI_E13 + CI_E2;
__device__ __forceinline__ void convert_item(const Params& p, int it, float* scr, int lane) {
    if (it < CI_WIN) { const int kb = it / 97, nb = it % 97; transpose_item(p.w_in, D, INC, 64 * kb, 64 * nb, p.WinT, 64 * nb, scr, lane, INC - 1 - 64 * nb); return; }
    it -= CI_WIN;
    if (it < CI_WOUT) { const int kb = it / 32, nb = it % 32; transpose_item(p.w_out, D, D, 64 * kb, 64 * nb, p.WoutT, 64 * nb, scr, lane); return; }
    it -= CI_WOUT;
    if (it < CI_S13) {
        const int which = it / 256, r = it % 256, kb = r / 8, nb = r % 8;
        transpose_item8(which ? p.sw3 : p.sw1, D, DE, 64 * kb, 64 * nb, (unsigned char*)p.S13T, (nb >> 1) * 256 + which * 128 + (nb & 1) * 64, scr, lane, W13SC); return; }
    it -= CI_S13;
    if (it < CI_S2) { const int kb = it / 32, nb = it % 32; transpose_item8(p.sw2, DE, D, 64 * kb, 64 * nb, (unsigned char*)p.S2T, 64 * nb, scr, lane, W2SC); return; }
    it -= CI_S2;
    if (it < CI_E13) {
        const int e = it / 512, r0 = it % 512, which = r0 / 256, r = r0 % 256, kb = r / 8, nb = r % 8;
        transpose_item8((which ? p.ew3 : p.ew1) + (size_t)e * D * DE, D, DE, 64 * kb, 64 * nb, (unsigned char*)p.E13T + (size_t)e * 1024 * D, (nb >> 1) * 256 + which * 128 + (nb & 1) * 64, scr, lane, W13SC); return; }
    it -= CI_E13;
    { const int e = it / 256, r = it % 256, kb = r / 32, nb = r % 32;
      transpose_item8(p.ew2 + (size_t)e * DE * D, DE, D, 64 * kb, 64 * nb, (unsigned char*)p.E2T + (size_t)e * D * DE, 64 * nb, scr, lane, W2SC); }
}
__device__ void ph_prologue(const Params& p, float* sm, const int wid0) {
    const int t = opaque_tid(wid0), w = t >> 6, lane = t & 63;
    if (blockIdx.x == 0 && t == 0) { p.QCTR[0] = 0; p.QCTR[32] = 0; }
    if (blockIdx.x == gridDim.x - 1) {
        for (int i = t; i < 64 * 32; i += NT) { const float ang = (float)(i >> 5) * powf(10000.f, -(float)(i & 31) / 32.f); p.RT[2 * i] = cosf(ang); p.RT[2 * i + 1] = sinf(ang); }
    }
    if (blockIdx.x < 192) {
        for (int i = t; i < 3 * D; i += NT) { const int r = i / D, k = i % D; sm[i] = siluf(r < 2 ? p.c[r * D + k] : p.c_ctx[k]); }
        __syncthreads();
        for (int item = blockIdx.x; item < 192; item += gridDim.x) adaln_item(p, sm, item, wid0);
    }
    __syncthreads();
    float* scr = sm + w * (64 * 65);
    for (int it = blockIdx.x * 8 + w; it < CI_TOTAL; it += gridDim.x * 8) convert_item(p, it, scr, lane);
}

__device__ void ph_norm1(const Params& p, const int wid0) {
    const int t = opaque_tid(wid0), w = t >> 6, lane = t & 63;
    for (int row = blockIdx.x * 8 + w; row < NROW; row += gridDim.x * 8) {
        const float* src; int mr;
        if (row < NLAT) { src = p.x + (size_t)row * D; mr = row / SEQ; } else { src = p.ctx + (size_t)(row - NLAT) * D; mr = 2; }
        const float* m = p.mod + (size_t)mr * 6 * D;
        float4 v[8]; float ss = 0.f;
#pragma unroll
        for (int j = 0; j < 8; ++j) { v[j] = *(const float4*)(src + 256 * j + 4 * lane); ss += v[j].x * v[j].x + v[j].y * v[j].y + v[j].z * v[j].z + v[j].w * v[j].w; }
        ss = wave_sum(ss);
        const float rs = rsqrtf(ss * (1.f / D) + 1e-6f);
#pragma unroll
        for (int j = 0; j < 8; ++j) {
            const int col = 256 * j + 4 * lane;
            const float4 g = *(const float4*)(p.norm1_g + col), sh = *(const float4*)(m + col), sc = *(const float4*)(m + D + col);
            u32x2 pk;
            pk.x = cvt_pk_bf16(v[j].x * rs * g.x * (1.f + sc.x) + sh.x, v[j].y * rs * g.y * (1.f + sc.y) + sh.y);
            pk.y = cvt_pk_bf16(v[j].z * rs * g.z * (1.f + sc.z) + sh.z, v[j].w * rs * g.w * (1.f + sc.w) + sh.w);
            *(u32x2*)(p.H + (size_t)row * D + col) = pk;
        }
    }
}

namespace g8 {
constexpr int BM = 256, BK = 64, HALF = 128, HTB = HALF * BK * 2;
__device__ __forceinline__ int lds_byte(int r, int c) { const int st = (r >> 4) * 2 + (c >> 5), rr = r & 15, cc = c & 31, ob = rr * 64 + cc * 2; return st * 1024 + (ob ^ (((ob >> 9) & 1) << 5)); }
__device__ __forceinline__ void stage_rc(int b, int& R, int& C) { const int st = b / 1024, sb = b % 1024, swz = sb ^ (((sb >> 9) & 1) << 5); R = (st >> 1) * 16 + swz / 64; C = (st & 1) * 32 + (swz % 64) / 2; }
__device__ __forceinline__ int perm32(int rho) { const int n = rho >> 4, i = rho & 15; return 8 * (i >> 2) + 4 * n + (i & 3); }

struct Unit { const char* A; const int* rows; int row0; const char* Bt; int orow, pn, aux; int nv = 256; };

__device__ __forceinline__ bool work_id(int i, int G, int c, int nwg, int& wgid) {
    const long L = (long)i * G + c; if (L >= nwg) return false;
    const int l = (int)L, q = nwg / 8, r = nwg % 8, xcd = l % 8, off = l / 8;
    wgid = (xcd < r ? xcd * (q + 1) : r * (q + 1) + (xcd - r) * q) + off; return true;
}

__device__ __forceinline__ i32x8 cat8(bf16x8 a, bf16x8 b) { const i32x4 x = __builtin_bit_cast(i32x4, a), y = __builtin_bit_cast(i32x4, b); return __builtin_shufflevector(x, y, 0, 1, 2, 3, 4, 5, 6, 7); }
template <class Epi, class Sched, bool F8 = false>
__device__ __forceinline__ void gemm_phase(LAS unsigned char* lds, const int K, const Sched& S, const Epi& E, const int wid0, const int kloop = 0) {
    const int tid_ = wid0 * 64 + fresh_lane_id();
    const int tid = tid_, wid = __builtin_amdgcn_readfirstlane(tid >> 6), lane = tid & 63, wr = wid >> 2, wc = wid & 3, fr = lane & 15, fq = lane >> 4;
    const int nt = (kloop ? kloop : K) / BK;
    int sR[2]; unsigned sC2[2], voffB[2], voffB1[2];
#pragma unroll
    for (int i = 0; i < 2; ++i) { int R, C; stage_rc(tid * 16 + i * 8192, R, C);
        const int Rb = Epi::PERM == 3 ? (64 * (R >> 5) + 16 * ((R & 15) >> 2) + 4 * ((R >> 4) & 1) + (R & 3)) : (Epi::PERM == 1 ? ((R & ~31) + perm32(R & 31)) : R);
        sR[i] = R; sC2[i] = (unsigned)C * 2u; voffB[i] = (unsigned)(Rb * K + C) * 2u; voffB1[i] = Epi::PERM == 3 ? (unsigned)((Rb + 8) * K + C) * 2u : voffB[i]; }
    const size_t kstep = (size_t)(BK * 2);
    const size_t hstep = (size_t)HALF * K * 2;
    const size_t hB1 = Epi::PERM == 3 ? 0 : hstep;
    const unsigned ldsw = (unsigned)wid * 1024u;
    const int aoff = lds_byte(wr * 64 + fr, fq * 8), boff = lds_byte(wc * 32 + fr, fq * 8);
#define G8_SA(b, h) (((b) * 2 + (h)) * g8::HTB)
#define G8_SB(b, h) ((4 + (b) * 2 + (h)) * g8::HTB)
#define G8_STAGE(bufoff, gbase, v0, v1) do { \
        __builtin_amdgcn_global_load_lds((const unsigned*)((const char*)(gbase) + (v0)), (LAS unsigned*)(lds + (bufoff) + ldsw), 16, 0, 0); \
        __builtin_amdgcn_global_load_lds((const unsigned*)((const char*)(gbase) + (v1)), (LAS unsigned*)(lds + (bufoff) + ldsw + 8192), 16, 0, 0); } while (0)
#define G8_LDA(dst, b, h) do { _Pragma("unroll") for (int m = 0; m < 4; ++m) _Pragma("unroll") for (int k = 0; k < 2; ++k) dst[m][k] = *(const LAS bf16x8*)(lds + G8_SA(b, h) + aoff + m * 2048 + k * 1024); } while (0)
#define G8_LDB(dst, b, h) do { _Pragma("unroll") for (int n = 0; n < 2; ++n) _Pragma("unroll") for (int k = 0; k < 2; ++k) dst[n][k] = *(const LAS bf16x8*)(lds + G8_SB(b, h) + boff + n * 2048 + k * 1024); } while (0)
#define G8_MMA(ai, bj, At, Bt) do { __builtin_amdgcn_s_setprio(1); \
        if constexpr (F8) { _Pragma("unroll") for (int m = 0; m < 4; ++m) _Pragma("unroll") for (int n = 0; n < 2; ++n) \
            acc[ai][bj][m][n] = __builtin_amdgcn_mfma_scale_f32_16x16x128_f8f6f4(cat8(Bt[n][0], Bt[n][1]), cat8(At[m][0], At[m][1]), acc[ai][bj][m][n], 0, 0, 0, 0, 0, 0); } \
        else { _Pragma("unroll") for (int m = 0; m < 4; ++m) _Pragma("unroll") for (int n = 0; n < 2; ++n) _Pragma("unroll") for (int k = 0; k < 2; ++k) \
            acc[ai][bj][m][n] = __builtin_amdgcn_mfma_f32_16x16x32_bf16(Bt[n][k], At[m][k], acc[ai][bj][m][n], 0, 0, 0); } \
        __builtin_amdgcn_s_setprio(0); } while (0)
#define G8_WAIT_V(n) asm volatile("s_waitcnt vmcnt(" #n ")" ::: "memory")
#define G8_WAIT_L(n) asm volatile("s_waitcnt lgkmcnt(" #n ")" ::: "memory")
#define G8_BAR __builtin_amdgcn_s_barrier()
#define G8_SCHED __builtin_amdgcn_sched_barrier(0)
    Unit cur, nxt; int ui = 0;
    if (!S.next(0, cur)) return;
    f32x4 acc[2][2][4][2];
#pragma unroll
    for (int a = 0; a < 2; ++a)
#pragma unroll
        for (int b = 0; b < 2; ++b)
#pragma unroll
            for (int m = 0; m < 4; ++m)
#pragma unroll
                for (int n = 0; n < 2; ++n) acc[a][b][m][n] = (f32x4){0.f, 0.f, 0.f, 0.f};
    bf16x8 At[4][2], B0[2][2], B1[2][2];
    unsigned vA00, vA01, vA10, vA11, nA00, nA01, nA10, nA11;
#define G8_MKOFF(u, o00, o01, o10, o11) do { \
        int r00, r01, r10, r11; \
        if ((u).rows) { r00 = (u).rows[sR[0]]; r01 = (u).rows[sR[1]]; r10 = (u).rows[128 + sR[0]]; r11 = (u).rows[128 + sR[1]]; } \
        else { r00 = (u).row0 + sR[0]; r01 = (u).row0 + sR[1]; r10 = (u).row0 + 128 + sR[0]; r11 = (u).row0 + 128 + sR[1]; } \
        o00 = (unsigned)r00 * (unsigned)(K * 2) + sC2[0]; o01 = (unsigned)r01 * (unsigned)(K * 2) + sC2[1]; \
        o10 = (unsigned)r10 * (unsigned)(K * 2) + sC2[0]; o11 = (unsigned)r11 * (unsigned)(K * 2) + sC2[1]; } while (0)
    G8_MKOFF(cur, vA00, vA01, vA10, vA11);
    const char* cA = cur.A; const char* cB = cur.Bt;
    G8_STAGE(G8_SB(0, 0), cB, voffB[0], voffB[1]); G8_STAGE(G8_SA(0, 0), cA, vA00, vA01); G8_STAGE(G8_SB(0, 1), cB + hB1, voffB1[0], voffB1[1]); G8_STAGE(G8_SA(0, 1), cA, vA10, vA11);
    if (wr == 1) G8_BAR;
    G8_WAIT_V(4); G8_BAR;
    G8_STAGE(G8_SB(1, 0), cB + kstep, voffB[0], voffB[1]); G8_STAGE(G8_SA(1, 0), cA + kstep, vA00, vA01); G8_STAGE(G8_SB(1, 1), cB + hB1 + kstep, voffB1[0], voffB1[1]);
    G8_WAIT_V(6); G8_BAR;
    for (;;) {
        const bool h1 = cur.nv > 128;
        const bool has_next = S.next(ui + 1, nxt);
        const char* nA = has_next ? nxt.A : cA; const char* nB = has_next ? nxt.Bt : cB;
        if (has_next) G8_MKOFF(nxt, nA00, nA01, nA10, nA11); else { nA00 = vA00; nA01 = vA01; nA10 = vA10; nA11 = vA11; }
#pragma nounroll
        for (int t = 0; t < nt; t += 2) {
            const bool last = (t == nt - 2);
            const char* a1 = cA + (size_t)(t + 1) * kstep;
            G8_LDB(B0, 0, 0); G8_SCHED; G8_LDA(At, 0, 0); G8_STAGE(G8_SA(1, 1), a1, vA10, vA11);
            G8_WAIT_L(8); G8_BAR; G8_WAIT_L(0); G8_MMA(0, 0, At, B0); G8_BAR; G8_SCHED;
            if (last) { vA00 = nA00; vA01 = nA01; vA10 = nA10; vA11 = nA11; }
            const char* a2 = last ? nA : cA + (size_t)(t + 2) * kstep; const char* b2 = last ? nB : cB + (size_t)(t + 2) * kstep;
            const char* a3 = a2 + kstep; const char* b3 = b2 + kstep;
            G8_LDB(B1, 0, 1); G8_STAGE(G8_SB(0, 0), b2, voffB[0], voffB[1]);
            G8_BAR; G8_WAIT_L(0); G8_MMA(0, 1, At, B1); G8_BAR;
            G8_LDA(At, 0, 1); G8_STAGE(G8_SA(0, 0), a2, vA00, vA01);
            G8_BAR; G8_WAIT_L(0); if (h1) G8_MMA(1, 0, At, B0); G8_BAR; G8_SCHED;
            G8_STAGE(G8_SB(0, 1), b2 + hB1, voffB1[0], voffB1[1]);
            G8_WAIT_V(6); G8_BAR; if (h1) G8_MMA(1, 1, At, B1); G8_BAR;
            G8_LDB(B0, 1, 0); G8_SCHED; G8_LDA(At, 1, 0); G8_STAGE(G8_SA(0, 1), a2, vA10, vA11);
            G8_WAIT_L(8); G8_BAR; G8_WAIT_L(0); G8_MMA(0, 0, At, B0); G8_BAR; G8_SCHED;
            G8_LDB(B1, 1, 1); G8_STAGE(G8_SB(1, 0), b3, voffB[0], voffB[1]);
            G8_BAR; G8_WAIT_L(0); G8_MMA(0, 1, At, B1); G8_BAR;
            G8_LDA(At, 1, 1); G8_STAGE(G8_SA(1, 0), a3, vA00, vA01);
            G8_BAR; G8_WAIT_L(0); if (h1) G8_MMA(1, 0, At, B0); G8_BAR; G8_SCHED;
            G8_STAGE(G8_SB(1, 1), b3 + hB1, voffB1[0], voffB1[1]);
            G8_WAIT_V(6); G8_BAR; if (h1) G8_MMA(1, 1, At, B1); G8_BAR;
        }
        E(acc, cur, wr, wc, fr, fq);
        if (!has_next) break;
#pragma unroll
        for (int a = 0; a < 2; ++a)
#pragma unroll
            for (int b = 0; b < 2; ++b)
#pragma unroll
                for (int m = 0; m < 4; ++m)
#pragma unroll
                    for (int n = 0; n < 2; ++n) acc[a][b][m][n] = (f32x4){0.f, 0.f, 0.f, 0.f};
        cur = nxt; cA = nA; cB = nB; ++ui;
    }
    G8_WAIT_V(0);
    if (wr == 0) G8_BAR;
    G8_BAR;
}
}

struct EpiInproj {
    static constexpr int PERM = 1;
    bf16_t* P;
    __device__ __forceinline__ void operator()(const f32x4 (&acc)[2][2][4][2], const g8::Unit& u, int wr, int wc, int fr, int fq) const {
#pragma unroll
        for (int ai = 0; ai < 2; ++ai)
#pragma unroll
            for (int m = 0; m < 4; ++m) { bf16_t* rowp = P + (size_t)(u.orow + ai * 128 + wr * 64 + m * 16 + fr) * PLD + u.pn * 256 + wc * 32 + 8 * fq;
#pragma unroll
                for (int bj = 0; bj < 2; ++bj) { const f32x4 v0 = acc[ai][bj][m][0], v1 = acc[ai][bj][m][1];
                    u32x4 w; w.x = cvt_pk_bf16(v0[0], v0[1]); w.y = cvt_pk_bf16(v0[2], v0[3]); w.z = cvt_pk_bf16(v1[0], v1[1]); w.w = cvt_pk_bf16(v1[2], v1[3]);
                    *(u32x4*)(rowp + bj * 128) = w; } }
    }
};
struct EpiInprojSplit {
    static constexpr int PERM = 0;
    float* PS; float* DDS;
    __device__ __forceinline__ void operator()(const f32x4 (&acc)[2][2][4][2], const g8::Unit& u, int wr, int wc, int fr, int fq) const {
        if (u.pn == PLD / 256) {
            if (wc == 0) {
#pragma unroll
                for (int ai = 0; ai < 2; ++ai)
#pragma unroll
                    for (int m = 0; m < 4; ++m) { float* rowp = DDS + (size_t)u.aux * DD_SLAB + (size_t)(u.orow + ai * 128 + wr * 64 + m * 16 + fr) * 32 + 4 * fq;
                        *(f32x4*)(rowp) = acc[ai][0][m][0]; *(f32x4*)(rowp + 16) = acc[ai][0][m][1]; }
            }
            return;
        }
        const int ccol = (u.pn < 12 ? u.pn - 4 : u.pn - 6) * 256;
#pragma unroll
        for (int ai = 0; ai < 2; ++ai)
#pragma unroll
            for (int m = 0; m < 4; ++m) { float* rowp = PS + (size_t)u.aux * PS_SLAB + (size_t)(u.orow - NLAT + ai * 128 + wr * 64 + m * 16 + fr) * PSLD + ccol + wc * 32 + 4 * fq;
#pragma unroll
                for (int bj = 0; bj < 2; ++bj)
#pragma unroll
                    for (int n = 0; n < 2; ++n) *(f32x4*)(rowp + bj * 128 + n * 16) = acc[ai][bj][m][n]; }
    }
};
struct SchedInprojSplit {
    const char* A; const char* Bt; int G, c;
    static constexpr int NITEM = 4 * (28 + 34);
    __device__ __forceinline__ bool next(int i, g8::Unit& u) const {
        int it; if (!g8::work_id(i, G, c, NITEM, it)) return false;
        int pm, pn; const int ks = it & 3, q = it >> 2;
        if (q < 28) { const int j = q % 14; pm = 32 + q / 14; pn = j < 8 ? 4 + j : (j < 10 ? 6 + j : 6 + j); }
        else { pm = q - 28; pn = PLD / 256; }
        u.A = A + ks * 1024; u.rows = nullptr; u.row0 = pm * 256; u.Bt = Bt + (size_t)pn * 256 * D * 2 + ks * 1024; u.orow = pm * 256; u.pn = pn; u.aux = ks; return true;
    }
};
struct EpiOutproj {
    static constexpr int PERM = 0;
    const float* x; const float* mod; float* X1;
    __device__ __forceinline__ void operator()(const f32x4 (&acc)[2][2][4][2], const g8::Unit& u, int wr, int wc, int fr, int fq) const {
        const int b = u.orow / SEQ; const int col0 = u.pn * 256 + wc * 32 + 4 * fq;
        f32x4 gv[2][2];
#pragma unroll
        for (int bj = 0; bj < 2; ++bj)
#pragma unroll
            for (int n = 0; n < 2; ++n) gv[bj][n] = *(const f32x4*)(mod + (size_t)b * 6 * D + 2 * D + col0 + bj * 128 + n * 16);
#pragma unroll
        for (int ai = 0; ai < 2; ++ai)
#pragma unroll
            for (int m = 0; m < 4; ++m) { const size_t ro = (size_t)(u.orow + ai * 128 + wr * 64 + m * 16 + fr) * D + col0;
#pragma unroll
                for (int bj = 0; bj < 2; ++bj)
#pragma unroll
                    for (int n = 0; n < 2; ++n) { const f32x4 xv = *(const f32x4*)(x + ro + bj * 128 + n * 16);
                        *(f32x4*)(X1 + ro + bj * 128 + n * 16) = xv + gv[bj][n] * acc[ai][bj][m][n]; } }
    }
};
struct EpiUp {
    static constexpr int PERM = 1;
    unsigned char* HB; unsigned char* SHH;
    __device__ __forceinline__ void operator()(const f32x4 (&acc)[2][2][4][2], const g8::Unit& u, int wr, int wc, int fr, int fq) const {
        unsigned char* O = u.aux ? SHH : HB;
#pragma unroll
        for (int ai = 0; ai < 2; ++ai)
#pragma unroll
            for (int m = 0; m < 4; ++m) {
                if (ai * 128 + wr * 64 + m * 16 + fr >= u.nv) continue;
                f32x4 h0, h1;
#pragma unroll
                for (int j = 0; j < 4; ++j) { const float a0 = acc[ai][0][m][0][j] * (1.f / W13SC), a1 = acc[ai][0][m][1][j] * (1.f / W13SC);
                    h0[j] = a0 * __builtin_amdgcn_rcpf(1.f + __builtin_amdgcn_exp2f(-1.4426950408889634f * a0)) * (acc[ai][1][m][0][j] * (HSC / W13SC));
                    h1[j] = a1 * __builtin_amdgcn_rcpf(1.f + __builtin_amdgcn_exp2f(-1.4426950408889634f * a1)) * (acc[ai][1][m][1][j] * (HSC / W13SC)); }
                u32x2 w; int pk = 0;
                pk = __builtin_amdgcn_cvt_pk_fp8_f32(h0[0], h0[1], pk, false); pk = __builtin_amdgcn_cvt_pk_fp8_f32(h0[2], h0[3], pk, true); w.x = (unsigned)pk;
                pk = __builtin_amdgcn_cvt_pk_fp8_f32(h1[0], h1[1], pk, false); pk = __builtin_amdgcn_cvt_pk_fp8_f32(h1[2], h1[3], pk, true); w.y = (unsigned)pk;
                *(u32x2*)(O + (size_t)(u.orow + ai * 128 + wr * 64 + m * 16 + fr) * DE + u.pn * 128 + wc * 32 + 8 * fq) = w;
            }
    }
};
struct EpiDown {
    static constexpr int PERM = 3;
    unsigned char* Y; unsigned char* YS;
    __device__ __forceinline__ void operator()(const f32x4 (&acc)[2][2][4][2], const g8::Unit& u, int wr, int wc, int fr, int fq) const {
        unsigned char* O = u.aux ? YS : Y;
#pragma unroll
        for (int ai = 0; ai < 2; ++ai)
#pragma unroll
            for (int m = 0; m < 4; ++m) { if (ai * 128 + wr * 64 + m * 16 + fr >= u.nv) continue;
                u32x4 w;
#pragma unroll
                for (int q = 0; q < 4; ++q) { const f32x4 v = acc[ai][q >> 1][m][q & 1] * (1.f / (W2SC * HSC)); int pk = 0;
                    pk = __builtin_amdgcn_cvt_pk_fp8_f32(v[0], v[1], pk, false); pk = __builtin_amdgcn_cvt_pk_fp8_f32(v[2], v[3], pk, true); w[q] = (unsigned)pk; }
                *(u32x4*)(O + (size_t)(u.orow + ai * 128 + wr * 64 + m * 16 + fr) * YLD8 + u.pn * 256 + wc * 64 + 16 * fq) = w; }
    }
};
struct SchedDense {
    const char* A; const char* Bt; int K, nM, nN, G, c;
    __device__ __forceinline__ bool next(int i, g8::Unit& u) const {
        int wgid; if (!g8::work_id(i, G, c, nM * nN, wgid)) return false;
        const int nig = 8 * nN, gid = wgid / nig, fm = gid * 8, gsz = (nM - fm) < 8 ? (nM - fm) : 8;
        const int pm = fm + ((wgid % nig) % gsz), pn = (wgid % nig) / gsz;
        u.A = A; u.rows = nullptr; u.row0 = pm * 256; u.Bt = Bt + (size_t)pn * 256 * K * 2; u.orow = pm * 256; u.pn = pn; u.aux = 0; return true;
    }
};
struct SchedUp {
    const int* tp; const char* H2; const int* LIST; const char* E13T; const char* S13T; int G, c;
    __device__ __forceinline__ bool next(int i, g8::Unit& u) const {
        const int T = tp[NE]; int wgid; if (!g8::work_id(i, G, c, 4 * T + 128, wgid)) return false;
        u.A = H2;
        if (wgid < 4 * T) {
            int e = 0;
#pragma unroll
            for (int s = 32; s > 0; s >>= 1) if (4 * tp[e + s] <= wgid) e += s;
            const int tc = tp[e + 1] - tp[e], li = wgid - 4 * tp[e], nt = li / tc, mt = li % tc, r0 = (tp[e] + mt) * 256;
            u.rows = LIST + r0; u.row0 = 0; u.Bt = E13T + ((size_t)e * 1024 + nt * 256) * D; u.orow = r0; u.pn = nt; u.aux = 0; u.nv = min(256, tp[80 + e] - mt * 256);
        } else {
            const int s = wgid - 4 * T, pn = s / 32, pm = s % 32;
            u.rows = nullptr; u.row0 = pm * 256; u.Bt = S13T + (size_t)pn * 256 * D; u.orow = pm * 256; u.pn = pn; u.aux = 1; u.nv = 256;
        }
        return true;
    }
};
struct SchedDown {
    const int* tp; const char* HB; const char* E2T; const char* SHH; const char* S2T; int G, c;
    __device__ __forceinline__ bool next(int i, g8::Unit& u) const {
        const int T = tp[NE]; int wgid; if (!g8::work_id(i, G, c, 8 * T + 256, wgid)) return false;
        u.rows = nullptr;
        if (wgid < 8 * T) {
            int e = 0;
#pragma unroll
            for (int s = 32; s > 0; s >>= 1) if (8 * tp[e + s] <= wgid) e += s;
            const int tc = tp[e + 1] - tp[e], li = wgid - 8 * tp[e], nt = li / tc, mt = li % tc, r0 = (tp[e] + mt) * 256;
            u.A = HB; u.row0 = r0; u.Bt = E2T + ((size_t)e * D + nt * 256) * DE; u.orow = r0; u.pn = nt; u.aux = 0; u.nv = min(256, tp[80 + e] - mt * 256);
        } else {
            const int s = wgid - 8 * T, pn = s / 32, pm = s % 32;
            u.A = SHH; u.row0 = pm * 256; u.Bt = S2T + (size_t)pn * 256 * DE; u.orow = pm * 256; u.pn = pn; u.aux = 1; u.nv = 256;
        }
        return true;
    }
};
__device__ __forceinline__ void moe_tables(const Params& p, int* tp, const int wid0) {
    __syncthreads();
    if (wid0 == 0) { const int e = xb_lane_id(), cn = p.CNT[e], tiles = (cn + 255) / 256; int v = tiles;
#pragma unroll
        for (int o = 1; o < 64; o <<= 1) { const int u = __shfl_up(v, o); if (e >= o) v += u; }
        tp[e] = v - tiles; tp[80 + e] = cn; if (e == 63) tp[NE] = v; }
    __syncthreads();
}

constexpr int NTILE = 136;
__device__ void ph_naprep(const Params& p, const int wid0, const int ubeg, const int uend, const int ustep) {
    const int t = opaque_tid(wid0), w = t >> 6, lane = t & 63, kk = lane >> 4, pc = lane & 15;
    for (int u = ubeg; u < uend; u += ustep) {
        const int b = u / NTILE, T = u % NTILE; const bool lat = T < 128;
        const int row0 = lat ? (b * SEQ + 32 * T) : (NLAT + b * CTXL + 32 * (T - 128));
#pragma unroll 2
        for (int it = w; it < 128; it += 8) {
            const int which = it & 1, hh = (it >> 1) & 7, tt = 4 * (it >> 4) + kk;
            if (which == 0 && !lat) continue;
            float4 v0, v1;
            if (lat) { const u32x4 r8 = *(const u32x4*)(p.P + (size_t)(row0 + tt) * PLD + which * 1024 + hh * 128 + 8 * pc);
                v0 = make_float4(bf2f(r8.x & 0xffffu), bf2f(r8.x >> 16), bf2f(r8.y & 0xffffu), bf2f(r8.y >> 16)); v1 = make_float4(bf2f(r8.z & 0xffffu), bf2f(r8.z >> 16), bf2f(r8.w & 0xffffu), bf2f(r8.w >> 16)); }
            else {
                const float* src = p.PS + (size_t)(row0 - NLAT + tt) * PSLD + hh * 128 + 8 * pc;
                v0 = *(const float4*)src; v1 = *(const float4*)(src + 4);
#pragma unroll
                for (int s = 1; s < 4; ++s) { const float4 a0 = *(const float4*)(src + s * PS_SLAB), a1 = *(const float4*)(src + s * PS_SLAB + 4);
                    v0.x += a0.x; v0.y += a0.y; v0.z += a0.z; v0.w += a0.w; v1.x += a1.x; v1.y += a1.y; v1.z += a1.z; v1.w += a1.w; }
            }
            float ss = v0.x * v0.x + v0.y * v0.y + v0.z * v0.z + v0.w * v0.w + v1.x * v1.x + v1.y * v1.y + v1.z * v1.z + v1.w * v1.w;
            ss += __shfl_xor(ss, 1); ss += __shfl_xor(ss, 2); ss += __shfl_xor(ss, 4); ss += __shfl_xor(ss, 8);
            const float* gp = (which ? p.k_norm_g : p.q_norm_g) + 8 * pc;
            const float4 g0 = *(const float4*)gp, g1 = *(const float4*)(gp + 4);
            const float r = rsqrtf(ss * (1.f / 128.f) + 1e-6f) * (which ? 1.f : 0.08838834764831845f * 1.4426950408889634f);
            u32x4 o;
            o.x = cvt_pk_bf16(v0.x * r * g0.x, v0.y * r * g0.y); o.y = cvt_pk_bf16(v0.z * r * g0.z, v0.w * r * g0.w);
            o.z = cvt_pk_bf16(v1.x * r * g1.x, v1.y * r * g1.y); o.w = cvt_pk_bf16(v1.z * r * g1.z, v1.w * r * g1.w);
            if (which) *(u32x4*)(p.NKf + (((size_t)((b * 8 + hh) * NTILE + T) * 8 + (pc >> 1)) * 64 + tt + 32 * (pc & 1)) * 8) = o;
            else *(u32x4*)(p.NQb + (size_t)(row0 + tt) * 1024 + hh * 128 + 8 * pc) = o;
        }
        if (lat) {
            const int col = 2 * t, hh = col >> 7, dv = col & 127;
            unsigned wv[32];
#pragma unroll
            for (int s = 0; s < 32; ++s) wv[s] = *(const unsigned*)(p.P + (size_t)(row0 + s) * PLD + 2048 + col);
            unsigned pk0[16], pk1[16];
#pragma unroll
            for (int s2 = 0; s2 < 16; ++s2) { pk0[s2] = (wv[2 * s2] & 0xffffu) | (wv[2 * s2 + 1] << 16); pk1[s2] = (wv[2 * s2] >> 16) | (wv[2 * s2 + 1] & 0xffff0000u); }
            bf16_t* o = p.VTf + ((((size_t)((b * 8 + hh) * NTILE + T) * 4 + (dv >> 5)) * 2) * 64 + (dv & 31)) * 8;
#pragma unroll
            for (int g2 = 0; g2 < 2; ++g2) {
                *(u32x4*)(o + (g2 * 64) * 8) = (u32x4){pk0[8 * g2], pk0[8 * g2 + 1], pk0[8 * g2 + 4], pk0[8 * g2 + 5]};
                *(u32x4*)(o + (g2 * 64 + 32) * 8) = (u32x4){pk0[8 * g2 + 2], pk0[8 * g2 + 3], pk0[8 * g2 + 6], pk0[8 * g2 + 7]};
                *(u32x4*)(o + (g2 * 64 + 1) * 8) = (u32x4){pk1[8 * g2], pk1[8 * g2 + 1], pk1[8 * g2 + 4], pk1[8 * g2 + 5]};
                *(u32x4*)(o + (g2 * 64 + 33) * 8) = (u32x4){pk1[8 * g2 + 2], pk1[8 * g2 + 3], pk1[8 * g2 + 6], pk1[8 * g2 + 7]};
            }
        } else {
#pragma unroll 1
        for (int i = 0; i < 2; ++i) {
            const int col = t + 512 * i, hh = col >> 7, dv = col & 127;
            unsigned pk[16];
#pragma unroll
            for (int s2 = 0; s2 < 16; ++s2) {
                const float* s0 = p.PS + (size_t)(row0 - NLAT + 2 * s2) * PSLD + 1024 + col;
                const float x0 = s0[0] + s0[PS_SLAB] + s0[2 * PS_SLAB] + s0[3 * PS_SLAB], x1 = s0[PSLD] + s0[PS_SLAB + PSLD] + s0[2 * PS_SLAB + PSLD] + s0[3 * PS_SLAB + PSLD];
                pk[s2] = cvt_pk_bf16(x0, x1);
            }
            bf16_t* o = p.VTf + ((((size_t)((b * 8 + hh) * NTILE + T) * 4 + (dv >> 5)) * 2) * 64 + (dv & 31)) * 8;
#pragma unroll
            for (int g2 = 0; g2 < 2; ++g2) {
                *(u32x4*)(o + (g2 * 64) * 8) = (u32x4){pk[8 * g2], pk[8 * g2 + 1], pk[8 * g2 + 4], pk[8 * g2 + 5]};
                *(u32x4*)(o + (g2 * 64 + 32) * 8) = (u32x4){pk[8 * g2 + 2], pk[8 * g2 + 3], pk[8 * g2 + 6], pk[8 * g2 + 7]};
            }
        }
        }
    }
}

__device__ __forceinline__ void attn_tile(const LAS unsigned char* sb, const float* bt0, const bf16x8 (&qf)[8], f32x16& o0, f32x16& o1, f32x16& o2, f32x16& o3, float& m, float& l,
                                          bool loc, int half, int dr, int c, int cs, int hi) {
    bf16x8 kc[8], va[8];
#pragma unroll
    for (int ks = 0; ks < 8; ++ks) kc[ks] = *(const LAS bf16x8*)(sb + ks * 1024);
#pragma unroll
    for (int q = 0; q < 8; ++q) va[q] = *(const LAS bf16x8*)(sb + 8192 + q * 1024);
    f32x16 s;
#pragma unroll
    for (int e = 0; e < 16; ++e) s[e] = 0.f;
#pragma unroll
    for (int ks = 0; ks < 8; ++ks) s = __builtin_amdgcn_mfma_f32_32x32x16_bf16(kc[ks], qf[ks], s, 0, 0, 0);
    if (loc) {
        int rel0 = 32 * half + 4 * hi - cs; asm volatile("" : "+v"(rel0));
        const float* bt = bt0 + dr * 31 + cs - c + 15;
        float bz[16];
#pragma unroll
        for (int e = 0; e < 16; ++e) bz[e] = bt[rel0 + (e & 3) + 8 * (e >> 2)];
#pragma unroll
        for (int e = 0; e < 16; ++e) asm volatile("" : "+v"(bz[e]));
#pragma unroll
        for (int e = 0; e < 16; ++e) {
            const int rel = rel0 + (e & 3) + 8 * (e >> 2);
            s[e] = ((unsigned)rel < 16u) ? (s[e] + bz[e]) : -INFINITY;
        }
    }
    float mt = s[0];
#pragma unroll
    for (int e = 1; e < 16; ++e) mt = fmaxf(mt, s[e]);
    mt = fmaxf(mt, __shfl_xor(mt, 32));
    if (__any(mt > m)) {
        const float mn = fmaxf(m, mt);
        const float alpha = __builtin_amdgcn_exp2f(m - mn);
        m = mn; l *= alpha;
#pragma unroll
        for (int e = 0; e < 16; ++e) { o0[e] *= alpha; o1[e] *= alpha; o2[e] *= alpha; o3[e] *= alpha; }
    }
    float ps = 0.f;
#pragma unroll
    for (int e = 0; e < 16; ++e) { s[e] = __builtin_amdgcn_exp2f(s[e] - m); ps += s[e]; }
    l += ps;
    bf16x8 pb[2];
#pragma unroll
    for (int s2 = 0; s2 < 2; ++s2) {
        const u32x4 cat = (u32x4){cvt_pk_bf16(s[8 * s2], s[8 * s2 + 1]), cvt_pk_bf16(s[8 * s2 + 2], s[8 * s2 + 3]), cvt_pk_bf16(s[8 * s2 + 4], s[8 * s2 + 5]), cvt_pk_bf16(s[8 * s2 + 6], s[8 * s2 + 7])};
        pb[s2] = __builtin_bit_cast(bf16x8, cat);
    }
#pragma unroll
    for (int s2 = 0; s2 < 2; ++s2) {
        o0 = __builtin_amdgcn_mfma_f32_32x32x16_bf16(va[0 + s2], pb[s2], o0, 0, 0, 0);
        o1 = __builtin_amdgcn_mfma_f32_32x32x16_bf16(va[2 + s2], pb[s2], o1, 0, 0, 0);
        o2 = __builtin_amdgcn_mfma_f32_32x32x16_bf16(va[4 + s2], pb[s2], o2, 0, 0, 0);
        o3 = __builtin_amdgcn_mfma_f32_32x32x16_bf16(va[6 + s2], pb[s2], o3, 0, 0, 0);
    }
}
__device__ __forceinline__ void glascan_wave(const Params& p, int unit, int dh, int lane, LAS unsigned char* ldsw);
__device__ void ph_attn(const Params& p, unsigned char* smb, const int wid0) {
    const int t = opaque_tid(wid0), lane = t & 63, l31 = lane & 31, hi = lane >> 5;
    const int w = __builtin_amdgcn_readfirstlane(t >> 6);
    LAS unsigned char* lds = (LAS unsigned char*)smb;
    for (int u0 = blockIdx.x; u0 < 256; u0 += gridDim.x) { const int unit = (((u0 & 7) + 8 * (u0 >> 7)) << 4) | ((u0 >> 3) & 15); glascan_wave(p, unit, w, lane, lds + w * 8192); }
    float* tab = (float*)(smb + 4 * 16384);
    for (int u0 = blockIdx.x; u0 < 256; u0 += gridDim.x) {
        const int u = (((u0 & 7) + 8 * (u0 >> 7)) << 4) | ((u0 >> 3) & 15);
        const int rg = u & 15, h = (u >> 4) & 7, b = u >> 7, bh8 = b * 8 + h;
        asm volatile("s_waitcnt vmcnt(0)" ::: "memory");
        __syncthreads();
        for (int i = t; i < 465; i += NT) tab[i] = p.na_rpb[h * 465 + i] * 1.4426950408889634f;
        const int r = 4 * rg + (w >> 1), qt = w & 1, c = 32 * qt + l31;
        const int rs = min(max(r - 4, 0), 56), cs = min(max(c - 8, 0), 48);
        const int Rlo = min(max(4 * rg - 4, 0), 56), Rhi = min(max(4 * rg - 1, 0), 56) + 7, nt = 8 + 2 * (Rhi - Rlo + 1);
        const int qrow = b * SEQ + r * 64 + c;
        bf16x8 qf[8];
#pragma unroll
        for (int ks = 0; ks < 8; ++ks) qf[ks] = *(const bf16x8*)(p.NQb + (size_t)qrow * 1024 + h * 128 + 16 * ks + 8 * hi);
#pragma unroll
        for (int ks = 0; ks < 8; ++ks) asm volatile("" : "+v"(qf[ks]));
        f32x16 o0, o1, o2, o3;
#pragma unroll
        for (int e = 0; e < 16; ++e) { o0[e] = 0.f; o1[e] = 0.f; o2[e] = 0.f; o3[e] = 0.f; }
        float m = -INFINITY, l = 0.f;
        const bf16_t* kg = p.NKf + ((size_t)bh8 * NTILE * 8 + w) * 512 + lane * 8;
        const bf16_t* vg = p.VTf + ((size_t)bh8 * NTILE * 8 + w) * 512 + lane * 8;
#define AT_T(i_) ((i_) < 8 ? (128 + (i_)) : (2 * Rlo + ((i_) - 8)))
#define AT_DMA(i_, st_) do { const int ii_ = (i_) < nt ? (i_) : nt - 1; const size_t to_ = (size_t)AT_T(ii_) * 4096; \
        __builtin_amdgcn_global_load_lds((const unsigned*)(kg + to_), (LAS unsigned*)(lds + (st_) * 16384 + w * 1024), 16, 0, 0); \
        __builtin_amdgcn_global_load_lds((const unsigned*)(vg + to_), (LAS unsigned*)(lds + (st_) * 16384 + 8192 + w * 1024), 16, 0, 0); } while (0)
        asm volatile("s_waitcnt vmcnt(0)" ::: "memory");
        __syncthreads();
        AT_DMA(0, 0); AT_DMA(1, 1); AT_DMA(2, 2);
        int st = 0;
#pragma unroll 1
        for (int i = 0; i < nt; ++i) {
            asm volatile("s_waitcnt vmcnt(4)" ::: "memory");
            __builtin_amdgcn_s_barrier();
            asm volatile("" ::: "memory");
            const int st2 = (st + 3) & 3;
            AT_DMA(i + 3, st2);
            const bool loc = i >= 8; const int R = Rlo + ((i - 8) >> 1), half = (i - 8) & 1;
            if (!loc || (unsigned)(R - rs) < 8u)
                attn_tile(lds + st * 16384 + lane * 16, tab, qf, o0, o1, o2, o3, m, l, loc, half, R - r + 7, c, cs, hi);
            st = (st + 1) & 3;
        }
#undef AT_T
#undef AT_DMA
        l += __shfl_xor(l, 32);
        const float inv = 1.f / l;
        bf16_t* orow = p.MIX + (size_t)qrow * D + h * 128 + 4 * hi;
#pragma unroll
        for (int g = 0; g < 4; ++g) {
            u32x2 pk;
            pk.x = cvt_pk_bf16(o0[4 * g] * inv, o0[4 * g + 1] * inv); pk.y = cvt_pk_bf16(o0[4 * g + 2] * inv, o0[4 * g + 3] * inv); *(u32x2*)(orow + 0 + 8 * g) = pk;
            pk.x = cvt_pk_bf16(o1[4 * g] * inv, o1[4 * g + 1] * inv); pk.y = cvt_pk_bf16(o1[4 * g + 2] * inv, o1[4 * g + 3] * inv); *(u32x2*)(orow + 32 + 8 * g) = pk;
            pk.x = cvt_pk_bf16(o2[4 * g] * inv, o2[4 * g + 1] * inv); pk.y = cvt_pk_bf16(o2[4 * g + 2] * inv, o2[4 * g + 3] * inv); *(u32x2*)(orow + 64 + 8 * g) = pk;
            pk.x = cvt_pk_bf16(o3[4 * g] * inv, o3[4 * g + 1] * inv); pk.y = cvt_pk_bf16(o3[4 * g + 2] * inv, o3[4 * g + 3] * inv); *(u32x2*)(orow + 96 + 8 * g) = pk;
        }
    }
    asm volatile("s_waitcnt vmcnt(0)" ::: "memory");
}

__device__ __forceinline__ float logsigf(float z) { return fminf(z, 0.f) - log1pf(expf(-fabsf(z))); }

__device__ __forceinline__ float fexp2(float x) { return __builtin_amdgcn_exp2f(x); }
__device__ __forceinline__ float logsig2_16(float z) { return (fminf(z, 0.f) * 1.4426950408889634f - __builtin_amdgcn_logf(1.f + fexp2(-fabsf(z) * 1.4426950408889634f))) * (1.f / 16.f); }

__device__ void ph_glaprep(const Params& p, float* sm, const int wid0, const int ubeg, const int uend, const int ustep) {
    const int t = opaque_tid(wid0), d2 = t & 63, tq = t >> 6, d = 2 * d2;
    float* qs = sm;
    float* ksm = sm + 8192;
    float* dds = sm + 16384;
    float* tot = sm + 16384 + 2048;
    for (int u = ubeg; u < uend; u += ustep) {
        const int bh = u / 68, c = u % 68, b = bh >> 2, h = bh & 3;
        const bool lat = c >= 4; const int j = c - 4;
        const int row0 = lat ? (b * SEQ + 64 * j) : (NLAT + b * CTXL + 64 * c);
        __syncthreads();
        {
            const int cq = t & 31, tr = t >> 5;
#pragma unroll
            for (int i = 0; i < 4; ++i) { const int tt = tr + 16 * i;
                if (lat) {
                    const u32x2 q4 = *(const u32x2*)(p.P + (size_t)(row0 + tt) * PLD + 3072 + h * 128 + 4 * cq), k4 = *(const u32x2*)(p.P + (size_t)(row0 + tt) * PLD + 3584 + h * 128 + 4 * cq);
                    *(float4*)(qs + tt * 128 + 4 * cq) = make_float4(bf2f(q4.x & 0xffffu), bf2f(q4.x >> 16), bf2f(q4.y & 0xffffu), bf2f(q4.y >> 16));
                    *(float4*)(ksm + tt * 128 + 4 * cq) = make_float4(bf2f(k4.x & 0xffffu), bf2f(k4.x >> 16), bf2f(k4.y & 0xffffu), bf2f(k4.y >> 16));
                } else {
                    const float* src = p.PS + (size_t)(row0 - NLAT + tt) * PSLD + 2048 + h * 128 + 4 * cq;
                    float4 kv = *(const float4*)src;
#pragma unroll
                    for (int s = 1; s < 4; ++s) { const float4 a0 = *(const float4*)(src + s * PS_SLAB); kv.x += a0.x; kv.y += a0.y; kv.z += a0.z; kv.w += a0.w; }
                    *(float4*)(qs + tt * 128 + 4 * cq) = make_float4(0.f, 0.f, 0.f, 0.f); *(float4*)(ksm + tt * 128 + 4 * cq) = kv;
                } }
            { const float* src = p.DDS + (size_t)row0 * 32 + 4 * t; float4 dv = *(const float4*)src;
#pragma unroll
              for (int s = 1; s < 4; ++s) { const float4 a0 = *(const float4*)(src + s * DD_SLAB); dv.x += a0.x; dv.y += a0.y; dv.z += a0.z; dv.w += a0.w; }
              *(float4*)(dds + 4 * t) = dv; }
        }
        __syncthreads();
        float gf0[8], gf1[8], gb0[8], gb1[8];
        {
            float uf0[16], uf1[16], ub0[16], ub1[16];
#pragma unroll
            for (int r = 0; r < 16; ++r) { const float2 a = *(const float2*)(p.up_f + r * 512 + h * 128 + d), bq = *(const float2*)(p.up_b + r * 512 + h * 128 + d); uf0[r] = a.x; uf1[r] = a.y; ub0[r] = bq.x; ub1[r] = bq.y; }
            const float2 bf = *(const float2*)(p.bias_f + h * 128 + d), bb = *(const float2*)(p.bias_b + h * 128 + d);
            float sf0 = 0.f, sf1 = 0.f, sb0 = 0.f, sb1 = 0.f;
#pragma unroll
            for (int i = 0; i < 8; ++i) {
                const float* dr = dds + (8 * tq + i) * 32; float zf0 = bf.x, zf1 = bf.y, zb0 = bb.x, zb1 = bb.y;
#pragma unroll
                for (int r = 0; r < 16; ++r) { const float x = dr[r], y = dr[16 + r]; zf0 += x * uf0[r]; zf1 += x * uf1[r]; zb0 += y * ub0[r]; zb1 += y * ub1[r]; }
                gf0[i] = logsig2_16(zf0); gf1[i] = logsig2_16(zf1); gb0[i] = logsig2_16(zb0); gb1[i] = logsig2_16(zb1);
                sf0 += gf0[i]; sf1 += gf1[i]; sb0 += gb0[i]; sb1 += gb1[i];
            }
            *(float2*)(tot + tq * 128 + d) = make_float2(sf0, sf1); *(float2*)(tot + (8 + tq) * 128 + d) = make_float2(sb0, sb1);
        }
        __syncthreads();
        float2 basef = make_float2(0.f, 0.f), baseb = basef, allf = basef, allb = basef;
#pragma unroll
        for (int q8 = 0; q8 < 8; ++q8) { const float2 a = *(const float2*)(tot + q8 * 128 + d), bq = *(const float2*)(tot + (8 + q8) * 128 + d);
            allf.x += a.x; allf.y += a.y; allb.x += bq.x; allb.y += bq.y;
            if (q8 < tq) { basef.x += a.x; basef.y += a.y; } if (q8 > tq) { baseb.x += bq.x; baseb.y += bq.y; } }
        { float r0 = basef.x, r1 = basef.y;
#pragma unroll
          for (int i = 0; i < 8; ++i) { r0 += gf0[i]; gf0[i] = r0; r1 += gf1[i]; gf1[i] = r1; }
          r0 = baseb.x; r1 = baseb.y;
#pragma unroll
          for (int i = 7; i >= 0; --i) { r0 += gb0[i]; gb0[i] = r0; r1 += gb1[i]; gb1[i] = r1; } }
        const int dd2 = d & 63, ii = dd2 & 31, partner = (dd2 < 32) ? (d + 32) : (d - 32);
        const float sgn = (dd2 < 32) ? -1.f : 1.f;
        unsigned khf0[4], khf1[4], khb0[4], khb1[4]; float pf0 = 0.f, pf1 = 0.f, pb0 = 0.f, pb1 = 0.f;
        const size_t tb = ((size_t)(bh * 64 + j) * 64) * 128;
#pragma unroll
        for (int i = 0; i < 8; ++i) {
            const int tt = 8 * tq + i;
            float2 qv = *(const float2*)(qs + tt * 128 + d), kv = *(const float2*)(ksm + tt * 128 + d);
            if (lat) {
                const int pos = (d < 64) ? j : tt;
                const float4 cssn = *(const float4*)(p.RT + (pos * 32 + ii) * 2);
                const float2 qp = *(const float2*)(qs + tt * 128 + partner), kp = *(const float2*)(ksm + tt * 128 + partner);
                qv.x = qv.x * cssn.x + sgn * qp.x * cssn.y; qv.y = qv.y * cssn.z + sgn * qp.y * cssn.w;
                kv.x = kv.x * cssn.x + sgn * kp.x * cssn.y; kv.y = kv.y * cssn.z + sgn * kp.y * cssn.w;
            }
            qv.x *= 0.08838834764831845f; qv.y *= 0.08838834764831845f;
            if (lat) {
                const float ef0 = fexp2(gf0[i]), ef1 = fexp2(gf1[i]), eb0 = fexp2(gb0[i]), eb1 = fexp2(gb1[i]);
                const float nf0 = fexp2(-gf0[i]), nf1 = fexp2(-gf1[i]), nb0 = fexp2(-gb0[i]), nb1 = fexp2(-gb1[i]);
                const size_t o = tb + (size_t)tt * 128 + d;
                *(unsigned*)(p.QF + o) = cvt_pk_bf16(qv.x * ef0, qv.y * ef1); *(unsigned*)(p.KF + o) = cvt_pk_bf16(kv.x * nf0, kv.y * nf1);
                *(unsigned*)(p.QB + o) = cvt_pk_bf16(qv.x * eb0, qv.y * eb1); *(unsigned*)(p.KB + o) = cvt_pk_bf16(kv.x * nb0, kv.y * nb1);
            }
            const float hf0 = kv.x * fexp2(allf.x - gf0[i]), hf1 = kv.y * fexp2(allf.y - gf1[i]), hb0 = kv.x * fexp2(allb.x - gb0[i]), hb1 = kv.y * fexp2(allb.y - gb1[i]);
            if (i & 1) { khf0[i >> 1] = cvt_pk_bf16(pf0, hf0); khf1[i >> 1] = cvt_pk_bf16(pf1, hf1); khb0[i >> 1] = cvt_pk_bf16(pb0, hb0); khb1[i >> 1] = cvt_pk_bf16(pb1, hb1); }
            else { pf0 = hf0; pf1 = hf1; pb0 = hb0; pb1 = hb1; }
        }
        {
            const size_t o = ((((size_t)(bh * 68 + c) * 8 + (d >> 4)) * 2 + (tq >> 2)) * 64 + (d & 15) + 16 * (tq & 3)) * 8;
            *(u32x4*)(p.KHF + o) = (u32x4){khf0[0], khf0[1], khf0[2], khf0[3]}; *(u32x4*)(p.KHF + o + 8) = (u32x4){khf1[0], khf1[1], khf1[2], khf1[3]};
            *(u32x4*)(p.KHB + o) = (u32x4){khb0[0], khb0[1], khb0[2], khb0[3]}; *(u32x4*)(p.KHB + o + 8) = (u32x4){khb1[0], khb1[1], khb1[2], khb1[3]};
            if (tq == 0) { *(float2*)(p.DF + (size_t)(bh * 68 + c) * 128 + d) = make_float2(fexp2(allf.x), fexp2(allf.y)); *(float2*)(p.DB + (size_t)(bh * 68 + c) * 128 + d) = make_float2(fexp2(allb.x), fexp2(allb.y)); }
        }
        if (lat) {
            const int v = 2 * (t & 127), qr = t >> 7;
            unsigned wv[16];
#pragma unroll
            for (int s = 0; s < 16; ++s) wv[s] = *(const unsigned*)(p.P + (size_t)(row0 + 16 * qr + s) * PLD + 4096 + h * 256 + v);
            unsigned pk0[8], pk1[8];
#pragma unroll
            for (int s2 = 0; s2 < 8; ++s2) { pk0[s2] = (wv[2 * s2] & 0xffffu) | (wv[2 * s2 + 1] << 16); pk1[s2] = (wv[2 * s2] >> 16) | (wv[2 * s2 + 1] & 0xffff0000u); }
            bf16_t* o = p.VT + ((size_t)(bh * 68 + c) * 256 + v) * 64 + 16 * qr;
#pragma unroll
            for (int q8 = 0; q8 < 2; ++q8) {
                const u32x4 a0 = (u32x4){pk0[4 * q8], pk0[4 * q8 + 1], pk0[4 * q8 + 2], pk0[4 * q8 + 3]}, a1 = (u32x4){pk1[4 * q8], pk1[4 * q8 + 1], pk1[4 * q8 + 2], pk1[4 * q8 + 3]};
                *(u32x4*)(o + 8 * q8) = a0; *(u32x4*)(o + 64 + 8 * q8) = a1;
                bf16_t* o2 = p.VTS + ((((size_t)(bh * 68 + c) * 16 + (v >> 4)) * 2 + (qr >> 1)) * 64 + (v & 15) + 16 * ((2 * qr + q8) & 3)) * 8;
                *(u32x4*)o2 = a0; *(u32x4*)(o2 + 8) = a1;
            }
        } else {
            const int v = t & 255, half = t >> 8;
            unsigned pk[16];
#pragma unroll
            for (int s2 = 0; s2 < 16; ++s2) {
                const float* s0 = p.PS + (size_t)(row0 - NLAT + 32 * half + 2 * s2) * PSLD + 2560 + h * 256 + v;
                const float a = s0[0] + s0[PS_SLAB] + s0[2 * PS_SLAB] + s0[3 * PS_SLAB], bq = s0[PSLD] + s0[PS_SLAB + PSLD] + s0[2 * PS_SLAB + PSLD] + s0[3 * PS_SLAB + PSLD];
                pk[s2] = cvt_pk_bf16(a, bq);
            }
            bf16_t* o = p.VT + ((size_t)(bh * 68 + c) * 256 + v) * 64 + 32 * half;
            bf16_t* o2 = p.VTS + ((((size_t)(bh * 68 + c) * 16 + (v >> 4)) * 2 + half) * 64 + (v & 15)) * 8;
#pragma unroll
            for (int q4 = 0; q4 < 4; ++q4) { const u32x4 pv = (u32x4){pk[4 * q4], pk[4 * q4 + 1], pk[4 * q4 + 2], pk[4 * q4 + 3]}; *(u32x4*)(o + 8 * q4) = pv; *(u32x4*)(o2 + (16 * q4) * 8) = pv; }
        }
    }
}

__device__ __forceinline__ void glascan_wave(const Params& p, int unit, int dh, int lane, LAS unsigned char* ldsw) {
    const int v16 = unit & 15, scan = unit >> 4, dir = scan >> 3, bh = scan & 7;
    const int fr = lane & 15, fq = lane >> 4, d0 = 16 * dh, v0 = 16 * v16;
    const bf16_t* KH = (dir ? p.KHB : p.KHF) + (((size_t)bh * 68 * 8 + dh) * 2) * 512 + lane * 8;
    const bf16_t* VTp = p.VTS + (((size_t)bh * 68 * 16 + v16) * 2) * 512 + lane * 8;
    const float* DV = (dir ? p.DB : p.DF) + (size_t)bh * 68 * 128 + d0 + 4 * fq;
    bf16_t* SSp = p.SS + ((((size_t)dir * 8 + bh) * 65) * 256 + v0 + fr) * 128 + d0 + 4 * fq;
    LAS u32x2* sl = (LAS u32x2*)ldsw + lane;
    f32x4 acc = (f32x4){0.f, 0.f, 0.f, 0.f};
#define SC_CHUNK(n) (dir ? ((n) < 4 ? 3 - (n) : 71 - (n)) : (n))
#define SC_LOAD(S_, n) do { const int nn_ = (n) < 68 ? (n) : 67; const int c_ = SC_CHUNK(nn_); \
        S_##a0 = *(const bf16x8*)(KH + (size_t)c_ * 8192); S_##a1 = *(const bf16x8*)(KH + (size_t)c_ * 8192 + 512); \
        S_##b0 = *(const bf16x8*)(VTp + (size_t)c_ * 16384); S_##b1 = *(const bf16x8*)(VTp + (size_t)c_ * 16384 + 512); \
        S_##d = *(const f32x4*)(DV + (size_t)c_ * 128); } while (0)
#define SC_STEP(S_, k) do { u32x2 pk; pk.x = cvt_pk_bf16(acc[0], acc[1]); pk.y = cvt_pk_bf16(acc[2], acc[3]); sl[(k) * 64] = pk; \
        acc = acc * S_##d; \
        acc = __builtin_amdgcn_mfma_f32_16x16x32_bf16(S_##a0, S_##b0, acc, 0, 0, 0); acc = __builtin_amdgcn_mfma_f32_16x16x32_bf16(S_##a1, S_##b1, acc, 0, 0, 0); } while (0)
    bf16x8 Aa0, Aa1, Ab0, Ab1, Ba0, Ba1, Bb0, Bb1, Ca0, Ca1, Cb0, Cb1, Da0, Da1, Db0, Db1; f32x4 Ad, Bd, Cd, Dd;
    SC_LOAD(A, 0); SC_LOAD(B, 1); SC_LOAD(C, 2);
#pragma unroll 1
    for (int nb = 0; nb < 68; nb += 16) {
        const int iters = (nb + 16 <= 68) ? 4 : 1;
#pragma unroll 1
        for (int it = 0; it < iters; ++it) {
            const int n = nb + 4 * it;
            SC_LOAD(D, n + 3); SC_STEP(A, 4 * it);
            SC_LOAD(A, n + 4); SC_STEP(B, 4 * it + 1);
            SC_LOAD(B, n + 5); SC_STEP(C, 4 * it + 2);
            SC_LOAD(C, n + 6); SC_STEP(D, 4 * it + 3);
        }
#pragma unroll 1
        for (int k = 0; k < 4 * iters; ++k) { const int c_ = SC_CHUNK(nb + k); *(u32x2*)(SSp + (size_t)(c_ >= 4 ? c_ - 4 : 64) * 256 * 128) = sl[k * 64]; }
    }
#undef SC_CHUNK
#undef SC_LOAD
#undef SC_STEP
}

__device__ void ph_glaout(const Params& p, unsigned char* smb, const int wid0) {
    const int t = opaque_tid(wid0), w = t >> 6, lane = t & 63, l31 = lane & 31, hi = lane >> 5;
    const int wv = w & 3, wt = w >> 2;
    bf16_t* att = (bf16_t*)smb;
    float* ssq = (float*)(smb + 2 * 64 * 144);
    for (int u = blockIdx.x; u < 512; u += gridDim.x) {
        const int bh = u >> 6, j = u & 63, b = bh >> 2, h = bh & 3;
        const size_t tb = ((size_t)(bh * 64 + j) * 64) * 128;
        {
            const int dir = w >> 2, ts = (w >> 1) & 1, tt = w & 1;
            const bf16_t* Qm = (dir ? p.QB : p.QF) + tb; const bf16_t* Km = (dir ? p.KB : p.KF) + tb;
            const bool zero = dir ? (ts < tt) : (ts > tt);
            f32x16 s;
#pragma unroll
            for (int r = 0; r < 16; ++r) s[r] = 0.f;
            if (!zero) {
#pragma unroll
                for (int ks = 0; ks < 8; ++ks) {
                    const bf16x8 ka = *(const bf16x8*)(Km + (size_t)(32 * ts + l31) * 128 + 16 * ks + 8 * hi);
                    const bf16x8 qb = *(const bf16x8*)(Qm + (size_t)(32 * tt + l31) * 128 + 16 * ks + 8 * hi);
                    s = __builtin_amdgcn_mfma_f32_32x32x16_bf16(ka, qb, s, 0, 0, 0);
                }
            }
            const int tcol = 32 * tt + l31;
#pragma unroll
            for (int g = 0; g < 4; ++g) {
                float vv[4];
#pragma unroll
                for (int e = 0; e < 4; ++e) { const int srow = 32 * ts + 8 * g + 4 * hi + e; const bool keep = dir ? (srow >= tcol) : (srow <= tcol); vv[e] = keep ? s[4 * g + e] : 0.f; }
                u32x2 pk; pk.x = cvt_pk_bf16(vv[0], vv[1]); pk.y = cvt_pk_bf16(vv[2], vv[3]);
                *(u32x2*)(att + ((size_t)dir * 64 + tcol) * 72 + 32 * ts + 8 * g + 4 * hi) = pk;
            }
        }
        __syncthreads();
        f32x16 o0, o1;
#pragma unroll
        for (int r = 0; r < 16; ++r) { o0[r] = 0.f; o1[r] = 0.f; }
        const int tB = 32 * wt + l31;
        const bf16_t* vt0 = p.VT + ((size_t)(bh * 68 + 4 + j) * 256 + 64 * wv + l31) * 64 + 8 * hi;
#pragma unroll
        for (int dir = 0; dir < 2; ++dir) {
#pragma unroll
            for (int ks = 0; ks < 4; ++ks) {
                const bf16x8 bb = *(const bf16x8*)(att + ((size_t)dir * 64 + tB) * 72 + 16 * ks + 8 * hi);
                const bf16x8 a0 = *(const bf16x8*)(vt0 + 16 * ks), a1 = *(const bf16x8*)(vt0 + 32 * 64 + 16 * ks);
                o0 = __builtin_amdgcn_mfma_f32_32x32x16_bf16(a0, bb, o0, 0, 0, 0);
                o1 = __builtin_amdgcn_mfma_f32_32x32x16_bf16(a1, bb, o1, 0, 0, 0);
            }
            const bf16_t* ss0 = p.SS + ((((size_t)dir * 8 + bh) * 65 + j) * 256 + 64 * wv + l31) * 128 + 8 * hi;
            const bf16_t* qm = (dir ? p.QB : p.QF) + tb + (size_t)tB * 128 + 8 * hi;
#pragma unroll
            for (int ks = 0; ks < 8; ++ks) {
                const bf16x8 bb = *(const bf16x8*)(qm + 16 * ks);
                const bf16x8 a0 = *(const bf16x8*)(ss0 + 16 * ks), a1 = *(const bf16x8*)(ss0 + 32 * 128 + 16 * ks);
                o0 = __builtin_amdgcn_mfma_f32_32x32x16_bf16(a0, bb, o0, 0, 0, 0);
                o1 = __builtin_amdgcn_mfma_f32_32x32x16_bf16(a1, bb, o1, 0, 0, 0);
            }
        }
        float ss = 0.f;
#pragma unroll
        for (int r = 0; r < 16; ++r) ss += o0[r] * o0[r] + o1[r] * o1[r];
        ss += __shfl_xor(ss, 32);
        if (hi == 0) ssq[(wt * 4 + wv) * 32 + l31] = ss;
        __syncthreads();
        const float tot = ssq[(wt * 4 + 0) * 32 + l31] + ssq[(wt * 4 + 1) * 32 + l31] + ssq[(wt * 4 + 2) * 32 + l31] + ssq[(wt * 4 + 3) * 32 + l31];
        const float rstd = rsqrtf(tot * (1.f / 256.f) + 1e-6f);
        const int row = b * SEQ + 64 * j + tB;
        f32x4 gateA[2][4], gnA[2][4];
#pragma unroll
        for (int vt = 0; vt < 2; ++vt)
#pragma unroll
            for (int g = 0; g < 4; ++g) { const int v = 64 * wv + 32 * vt + 8 * g + 4 * hi;
                const u32x2 g4 = *(const u32x2*)(p.P + (size_t)row * PLD + 5120 + h * 256 + v);
                gateA[vt][g] = (f32x4){bf2f(g4.x & 0xffffu), bf2f(g4.x >> 16), bf2f(g4.y & 0xffffu), bf2f(g4.y >> 16)}; gnA[vt][g] = *(const f32x4*)(p.gla_norm_g + v); }
#pragma unroll
        for (int vt = 0; vt < 2; ++vt)
#pragma unroll
            for (int g = 0; g < 4; ++g) {
                const int v = 64 * wv + 32 * vt + 8 * g + 4 * hi;
                const f32x4 gate = gateA[vt][g], gn = gnA[vt][g];
                float ov[4];
#pragma unroll
                for (int e = 0; e < 4; ++e) { const float x = vt ? o1[4 * g + e] : o0[4 * g + e];
                    ov[e] = x * rstd * gn[e] * gate[e] * __builtin_amdgcn_rcpf(1.f + __builtin_amdgcn_exp2f(-1.4426950408889634f * gate[e])); }
                u32x2 pk; pk.x = cvt_pk_bf16(ov[0], ov[1]); pk.y = cvt_pk_bf16(ov[2], ov[3]);
                *(u32x2*)(p.MIX + (size_t)row * D + 1024 + h * 256 + v) = pk;
            }
        __syncthreads();
    }
}

__device__ void ph_norm2_router(const Params& p, float* sm, const int wid0) {
    const int t = opaque_tid(wid0), w = t >> 6, lane = t & 63;
    float* hs = sm;
    float* part = sm + 8 * D;
    int* hist = (int*)(sm + 8 * D + 8 * 8 * 64);
    const int G = gridDim.x, gpb = (NLAT / 8 + G - 1) / G;
    if (t < 64) hist[t] = 0;
    const int rb0 = blockIdx.x * gpb, rb1 = min(NLAT / 8, rb0 + gpb);
    float4 v[8];
    if (rb0 < rb1) {
#pragma unroll
        for (int j = 0; j < 8; ++j) v[j] = *(const float4*)(p.X1 + (size_t)(rb0 * 8 + w) * D + 256 * j + 4 * lane);
    }
    for (int rb = rb0; rb < rb1; ++rb) {
        const int row = rb * 8 + w, b = row / SEQ;
        const float* m = p.mod + (size_t)b * 6 * D;
        float ss = 0.f;
#pragma unroll
        for (int j = 0; j < 8; ++j) ss += v[j].x * v[j].x + v[j].y * v[j].y + v[j].z * v[j].z + v[j].w * v[j].w;
        ss = wave_sum(ss);
        const float rs = rsqrtf(ss * (1.f / D) + 1e-6f);
        __syncthreads();
        float4 vn[8];
        if (rb + 1 < rb1) {
#pragma unroll
            for (int j = 0; j < 8; ++j) vn[j] = *(const float4*)(p.X1 + (size_t)(row + 8) * D + 256 * j + 4 * lane);
        }
#pragma unroll
        for (int j = 0; j < 8; ++j) {
            const int col = 256 * j + 4 * lane;
            const float4 g = *(const float4*)(p.norm2_g + col), sh = *(const float4*)(m + 3 * D + col), sc = *(const float4*)(m + 4 * D + col);
            float4 o;
            o.x = v[j].x * rs * g.x * (1.f + sc.x) + sh.x; o.y = v[j].y * rs * g.y * (1.f + sc.y) + sh.y;
            o.z = v[j].z * rs * g.z * (1.f + sc.z) + sh.z; o.w = v[j].w * rs * g.w * (1.f + sc.w) + sh.w;
            *(float4*)(hs + w * D + col) = o;
            int pk = 0; pk = __builtin_amdgcn_cvt_pk_fp8_f32(o.x, o.y, pk, false); pk = __builtin_amdgcn_cvt_pk_fp8_f32(o.z, o.w, pk, true);
            *(unsigned*)((unsigned char*)p.H + (size_t)row * D + col) = (unsigned)pk;
        }
        if (rb + 1 < rb1) {
#pragma unroll
            for (int j = 0; j < 8; ++j) v[j] = vn[j];
        }
        __syncthreads();
        {
            const int e4 = t & 15, kp = t >> 4;
            float a[8][4];
#pragma unroll
            for (int r = 0; r < 8; ++r)
#pragma unroll
                for (int j = 0; j < 4; ++j) a[r][j] = 0.f;
#pragma unroll 4
            for (int kk = 0; kk < 64; ++kk) {
                const int k = kk * 32 + kp;
                const float4 wv = *(const float4*)(p.router_w + (size_t)k * NE + 4 * e4);
#pragma unroll
                for (int r = 0; r < 8; ++r) { const float hv = hs[r * D + k]; a[r][0] += hv * wv.x; a[r][1] += hv * wv.y; a[r][2] += hv * wv.z; a[r][3] += hv * wv.w; }
            }
#pragma unroll
            for (int r = 0; r < 8; ++r)
#pragma unroll
                for (int j = 0; j < 4; ++j) { float x = a[r][j]; x += __shfl_xor(x, 16); x += __shfl_xor(x, 32); a[r][j] = x; }
            if (lane < 16) {
#pragma unroll
                for (int r = 0; r < 8; ++r) *(float4*)(part + (w * 8 + r) * 64 + 4 * lane) = make_float4(a[r][0], a[r][1], a[r][2], a[r][3]);
            }
        }
        __syncthreads();
        {
            float lgt = 0.f;
#pragma unroll
            for (int i = 0; i < 8; ++i) lgt += part[(i * 8 + w) * 64 + lane];
            const float sc = 1.f / (1.f + expf(-lgt));
            const float bs = sc + p.router_bias[lane];
            float m1 = bs; m1 = fmaxf(m1, __shfl_xor(m1, 1)); m1 = fmaxf(m1, __shfl_xor(m1, 2)); m1 = fmaxf(m1, __shfl_xor(m1, 4));
            int ai = (bs == m1) ? lane : 64; ai = min(ai, __shfl_xor(ai, 1)); ai = min(ai, __shfl_xor(ai, 2)); ai = min(ai, __shfl_xor(ai, 4));
            float m2 = (lane == ai) ? -INFINITY : bs; m2 = fmaxf(m2, __shfl_xor(m2, 1)); m2 = fmaxf(m2, __shfl_xor(m2, 2)); m2 = fmaxf(m2, __shfl_xor(m2, 4));
            const float gs = m1 + m2;
            float g0 = __shfl(gs, 0), g1 = __shfl(gs, 8), g2 = __shfl(gs, 16), g3 = __shfl(gs, 24), g4 = __shfl(gs, 32), g5 = __shfl(gs, 40), g6 = __shfl(gs, 48), g7 = __shfl(gs, 56);
            unsigned selmask = 0u;
#pragma unroll
            for (int it = 0; it < 4; ++it) {
                float best = -INFINITY; int bi = 0;
                if (!(selmask & 1u) && g0 > best) { best = g0; bi = 0; }
                if (!(selmask & 2u) && g1 > best) { best = g1; bi = 1; }
                if (!(selmask & 4u) && g2 > best) { best = g2; bi = 2; }
                if (!(selmask & 8u) && g3 > best) { best = g3; bi = 3; }
                if (!(selmask & 16u) && g4 > best) { best = g4; bi = 4; }
                if (!(selmask & 32u) && g5 > best) { best = g5; bi = 5; }
                if (!(selmask & 64u) && g6 > best) { best = g6; bi = 6; }
                if (!(selmask & 128u) && g7 > best) { best = g7; bi = 7; }
                selmask |= 1u << bi;
            }
            float cand = ((selmask >> (lane >> 3)) & 1u) ? bs : -INFINITY;
            int myslot = -1; float ssum = 0.f;
#pragma unroll
            for (int k = 0; k < TOPK; ++k) {
                const float mv = wave_max(cand);
                const int idx = wave_min_i((cand == mv) ? lane : 64);
                const float sv = __shfl(sc, idx);
                ssum += sv;
                if (lane == idx) { myslot = k; cand = -INFINITY; }
            }
            if (myslot >= 0) {
                p.EIDX[row * TOPK + myslot] = lane;
                p.EW[row * TOPK + myslot] = sc / ssum * 2.5f;
                p.LRANK[row * TOPK + myslot] = atomicAdd(&hist[lane], 1);
            }
        }
    }
    __syncthreads();
    if (t < 64) p.CNTB[blockIdx.x * 64 + t] = hist[t];
}

__device__ void ph_lists(const Params& p, int* smi, int* scr, const int wid0) {
    const int t = opaque_tid(wid0);
    const int G = gridDim.x, gpb = (NLAT / 8 + G - 1) / G;
    int* tp = smi + 128; int* tot = smi + 64;
    __syncthreads();
    {
        const int e = t & 63, part = t >> 6;
        int before = 0, all = 0;
        for (int b0 = part; b0 < G; b0 += 256) {
            int cv[32];
#pragma unroll
            for (int j = 0; j < 32; ++j) { const int bb = b0 + 8 * j; cv[j] = bb < G ? p.CNTB[bb * 64 + e] : 0; }
#pragma unroll
            for (int j = 0; j < 32; ++j) { const int bb = b0 + 8 * j; all += cv[j]; if (bb < (int)blockIdx.x) before += cv[j]; }
        }
        scr[part * 64 + e] = before; scr[512 + part * 64 + e] = all;
    }
    __syncthreads();
    if (t < 64) {
        int before = 0, all = 0;
#pragma unroll
        for (int q = 0; q < 8; ++q) { before += scr[q * 64 + t]; all += scr[512 + q * 64 + t]; }
        smi[t] = before; tot[t] = all;
        if (blockIdx.x == 0) p.CNT[t] = all;
        const int tiles = (all + 255) / 256; int v = tiles;
#pragma unroll
        for (int o = 1; o < 64; o <<= 1) { const int u = __shfl_up(v, o); if (t >= o) v += u; }
        tp[t] = v - tiles; if (t == 63) tp[NE] = v;
    }
    __syncthreads();
    const int r0 = blockIdx.x * gpb * 8, r1 = min(NLAT, r0 + gpb * 8);
    for (int i = r0 * TOPK + t; i < r1 * TOPK; i += NT) {
        const int e = p.EIDX[i];
        const int pos = tp[e] * 256 + smi[e] + p.LRANK[i];
        p.PAIRPOS[i] = pos; p.LIST[pos] = i / TOPK;
    }
    for (int e = blockIdx.x; e < NE; e += G) {
        const int cn = tot[e], end = (tp[e + 1] - tp[e]) * 256;
        for (int i = cn + t; i < end; i += NT) p.LIST[tp[e] * 256 + i] = 0;
    }
}


__device__ void ph_prep(const Params& p, float* sm, const int wid0) {
    int* qslot = (int*)(sm + 21000);
    for (;;) {
        __syncthreads();
        if (wid0 == 0 && xb_lane_id() == 0) *qslot = atomicAdd(p.QCTR, 1);
        __syncthreads();
        const int it = *qslot;
        if (it >= 272 + 544) break;
        if (it < 272) { const int u = it < 16 ? ((it >> 3) * NTILE + 128 + (it & 7)) : (((it - 16) >> 7) * NTILE + ((it - 16) & 127)); ph_naprep(p, wid0, u, u + 1, 1); }
        else ph_glaprep(p, sm, wid0, it - 272, it - 271, 1);
    }
}

__device__ void ph_combine(const Params& p, const int wid0) {
    const int t = opaque_tid(wid0), w = t >> 6, lane = t & 63;
    for (int row = blockIdx.x * 8 + w; row < NLAT; row += gridDim.x * 8) {
        const int b = row / SEQ;
        float wk[TOPK]; const unsigned char* yr[TOPK];
#pragma unroll
        for (int k = 0; k < TOPK; ++k) { wk[k] = p.EW[row * TOPK + k]; yr[k] = p.Y8 + (size_t)p.PAIRPOS[row * TOPK + k] * YLD8 + 16 * lane; }
        const unsigned char* ys = p.YS8 + (size_t)row * YLD8 + 16 * lane;
        const float* x1 = p.X1 + (size_t)row * D + 16 * lane;
        const float* g2 = p.mod + (size_t)b * 6 * D + 5 * D + 16 * lane;
        float* o = p.out + (size_t)row * D + 16 * lane;
#pragma unroll
        for (int j = 0; j < 2; ++j) {
            float s[16];
            { const u32x4 v = *(const u32x4*)(ys + 1024 * j);
#pragma unroll
              for (int q = 0; q < 4; ++q) { const f32x2 lo = __builtin_amdgcn_cvt_pk_f32_fp8((int)v[q], false), hi = __builtin_amdgcn_cvt_pk_f32_fp8((int)v[q], true);
                  s[4 * q] = lo[0]; s[4 * q + 1] = lo[1]; s[4 * q + 2] = hi[0]; s[4 * q + 3] = hi[1]; } }
#pragma unroll
            for (int k = 0; k < TOPK; ++k) {
                const u32x4 v = *(const u32x4*)(yr[k] + 1024 * j); const float wv = wk[k];
#pragma unroll
                for (int q = 0; q < 4; ++q) { const f32x2 lo = __builtin_amdgcn_cvt_pk_f32_fp8((int)v[q], false), hi = __builtin_amdgcn_cvt_pk_f32_fp8((int)v[q], true);
                    s[4 * q] += wv * lo[0]; s[4 * q + 1] += wv * lo[1]; s[4 * q + 2] += wv * hi[0]; s[4 * q + 3] += wv * hi[1]; }
            }
#pragma unroll
            for (int q = 0; q < 4; ++q) { const f32x4 xa = *(const f32x4*)(x1 + 1024 * j + 4 * q), ga = *(const f32x4*)(g2 + 1024 * j + 4 * q);
                *(f32x4*)(o + 1024 * j + 4 * q) = (f32x4){xa[0] + ga[0] * s[4 * q], xa[1] + ga[1] * s[4 * q + 1], xa[2] + ga[2] * s[4 * q + 2], xa[3] + ga[3] * s[4 * q + 3]}; }
        }
    }
}

__global__ void __launch_bounds__(NT, 2) mega(Params p) {
    extern __shared__ __attribute__((aligned(16))) unsigned char dynlds[];
    int wid0;
    wid0 = __builtin_amdgcn_readfirstlane((int)threadIdx.x >> 6); asm volatile("" : "+s"(wid0));
    if (wid0 == 0 && xb_lane_id() < 4) ((unsigned*)(dynlds + LDS_BARW))[xb_lane_id()] = 0u;
    __syncthreads();
    XcdBarrier bar = xcd_barrier_post(p.bar, (volatile LAS unsigned*)(dynlds + LDS_BARW), wid0);
    float* sm = (float*)dynlds;
    int* tp = (int*)(dynlds + LDS_TAB);
    LAS unsigned char* lds = (LAS unsigned char*)dynlds;
    const int G = gridDim.x, c = blockIdx.x;

#ifndef REP
#define REP 0
#endif
#define PH(bit, ...) do { __VA_ARGS__; if (REP & (1 << (bit))) { xcd_barrier(bar); __VA_ARGS__; } } while (0)
    PH(0, ph_prologue(p, sm, wid0));                            xcd_barrier(bar);
    PH(1, ph_norm1(p, wid0));                               xcd_barrier(bar);
    { SchedDense S{(const char*)p.H, (const char*)p.WinT, D, NLAT / 256, PLD / 256, G, c}; EpiInproj E{p.P};
      g8::gemm_phase(lds, D, S, E, wid0); }
    { SchedInprojSplit S{(const char*)p.H, (const char*)p.WinT, G, c}; EpiInprojSplit E{p.PS, p.DDS};
      g8::gemm_phase(lds, D, S, E, wid0, 512); }                xcd_barrier(bar);
    ph_prep(p, sm, wid0);                                       xcd_barrier(bar);
    PH(6, ph_attn(p, dynlds, wid0));                            xcd_barrier(bar);
    PH(7, ph_glaout(p, dynlds, wid0));                          xcd_barrier(bar);
    PH(8, { SchedDense S{(const char*)p.MIX, (const char*)p.WoutT, D, NLAT / 256, D / 256, G, c}; EpiOutproj E{p.x, p.mod, p.X1};
      g8::gemm_phase(lds, D, S, E, wid0); });                   xcd_barrier(bar);
    PH(12, ph_norm2_router(p, sm, wid0));                       xcd_barrier(bar);
    PH(13, ph_lists(p, tp, (int*)dynlds, wid0));                              xcd_barrier(bar);
    moe_tables(p, tp, wid0);
    PH(9, { SchedUp S{tp, (const char*)p.H, p.LIST, (const char*)p.E13T, (const char*)p.S13T, G, c}; EpiUp E{(unsigned char*)p.HB, (unsigned char*)p.SHH};
      g8::gemm_phase<EpiUp, SchedUp, true>(lds, D / 2, S, E, wid0); });                   xcd_barrier(bar);
    PH(10, { SchedDown S{tp, (const char*)p.HB, (const char*)p.E2T, (const char*)p.SHH, (const char*)p.S2T, G, c}; EpiDown E{p.Y8, p.YS8};
      g8::gemm_phase<EpiDown, SchedDown, true>(lds, DE / 2, S, E, wid0); });                  xcd_barrier(bar);
    PH(11, ph_combine(p, wid0));
}

extern "C" void kernel_launch(void* const* d_in, const int* in_sizes, int n_in, void* d_out, int out_size, void* d_ws, size_t ws_size, hipStream_t stream) {
    Params p{};
    const float* const* in = (const float* const*)d_in;
    p.x = in[0]; p.c = in[1]; p.ctx = in[2]; p.c_ctx = in[3]; p.w_mod = in[4]; p.b_mod = in[5]; p.norm1_g = in[6]; p.norm2_g = in[7]; p.w_in = in[8];
    p.q_norm_g = in[9]; p.k_norm_g = in[10]; p.na_rpb = in[11]; p.up_f = in[12]; p.bias_f = in[13]; p.up_b = in[14]; p.bias_b = in[15]; p.gla_norm_g = in[16];
    p.w_out = in[17]; p.router_w = in[18]; p.router_bias = in[19]; p.ew1 = in[20]; p.ew3 = in[21]; p.ew2 = in[22]; p.sw1 = in[23]; p.sw3 = in[24]; p.sw2 = in[25];
    p.out = (float*)d_out;
    char* w = (char*)d_ws; size_t o = 0;
    auto take = [&](size_t bytes) { void* r = w + o; o += (bytes + 255) & ~(size_t)255; return r; };
    p.bar = (unsigned*)take((size_t)XCD_BAR_WORDS * 4);
    p.CNT = (int*)take(64 * 4); p.QCTR = (int*)take(64 * 4); p.LRANK = (int*)take((size_t)NPAIR * 4); p.CNTB = (int*)take((size_t)1024 * 64 * 4);
    p.mod = (float*)take((size_t)3 * 6 * D * 4); p.RT = (float*)take((size_t)64 * 32 * 2 * 4);
    p.EIDX = (int*)take((size_t)NPAIR * 4); p.EW = (float*)take((size_t)NPAIR * 4); p.PAIRPOS = (int*)take((size_t)NPAIR * 4); p.LIST = (int*)take((size_t)PADROWS * 4);
    p.WinT = (bf16_t*)take((size_t)(PLD + 256) * D * 2); p.WoutT = (bf16_t*)take((size_t)D * D * 2); p.S13T = (bf16_t*)take((size_t)1024 * D * 2); p.S2T = (bf16_t*)take((size_t)D * DE * 2);
    p.E13T = (bf16_t*)take((size_t)NE * 1024 * D * 2); p.E2T = (bf16_t*)take((size_t)NE * D * DE * 2);
    p.H = (bf16_t*)take((size_t)NROW * D * 2);
    p.X1 = (float*)take((size_t)NLAT * D * 4);
    const size_t big = o;
    p.P = (bf16_t*)take((size_t)NLAT * PLD * 2); p.PS = (float*)take(4 * PS_SLAB * 4); p.DDS = (float*)take(4 * DD_SLAB * 4); p.NQb = (bf16_t*)take((size_t)NLAT * 1024 * 2); p.NKf = (bf16_t*)take((size_t)16 * NTILE * 4096 * 2); p.VTf = (bf16_t*)take((size_t)16 * NTILE * 4096 * 2);
    p.MIX = (bf16_t*)take((size_t)NLAT * D * 2);
    p.QF = (bf16_t*)take((size_t)8 * 64 * 64 * 128 * 2); p.KF = (bf16_t*)take((size_t)8 * 64 * 64 * 128 * 2); p.QB = (bf16_t*)take((size_t)8 * 64 * 64 * 128 * 2); p.KB = (bf16_t*)take((size_t)8 * 64 * 64 * 128 * 2);
    p.KHF = (bf16_t*)take((size_t)8 * 68 * 128 * 64 * 2); p.KHB = (bf16_t*)take((size_t)8 * 68 * 128 * 64 * 2); p.VT = (bf16_t*)take((size_t)8 * 68 * 256 * 64 * 2); p.VTS = (bf16_t*)take((size_t)8 * 68 * 256 * 64 * 2);
    p.DF = (float*)take((size_t)8 * 68 * 128 * 4); p.DB = (float*)take((size_t)8 * 68 * 128 * 4); p.SS = (bf16_t*)take((size_t)16 * 65 * 256 * 128 * 2);
    o = big;
    p.HB = (bf16_t*)take((size_t)PADROWS * DE * 2); p.SHH = (bf16_t*)take((size_t)NLAT * DE * 2); p.Y8 = (unsigned char*)take((size_t)PADROWS * YLD8); p.YS8 = (unsigned char*)take((size_t)NLAT * YLD8);
    static int grid = 0;
    if (!grid) {
        int dev = 0, cus = 0, per_cu = 0;
        hipGetDevice(&dev);
        hipDeviceGetAttribute(&cus, hipDeviceAttributeMultiprocessorCount, dev);
        (void)hipFuncSetAttribute((const void*)mega, hipFuncAttributeMaxDynamicSharedMemorySize, LDS_BYTES);
        (void)hipOccupancyMaxActiveBlocksPerMultiprocessor(&per_cu, (const void*)mega, NT, LDS_BYTES);
        (void)hipGetLastError();
        grid = cus;
    }
    (void)hipMemsetAsync(p.bar, 0, (size_t)XCD_BAR_WORDS * 4, stream);
    hipLaunchKernelGGL(mega, dim3(grid), dim3(NT), LDS_BYTES, stream, p);
}
```
